# Optimizing an MI355X kernel written in HIP

```python
import math
import jax, jax.numpy as jnp
from jax import lax
import numpy as np

D_MODEL = 1024
BATCH = 2
SEQ = 16384
DEPTH = 2

N_A_LAYERS = DEPTH // 2
N_B_LAYERS = DEPTH - N_A_LAYERS
RMS_EPS = 1e-6

RET_HEADS = 4
RET_QK_DIM = D_MODEL // RET_HEADS
RET_V_DIM = 2 * D_MODEL // RET_HEADS
RET_CHUNK = 128
RET_IN = 2 * RET_HEADS * RET_QK_DIM + 2 * RET_HEADS * RET_V_DIM

FFN_HIDDEN = ((8 * D_MODEL + 3 * 256 - 1) // (3 * 256)) * 256

NSA_HEADS = 16
NSA_GROUPS = 4
NSA_REP = NSA_HEADS // NSA_GROUPS
NSA_HEAD_DIM = 64
CMP_LEN = 32
CMP_STRIDE = 16
CMP_HIDDEN = 256
SEL_LEN = 64
SEL_TOPK = 16
WINDOW = 512
Q_BLOCK = 128
NSA_IN = NSA_HEADS * NSA_HEAD_DIM + 3 * NSA_HEADS
KV_SHARED_OUT = 6 * NSA_GROUPS * NSA_HEAD_DIM

REL_BUCKETS = 32
REL_MAX_DIST = 128

kernel_name = "yoco_retnet_nsa_hybrid"


def rms_norm(x, g):
    xf = x.astype(jnp.float32)
    y = xf * lax.rsqrt(jnp.mean(xf * xf, axis=-1, keepdims=True) + RMS_EPS)
    return (y * g.astype(jnp.float32)).astype(x.dtype)


def swiglu_ffn(x, w_in, w_out):
    gate, up = jnp.split(x @ w_in, 2, axis=-1)
    return (jax.nn.silu(gate) * up) @ w_out


def rotate_pairs(x, cos, sin):
    x1 = x[..., 0::2]
    x2 = x[..., 1::2]
    return jnp.stack([x1 * cos - x2 * sin, x1 * sin + x2 * cos], axis=-1).reshape(x.shape)


def t5_bucket(dist):
    n = jnp.maximum(dist, 0)
    max_exact = REL_BUCKETS // 2
    nf = jnp.maximum(n, 1).astype(jnp.float32)
    large = max_exact + (jnp.log(nf / max_exact) / math.log(REL_MAX_DIST / max_exact)
                         * (REL_BUCKETS - max_exact)).astype(jnp.int32)
    large = jnp.minimum(large, REL_BUCKETS - 1)
    return jnp.where(n < max_exact, n, large)


def masked_softmax(logits, mask):
    logits = jnp.where(mask, logits, -jnp.inf)
    m = jnp.max(logits, axis=-1, keepdims=True)
    m = jnp.where(jnp.isfinite(m), m, 0.0)
    p = jnp.exp(logits - m)
    return p / jnp.maximum(jnp.sum(p, axis=-1, keepdims=True), jnp.finfo(jnp.float32).tiny)


def retention_mixer(x, w_in, w_out):
    B, S, _ = x.shape
    h, dk, dv, C = RET_HEADS, RET_QK_DIM, RET_V_DIM, RET_CHUNK
    proj = x @ w_in
    q, k, v, g = jnp.split(proj, [h * dk, 2 * h * dk, 2 * h * dk + h * dv], axis=-1)
    q = q.reshape(B, S, h, dk).astype(jnp.float32)
    k = k.reshape(B, S, h, dk).astype(jnp.float32)
    v = v.reshape(B, S, h, dv).astype(jnp.float32)
    pos = jnp.arange(S, dtype=jnp.float32)
    theta = 1.0 / (10000.0 ** jnp.linspace(0.0, 1.0, dk // 2, dtype=jnp.float32))
    ang = pos[:, None] * theta[None, :]
    cos = jnp.cos(ang)[:, None, :]
    sin = jnp.sin(ang)[:, None, :]
    q = rotate_pairs(q, cos, sin)
    k = rotate_pairs(k, cos, sin) * (dk ** -0.5)
    log_gamma = jnp.log(1.0 - 2.0 ** (-5.0 - jnp.arange(h, dtype=jnp.float32)))
    idx = jnp.arange(C, dtype=jnp.float32)
    rel = idx[:, None] - idx[None, :]
    intra_decay = jnp.where(rel >= 0, jnp.exp(jnp.maximum(rel, 0.0) * log_gamma[:, None, None]), 0.0)
    q_decay = jnp.exp((idx + 1.0)[None, :] * log_gamma[:, None])
    k_decay = jnp.exp((C - 1.0 - idx)[None, :] * log_gamma[:, None])
    chunk_decay = jnp.exp(C * log_gamma)
    nC = S // C

    def to_chunks(t):
        return t.reshape(B, nC, C, h, t.shape[-1]).transpose(1, 0, 3, 2, 4)

    def step(state, inp):
        qc, kc, vc = inp
        scores = jnp.einsum('bhid,bhjd->bhij', qc, kc) * intra_decay
        o = (jnp.einsum('bhij,bhje->bhie', scores, vc)
             + jnp.einsum('bhid,bhde->bhie', qc * q_decay[..., None], state))
        state = (state * chunk_decay[:, None, None]
                 + jnp.einsum('bhjd,bhje->bhde', kc * k_decay[..., None], vc))
        return state, o

    state0 = jnp.zeros((B, h, dk, dv), jnp.float32)
    _, o = lax.scan(step, state0, (to_chunks(q), to_chunks(k), to_chunks(v)))
    o = o.transpose(1, 0, 3, 2, 4).reshape(B, S, h, dv)
    o = o * lax.rsqrt(jnp.mean(o * o, axis=-1, keepdims=True) + RMS_EPS)
    o = (o.reshape(B, S, h * dv) * jax.nn.silu(g.astype(jnp.float32))).astype(x.dtype)
    return o @ w_out


def nsa_shared_kv(h, kv_norm, kv_w, cmp_pe_k, cmp_w1_k, cmp_w2_k, cmp_pe_v, cmp_w1_v, cmp_w2_v):
    B, S, _ = h.shape
    G, d = NSA_GROUPS, NSA_HEAD_DIM
    kv = rms_norm(h, kv_norm) @ kv_w
    k_c, v_c, k_s, v_s, k_w, v_w = [t.reshape(B, S, G, d) for t in jnp.split(kv, 6, axis=-1)]
    n_cmp = (S - CMP_LEN) // CMP_STRIDE + 1
    blk_idx = np.arange(n_cmp)[:, None] * CMP_STRIDE + np.arange(CMP_LEN)[None, :]

    def compress(t, pe, w1, w2):
        blocks = t[:, blk_idx] + pe[:, None, :]
        blocks = blocks.transpose(0, 1, 3, 2, 4).reshape(B, n_cmp, G, CMP_LEN * d)
        return jax.nn.silu(blocks @ w1) @ w2

    kc = compress(k_c, cmp_pe_k, cmp_w1_k, cmp_w2_k)
    vc = compress(v_c, cmp_pe_v, cmp_w1_v, cmp_w2_v)
    n_sel = S // SEL_LEN
    ks = k_s.reshape(B, n_sel, SEL_LEN, G, d).transpose(0, 3, 1, 2, 4)
    vs = v_s.reshape(B, n_sel, SEL_LEN, G, d).transpose(0, 3, 1, 2, 4)
    pad = ((0, 0), (WINDOW, 0), (0, 0), (0, 0))
    kw = jnp.pad(k_w, pad)
    vw = jnp.pad(v_w, pad)
    return (kc, vc, ks, vs, kw, vw)


def nsa_mixer(x, w_in, w_out, rel_bias, shared):
    B, S, _ = x.shape
    H, G, R, d = NSA_HEADS, NSA_GROUPS, NSA_REP, NSA_HEAD_DIM
    Q = Q_BLOCK
    kc, vc, ks, vs, kw, vw = shared
    proj = x @ w_in
    q = proj[..., :H * d].reshape(B, S, G, R, d)
    gate = jax.nn.sigmoid(proj[..., H * d:].astype(jnp.float32)).reshape(B, S, G, R, 3)
    n_cmp = kc.shape[1]
    n_sel = ks.shape[2]
    n_top = min(SEL_TOPK, n_sel)
    cmp_end = jnp.arange(n_cmp, dtype=jnp.int32) * CMP_STRIDE + CMP_LEN - 1
    ratio = SEL_LEN // CMP_STRIDE
    lead = CMP_LEN // CMP_STRIDE - 1
    span = ratio + lead
    sel_map = ratio * np.arange(n_sel)[:, None] - lead + np.arange(span)[None, :]
    sel_map = np.where((sel_map >= 0) & (sel_map < n_cmp), sel_map, n_cmp)
    bias_tab = rel_bias.astype(jnp.float32)
    bias_gr = bias_tab.reshape(REL_BUCKETS, G, R).transpose(1, 0, 2)
    scale = d ** -0.5
    gather_blocks = jax.vmap(jax.vmap(lambda kb, ib: kb[ib]))
    kc32 = kc.astype(jnp.float32)
    vc32 = vc.astype(jnp.float32)
    sel_ids = jnp.arange(n_sel, dtype=jnp.int32)
    blk_start = sel_ids * SEL_LEN
    win_off = jnp.arange(WINDOW + Q, dtype=jnp.int32)
    g_ids = jnp.arange(G)[None, :, None, None, None]

    def block(qb):
        start = qb * Q
        t = start + jnp.arange(Q, dtype=jnp.int32)
        qblk = lax.dynamic_slice_in_dim(q, start, Q, 1).astype(jnp.float32) * scale
        gg = lax.dynamic_slice_in_dim(gate, start, Q, 1)
        dist_c = t[:, None] - cmp_end[None, :]
        s = jnp.einsum('bqgrd,bngd->bgrqn', qblk, kc32)
        s = s + bias_tab[t5_bucket(dist_c)].reshape(Q, n_cmp, G, R).transpose(2, 3, 0, 1)
        p_c = masked_softmax(s, dist_c >= 0)
        o_c = jnp.einsum('bgrqn,bngd->bqgrd', p_c, vc32)
        imp_c = jnp.sum(p_c, axis=2)
        imp_c = jnp.concatenate([imp_c, jnp.zeros(imp_c.shape[:-1] + (1,), imp_c.dtype)], axis=-1)
        imp = jnp.sum(imp_c[..., sel_map], axis=-1)
        cur = t // SEL_LEN
        valid = blk_start[None, :] <= t[:, None]
        forced = ((sel_ids[None, :] == 0) | (sel_ids[None, :] == cur[:, None])
                  | (sel_ids[None, :] == cur[:, None] - 1))
        imp = jnp.where(forced, jnp.inf, jnp.where(valid, imp, -jnp.inf))
        _, sel_idx = lax.top_k(imp, n_top)
        k_sel = gather_blocks(ks, sel_idx).astype(jnp.float32)
        v_sel = gather_blocks(vs, sel_idx).astype(jnp.float32)
        pos = sel_idx[..., None] * SEL_LEN + jnp.arange(SEL_LEN, dtype=jnp.int32)
        dist_s = t[None, None, :, None, None] - pos
        s = jnp.einsum('bqgrd,bgqnld->bgrqnl', qblk, k_sel)
        s = s + jnp.moveaxis(bias_gr[g_ids, t5_bucket(dist_s)], -1, 2)
        s = s.reshape(B, G, R, Q, n_top * SEL_LEN)
        mask_s = (dist_s >= 0).reshape(B, G, 1, Q, n_top * SEL_LEN)
        p_s = masked_softmax(s, mask_s).reshape(B, G, R, Q, n_top, SEL_LEN)
        o_s = jnp.einsum('bgrqnl,bgqnld->bqgrd', p_s, v_sel)
        kwin = lax.dynamic_slice_in_dim(kw, start, WINDOW + Q, 1).astype(jnp.float32)
        vwin = lax.dynamic_slice_in_dim(vw, start, WINDOW + Q, 1).astype(jnp.float32)
        kpos = start - WINDOW + win_off
        dist_w = t[:, None] - kpos[None, :]
        s = jnp.einsum('bqgrd,bkgd->bgrqk', qblk, kwin)
        s = s + bias_tab[t5_bucket(dist_w)].reshape(Q, WINDOW + Q, G, R).transpose(2, 3, 0, 1)
        mask_w = (dist_w >= 0) & (dist_w < WINDOW) & (kpos[None, :] >= 0)
        p_w = masked_softmax(s, mask_w)
        o_w = jnp.einsum('bgrqk,bkgd->bqgrd', p_w, vwin)
        o = gg[..., 0:1] * o_c + gg[..., 1:2] * o_s + gg[..., 2:3] * o_w
        return o.reshape(B, Q, H * d)

    o = lax.map(block, jnp.arange(S // Q, dtype=jnp.int32))
    o = o.transpose(1, 0, 2, 3).reshape(B, S, H * d).astype(x.dtype)
    return o @ w_out


def setup_inputs(seed: int = 0) -> dict:
    key = jax.random.key(seed)
    ks = jax.random.split(key, 24)
    f32 = jnp.float32

    def dense(k, shape, fan_in):
        return jax.random.normal(k, shape, f32) * (fan_in ** -0.5)

    def gain(k, shape):
        return 1.0 + 0.1 * jax.random.normal(k, shape, f32)

    d = NSA_HEAD_DIM
    return {
        "x": jax.random.normal(ks[0], (BATCH, SEQ, D_MODEL), f32),
        "mix_norm_pre": gain(ks[1], (DEPTH, D_MODEL)),
        "mix_norm_post": gain(ks[2], (DEPTH, D_MODEL)),
        "ffn_norm_pre": gain(ks[3], (DEPTH, D_MODEL)),
        "ffn_norm_post": gain(ks[4], (DEPTH, D_MODEL)),
        "ffn_w_in": dense(ks[5], (DEPTH, D_MODEL, 2 * FFN_HIDDEN), D_MODEL),
        "ffn_w_out": dense(ks[6], (DEPTH, FFN_HIDDEN, D_MODEL), FFN_HIDDEN),
        "ret_w_in": dense(ks[7], (N_A_LAYERS, D_MODEL, RET_IN), D_MODEL),
        "ret_w_out": dense(ks[8], (N_A_LAYERS, RET_HEADS * RET_V_DIM, D_MODEL), RET_HEADS * RET_V_DIM),
        "kv_norm": gain(ks[9], (D_MODEL,)),
        "kv_w": dense(ks[10], (D_MODEL, KV_SHARED_OUT), D_MODEL),
        "cmp_pe_k": 0.5 * jax.random.normal(ks[11], (CMP_LEN, d), f32),
        "cmp_w1_k": dense(ks[12], (CMP_LEN * d, CMP_HIDDEN), CMP_LEN * d),
        "cmp_w2_k": dense(ks[13], (CMP_HIDDEN, d), CMP_HIDDEN),
        "cmp_pe_v": 0.5 * jax.random.normal(ks[14], (CMP_LEN, d), f32),
        "cmp_w1_v": dense(ks[15], (CMP_LEN * d, CMP_HIDDEN), CMP_LEN * d),
        "cmp_w2_v": dense(ks[16], (CMP_HIDDEN, d), CMP_HIDDEN),
        "nsa_w_in": dense(ks[17], (N_B_LAYERS, D_MODEL, NSA_IN), D_MODEL),
        "nsa_w_out": dense(ks[18], (N_B_LAYERS, NSA_HEADS * d, D_MODEL), NSA_HEADS * d),
        "rel_bias": 0.5 * jax.random.normal(ks[19], (REL_BUCKETS, NSA_HEADS), f32),
    }


def reference(x, mix_norm_pre, mix_norm_post, ffn_norm_pre, ffn_norm_post, ffn_w_in, ffn_w_out,
              ret_w_in, ret_w_out, kv_norm, kv_w, cmp_pe_k, cmp_w1_k, cmp_w2_k,
              cmp_pe_v, cmp_w1_v, cmp_w2_v, nsa_w_in, nsa_w_out, rel_bias):
    h = x
    shared = None
    for layer in range(DEPTH):
        if layer == N_A_LAYERS:
            shared = nsa_shared_kv(h, kv_norm, kv_w, cmp_pe_k, cmp_w1_k, cmp_w2_k,
                                   cmp_pe_v, cmp_w1_v, cmp_w2_v)
        normed = rms_norm(h, mix_norm_pre[layer])
        if layer < N_A_LAYERS:
            mixed = retention_mixer(normed, ret_w_in[layer], ret_w_out[layer])
        else:
            j = layer - N_A_LAYERS
            mixed = nsa_mixer(normed, nsa_w_in[j], nsa_w_out[j], rel_bias, shared)
        h = h + rms_norm(mixed, mix_norm_post[layer])
        normed = rms_norm(h, ffn_norm_pre[layer])
        h = h + rms_norm(swiglu_ffn(normed, ffn_w_in[layer], ffn_w_out[layer]), ffn_norm_post[layer])
    return h
```

```cpp
#include <hip/hip_runtime.h>
#include <cstdio>
#include <cstdint>
#include <utility>

namespace pg8 {
#define PG8_LAS __attribute__((address_space(3)))
typedef unsigned short bf16_t;
typedef short bf16x8 __attribute__((ext_vector_type(8)));
typedef float f32x4 __attribute__((ext_vector_type(4)));
typedef unsigned u32x4 __attribute__((ext_vector_type(4)));
constexpr int BM = 256, BK = 64, HALF = 128, HTB = HALF * BK * 2  , STAGE_BYTES = 8 * HTB, NXCD = 8, WGM = 8;

__host__ __device__ __forceinline__ int lds_byte(int r, int c) { const int st = (r >> 4) * 2 + (c >> 5), rr = r & 15, cc = c & 31, ob = rr * 64 + cc * 2; return st * 1024 + (ob ^ (((ob >> 9) & 1) << 5)); }
__host__ __device__ __forceinline__ void stage_rc(int b, int& R, int& C) { const int st = b / 1024, sb = b % 1024, swz = sb ^ (((sb >> 9) & 1) << 5); R = (st >> 1) * 16 + swz / 64; C = (st & 1) * 32 + (swz % 64) / 2; }
__host__ __device__ __forceinline__ int perm32(int rho) { const int n = rho >> 4, i = rho & 15; return 8 * (i >> 2) + 4 * n + (i & 3); }

struct Unit { int pm, pn; size_t offA, offB; };
struct Gemm { const bf16_t* A; const bf16_t* Bt; int lda, ldb, K; };

template <class Map> struct Order {
    int nM, nN, nwg, G, c; Map map;
    __device__ __forceinline__ void init(int nM_, int nN_, int G_, int c_, const Map& m) { nM = nM_; nN = nN_; nwg = nM * nN; G = G_; c = c_; map = m; }
    __device__ __forceinline__ bool next(int i, Unit& u) const {
        const long L = (long)i * G + c; if (L >= nwg) return false;
        int wgid = (int)L; { const int q = nwg / NXCD, r = nwg % NXCD, xcd = wgid % NXCD, off = wgid / NXCD; wgid = (xcd < r ? xcd * (q + 1) : r * (q + 1) + (xcd - r) * q) + off; }
        const int nig = WGM * nN, gid = wgid / nig, fm = gid * WGM, gsz = (nM - fm) < WGM ? (nM - fm) : WGM;
        u.pm = fm + ((wgid % nig) % gsz); u.pn = (wgid % nig) / gsz; map(u); return true;
    }
    __device__ __forceinline__ void a_ready(const Unit&) const {}
    __device__ __forceinline__ void done(const Unit&) const {}
};
struct MapPlain { int lda, ldb; __device__ __forceinline__ void operator()(Unit& u) const { u.offA = (size_t)u.pm * 256 * lda * 2; u.offB = (size_t)u.pn * 256 * ldb * 2; } };

template <class Epi, class Sched, bool ALIGN_EPI = false, bool SP2 = false>
__device__ __forceinline__ void gemm_phase(PG8_LAS unsigned char* lds, const Gemm g, const Sched& S, const Epi& E) {
    const int tid = threadIdx.x, wid = __builtin_amdgcn_readfirstlane(tid >> 6), lane = tid & 63, wr = wid >> 2, wc = wid & 3, fr = lane & 15, fq = lane >> 4;
    const int K = g.K, nt = K / BK;
    unsigned voffA[2], voffB[2];
#pragma unroll
    for (int i = 0; i < 2; ++i) { int R, C; stage_rc(tid * 16 + i * 8192, R, C); const int Rb = Epi::PERM ? ((R & ~31) + perm32(R & 31)) : R;
        voffA[i] = (unsigned)(R * g.lda + C) * 2u; voffB[i] = (unsigned)(Rb * g.ldb + C) * 2u; }
    const size_t kstep = (size_t)(BK * 2);
    const size_t hstepA = (size_t)HALF * g.lda * 2, hstepB = (size_t)HALF * g.ldb * 2;
    const unsigned ldsw = (unsigned)wid * 1024u;
    const int aoff = lds_byte(wr * 64 + fr, fq * 8), boff = lds_byte(wc * 32 + fr, fq * 8);
#define PG8_SA(b, h) (((b) * 2 + (h)) * HTB)
#define PG8_SB(b, h) ((4 + (b) * 2 + (h)) * HTB)
#define PG8_STAGE(bufoff, gbase, voff) do { _Pragma("unroll") for (int _i = 0; _i < 2; ++_i) \
        __builtin_amdgcn_global_load_lds((const unsigned*)((const char*)(gbase) + (voff)[_i]), (PG8_LAS unsigned*)(lds + (bufoff) + ldsw + _i * 8192), 16, 0, 0); } while (0)
#define PG8_LDA(dst, b, h) do { _Pragma("unroll") for (int m = 0; m < 4; ++m) _Pragma("unroll") for (int k = 0; k < 2; ++k) dst[m][k] = *(const PG8_LAS bf16x8*)(lds + PG8_SA(b, h) + aoff + m * 2048 + k * 1024); } while (0)
#define PG8_LDB(dst, b, h) do { _Pragma("unroll") for (int n = 0; n < 2; ++n) _Pragma("unroll") for (int k = 0; k < 2; ++k) dst[n][k] = *(const PG8_LAS bf16x8*)(lds + PG8_SB(b, h) + boff + n * 2048 + k * 1024); } while (0)
#define PG8_MMA(ai, bj, At, Bt) do { __builtin_amdgcn_s_setprio(1); _Pragma("unroll") for (int m = 0; m < 4; ++m) _Pragma("unroll") for (int n = 0; n < 2; ++n) _Pragma("unroll") for (int k = 0; k < 2; ++k) \
        acc[ai][bj][m][n] = __builtin_amdgcn_mfma_f32_16x16x32_bf16(Bt[n][k], At[m][k], acc[ai][bj][m][n], 0, 0, 0); __builtin_amdgcn_s_setprio(0); } while (0)
#define PG8_WAIT_V(n) asm volatile("s_waitcnt vmcnt(" #n ")" ::: "memory")
#define PG8_WAIT_L(n) asm volatile("s_waitcnt lgkmcnt(" #n ")" ::: "memory")
#define PG8_BAR __builtin_amdgcn_s_barrier()
#define PG8_SCHED __builtin_amdgcn_sched_barrier(0)
    Unit cur, nxt; int ui = 0;
    if (!S.next(0, cur)) return;
    f32x4 acc[2][2][4][2];
#pragma unroll
    for (int a = 0; a < 2; ++a)
#pragma unroll
        for (int b = 0; b < 2; ++b)
#pragma unroll
            for (int m = 0; m < 4; ++m)
#pragma unroll
                for (int n = 0; n < 2; ++n) acc[a][b][m][n] = (f32x4){0.f, 0.f, 0.f, 0.f};
    bf16x8 At[4][2], B0[2][2], B1[2][2];
    const char* cA = (const char*)g.A + cur.offA; const char* cB = (const char*)g.Bt + cur.offB;
    S.a_ready(cur);
    if constexpr (SP2) {
        PG8_STAGE(PG8_SB(0, 0), cB, voffB); PG8_STAGE(PG8_SB(0, 1), cB + hstepB, voffB); PG8_STAGE(PG8_SA(0, 0), cA, voffA); PG8_STAGE(PG8_SA(0, 1), cA + hstepA, voffA);
        if (wr == 1) PG8_BAR;
        PG8_WAIT_V(2); PG8_BAR;
        PG8_STAGE(PG8_SB(1, 0), cB + kstep, voffB); PG8_STAGE(PG8_SA(1, 0), cA + kstep, voffA); PG8_STAGE(PG8_SB(1, 1), cB + hstepB + kstep, voffB);
        PG8_WAIT_V(6); PG8_BAR;
    } else {
        PG8_STAGE(PG8_SB(0, 0), cB, voffB); PG8_STAGE(PG8_SA(0, 0), cA, voffA); PG8_STAGE(PG8_SB(0, 1), cB + hstepB, voffB); PG8_STAGE(PG8_SA(0, 1), cA + hstepA, voffA);
        if (wr == 1) PG8_BAR;
        PG8_WAIT_V(4); PG8_BAR;
        PG8_STAGE(PG8_SB(1, 0), cB + kstep, voffB); PG8_STAGE(PG8_SA(1, 0), cA + kstep, voffA); PG8_STAGE(PG8_SB(1, 1), cB + hstepB + kstep, voffB);
        PG8_WAIT_V(6); PG8_BAR;
    }
    for (;;) {
        const bool has_next = S.next(ui + 1, nxt);
        const char* nA = has_next ? (const char*)g.A + nxt.offA : cA; const char* nB = has_next ? (const char*)g.Bt + nxt.offB : cB;
        for (int t = 0; t < nt; t += 2) {
            const bool last = (t == nt - 2);
            const char* a1 = cA + (size_t)(t + 1) * kstep;
            const char* a2 = last ? nA : cA + (size_t)(t + 2) * kstep; const char* b2 = last ? nB : cB + (size_t)(t + 2) * kstep;
            const char* a3 = a2 + kstep; const char* b3 = b2 + kstep;
            if (last && has_next) S.a_ready(nxt);
            if constexpr (SP2) {
            PG8_LDB(B0, 0, 0); PG8_LDB(B1, 0, 1); PG8_SCHED; PG8_LDA(At, 0, 0); PG8_STAGE(PG8_SA(1, 1), a1 + hstepA, voffA);
            PG8_WAIT_V(8); PG8_WAIT_L(0); PG8_BAR; PG8_MMA(0, 0, At, B0); PG8_MMA(0, 1, At, B1); PG8_BAR; PG8_SCHED;
            PG8_LDA(At, 0, 1); PG8_STAGE(PG8_SB(0, 0), b2, voffB); PG8_STAGE(PG8_SB(0, 1), b2 + hstepB, voffB); PG8_STAGE(PG8_SA(0, 0), a2, voffA);
            PG8_WAIT_V(8); PG8_WAIT_L(0); PG8_BAR; PG8_MMA(1, 0, At, B0); PG8_MMA(1, 1, At, B1); PG8_BAR; PG8_SCHED;
            PG8_LDB(B0, 1, 0); PG8_LDB(B1, 1, 1); PG8_SCHED; PG8_LDA(At, 1, 0); PG8_STAGE(PG8_SA(0, 1), a2 + hstepA, voffA);
            PG8_WAIT_V(8); PG8_WAIT_L(0); PG8_BAR; PG8_MMA(0, 0, At, B0); PG8_MMA(0, 1, At, B1); PG8_BAR; PG8_SCHED;
            PG8_LDA(At, 1, 1); PG8_STAGE(PG8_SB(1, 0), b3, voffB); PG8_STAGE(PG8_SB(1, 1), b3 + hstepB, voffB); PG8_STAGE(PG8_SA(1, 0), a3, voffA);
            PG8_WAIT_V(8); PG8_WAIT_L(0); PG8_BAR; PG8_MMA(1, 0, At, B0); PG8_MMA(1, 1, At, B1); PG8_BAR; PG8_SCHED;
            } else {
            PG8_LDB(B0, 0, 0); PG8_SCHED; PG8_LDA(At, 0, 0); PG8_STAGE(PG8_SA(1, 1), a1 + hstepA, voffA);
            PG8_WAIT_L(8); PG8_BAR; PG8_WAIT_L(0); PG8_MMA(0, 0, At, B0); PG8_BAR; PG8_SCHED;
            PG8_LDB(B1, 0, 1); PG8_STAGE(PG8_SB(0, 0), b2, voffB);
            PG8_BAR; PG8_WAIT_L(0); PG8_MMA(0, 1, At, B1); PG8_BAR;
            PG8_LDA(At, 0, 1); PG8_STAGE(PG8_SA(0, 0), a2, voffA);
            PG8_BAR; PG8_WAIT_L(0); PG8_MMA(1, 0, At, B0); PG8_BAR; PG8_SCHED;
            PG8_STAGE(PG8_SB(0, 1), b2 + hstepB, voffB);
            PG8_WAIT_V(6); PG8_BAR; PG8_MMA(1, 1, At, B1); PG8_BAR;
            PG8_LDB(B0, 1, 0); PG8_SCHED; PG8_LDA(At, 1, 0); PG8_STAGE(PG8_SA(0, 1), a2 + hstepA, voffA);
            PG8_WAIT_L(8); PG8_BAR; PG8_WAIT_L(0); PG8_MMA(0, 0, At, B0); PG8_BAR; PG8_SCHED;
            PG8_LDB(B1, 1, 1); PG8_STAGE(PG8_SB(1, 0), b3, voffB);
            PG8_BAR; PG8_WAIT_L(0); PG8_MMA(0, 1, At, B1); PG8_BAR;
            PG8_LDA(At, 1, 1); PG8_STAGE(PG8_SA(1, 0), a3, voffA);
            PG8_BAR; PG8_WAIT_L(0); PG8_MMA(1, 0, At, B0); PG8_BAR; PG8_SCHED;
            PG8_STAGE(PG8_SB(1, 1), b3 + hstepB, voffB);
            PG8_WAIT_V(6); PG8_BAR; PG8_MMA(1, 1, At, B1); PG8_BAR;
            }
        }
        if constexpr (ALIGN_EPI) { if (wr == 0) PG8_BAR; }
        if constexpr (!Epi::AFTER_DRAIN) { E(acc, cur, wr, wc, fr, fq); S.done(cur); }
        if (!has_next) break;
#pragma unroll
        for (int a = 0; a < 2; ++a)
#pragma unroll
            for (int b = 0; b < 2; ++b)
#pragma unroll
                for (int m = 0; m < 4; ++m)
#pragma unroll
                    for (int n = 0; n < 2; ++n) acc[a][b][m][n] = (f32x4){0.f, 0.f, 0.f, 0.f};
        cur = nxt; cA = nA; cB = nB; ++ui;
        if constexpr (ALIGN_EPI) { if (wr == 1) PG8_BAR; }
    }
    PG8_WAIT_V(0);
    if constexpr (!ALIGN_EPI) { if (wr == 0) PG8_BAR; }
    PG8_BAR;
    if constexpr (Epi::AFTER_DRAIN) { E.fused(acc, cur, wr, wc, fr, fq, lds, wid, lane); S.done(cur); }
#undef PG8_SA
#undef PG8_SB
#undef PG8_STAGE
#undef PG8_LDA
#undef PG8_LDB
#undef PG8_MMA
#undef PG8_WAIT_V
#undef PG8_WAIT_L
#undef PG8_BAR
#undef PG8_SCHED
}
}

constexpr int DM = 1024, NBATCH = 2, SEQ = 16384, MTOK = NBATCH * SEQ;
constexpr int FFH = 2816;
constexpr int RH = 4, RDK = 256, RDV = 512, RCH = 512, NCH = SEQ / RCH;
constexpr int RIN = 2 * RH * RDK + 2 * RH * RDV;
constexpr int NG = 4, NR = 4, HD = 64, NCMP = 1023, NSEL = 256, NSAIN = 1072;
constexpr float RMS_EPS = 1e-6f;
constexpr int APLD = 768;

constexpr size_t MiB = 1u << 20;
constexpr size_t WS_CTL = 0, CTL_ZERO_BYTES = 1 * MiB;
constexpr size_t WS_RINV = 1 * MiB;
constexpr size_t WS_BIAST = WS_RINV + 256 * 1024;
constexpr size_t WS_PEB = WS_BIAST + 16 * 1024;
constexpr size_t WS_PEBP = WS_PEB + 4 * 1024;
constexpr size_t WS_GSLOT = 2 * MiB;
constexpr size_t WS_OSLOT = 6 * MiB;
constexpr size_t WS_W = 8 * MiB;
constexpr size_t W_RI = WS_W, W_RO = W_RI + 12 * MiB, W_FI0 = W_RO + 4 * MiB, W_FI1 = W_FI0 + 11 * MiB, W_FO0 = W_FI1 + 11 * MiB, W_FO1 = W_FO0 + 11 * MiB / 2,
                 W_KVQ = W_FO1 + 11 * MiB / 2, W_KVV = W_KVQ + 9 * MiB / 2, W_NO = W_KVV + 1 * MiB, W_C1 = W_NO + 2 * MiB, W_END = W_C1 + 2 * MiB;
static_assert(W_END <= 68 * MiB, "weights");
constexpr size_t WS_TABA = 68 * MiB, WS_TABB = 84 * MiB;
constexpr size_t WS_XB = 100 * MiB;
constexpr size_t WS_MIX = 164 * MiB;
constexpr size_t WS_KT = WS_MIX, WS_KV = WS_MIX + 32 * MiB;
constexpr size_t WS_SCR = 228 * MiB;
constexpr size_t WS_AP = WS_SCR, WS_BP = WS_AP + 96 * MiB, WS_KN = WS_BP + 96 * MiB;
static_assert(WS_KN + 32 * MiB <= 512 * MiB, "ret scratch");
constexpr size_t WS_HID = WS_SCR;
constexpr size_t WS_KC = WS_SCR, WS_VC = WS_KC + 16 * MiB, WS_KS = WS_VC + 17 * MiB, WS_KW = WS_KS + 16 * MiB, WS_VST = WS_KW + 16 * MiB, WS_VWT = WS_VST + 16 * MiB,
                 WS_Q = WS_VWT + 16 * MiB, WS_GATE = WS_Q + 64 * MiB, WS_HIDC = WS_GATE + 6 * MiB, WS_KCMP = WS_HIDC + 8 * MiB, WS_VCMPT = WS_KCMP + 1 * MiB, WS_ONSA = WS_VCMPT + 1 * MiB,
                 WS_NSA_END = WS_ONSA + 64 * MiB;
static_assert(WS_NSA_END <= 512 * MiB, "nsa scratch");
constexpr size_t WS_NEED = 512 * MiB;

#define GAS __attribute__((address_space(1)))
#define LAS __attribute__((address_space(3)))
typedef unsigned short bf16;
typedef unsigned v4u __attribute__((ext_vector_type(4)));
typedef unsigned v2u __attribute__((ext_vector_type(2)));
typedef float f32x4 __attribute__((ext_vector_type(4)));
typedef float f32x2_t __attribute__((ext_vector_type(2)));
typedef __bf16 bf16x2_t __attribute__((ext_vector_type(2)));
typedef GAS unsigned gu32;
#define RLX_AGENT __ATOMIC_RELAXED, __HIP_MEMORY_SCOPE_AGENT
__device__ __forceinline__ unsigned cvtpk(float lo, float hi) { f32x2_t v = {lo, hi}; bf16x2_t b = __builtin_convertvector(v, bf16x2_t); return __builtin_bit_cast(unsigned, b); }
__device__ __forceinline__ v4u pack8(f32x4 a, f32x4 b) { v4u w; w.x = cvtpk(a[0], a[1]); w.y = cvtpk(a[2], a[3]); w.z = cvtpk(b[0], b[1]); w.w = cvtpk(b[2], b[3]); return w; }
__device__ __forceinline__ float bflo(unsigned w) { return __uint_as_float(w << 16); }
__device__ __forceinline__ float bfhi(unsigned w) { return __uint_as_float(w & 0xffff0000u); }
__device__ __forceinline__ float bf2f(bf16 b) { return __uint_as_float(((unsigned)b) << 16); }
__device__ __forceinline__ void unpack8(v4u w, float* f) { f[0] = bflo(w.x); f[1] = bfhi(w.x); f[2] = bflo(w.y); f[3] = bfhi(w.y); f[4] = bflo(w.z); f[5] = bfhi(w.z); f[6] = bflo(w.w); f[7] = bfhi(w.w); }
__device__ __forceinline__ bf16 f2bf(float f) { return (bf16)(cvtpk(f, 0.f) & 0xffffu); }
__device__ __forceinline__ float sigm(float x) { return 1.f / (1.f + __expf(-x)); }
__device__ __forceinline__ float silu(float x) { return x / (1.f + __expf(-x)); }
__device__ __forceinline__ float lg2gamma(int h) { return log2f(1.0f - exp2f(-5.0f - (float)h)); }
__device__ __forceinline__ float wave_sum(float v) {
#pragma unroll
    for (int o = 1; o < 64; o <<= 1) v += __shfl_xor(v, o);
    return v;
}
__device__ __forceinline__ float wave_max(float v) {
#pragma unroll
    for (int o = 1; o < 64; o <<= 1) v = fmaxf(v, __shfl_xor(v, o));
    return v;
}
__device__ __forceinline__ int t5_bucket(int n) {
    if (n < 16) return n;
    if (n >= 113) return 31;
    int b = 16 + (int)(logf((float)n * 0.0625f) / 2.0794415416798357f * 16.0f);
    return b < 31 ? b : 31;
}

#define XB_TMO      128
#define XB_XCNT(j)  (256  + 64 * (j))
#define XB_XSUB(j)  (1280 + 64 * (j))
#define XB_XGEN(j)  (2304 + 64 * (j))
#define XB_TOP      3328
#define XB_TOPGEN   3392
#define XCD_BAR_WORDS 3456
#define XB_SPIN_CAP (1u << 18)
__device__ __forceinline__ unsigned xb_ld(unsigned* p)              { return __hip_atomic_load(p, __ATOMIC_RELAXED, __HIP_MEMORY_SCOPE_AGENT); }
__device__ __forceinline__ unsigned xb_add(unsigned* p, unsigned v) { return __hip_atomic_fetch_add(p, v, __ATOMIC_RELAXED, __HIP_MEMORY_SCOPE_AGENT); }
__device__ __forceinline__ unsigned xb_xcc_id() { return (unsigned)__builtin_amdgcn_s_getreg((3 << 11) | 20) & 0xFu; }
#define XB_SPIN(cond, bar) do { unsigned _sp = 0; while (cond) { __builtin_amdgcn_s_sleep(1); \
    if ((++_sp & 255u) == 0u) { if (xb_ld(&(bar)[XB_TMO])) break; if (_sp > XB_SPIN_CAP) { atomicAdd(&(bar)[XB_TMO], 1u); break; } } } } while (0)
struct XcdBarrier { unsigned* bar; unsigned x; volatile LAS unsigned* st; };
__device__ __forceinline__ XcdBarrier xcd_barrier_post(unsigned* bar, volatile LAS unsigned* st) {
    XcdBarrier b; b.bar = bar; b.x = xb_xcc_id(); b.st = st;
    if (threadIdx.x == 0) (void)xb_add(&bar[XB_XCNT(b.x)], 1u);
    return b;
}
__device__ __forceinline__ void xcd_barrier_complete(unsigned* bar, unsigned x, unsigned& nloc, unsigned& nx) {
    const unsigned G = gridDim.x * gridDim.y * gridDim.z;
    unsigned sum, cnt, mine, sp = 0u;
    for (;;) {
        sum = 0u; cnt = 0u; mine = 0u;
#pragma unroll
        for (unsigned j = 0; j < 16; ++j) { const unsigned c = xb_ld(&bar[XB_XCNT(j)]); sum += c; cnt += (c > 0u) ? 1u : 0u; mine = (j == x) ? c : mine; }
        if (sum == G) break;
        __builtin_amdgcn_s_sleep(1);
        if ((++sp & 255u) == 0u) { if (xb_ld(&bar[XB_TMO])) break; if (sp > XB_SPIN_CAP) { atomicAdd(&bar[XB_TMO], 1u); break; } }
    }
    nloc = mine > 0u ? mine : 1u; nx = cnt > 0u ? cnt : 1u;
}
__device__ __forceinline__ void xcd_barrier(const XcdBarrier& b) {
    asm volatile("s_waitcnt vmcnt(0)" ::: "memory");
    __syncthreads();
    if (threadIdx.x == 0) {
        unsigned* bar = b.bar;
        __builtin_amdgcn_s_waitcnt(0);
        unsigned nloc = b.st[0], nx = b.st[1];
        if (nloc == 0u) { xcd_barrier_complete(bar, b.x, nloc, nx); b.st[0] = nloc; b.st[1] = nx; }
        const unsigned old = xb_add(&bar[XB_XSUB(b.x)], 1u);
        const unsigned gen = old / nloc;
        if (old + 1u == (gen + 1u) * nloc) {
            __builtin_amdgcn_fence(__ATOMIC_RELEASE, "agent");
            asm volatile("s_waitcnt vmcnt(0)" ::: "memory");
            const unsigned og = xb_add(&bar[XB_TOP], 1u);
            const unsigned tg = og / nx;
            if (og + 1u == (tg + 1u) * nx) xb_add(&bar[XB_TOPGEN], 1u);
            else XB_SPIN(xb_ld(&bar[XB_TOPGEN]) == tg, bar);
            __builtin_amdgcn_fence(__ATOMIC_ACQUIRE, "agent");
            xb_add(&bar[XB_XGEN(b.x)], 1u);
            asm volatile("s_waitcnt vmcnt(0)" ::: "memory");
        } else {
            XB_SPIN(xb_ld(&bar[XB_XGEN(b.x)]) == gen, bar);
            __builtin_amdgcn_fence(__ATOMIC_ACQUIRE, "agent");
            asm volatile("s_waitcnt vmcnt(0)" ::: "memory");
        }
    }
    __syncthreads();
}

using pg8::Unit;
typedef const f32x4 (&AccRef)[2][2][4][2];
#define EPI_ROW(u, ai, m) ((u).pm * 256 + (ai) * 128 + wr * 64 + (m) * 16 + fr)
#define EPI_COL(bj) ((bj) * 128 + wc * 32 + 8 * fq)

struct EpiP1N {
    static constexpr bool PERM = true, AFTER_DRAIN = false;
    const float* rinv; const f32x4* tabA; bf16* AP; bf16* KN;
    __device__ __forceinline__ void operator()(AccRef acc, const Unit& u, int wr, int wc, int fr, int fq) const {
        const int h = u.pn & 3; const bool isk = u.pn >= 4; const float lg = lg2gamma(h);
#pragma unroll
        for (int ai = 0; ai < 2; ++ai)
#pragma unroll
            for (int m = 0; m < 4; ++m) {
                const int t = EPI_ROW(u, ai, m); const int p = t & (RCH - 1), c = t / RCH;
                const float rs = rinv[t] * (isk ? 0.0625f * exp2f(-(float)p * lg) : exp2f((float)p * lg));
#pragma unroll
                for (int bj = 0; bj < 2; ++bj) {
                    const int d0 = EPI_COL(bj);
                    const f32x4 c0 = tabA[(size_t)t * 64 + (d0 >> 2)], c1 = tabA[(size_t)t * 64 + (d0 >> 2) + 1];
                    const f32x4 v0 = acc[ai][bj][m][0] * rs, v1 = acc[ai][bj][m][1] * rs;
                    const f32x4 o0 = {v0[0] * c0[0] - v0[1] * c0[1], v0[0] * c0[1] + v0[1] * c0[0], v0[2] * c0[2] - v0[3] * c0[3], v0[2] * c0[3] + v0[3] * c0[2]};
                    const f32x4 o1 = {v1[0] * c1[0] - v1[1] * c1[1], v1[0] * c1[1] + v1[1] * c1[0], v1[2] * c1[2] - v1[3] * c1[3], v1[2] * c1[3] + v1[3] * c1[2]};
                    const v4u w = pack8(o0, o1);
                    if (isk) *(v4u*)(KN + (size_t)t * 1024 + h * 256 + d0) = w;
                    else *(v4u*)(AP + ((size_t)(h * NCH + c) * RCH + p) * APLD + RCH + d0) = w;
                }
            }
    }
};
struct EpiP1S {
    static constexpr bool PERM = true, AFTER_DRAIN = false;
    const float* rinv; const f32x4* tabB; bf16* KT; bf16* BP;
    __device__ __forceinline__ void operator()(AccRef acc, const Unit& u, int wr, int wc, int fr, int fq) const {
        const bool isk = u.pm < 4; const float lg = lg2gamma(u.pm & 3);
#pragma unroll
        for (int bj = 0; bj < 2; ++bj) {
            const int t0 = u.pn * 256 + EPI_COL(bj); const int c = t0 / RCH, p0 = t0 & (RCH - 1);
            const f32x4 r0 = *(const f32x4*)(rinv + t0), r1 = *(const f32x4*)(rinv + t0 + 4);
            f32x4 s0, s1;
#pragma unroll
            for (int j = 0; j < 4; ++j) { s0[j] = r0[j] * 0.0625f * exp2f(-(float)(p0 + j) * lg); s1[j] = r1[j] * 0.0625f * exp2f(-(float)(p0 + 4 + j) * lg); }
#pragma unroll
            for (int ai = 0; ai < 2; ++ai)
#pragma unroll
                for (int m = 0; m < 4; ++m) {
                    const int row = EPI_ROW(u, ai, m);
                    if (isk) {
                        const int d = row & 255, i = d >> 1; const bool odd = d & 1;
                        const f32x4 v0 = acc[ai][bj][m][0] * s0, v1 = acc[ai][bj][m][1] * s1; f32x4 q0, q1;
#pragma unroll
                        for (int j = 0; j < 4; ++j) { q0[j] = __shfl_xor(v0[j], 1); q1[j] = __shfl_xor(v1[j], 1); }
                        const f32x4* tb = tabB + ((size_t)i * SEQ + t0) / 2;
                        const f32x4 ca = tb[0], cb = tb[1], cc = tb[2], cd = tb[3];
                        f32x4 o0, o1;
                        if (odd) { o0 = (f32x4){q0[0] * ca[1] + v0[0] * ca[0], q0[1] * ca[3] + v0[1] * ca[2], q0[2] * cb[1] + v0[2] * cb[0], q0[3] * cb[3] + v0[3] * cb[2]};
                                   o1 = (f32x4){q1[0] * cc[1] + v1[0] * cc[0], q1[1] * cc[3] + v1[1] * cc[2], q1[2] * cd[1] + v1[2] * cd[0], q1[3] * cd[3] + v1[3] * cd[2]}; }
                        else     { o0 = (f32x4){v0[0] * ca[0] - q0[0] * ca[1], v0[1] * ca[2] - q0[1] * ca[3], v0[2] * cb[0] - q0[2] * cb[1], v0[3] * cb[2] - q0[3] * cb[3]};
                                   o1 = (f32x4){v1[0] * cc[0] - q1[0] * cc[1], v1[1] * cc[2] - q1[1] * cc[3], v1[2] * cd[0] - q1[2] * cd[1], v1[3] * cd[2] - q1[3] * cd[3]}; }
                        *(v4u*)(KT + (size_t)row * SEQ + t0) = pack8(o0, o1);
                    } else {
                        const int eg = row - 1024, h = eg >> 9, e = eg & 511;
                        *(v4u*)(BP + ((size_t)(h * NCH + c) * RCH + e) * APLD + p0) = pack8(acc[ai][bj][m][0] * r0, acc[ai][bj][m][1] * r1);
                    }
                }
        }
    }
};
struct EpiG {
    static constexpr bool PERM = true, AFTER_DRAIN = false;
    const float* rinv; const float* gslots; bf16* O;
    __device__ __forceinline__ void operator()(AccRef acc, const Unit& u, int wr, int wc, int fr, int fq) const {
        const int h = u.pn >> 1;
#pragma unroll
        for (int ai = 0; ai < 2; ++ai)
#pragma unroll
            for (int m = 0; m < 4; ++m) {
                const int row = EPI_ROW(u, ai, m); const float rin = rinv[row];
                const f32x4 sa = *(const f32x4*)(gslots + (size_t)row * 32 + h * 8), sb = *(const f32x4*)(gslots + (size_t)row * 32 + h * 8 + 4);
                const float ss = ((sa[0] + sa[1]) + (sa[2] + sa[3])) + ((sb[0] + sb[1]) + (sb[2] + sb[3]));
                const float rs = rsqrtf(ss * (1.0f / RDV) + RMS_EPS);
#pragma unroll
                for (int bj = 0; bj < 2; ++bj) {
                    bf16* op = O + (size_t)row * 2048 + u.pn * 256 + EPI_COL(bj);
                    float o[8]; unpack8(*(const v4u*)op, o);
                    const f32x4 g0 = acc[ai][bj][m][0] * rin, g1 = acc[ai][bj][m][1] * rin; f32x4 a, b;
#pragma unroll
                    for (int j = 0; j < 4; ++j) { a[j] = o[j] * rs * silu(g0[j]); b[j] = o[4 + j] * rs * silu(g1[j]); }
                    *(v4u*)op = pack8(a, b);
                }
            }
    }
};
struct EpiOut {
    static constexpr bool PERM = true, AFTER_DRAIN = false;
    bf16* MIX; float* oslots;
    __device__ __forceinline__ void operator()(AccRef acc, const Unit& u, int wr, int wc, int fr, int fq) const {
#pragma unroll
        for (int ai = 0; ai < 2; ++ai)
#pragma unroll
            for (int m = 0; m < 4; ++m) {
                const int row = EPI_ROW(u, ai, m); float ss = 0.f;
#pragma unroll
                for (int bj = 0; bj < 2; ++bj) {
                    const f32x4 v0 = acc[ai][bj][m][0], v1 = acc[ai][bj][m][1];
                    ss += (v0[0] * v0[0] + v0[1] * v0[1]) + (v0[2] * v0[2] + v0[3] * v0[3]) + (v1[0] * v1[0] + v1[1] * v1[1]) + (v1[2] * v1[2] + v1[3] * v1[3]);
                    *(v4u*)(MIX + (size_t)row * 1024 + u.pn * 256 + EPI_COL(bj)) = pack8(v0, v1);
                }
                ss += __shfl_xor(ss, 16); ss += __shfl_xor(ss, 32);
                if (fq == 0) oslots[(size_t)row * 16 + u.pn * 4 + wc] = ss;
            }
    }
};
struct EpiFfnIn {
    static constexpr bool PERM = true, AFTER_DRAIN = false;
    const float* rinv; bf16* HID;
    __device__ __forceinline__ void operator()(AccRef acc, const Unit& u, int wr, int wc, int fr, int fq) const {
#pragma unroll
        for (int ai = 0; ai < 2; ++ai)
#pragma unroll
            for (int m = 0; m < 4; ++m) {
                const int row = EPI_ROW(u, ai, m); const float rin = rinv[row];
                const f32x4 a0 = acc[ai][0][m][0] * rin, a1 = acc[ai][0][m][1] * rin, b0 = acc[ai][1][m][0] * rin, b1 = acc[ai][1][m][1] * rin; f32x4 x, y;
#pragma unroll
                for (int j = 0; j < 4; ++j) { x[j] = silu(a0[j]) * b0[j]; y[j] = silu(a1[j]) * b1[j]; }
                *(v4u*)(HID + (size_t)row * FFH + u.pn * 128 + wc * 32 + 8 * fq) = pack8(x, y);
            }
    }
};
struct EpiKvqN {
    static constexpr bool PERM = true, AFTER_DRAIN = false;
    const float* rinv; bf16 *KC, *VC, *KS, *KW, *Q; float* GATE;
    __device__ __forceinline__ void operator()(AccRef acc, const Unit& u, int wr, int wc, int fr, int fq) const {
        bf16* plane = u.pn == 0 ? KC : u.pn == 1 ? VC : u.pn == 2 ? KS : KW;
#pragma unroll
        for (int ai = 0; ai < 2; ++ai)
#pragma unroll
            for (int m = 0; m < 4; ++m) {
                const int row = EPI_ROW(u, ai, m); const float rin = rinv[row]; const int b = row / SEQ, t = row % SEQ;
#pragma unroll
                for (int bj = 0; bj < 2; ++bj) {
                    const int cc = EPI_COL(bj);
                    f32x4 v0 = acc[ai][bj][m][0] * rin, v1 = acc[ai][bj][m][1] * rin;
                    if (u.pn < 4) { const int g = cc >> 6, d = cc & 63; *(v4u*)(plane + ((size_t)(b * NG + g) * SEQ + t) * HD + d) = pack8(v0, v1); }
                    else if (u.pn < 8) { *(v4u*)(Q + (size_t)row * 1024 + (u.pn - 4) * 256 + cc) = pack8(v0 * 0.125f, v1 * 0.125f); }
                    else if (cc < 48) {
#pragma unroll
                        for (int j = 0; j < 4; ++j) { v0[j] = sigm(v0[j]); v1[j] = sigm(v1[j]); }
                        *(f32x4*)(GATE + (size_t)row * 48 + cc) = v0; *(f32x4*)(GATE + (size_t)row * 48 + cc + 4) = v1;
                    }
                }
            }
    }
};
struct EpiKvqS {
    static constexpr bool PERM = true, AFTER_DRAIN = false;
    const float* rinv; bf16 *VST, *VWT;
    __device__ __forceinline__ void operator()(AccRef acc, const Unit& u, int wr, int wc, int fr, int fq) const {
        bf16* plane = u.pm == 0 ? VST : VWT;
#pragma unroll
        for (int bj = 0; bj < 2; ++bj) {
            const int mg = u.pn * 256 + EPI_COL(bj); const int b = mg / SEQ, t = mg % SEQ;
            const f32x4 r0 = *(const f32x4*)(rinv + mg), r1 = *(const f32x4*)(rinv + mg + 4);
#pragma unroll
            for (int ai = 0; ai < 2; ++ai)
#pragma unroll
                for (int m = 0; m < 4; ++m) {
                    const int r256 = ai * 128 + wr * 64 + m * 16 + fr; const int g = r256 >> 6, d = r256 & 63;
                    *(v4u*)(plane + ((size_t)((b * NG + g) * HD + d)) * SEQ + t) = pack8(acc[ai][bj][m][0] * r0, acc[ai][bj][m][1] * r1);
                }
        }
    }
};
struct EpiCmp {
    static constexpr bool PERM = true, AFTER_DRAIN = false;
    const float* peb; bf16* HIDC;
    __device__ __forceinline__ void operator()(AccRef acc, const Unit& u, int wr, int wc, int fr, int fq) const {
        const int kv = u.pm >= 32 ? 1 : 0;
#pragma unroll
        for (int bj = 0; bj < 2; ++bj) {
            const int col = EPI_COL(bj);
            const f32x4 b0 = *(const f32x4*)(peb + kv * 256 + col), b1 = *(const f32x4*)(peb + kv * 256 + col + 4);
#pragma unroll
            for (int ai = 0; ai < 2; ++ai)
#pragma unroll
                for (int m = 0; m < 4; ++m) {
                    const int row = EPI_ROW(u, ai, m); f32x4 x = acc[ai][bj][m][0] + b0, y = acc[ai][bj][m][1] + b1;
#pragma unroll
                    for (int j = 0; j < 4; ++j) { x[j] = silu(x[j]); y[j] = silu(y[j]); }
                    *(v4u*)(HIDC + (size_t)row * 256 + col) = pack8(x, y);
                }
        }
    }
};
struct MapCmp { __device__ __forceinline__ void operator()(Unit& u) const { u.offA = (size_t)u.pm * 256 * 1024 * 2; u.offB = (size_t)(u.pm >= 32 ? 256 : 0) * 2048 * 2; } };

constexpr int NWAVES = 8, NTHREADS = NWAVES * 64;
constexpr int RING_OFF = 0, RING_BYTES = 131072;
constexpr int LDSCTL_OFF = RING_BYTES, MISC_OFF = LDSCTL_OFF + 320;
constexpr int LDS_BYTES = 147456;
constexpr int CW_BAR = 4096;

struct Args { const float* in[20]; float* out; unsigned char* ws; int ph, b; };
struct Frame {
    LAS unsigned char* lds; unsigned char* ws; float* out; const float* const* in;
    int tid, lane, wave, G, vcu, gw, NGW;
};

template <class DestRow>
__device__ __forceinline__ void transpose_item(const float* W, int K, int ldw, int ncols, const float* gain, bf16* WT, LAS float* scr, int k0, int n0, int lane, const DestRow& dr) {
#pragma unroll 8
    for (int i = 0; i < 32; ++i) { const int kk = 2 * i + (lane >> 5), n = n0 + (lane & 31);
        float v = 0.f; if (n < ncols) v = W[(size_t)(k0 + kk) * ldw + n]; if (gain) v *= gain[k0 + kk];
        scr[kk * 33 + (lane & 31)] = v; }
    asm volatile("s_waitcnt lgkmcnt(0)" ::: "memory");
    const int c = lane & 7;
#pragma unroll
    for (int j = 0; j < 4; ++j) { const int n = (lane >> 3) + 8 * j; const LAS float* s = scr + (8 * c) * 33 + n;
        v4u o; o.x = cvtpk(s[0 * 33], s[1 * 33]); o.y = cvtpk(s[2 * 33], s[3 * 33]); o.z = cvtpk(s[4 * 33], s[5 * 33]); o.w = cvtpk(s[6 * 33], s[7 * 33]);
        const int drow = dr(n0 + n); if (drow >= 0) *(v4u*)(WT + (size_t)drow * K + k0 + 8 * c) = o; }
    asm volatile("s_waitcnt lgkmcnt(0)" ::: "memory");
}
template <class DestRow>
__device__ __forceinline__ void transpose_matrix(const Frame& F, const float* W, int K, int ldw, int ncols, int ncols_pad, const float* gain, bf16* WT, const DestRow& dr) {
    LAS float* scr = (LAS float*)(F.lds + RING_OFF + F.wave * 16384);
    const int nblk = ncols_pad / 32, items = (K / 64) * nblk;
    for (int it = F.gw; it < items; it += F.NGW) transpose_item(W, K, ldw, ncols, gain, WT, scr, 64 * (it / nblk), 32 * (it % nblk), F.lane, dr);
}
struct DrOff { int off; __device__ __forceinline__ int operator()(int n) const { return n + off; } };
struct DrFfn { __device__ __forceinline__ int operator()(int n) const { const int up = n >= FFH, j = up ? n - FFH : n; return (j >> 7) * 256 + up * 128 + (j & 127); } };
struct DrKv { __device__ __forceinline__ int operator()(int n) const {
        const int s = n >> 8, d = n & 255; return s < 3 ? n : s == 3 ? 2304 + d : s == 4 ? 768 + d : 2304 + 256 + d; } };

__device__ __forceinline__ void row_to_bf16(const float* xrow, bf16* orow, float* rinv, int lane) {
    const f32x4* xr = (const f32x4*)xrow + lane; f32x4 v[4]; float s = 0.f;
#pragma unroll
    for (int j = 0; j < 4; ++j) { v[j] = xr[64 * j]; s += (v[j][0] * v[j][0] + v[j][1] * v[j][1]) + (v[j][2] * v[j][2] + v[j][3] * v[j][3]); }
    s = wave_sum(s);
    v2u* o8 = (v2u*)orow + lane;
#pragma unroll
    for (int j = 0; j < 4; ++j) { v2u w; w.x = cvtpk(v[j][0], v[j][1]); w.y = cvtpk(v[j][2], v[j][3]); o8[64 * j] = w; }
    if (lane == 0) *rinv = rsqrtf(s * (1.0f / DM) + RMS_EPS);
}

__device__ __forceinline__ void phase_prologue(const Frame& F) {
    unsigned char* ws = F.ws; const float* const* in = F.in;
    transpose_matrix(F, in[7], DM, RIN, RIN, RIN, in[1], (bf16*)(ws + W_RI), DrOff{0});
    transpose_matrix(F, in[8], 2048, DM, DM, DM, nullptr, (bf16*)(ws + W_RO), DrOff{0});
    transpose_matrix(F, in[5], DM, 2 * FFH, 2 * FFH, 2 * FFH, in[3], (bf16*)(ws + W_FI0), DrFfn{});
    transpose_matrix(F, in[5] + (size_t)DM * 2 * FFH, DM, 2 * FFH, 2 * FFH, 2 * FFH, in[3] + DM, (bf16*)(ws + W_FI1), DrFfn{});
    transpose_matrix(F, in[6], FFH, DM, DM, DM, nullptr, (bf16*)(ws + W_FO0), DrOff{0});
    transpose_matrix(F, in[6] + (size_t)FFH * DM, FFH, DM, DM, DM, nullptr, (bf16*)(ws + W_FO1), DrOff{0});
    transpose_matrix(F, in[10], DM, 1536, 1536, 1536, in[9], (bf16*)(ws + W_KVQ), DrKv{});
    transpose_matrix(F, in[17], DM, NSAIN, NSAIN, 1280, in[1] + DM, (bf16*)(ws + W_KVQ), DrOff{1024});
    transpose_matrix(F, in[18], DM, DM, DM, DM, nullptr, (bf16*)(ws + W_NO), DrOff{0});
    transpose_matrix(F, in[12], 2048, 256, 256, 256, nullptr, (bf16*)(ws + W_C1), DrOff{0});
    transpose_matrix(F, in[15], 2048, 256, 256, 256, nullptr, (bf16*)(ws + W_C1), DrOff{256});
    {
        f32x2_t* tabA = (f32x2_t*)(ws + WS_TABA); f32x2_t* tabB = (f32x2_t*)(ws + WS_TABB);
        for (int idx = F.vcu * NTHREADS + F.tid; idx < SEQ * 128; idx += F.G * NTHREADS) {
            const int t = idx >> 7, i = idx & 127;
            const float theta = 1.0f / powf(10000.0f, (float)i * (1.0f / 127.0f));
            const float ang = (float)t * theta; float s, c; sincosf(ang, &s, &c);
            const f32x2_t v = {c, s}; tabA[idx] = v; tabB[(size_t)i * SEQ + t] = v;
        }
    }
    for (int m = F.gw; m < MTOK; m += F.NGW) row_to_bf16(in[0] + (size_t)m * DM, (bf16*)(ws + WS_XB) + (size_t)m * DM, (float*)(ws + WS_RINV) + m, F.lane);
    if (blockIdx.x == 0) for (int i = F.tid; i < 128 * 16; i += NTHREADS) ((float*)(ws + WS_BIAST))[i] = in[19][t5_bucket(i >> 4) * 16 + (i & 15)];
    if (blockIdx.x < 32) {
        const int kv = F.tid >> 8, c = F.tid & 255; const float* pe = kv ? in[14] : in[11]; const float* w1 = kv ? in[15] : in[12]; float s = 0.f;
        for (int k = 64 * blockIdx.x; k < 64 * blockIdx.x + 64; ++k) s += pe[k] * w1[(size_t)k * 256 + c];
        ((float*)(ws + WS_PEBP))[blockIdx.x * 512 + F.tid] = s;
    }
}
__device__ __forceinline__ void phase_peb_final(const Frame& F) {
    if (blockIdx.x == 0) { float s = 0.f; for (int w = 0; w < 32; ++w) s += ((const float*)(F.ws + WS_PEBP))[w * 512 + F.tid]; ((float*)(F.ws + WS_PEB))[F.tid] = s; }
}

__device__ __forceinline__ void phase_resid(const Frame& F, const float* hold, const float* gpost, bool last) {
    const bf16* MIX = (const bf16*)(F.ws + WS_MIX); const float* oslots = (const float*)(F.ws + WS_OSLOT);
    bf16* XB = (bf16*)(F.ws + WS_XB); float* rinv = (float*)(F.ws + WS_RINV);
    f32x4 gp[4];
#pragma unroll
    for (int j = 0; j < 4; ++j) gp[j] = ((const f32x4*)gpost)[F.lane + 64 * j];
    for (int m = F.gw; m < MTOK; m += F.NGW) {
        const f32x4* sl = (const f32x4*)(oslots + (size_t)m * 16); const f32x4 s0 = sl[0], s1 = sl[1], s2 = sl[2], s3 = sl[3];
        const float ss = (((s0[0] + s0[1]) + (s0[2] + s0[3])) + ((s1[0] + s1[1]) + (s1[2] + s1[3]))) + (((s2[0] + s2[1]) + (s2[2] + s2[3])) + ((s3[0] + s3[1]) + (s3[2] + s3[3])));
        const float rs = rsqrtf(ss * (1.0f / DM) + RMS_EPS);
        const f32x4* hr = (const f32x4*)(hold + (size_t)m * DM) + F.lane; const v2u* mr = (const v2u*)(MIX + (size_t)m * DM) + F.lane;
        f32x4 hn[4]; float s = 0.f;
#pragma unroll
        for (int j = 0; j < 4; ++j) { const f32x4 hv = hr[64 * j]; const v2u mw = mr[64 * j];
            const f32x4 mx = {bflo(mw.x), bfhi(mw.x), bflo(mw.y), bfhi(mw.y)};
            hn[j] = hv + mx * rs * gp[j]; s += (hn[j][0] * hn[j][0] + hn[j][1] * hn[j][1]) + (hn[j][2] * hn[j][2] + hn[j][3] * hn[j][3]); }
        f32x4* ho = (f32x4*)(F.out + (size_t)m * DM) + F.lane;
#pragma unroll
        for (int j = 0; j < 4; ++j) ho[64 * j] = hn[j];
        if (!last) {
            s = wave_sum(s); v2u* o8 = (v2u*)(XB + (size_t)m * DM) + F.lane;
#pragma unroll
            for (int j = 0; j < 4; ++j) { v2u w; w.x = cvtpk(hn[j][0], hn[j][1]); w.y = cvtpk(hn[j][2], hn[j][3]); o8[64 * j] = w; }
            if (F.lane == 0) rinv[m] = rsqrtf(s * (1.0f / DM) + RMS_EPS);
        }
    }
}

__device__ __forceinline__ void phase_ret_naive(const Frame& F, int b) {
    const bf16* AP = (const bf16*)(F.ws + WS_AP); const bf16* BP = (const bf16*)(F.ws + WS_BP); const bf16* KN = (const bf16*)(F.ws + WS_KN);
    bf16* O = (bf16*)F.out;
    for (int item = blockIdx.x; item < RH * 8; item += F.G) {
        const int h = item >> 3, et = item & 7, el = F.tid >> 3, ds = F.tid & 7, e = et * 64 + el;
        const float cdec = exp2f((float)RCH * lg2gamma(h));
        float U[32];
#pragma unroll
        for (int i = 0; i < 32; ++i) U[i] = 0.f;
        v4u kb[4], qb[4]; bf16 vb;
#define RN_LOAD(tt, KB, QB, VB) do { const int c_ = (tt) / RCH, p_ = (tt) & (RCH - 1); \
            const v4u* kp_ = (const v4u*)(KN + (size_t)(tt) * 1024 + h * 256 + ds * 32); const v4u* qp_ = (const v4u*)(AP + ((size_t)(h * NCH + c_) * RCH + p_) * APLD + RCH + ds * 32); \
            _Pragma("unroll") for (int j_ = 0; j_ < 4; ++j_) { KB[j_] = kp_[j_]; QB[j_] = qp_[j_]; } VB = BP[((size_t)(h * NCH + c_) * RCH + e) * APLD + p_]; } while (0)
        RN_LOAD(0, kb, qb, vb);
        for (int t = 0; t < SEQ; ++t) {
            v4u kn[4], qn[4]; bf16 vn; const int tn = t + 1 < SEQ ? t + 1 : t;
            RN_LOAD(tn, kn, qn, vn);
            const float v = bf2f(vb); float acc = 0.f;
#pragma unroll
            for (int j = 0; j < 4; ++j) { float kf[8], qf[8]; unpack8(kb[j], kf); unpack8(qb[j], qf);
#pragma unroll
                for (int i = 0; i < 8; ++i) { U[8 * j + i] += kf[i] * v; acc += qf[i] * U[8 * j + i]; } }
            acc += __shfl_xor(acc, 1); acc += __shfl_xor(acc, 2); acc += __shfl_xor(acc, 4);
            if (ds == 0) O[(size_t)(b * SEQ + t) * 2048 + h * 512 + e] = f2bf(acc);
            if ((t & (RCH - 1)) == RCH - 1) {
#pragma unroll
                for (int i = 0; i < 32; ++i) U[i] *= cdec; }
#pragma unroll
            for (int j = 0; j < 4; ++j) { kb[j] = kn[j]; qb[j] = qn[j]; } vb = vn;
        }
#undef RN_LOAD
    }
}
__device__ __forceinline__ void phase_ret_ssq(const Frame& F, int b) {
    const bf16* O = (const bf16*)F.out; float* gs = (float*)(F.ws + WS_GSLOT);
    for (int r = F.gw; r < SEQ * RH; r += F.NGW) {
        const int m = b * SEQ + (r >> 2), h = r & 3; float f[8]; unpack8(((const v4u*)(O + (size_t)m * 2048 + h * 512))[F.lane], f);
        float s = 0.f;
#pragma unroll
        for (int i = 0; i < 8; ++i) s += f[i] * f[i];
        s = wave_sum(s);
        if (F.lane < 8) gs[(size_t)m * 32 + h * 8 + F.lane] = F.lane == 0 ? s : 0.f;
    }
}

__device__ __forceinline__ void phase_cmp2(const Frame& F) {
    const bf16* HIDC = (const bf16*)(F.ws + WS_HIDC); bf16* KCMP = (bf16*)(F.ws + WS_KCMP); bf16* VCT = (bf16*)(F.ws + WS_VCMPT);
    LAS float* scr = (LAS float*)(F.lds + RING_OFF + F.wave * 2048);
    for (int R = F.gw; R < 16384; R += F.NGW) {
        const int kv = R >> 13, pl = (R >> 10) & 7, n = R & 1023; const float* w2 = kv ? F.in[16] : F.in[13];
        const v2u hw = ((const v2u*)(HIDC + (size_t)R * 256))[F.lane];
        scr[4 * F.lane + 0] = bflo(hw.x); scr[4 * F.lane + 1] = bfhi(hw.x); scr[4 * F.lane + 2] = bflo(hw.y); scr[4 * F.lane + 3] = bfhi(hw.y);
        asm volatile("s_waitcnt lgkmcnt(0)" ::: "memory");
        float s = 0.f;
#pragma unroll 8
        for (int c = 0; c < 256; ++c) s += scr[c] * w2[c * 64 + F.lane];
        if (n == NCMP) s = 0.f;
        if (kv == 0) KCMP[((size_t)pl * 1024 + n) * 64 + F.lane] = f2bf(s);
        else VCT[((size_t)pl * 64 + F.lane) * 1024 + n] = f2bf(s);
        asm volatile("s_waitcnt lgkmcnt(0)" ::: "memory");
    }
}

__device__ __forceinline__ float dot64(const float* q, const bf16* krow) {
    const v4u* kp = (const v4u*)krow; float s = 0.f;
#pragma unroll
    for (int j = 0; j < 8; ++j) { float kf[8]; unpack8(kp[j], kf);
#pragma unroll
        for (int i = 0; i < 8; ++i) s += q[8 * j + i] * kf[i]; }
    return s;
}
__device__ __forceinline__ void wave_softmax(LAS float* S, int n, int n8, int ln) {
    float mx = -INFINITY;
    for (int i = ln; i < n; i += 64) mx = fmaxf(mx, S[i]);
    mx = wave_max(mx); if (!(mx > -INFINITY)) mx = 0.f;
    float sum = 0.f;
    for (int i = ln; i < n; i += 64) { const float p = __expf(S[i] - mx); S[i] = p; sum += p; }
    sum = wave_sum(sum); const float inv = 1.0f / fmaxf(sum, 1.17549435e-38f);
    for (int i = ln; i < n8; i += 64) S[i] = i < n ? S[i] * inv : 0.f;
}
__device__ __forceinline__ void phase_nsa_naive(const Frame& F) {
    const int half = F.tid >> 8, tl = F.tid & 255, r = tl >> 6, ln = tl & 63;
    LAS float* S = (LAS float*)(F.lds + RING_OFF + half * 32768);
    LAS float* IMPC = S + 4096; LAS float* IMP = IMPC + 1024; LAS int* SELF = (LAS int*)(IMP + 256); LAS int* BLK = SELF + 256;
    LAS float* Sr = S + r * 1024;
    const bf16* Q = (const bf16*)(F.ws + WS_Q); const bf16* KCMP = (const bf16*)(F.ws + WS_KCMP); const bf16* VCT = (const bf16*)(F.ws + WS_VCMPT);
    const bf16* KS = (const bf16*)(F.ws + WS_KS); const bf16* KW = (const bf16*)(F.ws + WS_KW); const bf16* VST = (const bf16*)(F.ws + WS_VST); const bf16* VWT = (const bf16*)(F.ws + WS_VWT);
    const float* GATE = (const float*)(F.ws + WS_GATE); const float* biasT = (const float*)(F.ws + WS_BIAST); bf16* ONSA = (bf16*)(F.ws + WS_ONSA);
    for (int it = blockIdx.x; it < MTOK * NG / 2; it += F.G) {
        const int item = it * 2 + half, m = item >> 2, g = item & 3, b = m / SEQ, t = m % SEQ, pl = b * NG + g, H = g * NR + r;
        float q[64];
        { const v4u* qp = (const v4u*)(Q + (size_t)m * 1024 + H * 64);
#pragma unroll
          for (int j = 0; j < 8; ++j) unpack8(qp[j], q + 8 * j); }
        const float* bT = biasT + H;
        const int nvalid = t >= 31 ? ((t - 31) / 16 + 1 < NCMP ? (t - 31) / 16 + 1 : NCMP) : 0, nv8 = (nvalid + 7) & ~7;
        for (int n = ln; n < nvalid; n += 64) { const int dist = t - 16 * n - 31; Sr[n] = dot64(q, KCMP + ((size_t)pl * 1024 + n) * 64) + bT[(dist < 127 ? dist : 127) * 16]; }
        __syncthreads();
        wave_softmax(Sr, nvalid, nv8, ln);
        __syncthreads();
        for (int n = tl; n < 1024; n += 256) IMPC[n] = n < nvalid ? (S[n] + S[1024 + n]) + (S[2048 + n] + S[3072 + n]) : 0.f;
        const int cur = t >> 6;
        SELF[tl] = (tl == 0 || tl == cur || tl == cur - 1) ? 1 : 0;
        __syncthreads();
        { float s = 0.f;
#pragma unroll
          for (int k = -1; k < 4; ++k) { const int n = 4 * tl + k; if (n >= 0 && n < NCMP) s += IMPC[n]; }
          IMP[tl] = s; }
        float oc = 0.f;
        for (int n0 = 0; n0 < nvalid; n0 += 8) { float vf[8]; unpack8(*(const v4u*)(VCT + ((size_t)pl * 64 + ln) * 1024 + n0), vf);
#pragma unroll
            for (int i = 0; i < 8; ++i) oc += Sr[n0 + i] * vf[i]; }
        __syncthreads();
        if (r == 0) {
            const int ncand = cur - 2, nf = cur + 1 < 3 ? cur + 1 : 3, need = 16 - nf;
            if (ncand <= need) { for (int j = ln; j < 256; j += 64) if (j >= 1 && j <= cur - 2) SELF[j] = 1; }
            else {
                float v[4];
#pragma unroll
                for (int i = 0; i < 4; ++i) { const int j = ln + 64 * i; v[i] = (j >= 1 && j <= cur - 2) ? IMP[j] : -INFINITY; }
                for (int round = 0; round < need; ++round) {
                    float bv = v[0]; int bj = ln;
#pragma unroll
                    for (int i = 1; i < 4; ++i) if (v[i] > bv) { bv = v[i]; bj = ln + 64 * i; }
#pragma unroll
                    for (int o = 1; o < 64; o <<= 1) { const float ov = __shfl_xor(bv, o); const int oj = __shfl_xor(bj, o); if (ov > bv || (ov == bv && oj < bj)) { bv = ov; bj = oj; } }
#pragma unroll
                    for (int i = 0; i < 4; ++i) if (bj == ln + 64 * i) { v[i] = -INFINITY; SELF[bj] = 1; }
                }
            }
        }
        __syncthreads();
        int nk = 0;
        for (int j = 0; j <= cur; ++j) {
            if (SELF[j]) {
                const int pos = 64 * j + ln, dist = t - pos;
                Sr[nk * 64 + ln] = pos <= t ? dot64(q, KS + ((size_t)pl * SEQ + pos) * 64) + bT[(dist < 127 ? dist : 127) * 16] : -INFINITY;
                if (tl == 0) BLK[nk] = j;
                ++nk;
            }
        }
        __syncthreads();
        wave_softmax(Sr, nk * 64, nk * 64, ln);
        float os = 0.f;
        for (int k = 0; k < nk; ++k) { const int j = BLK[k];
            for (int l0 = 0; l0 < 64; l0 += 8) { float vf[8]; unpack8(*(const v4u*)(VST + ((size_t)pl * 64 + ln) * SEQ + 64 * j + l0), vf);
#pragma unroll
                for (int i = 0; i < 8; ++i) os += Sr[k * 64 + l0 + i] * vf[i]; } }
        __syncthreads();
        for (int i = ln; i < 512; i += 64) { const int pos = t - 511 + i; Sr[i] = pos >= 0 ? dot64(q, KW + ((size_t)pl * SEQ + pos) * 64) + bT[((511 - i) < 127 ? (511 - i) : 127) * 16] : -INFINITY; }
        wave_softmax(Sr, 512, 512, ln);
        float ow = 0.f;
        for (int i = t >= 511 ? 0 : 511 - t; i < 512; ++i) ow += Sr[i] * bf2f(VWT[((size_t)pl * 64 + ln) * SEQ + (t - 511 + i)]);
        const float* gt = GATE + (size_t)m * 48 + H * 3;
        ONSA[(size_t)m * 1024 + H * 64 + ln] = f2bf(gt[0] * oc + gt[1] * os + gt[2] * ow);
        __syncthreads();
    }
}

template <class Epi, class Map>
__device__ __forceinline__ void run_gemm(const Frame& F, const bf16* A, const bf16* Bt, int lda, int ldb, int K, int nM, int nN, const Map& map, const Epi& E) {
    pg8::Gemm g{A, Bt, lda, ldb, K}; pg8::Order<Map> S; S.init(nM, nN, F.G, (int)blockIdx.x, map);
    pg8::gemm_phase<Epi, pg8::Order<Map>, true, true>(F.lds + RING_OFF, g, S, E);
}
enum { PH_PRO, PH_P1N, PH_P1S, PH_RETN, PH_RSSQ, PH_G, PH_RO, PH_RES, PH_FI, PH_FO, PH_KVQN, PH_KVQS, PH_CMP, PH_CMP2, PH_NSAN, PH_NO, PH_COUNT };

template <int PH> __device__ __forceinline__ void phase_body(const Frame& F, int b) {
    unsigned char* ws = F.ws; float* rinv = (float*)(ws + WS_RINV); bf16* XB = (bf16*)(ws + WS_XB);
    if constexpr (PH == PH_PRO) phase_prologue(F);
    if constexpr (PH == PH_P1N) { EpiP1N E{rinv + b * SEQ, (const f32x4*)(ws + WS_TABA), (bf16*)(ws + WS_AP), (bf16*)(ws + WS_KN)};
        run_gemm(F, XB + (size_t)b * SEQ * DM, (const bf16*)(ws + W_RI), DM, DM, DM, SEQ / 256, 8, pg8::MapPlain{DM, DM}, E); }
    if constexpr (PH == PH_P1S) { EpiP1S E{rinv + b * SEQ, (const f32x4*)(ws + WS_TABB), (bf16*)(ws + WS_KT), (bf16*)(ws + WS_BP)};
        run_gemm(F, (const bf16*)(ws + W_RI) + (size_t)1024 * DM, XB + (size_t)b * SEQ * DM, DM, DM, DM, 12, SEQ / 256, pg8::MapPlain{DM, DM}, E); }
    if constexpr (PH == PH_RETN) phase_ret_naive(F, b);
    if constexpr (PH == PH_RSSQ) phase_ret_ssq(F, b);
    if constexpr (PH == PH_G) { EpiG E{rinv, (const float*)(ws + WS_GSLOT), (bf16*)F.out};
        run_gemm(F, XB, (const bf16*)(ws + W_RI) + (size_t)4096 * DM, DM, DM, DM, MTOK / 256, 8, pg8::MapPlain{DM, DM}, E); }
    if constexpr (PH == PH_RO) { EpiOut E{(bf16*)(ws + WS_MIX), (float*)(ws + WS_OSLOT)};
        run_gemm(F, (const bf16*)F.out, (const bf16*)(ws + W_RO), 2048, 2048, 2048, MTOK / 256, 4, pg8::MapPlain{2048, 2048}, E); }
    if constexpr (PH == PH_RES) phase_resid(F, b == 0 ? F.in[0] : F.out, (b & 1 ? F.in[4] : F.in[2]) + (b >> 1) * DM, b == 3);
    if constexpr (PH == PH_FI) { EpiFfnIn E{rinv, (bf16*)(ws + WS_HID)};
        run_gemm(F, XB, (const bf16*)(ws + (b ? W_FI1 : W_FI0)), DM, DM, DM, MTOK / 256, 22, pg8::MapPlain{DM, DM}, E); }
    if constexpr (PH == PH_FO) { EpiOut E{(bf16*)(ws + WS_MIX), (float*)(ws + WS_OSLOT)};
        run_gemm(F, (const bf16*)(ws + WS_HID), (const bf16*)(ws + (b ? W_FO1 : W_FO0)), FFH, FFH, FFH, MTOK / 256, 4, pg8::MapPlain{FFH, FFH}, E); }
    if constexpr (PH == PH_KVQN) { phase_peb_final(F);
        EpiKvqN E{rinv, (bf16*)(ws + WS_KC), (bf16*)(ws + WS_VC), (bf16*)(ws + WS_KS), (bf16*)(ws + WS_KW), (bf16*)(ws + WS_Q), (float*)(ws + WS_GATE)};
        run_gemm(F, XB, (const bf16*)(ws + W_KVQ), DM, DM, DM, MTOK / 256, 9, pg8::MapPlain{DM, DM}, E); }
    if constexpr (PH == PH_KVQS) { EpiKvqS E{rinv, (bf16*)(ws + WS_VST), (bf16*)(ws + WS_VWT)};
        run_gemm(F, (const bf16*)(ws + W_KVV), XB, DM, DM, DM, 2, MTOK / 256, pg8::MapPlain{DM, DM}, E); }
    if constexpr (PH == PH_CMP) { EpiCmp E{(const float*)(ws + WS_PEB), (bf16*)(ws + WS_HIDC)};
        run_gemm(F, (const bf16*)(ws + WS_KC), (const bf16*)(ws + W_C1), 1024, 2048, 2048, 64, 1, MapCmp{}, E); }
    if constexpr (PH == PH_CMP2) phase_cmp2(F);
    if constexpr (PH == PH_NSAN) phase_nsa_naive(F);
    if constexpr (PH == PH_NO) { EpiOut E{(bf16*)(ws + WS_MIX), (float*)(ws + WS_OSLOT)};
        run_gemm(F, (const bf16*)(ws + WS_ONSA), (const bf16*)(ws + W_NO), DM, DM, DM, MTOK / 256, 4, pg8::MapPlain{DM, DM}, E); }
}
__device__ __forceinline__ void make_frame(Frame& F, unsigned char* lds, const Args& args) {
    F.lds = (LAS unsigned char*)lds; F.ws = args.ws; F.out = args.out; F.in = args.in;
    F.tid = threadIdx.x; F.lane = F.tid & 63; F.wave = __builtin_amdgcn_readfirstlane(F.tid >> 6);
    F.G = gridDim.x; { const int bx = blockIdx.x; F.vcu = (F.G % 8 == 0) ? (bx % 8) * (F.G / 8) + bx / 8 : bx; }
    F.gw = F.vcu * NWAVES + F.wave; F.NGW = F.G * NWAVES;
}
template <int PH> __global__ void __launch_bounds__(NTHREADS, 2) k_phase(Args args) {
    extern __shared__ __attribute__((aligned(16))) unsigned char lds[];
    Frame F; make_frame(F, lds, args);
    phase_body<PH>(F, args.b);
}

template <int PH> static bool setup_one() { return hipFuncSetAttribute((const void*)k_phase<PH>, hipFuncAttributeMaxDynamicSharedMemorySize, LDS_BYTES) == hipSuccess; }
template <int... I> static bool setup_all(std::integer_sequence<int, I...>) { bool ok = true; ((ok = setup_one<I>() && ok), ...); return ok; }
template <int PH> static void launch(int grid, hipStream_t stream, Args a, int b) { a.ph = PH; a.b = b; hipLaunchKernelGGL(k_phase<PH>, dim3(grid), dim3(NTHREADS), LDS_BYTES, stream, a); }
extern "C" void kernel_launch(void* const* d_in, const int* in_sizes, int n_in, void* d_out, int out_size, void* d_ws, size_t ws_size, hipStream_t stream) {
    static int grid = 0;
    if (grid == 0) {
        if (n_in != 20 || out_size != MTOK * DM || ws_size < WS_NEED) { fprintf(stderr, "kernel_launch: unexpected problem shape (n_in %d, out %d, ws %zu)\n", n_in, out_size, ws_size); grid = -1; return; }
        int dev = 0, cus = 0;
        if (hipGetDevice(&dev) != hipSuccess || hipDeviceGetAttribute(&cus, hipDeviceAttributeMultiprocessorCount, dev) != hipSuccess) { grid = -1; return; }
        if (!setup_all(std::make_integer_sequence<int, PH_COUNT>{})) { fprintf(stderr, "kernel_launch: hipFuncSetAttribute failed\n"); grid = -1; return; }
        (void)hipGetLastError();
        grid = cus;
    }
    if (grid < 0) return;
    Args a{};
    for (int i = 0; i < 20; ++i) a.in[i] = (const float*)d_in[i];
    a.out = (float*)d_out; a.ws = (unsigned char*)d_ws;
    launch<PH_PRO>(grid, stream, a, 0);
    for (int b = 0; b < NBATCH; ++b) { launch<PH_P1N>(grid, stream, a, b); launch<PH_P1S>(grid, stream, a, b); launch<PH_RETN>(grid, stream, a, b); launch<PH_RSSQ>(grid, stream, a, b); }
    launch<PH_G>(grid, stream, a, 0); launch<PH_RO>(grid, stream, a, 0); launch<PH_RES>(grid, stream, a, 0);
    launch<PH_FI>(grid, stream, a, 0); launch<PH_FO>(grid, stream, a, 0); launch<PH_RES>(grid, stream, a, 1);
    launch<PH_KVQN>(grid, stream, a, 0); launch<PH_KVQS>(grid, stream, a, 0); launch<PH_CMP>(grid, stream, a, 0); launch<PH_CMP2>(grid, stream, a, 0);
    launch<PH_NSAN>(grid, stream, a, 0); launch<PH_NO>(grid, stream, a, 0); launch<PH_RES>(grid, stream, a, 2);
    launch<PH_FI>(grid, stream, a, 1); launch<PH_FO>(grid, stream, a, 1); launch<PH_RES>(grid, stream, a, 3);
}
```

```cpp
#include <hip/hip_runtime.h>
#include <cstdio>
#include <cstdint>
#include <utility>

namespace pg8 {
#define PG8_LAS __attribute__((address_space(3)))
typedef unsigned short bf16_t;
typedef short bf16x8 __attribute__((ext_vector_type(8)));
typedef float f32x4 __attribute__((ext_vector_type(4)));
typedef unsigned u32x4 __attribute__((ext_vector_type(4)));
constexpr int BM = 256, BK = 64, HALF = 128, HTB = HALF * BK * 2  , STAGE_BYTES = 8 * HTB, NXCD = 8, WGM = 8;

__host__ __device__ __forceinline__ int lds_byte(int r, int c) { const int st = (r >> 4) * 2 + (c >> 5), rr = r & 15, cc = c & 31, ob = rr * 64 + cc * 2; return st * 1024 + (ob ^ (((ob >> 9) & 1) << 5)); }
__host__ __device__ __forceinline__ void stage_rc(int b, int& R, int& C) { const int st = b / 1024, sb = b % 1024, swz = sb ^ (((sb >> 9) & 1) << 5); R = (st >> 1) * 16 + swz / 64; C = (st & 1) * 32 + (swz % 64) / 2; }
__host__ __device__ __forceinline__ int perm32(int rho) { const int n = rho >> 4, i = rho & 15; return 8 * (i >> 2) + 4 * n + (i & 3); }

struct Unit { int pm, pn; size_t offA, offB; };
struct Gemm { const bf16_t* A; const bf16_t* Bt; int lda, ldb, K; };

template <class Map> struct Order {
    int nM, nN, nwg, G, c; Map map;
    __device__ __forceinline__ void init(int nM_, int nN_, int G_, int c_, const Map& m) { nM = nM_; nN = nN_; nwg = nM * nN; G = G_; c = c_; map = m; }
    __device__ __forceinline__ bool next(int i, Unit& u) const {
        const long L = (long)i * G + c; if (L >= nwg) return false;
        int wgid = (int)L; { const int q = nwg / NXCD, r = nwg % NXCD, xcd = wgid % NXCD, off = wgid / NXCD; wgid = (xcd < r ? xcd * (q + 1) : r * (q + 1) + (xcd - r) * q) + off; }
        const int nig = WGM * nN, gid = wgid / nig, fm = gid * WGM, gsz = (nM - fm) < WGM ? (nM - fm) : WGM;
        u.pm = fm + ((wgid % nig) % gsz); u.pn = (wgid % nig) / gsz; map(u); return true;
    }
    __device__ __forceinline__ void a_ready(const Unit&) const {}
    __device__ __forceinline__ void done(const Unit&) const {}
};
struct MapPlain { int lda, ldb; __device__ __forceinline__ void operator()(Unit& u) const { u.offA = (size_t)u.pm * 256 * lda * 2; u.offB = (size_t)u.pn * 256 * ldb * 2; } };

template <class Epi, class Sched, bool ALIGN_EPI = false, bool SP2 = false>
__device__ __forceinline__ void gemm_phase(PG8_LAS unsigned char* lds, const Gemm g, const Sched& S, const Epi& E, const int tid) {
    const int wid = __builtin_amdgcn_readfirstlane(tid >> 6), lane = tid & 63, wr = wid >> 2, wc = wid & 3, fr = lane & 15, fq = lane >> 4;
    const int K = g.K, nt = K / BK;
    unsigned voffA[2], voffB[2];
#pragma unroll
    for (int i = 0; i < 2; ++i) { int R, C; stage_rc(tid * 16 + i * 8192, R, C); const int Rb = Epi::PERM ? ((R & ~31) + perm32(R & 31)) : R;
        voffA[i] = (unsigned)(R * g.lda + C) * 2u; voffB[i] = (unsigned)(Rb * g.ldb + C) * 2u; }
    const size_t kstep = (size_t)(BK * 2);
    const size_t hstepA = (size_t)HALF * g.lda * 2, hstepB = (size_t)HALF * g.ldb * 2;
    const unsigned ldsw = (unsigned)wid * 1024u;
    const int aoff = lds_byte(wr * 64 + fr, fq * 8), boff = lds_byte(wc * 32 + fr, fq * 8);
#define PG8_SA(b, h) (((b) * 2 + (h)) * HTB)
#define PG8_SB(b, h) ((4 + (b) * 2 + (h)) * HTB)
#define PG8_STAGE(bufoff, gbase, voff) do { _Pragma("unroll") for (int _i = 0; _i < 2; ++_i) \
        __builtin_amdgcn_global_load_lds((const unsigned*)((const char*)(gbase) + (voff)[_i]), (PG8_LAS unsigned*)(lds + (bufoff) + ldsw + _i * 8192), 16, 0, 0); } while (0)
#define PG8_LDA(dst, b, h) do { _Pragma("unroll") for (int m = 0; m < 4; ++m) _Pragma("unroll") for (int k = 0; k < 2; ++k) dst[m][k] = *(const PG8_LAS bf16x8*)(lds + PG8_SA(b, h) + aoff + m * 2048 + k * 1024); } while (0)
#define PG8_LDB(dst, b, h) do { _Pragma("unroll") for (int n = 0; n < 2; ++n) _Pragma("unroll") for (int k = 0; k < 2; ++k) dst[n][k] = *(const PG8_LAS bf16x8*)(lds + PG8_SB(b, h) + boff + n * 2048 + k * 1024); } while (0)
#define PG8_MMA(ai, bj, At, Bt) do { __builtin_amdgcn_s_setprio(1); _Pragma("unroll") for (int m = 0; m < 4; ++m) _Pragma("unroll") for (int n = 0; n < 2; ++n) _Pragma("unroll") for (int k = 0; k < 2; ++k) \
        acc[ai][bj][m][n] = __builtin_amdgcn_mfma_f32_16x16x32_bf16(Bt[n][k], At[m][k], acc[ai][bj][m][n], 0, 0, 0); __builtin_amdgcn_s_setprio(0); } while (0)
#define PG8_WAIT_V(n) asm volatile("s_waitcnt vmcnt(" #n ")" ::: "memory")
#define PG8_WAIT_L(n) asm volatile("s_waitcnt lgkmcnt(" #n ")" ::: "memory")
#define PG8_BAR __builtin_amdgcn_s_barrier()
#define PG8_SCHED __builtin_amdgcn_sched_barrier(0)
    Unit cur, nxt; int ui = 0;
    if (!S.next(0, cur)) return;
    f32x4 acc[2][2][4][2];
#pragma unroll
    for (int a = 0; a < 2; ++a)
#pragma unroll
        for (int b = 0; b < 2; ++b)
#pragma unroll
            for (int m = 0; m < 4; ++m)
#pragma unroll
                for (int n = 0; n < 2; ++n) acc[a][b][m][n] = (f32x4){0.f, 0.f, 0.f, 0.f};
    bf16x8 At[4][2], B0[2][2], B1[2][2];
    const char* cA = (const char*)g.A + cur.offA; const char* cB = (const char*)g.Bt + cur.offB;
    S.a_ready(cur);
    if constexpr (SP2) {
        PG8_STAGE(PG8_SB(0, 0), cB, voffB); PG8_STAGE(PG8_SB(0, 1), cB + hstepB, voffB); PG8_STAGE(PG8_SA(0, 0), cA, voffA); PG8_STAGE(PG8_SA(0, 1), cA + hstepA, voffA);
        if (wr == 1) PG8_BAR;
        PG8_WAIT_V(2); PG8_BAR;
        PG8_STAGE(PG8_SB(1, 0), cB + kstep, voffB); PG8_STAGE(PG8_SA(1, 0), cA + kstep, voffA); PG8_STAGE(PG8_SB(1, 1), cB + hstepB + kstep, voffB);
        PG8_WAIT_V(6); PG8_BAR;
    } else {
        PG8_STAGE(PG8_SB(0, 0), cB, voffB); PG8_STAGE(PG8_SA(0, 0), cA, voffA); PG8_STAGE(PG8_SB(0, 1), cB + hstepB, voffB); PG8_STAGE(PG8_SA(0, 1), cA + hstepA, voffA);
        if (wr == 1) PG8_BAR;
        PG8_WAIT_V(4); PG8_BAR;
        PG8_STAGE(PG8_SB(1, 0), cB + kstep, voffB); PG8_STAGE(PG8_SA(1, 0), cA + kstep, voffA); PG8_STAGE(PG8_SB(1, 1), cB + hstepB + kstep, voffB);
        PG8_WAIT_V(6); PG8_BAR;
    }
    for (;;) {
        const bool has_next = S.next(ui + 1, nxt);
        const char* nA = has_next ? (const char*)g.A + nxt.offA : cA; const char* nB = has_next ? (const char*)g.Bt + nxt.offB : cB;
        for (int t = 0; t < nt; t += 2) {
            const bool last = (t == nt - 2);
            const char* a1 = cA + (size_t)(t + 1) * kstep;
            const char* a2 = last ? nA : cA + (size_t)(t + 2) * kstep; const char* b2 = last ? nB : cB + (size_t)(t + 2) * kstep;
            const char* a3 = a2 + kstep; const char* b3 = b2 + kstep;
            if (last && has_next) S.a_ready(nxt);
            if constexpr (SP2) {
            PG8_LDB(B0, 0, 0); PG8_LDB(B1, 0, 1); PG8_SCHED; PG8_LDA(At, 0, 0); PG8_STAGE(PG8_SA(1, 1), a1 + hstepA, voffA);
            PG8_WAIT_V(8); PG8_WAIT_L(0); PG8_BAR; PG8_MMA(0, 0, At, B0); PG8_MMA(0, 1, At, B1); PG8_BAR; PG8_SCHED;
            PG8_LDA(At, 0, 1); PG8_STAGE(PG8_SB(0, 0), b2, voffB); PG8_STAGE(PG8_SB(0, 1), b2 + hstepB, voffB); PG8_STAGE(PG8_SA(0, 0), a2, voffA);
            PG8_WAIT_V(8); PG8_WAIT_L(0); PG8_BAR; PG8_MMA(1, 0, At, B0); PG8_MMA(1, 1, At, B1); PG8_BAR; PG8_SCHED;
            PG8_LDB(B0, 1, 0); PG8_LDB(B1, 1, 1); PG8_SCHED; PG8_LDA(At, 1, 0); PG8_STAGE(PG8_SA(0, 1), a2 + hstepA, voffA);
            PG8_WAIT_V(8); PG8_WAIT_L(0); PG8_BAR; PG8_MMA(0, 0, At, B0); PG8_MMA(0, 1, At, B1); PG8_BAR; PG8_SCHED;
            PG8_LDA(At, 1, 1); PG8_STAGE(PG8_SB(1, 0), b3, voffB); PG8_STAGE(PG8_SB(1, 1), b3 + hstepB, voffB); PG8_STAGE(PG8_SA(1, 0), a3, voffA);
            PG8_WAIT_V(8); PG8_WAIT_L(0); PG8_BAR; PG8_MMA(1, 0, At, B0); PG8_MMA(1, 1, At, B1); PG8_BAR; PG8_SCHED;
            } else {
            PG8_LDB(B0, 0, 0); PG8_SCHED; PG8_LDA(At, 0, 0); PG8_STAGE(PG8_SA(1, 1), a1 + hstepA, voffA);
            PG8_WAIT_L(8); PG8_BAR; PG8_WAIT_L(0); PG8_MMA(0, 0, At, B0); PG8_BAR; PG8_SCHED;
            PG8_LDB(B1, 0, 1); PG8_STAGE(PG8_SB(0, 0), b2, voffB);
            PG8_BAR; PG8_WAIT_L(0); PG8_MMA(0, 1, At, B1); PG8_BAR;
            PG8_LDA(At, 0, 1); PG8_STAGE(PG8_SA(0, 0), a2, voffA);
            PG8_BAR; PG8_WAIT_L(0); PG8_MMA(1, 0, At, B0); PG8_BAR; PG8_SCHED;
            PG8_STAGE(PG8_SB(0, 1), b2 + hstepB, voffB);
            PG8_WAIT_V(6); PG8_BAR; PG8_MMA(1, 1, At, B1); PG8_BAR;
            PG8_LDB(B0, 1, 0); PG8_SCHED; PG8_LDA(At, 1, 0); PG8_STAGE(PG8_SA(0, 1), a2 + hstepA, voffA);
            PG8_WAIT_L(8); PG8_BAR; PG8_WAIT_L(0); PG8_MMA(0, 0, At, B0); PG8_BAR; PG8_SCHED;
            PG8_LDB(B1, 1, 1); PG8_STAGE(PG8_SB(1, 0), b3, voffB);
            PG8_BAR; PG8_WAIT_L(0); PG8_MMA(0, 1, At, B1); PG8_BAR;
            PG8_LDA(At, 1, 1); PG8_STAGE(PG8_SA(1, 0), a3, voffA);
            PG8_BAR; PG8_WAIT_L(0); PG8_MMA(1, 0, At, B0); PG8_BAR; PG8_SCHED;
            PG8_STAGE(PG8_SB(1, 1), b3 + hstepB, voffB);
            PG8_WAIT_V(6); PG8_BAR; PG8_MMA(1, 1, At, B1); PG8_BAR;
            }
        }
        if constexpr (ALIGN_EPI) { if (wr == 0) PG8_BAR; }
        if constexpr (!Epi::AFTER_DRAIN) { E(acc, cur, wr, wc, fr, fq); S.done(cur); }
        if (!has_next) break;
#pragma unroll
        for (int a = 0; a < 2; ++a)
#pragma unroll
            for (int b = 0; b < 2; ++b)
#pragma unroll
                for (int m = 0; m < 4; ++m)
#pragma unroll
                    for (int n = 0; n < 2; ++n) acc[a][b][m][n] = (f32x4){0.f, 0.f, 0.f, 0.f};
        cur = nxt; cA = nA; cB = nB; ++ui;
        if constexpr (ALIGN_EPI) { if (wr == 1) PG8_BAR; }
    }
    PG8_WAIT_V(0);
    if constexpr (!ALIGN_EPI) { if (wr == 0) PG8_BAR; }
    PG8_BAR;
    if constexpr (Epi::AFTER_DRAIN) { E.fused(acc, cur, wr, wc, fr, fq, lds, wid, lane); S.done(cur); }
#undef PG8_SA
#undef PG8_SB
#undef PG8_STAGE
#undef PG8_LDA
#undef PG8_LDB
#undef PG8_MMA
#undef PG8_WAIT_V
#undef PG8_WAIT_L
#undef PG8_BAR
#undef PG8_SCHED
}
}

constexpr int DM = 1024, NBATCH = 2, SEQ = 16384, MTOK = NBATCH * SEQ;
constexpr int FFH = 2816;
constexpr int RH = 4, RDK = 256, RDV = 512, RCH = 512, NCH = SEQ / RCH;
constexpr int RIN = 2 * RH * RDK + 2 * RH * RDV;
constexpr int NG = 4, NR = 4, HD = 64, NCMP = 1023, NSEL = 256, NSAIN = 1072;
constexpr float RMS_EPS = 1e-6f;
constexpr int APLD = 768;

constexpr size_t MiB = 1u << 20;
constexpr size_t WS_CTL = 0, CTL_ZERO_BYTES = 1 * MiB;
constexpr size_t WS_RINV = 1 * MiB;
constexpr size_t WS_BIAST = WS_RINV + 256 * 1024;
constexpr size_t WS_PEB = WS_BIAST + 16 * 1024;
constexpr size_t WS_PEBP = WS_PEB + 4 * 1024;
constexpr size_t WS_GSLOT = 2 * MiB;
constexpr size_t WS_OSLOT = 6 * MiB;
constexpr size_t WS_W = 8 * MiB;
constexpr size_t W_RI = WS_W, W_RO = W_RI + 12 * MiB, W_FI0 = W_RO + 4 * MiB, W_FI1 = W_FI0 + 11 * MiB, W_FO0 = W_FI1 + 11 * MiB, W_FO1 = W_FO0 + 11 * MiB / 2,
                 W_KVQ = W_FO1 + 11 * MiB / 2, W_KVV = W_KVQ + 9 * MiB / 2, W_NO = W_KVV + 1 * MiB, W_C1 = W_NO + 2 * MiB, W_END = W_C1 + 2 * MiB;
static_assert(W_END <= 68 * MiB, "weights");
constexpr size_t WS_TABA = 68 * MiB, WS_TABB = 84 * MiB;
constexpr size_t WS_XB = 100 * MiB;
constexpr size_t WS_MIX = 164 * MiB;
constexpr size_t WS_KT = WS_MIX, WS_KV = WS_MIX + 32 * MiB;
constexpr size_t WS_SCR = 228 * MiB;
constexpr size_t WS_AP = WS_SCR, WS_BP = WS_AP + 96 * MiB, WS_KN = WS_BP + 96 * MiB;
static_assert(WS_KN + 32 * MiB <= 512 * MiB, "ret scratch");
constexpr size_t WS_HID = WS_SCR;
constexpr size_t WS_KC = WS_SCR, WS_VC = WS_KC + 16 * MiB, WS_KS = WS_VC + 17 * MiB, WS_KW = WS_KS + 16 * MiB, WS_VST = WS_KW + 16 * MiB, WS_VWT = WS_VST + 16 * MiB,
                 WS_Q = WS_VWT + 16 * MiB, WS_GATE = WS_Q + 64 * MiB, WS_HIDC = WS_GATE + 6 * MiB, WS_KCMP = WS_HIDC + 8 * MiB, WS_VCMPT = WS_KCMP + 1 * MiB, WS_ONSA = WS_VCMPT + 1 * MiB,
                 WS_NSA_END = WS_ONSA + 64 * MiB;
static_assert(WS_NSA_END <= 512 * MiB, "nsa scratch");
constexpr size_t WS_NEED = 512 * MiB;

#define GAS __attribute__((address_space(1)))
#define LAS __attribute__((address_space(3)))
typedef unsigned short bf16;
typedef unsigned v4u __attribute__((ext_vector_type(4)));
typedef unsigned v2u __attribute__((ext_vector_type(2)));
typedef float f32x4 __attribute__((ext_vector_type(4)));
typedef float f32x2_t __attribute__((ext_vector_type(2)));
typedef __bf16 bf16x2_t __attribute__((ext_vector_type(2)));
typedef GAS unsigned gu32;
#define RLX_AGENT __ATOMIC_RELAXED, __HIP_MEMORY_SCOPE_AGENT
__device__ __forceinline__ unsigned cvtpk(float lo, float hi) { f32x2_t v = {lo, hi}; bf16x2_t b = __builtin_convertvector(v, bf16x2_t); return __builtin_bit_cast(unsigned, b); }
__device__ __forceinline__ v4u pack8(f32x4 a, f32x4 b) { v4u w; w.x = cvtpk(a[0], a[1]); w.y = cvtpk(a[2], a[3]); w.z = cvtpk(b[0], b[1]); w.w = cvtpk(b[2], b[3]); return w; }
__device__ __forceinline__ float bflo(unsigned w) { return __uint_as_float(w << 16); }
__device__ __forceinline__ float bfhi(unsigned w) { return __uint_as_float(w & 0xffff0000u); }
__device__ __forceinline__ float bf2f(bf16 b) { return __uint_as_float(((unsigned)b) << 16); }
__device__ __forceinline__ void unpack8(v4u w, float* f) { f[0] = bflo(w.x); f[1] = bfhi(w.x); f[2] = bflo(w.y); f[3] = bfhi(w.y); f[4] = bflo(w.z); f[5] = bfhi(w.z); f[6] = bflo(w.w); f[7] = bfhi(w.w); }
__device__ __forceinline__ bf16 f2bf(float f) { return (bf16)(cvtpk(f, 0.f) & 0xffffu); }
__device__ __forceinline__ float sigm(float x) { return 1.f / (1.f + __expf(-x)); }
__device__ __forceinline__ float silu(float x) { return x / (1.f + __expf(-x)); }
__device__ __forceinline__ float lg2gamma(int h) { return log2f(1.0f - exp2f(-5.0f - (float)h)); }
__device__ __forceinline__ float wave_sum(float v) {
#pragma unroll
    for (int o = 1; o < 64; o <<= 1) v += __shfl_xor(v, o);
    return v;
}
__device__ __forceinline__ float wave_max(float v) {
#pragma unroll
    for (int o = 1; o < 64; o <<= 1) v = fmaxf(v, __shfl_xor(v, o));
    return v;
}
__device__ __forceinline__ int t5_bucket(int n) {
    if (n < 16) return n;
    if (n >= 113) return 31;
    int b = 16 + (int)(logf((float)n * 0.0625f) / 2.0794415416798357f * 16.0f);
    return b < 31 ? b : 31;
}

#define XB_TMO      128
#define XB_XCNT(j)  (256  + 64 * (j))
#define XB_XSUB(j)  (1280 + 64 * (j))
#define XB_XGEN(j)  (2304 + 64 * (j))
#define XB_TOP      3328
#define XB_TOPGEN   3392
#define XCD_BAR_WORDS 3456
#define XB_SPIN_CAP (1u << 18)
__device__ __forceinline__ unsigned xb_ld(unsigned* p)              { return __hip_atomic_load(p, __ATOMIC_RELAXED, __HIP_MEMORY_SCOPE_AGENT); }
__device__ __forceinline__ unsigned xb_add(unsigned* p, unsigned v) { return __hip_atomic_fetch_add(p, v, __ATOMIC_RELAXED, __HIP_MEMORY_SCOPE_AGENT); }
__device__ __forceinline__ unsigned xb_xcc_id() { return (unsigned)__builtin_amdgcn_s_getreg((3 << 11) | 20) & 0xFu; }
#define XB_SPIN(cond, bar) do { unsigned _sp = 0; while (cond) { __builtin_amdgcn_s_sleep(1); \
    if ((++_sp & 255u) == 0u) { if (xb_ld(&(bar)[XB_TMO])) break; if (_sp > XB_SPIN_CAP) { atomicAdd(&(bar)[XB_TMO], 1u); break; } } } } while (0)
struct XcdBarrier { unsigned* bar; unsigned x; volatile LAS unsigned* st; };
__device__ __forceinline__ XcdBarrier xcd_barrier_post(unsigned* bar, volatile LAS unsigned* st) {
    XcdBarrier b; b.bar = bar; b.x = xb_xcc_id(); b.st = st;
    if (threadIdx.x == 0) (void)xb_add(&bar[XB_XCNT(b.x)], 1u);
    return b;
}
__device__ __forceinline__ void xcd_barrier_complete(unsigned* bar, unsigned x, unsigned& nloc, unsigned& nx) {
    const unsigned G = gridDim.x * gridDim.y * gridDim.z;
    unsigned sum, cnt, mine, sp = 0u;
    for (;;) {
        sum = 0u; cnt = 0u; mine = 0u;
#pragma unroll
        for (unsigned j = 0; j < 16; ++j) { const unsigned c = xb_ld(&bar[XB_XCNT(j)]); sum += c; cnt += (c > 0u) ? 1u : 0u; mine = (j == x) ? c : mine; }
        if (sum == G) break;
        __builtin_amdgcn_s_sleep(1);
        if ((++sp & 255u) == 0u) { if (xb_ld(&bar[XB_TMO])) break; if (sp > XB_SPIN_CAP) { atomicAdd(&bar[XB_TMO], 1u); break; } }
    }
    nloc = mine > 0u ? mine : 1u; nx = cnt > 0u ? cnt : 1u;
}
__device__ __forceinline__ void xcd_barrier(const XcdBarrier& b) {
    asm volatile("s_waitcnt vmcnt(0)" ::: "memory");
    __syncthreads();
    if (threadIdx.x == 0) {
        unsigned* bar = b.bar;
        __builtin_amdgcn_s_waitcnt(0);
        unsigned nloc = b.st[0], nx = b.st[1];
        if (nloc == 0u) { xcd_barrier_complete(bar, b.x, nloc, nx); b.st[0] = nloc; b.st[1] = nx; }
        const unsigned old = xb_add(&bar[XB_XSUB(b.x)], 1u);
        const unsigned gen = old / nloc;
        if (old + 1u == (gen + 1u) * nloc) {
            __builtin_amdgcn_fence(__ATOMIC_RELEASE, "agent");
            asm volatile("s_waitcnt vmcnt(0)" ::: "memory");
            const unsigned og = xb_add(&bar[XB_TOP], 1u);
            const unsigned tg = og / nx;
            if (og + 1u == (tg + 1u) * nx) xb_add(&bar[XB_TOPGEN], 1u);
            else XB_SPIN(xb_ld(&bar[XB_TOPGEN]) == tg, bar);
            __builtin_amdgcn_fence(__ATOMIC_ACQUIRE, "agent");
            xb_add(&bar[XB_XGEN(b.x)], 1u);
            asm volatile("s_waitcnt vmcnt(0)" ::: "memory");
        } else {
            XB_SPIN(xb_ld(&bar[XB_XGEN(b.x)]) == gen, bar);
            __builtin_amdgcn_fence(__ATOMIC_ACQUIRE, "agent");
            asm volatile("s_waitcnt vmcnt(0)" ::: "memory");
        }
    }
    __syncthreads();
}

using pg8::Unit;
typedef const f32x4 (&AccRef)[2][2][4][2];
#define EPI_ROW(u, ai, m) ((u).pm * 256 + (ai) * 128 + wr * 64 + (m) * 16 + fr)
#define EPI_COL(bj) ((bj) * 128 + wc * 32 + 8 * fq)

struct EpiP1N {
    static constexpr bool PERM = true, AFTER_DRAIN = false;
    const float* rinv; const f32x4* tabA; bf16* AP; bf16* KN;
    __device__ __forceinline__ void operator()(AccRef acc, const Unit& u, int wr, int wc, int fr, int fq) const {
        const int h = u.pn & 3; const bool isk = u.pn >= 4; const float lg = lg2gamma(h);
#pragma unroll
        for (int ai = 0; ai < 2; ++ai)
#pragma unroll
            for (int m = 0; m < 4; ++m) {
                const int t = EPI_ROW(u, ai, m); const int p = t & (RCH - 1), c = t / RCH;
                const float rs = rinv[t] * (isk ? 0.0625f * exp2f(-(float)p * lg) : exp2f((float)p * lg));
#pragma unroll
                for (int bj = 0; bj < 2; ++bj) {
                    const int d0 = EPI_COL(bj);
                    const f32x4 c0 = tabA[(size_t)t * 64 + (d0 >> 2)], c1 = tabA[(size_t)t * 64 + (d0 >> 2) + 1];
                    const f32x4 v0 = acc[ai][bj][m][0] * rs, v1 = acc[ai][bj][m][1] * rs;
                    const f32x4 o0 = {v0[0] * c0[0] - v0[1] * c0[1], v0[0] * c0[1] + v0[1] * c0[0], v0[2] * c0[2] - v0[3] * c0[3], v0[2] * c0[3] + v0[3] * c0[2]};
                    const f32x4 o1 = {v1[0] * c1[0] - v1[1] * c1[1], v1[0] * c1[1] + v1[1] * c1[0], v1[2] * c1[2] - v1[3] * c1[3], v1[2] * c1[3] + v1[3] * c1[2]};
                    const v4u w = pack8(o0, o1);
                    if (isk) *(v4u*)(KN + (size_t)t * 1024 + h * 256 + d0) = w;
                    else *(v4u*)(AP + ((size_t)(h * NCH + c) * RCH + p) * APLD + RCH + d0) = w;
                }
            }
    }
};
struct EpiP1S {
    static constexpr bool PERM = true, AFTER_DRAIN = false;
    const float* rinv; const f32x4* tabB; bf16* KT; bf16* BP;
    __device__ __forceinline__ void operator()(AccRef acc, const Unit& u, int wr, int wc, int fr, int fq) const {
        const bool isk = u.pm < 4; const float lg = lg2gamma(u.pm & 3);
#pragma unroll
        for (int bj = 0; bj < 2; ++bj) {
            const int t0 = u.pn * 256 + EPI_COL(bj); const int c = t0 / RCH, p0 = t0 & (RCH - 1);
            const f32x4 r0 = *(const f32x4*)(rinv + t0), r1 = *(const f32x4*)(rinv + t0 + 4);
            f32x4 s0, s1;
#pragma unroll
            for (int j = 0; j < 4; ++j) { s0[j] = r0[j] * 0.0625f * exp2f(-(float)(p0 + j) * lg); s1[j] = r1[j] * 0.0625f * exp2f(-(float)(p0 + 4 + j) * lg); }
#pragma unroll
            for (int ai = 0; ai < 2; ++ai)
#pragma unroll
                for (int m = 0; m < 4; ++m) {
                    const int row = EPI_ROW(u, ai, m);
                    if (isk) {
                        const int d = row & 255, i = d >> 1; const bool odd = d & 1;
                        const f32x4 v0 = acc[ai][bj][m][0] * s0, v1 = acc[ai][bj][m][1] * s1; f32x4 q0, q1;
#pragma unroll
                        for (int j = 0; j < 4; ++j) { q0[j] = __shfl_xor(v0[j], 1); q1[j] = __shfl_xor(v1[j], 1); }
                        const f32x4* tb = tabB + ((size_t)i * SEQ + t0) / 2;
                        const f32x4 ca = tb[0], cb = tb[1], cc = tb[2], cd = tb[3];
                        f32x4 o0, o1;
                        if (odd) { o0 = (f32x4){q0[0] * ca[1] + v0[0] * ca[0], q0[1] * ca[3] + v0[1] * ca[2], q0[2] * cb[1] + v0[2] * cb[0], q0[3] * cb[3] + v0[3] * cb[2]};
                                   o1 = (f32x4){q1[0] * cc[1] + v1[0] * cc[0], q1[1] * cc[3] + v1[1] * cc[2], q1[2] * cd[1] + v1[2] * cd[0], q1[3] * cd[3] + v1[3] * cd[2]}; }
                        else     { o0 = (f32x4){v0[0] * ca[0] - q0[0] * ca[1], v0[1] * ca[2] - q0[1] * ca[3], v0[2] * cb[0] - q0[2] * cb[1], v0[3] * cb[2] - q0[3] * cb[3]};
                                   o1 = (f32x4){v1[0] * cc[0] - q1[0] * cc[1], v1[1] * cc[2] - q1[1] * cc[3], v1[2] * cd[0] - q1[2] * cd[1], v1[3] * cd[2] - q1[3] * cd[3]}; }
                        *(v4u*)(KT + (size_t)row * SEQ + t0) = pack8(o0, o1);
                    } else {
                        const int eg = row - 1024, h = eg >> 9, e = eg & 511;
                        *(v4u*)(BP + ((size_t)(h * NCH + c) * RCH + e) * APLD + p0) = pack8(acc[ai][bj][m][0] * r0, acc[ai][bj][m][1] * r1);
                    }
                }
        }
    }
};
struct EpiG {
    static constexpr bool PERM = true, AFTER_DRAIN = false;
    const float* rinv; const float* gslots; bf16* O;
    __device__ __forceinline__ void operator()(AccRef acc, const Unit& u, int wr, int wc, int fr, int fq) const {
        const int h = u.pn >> 1;
#pragma unroll
        for (int ai = 0; ai < 2; ++ai)
#pragma unroll
            for (int m = 0; m < 4; ++m) {
                const int row = EPI_ROW(u, ai, m); const float rin = rinv[row];
                const f32x4 sa = *(const f32x4*)(gslots + (size_t)row * 32 + h * 8), sb = *(const f32x4*)(gslots + (size_t)row * 32 + h * 8 + 4);
                const float ss = ((sa[0] + sa[1]) + (sa[2] + sa[3])) + ((sb[0] + sb[1]) + (sb[2] + sb[3]));
                const float rs = rsqrtf(ss * (1.0f / RDV) + RMS_EPS);
#pragma unroll
                for (int bj = 0; bj < 2; ++bj) {
                    bf16* op = O + (size_t)row * 2048 + u.pn * 256 + EPI_COL(bj);
                    float o[8]; unpack8(*(const v4u*)op, o);
                    const f32x4 g0 = acc[ai][bj][m][0] * rin, g1 = acc[ai][bj][m][1] * rin; f32x4 a, b;
#pragma unroll
                    for (int j = 0; j < 4; ++j) { a[j] = o[j] * rs * silu(g0[j]); b[j] = o[4 + j] * rs * silu(g1[j]); }
                    *(v4u*)op = pack8(a, b);
                }
            }
    }
};
struct EpiOut {
    static constexpr bool PERM = true, AFTER_DRAIN = false;
    bf16* MIX; float* oslots;
    __device__ __forceinline__ void operator()(AccRef acc, const Unit& u, int wr, int wc, int fr, int fq) const {
#pragma unroll
        for (int ai = 0; ai < 2; ++ai)
#pragma unroll
            for (int m = 0; m < 4; ++m) {
                const int row = EPI_ROW(u, ai, m); float ss = 0.f;
#pragma unroll
                for (int bj = 0; bj < 2; ++bj) {
                    const f32x4 v0 = acc[ai][bj][m][0], v1 = acc[ai][bj][m][1];
                    ss += (v0[0] * v0[0] + v0[1] * v0[1]) + (v0[2] * v0[2] + v0[3] * v0[3]) + (v1[0] * v1[0] + v1[1] * v1[1]) + (v1[2] * v1[2] + v1[3] * v1[3]);
                    *(v4u*)(MIX + (size_t)row * 1024 + u.pn * 256 + EPI_COL(bj)) = pack8(v0, v1);
                }
                ss += __shfl_xor(ss, 16); ss += __shfl_xor(ss, 32);
                if (fq == 0) oslots[(size_t)row * 16 + u.pn * 4 + wc] = ss;
            }
    }
};
struct EpiFfnIn {
    static constexpr bool PERM = true, AFTER_DRAIN = false;
    const float* rinv; bf16* HID;
    __device__ __forceinline__ void operator()(AccRef acc, const Unit& u, int wr, int wc, int fr, int fq) const {
#pragma unroll
        for (int ai = 0; ai < 2; ++ai)
#pragma unroll
            for (int m = 0; m < 4; ++m) {
                const int row = EPI_ROW(u, ai, m); const float rin = rinv[row];
                const f32x4 a0 = acc[ai][0][m][0] * rin, a1 = acc[ai][0][m][1] * rin, b0 = acc[ai][1][m][0] * rin, b1 = acc[ai][1][m][1] * rin; f32x4 x, y;
#pragma unroll
                for (int j = 0; j < 4; ++j) { x[j] = silu(a0[j]) * b0[j]; y[j] = silu(a1[j]) * b1[j]; }
                *(v4u*)(HID + (size_t)row * FFH + u.pn * 128 + wc * 32 + 8 * fq) = pack8(x, y);
            }
    }
};
struct EpiKvqN {
    static constexpr bool PERM = true, AFTER_DRAIN = false;
    const float* rinv; bf16 *KC, *VC, *KS, *KW, *Q; float* GATE;
    __device__ __forceinline__ void operator()(AccRef acc, const Unit& u, int wr, int wc, int fr, int fq) const {
        bf16* plane = u.pn == 0 ? KC : u.pn == 1 ? VC : u.pn == 2 ? KS : KW;
#pragma unroll
        for (int ai = 0; ai < 2; ++ai)
#pragma unroll
            for (int m = 0; m < 4; ++m) {
                const int row = EPI_ROW(u, ai, m); const float rin = rinv[row]; const int b = row / SEQ, t = row % SEQ;
#pragma unroll
                for (int bj = 0; bj < 2; ++bj) {
                    const int cc = EPI_COL(bj);
                    f32x4 v0 = acc[ai][bj][m][0] * rin, v1 = acc[ai][bj][m][1] * rin;
                    if (u.pn < 4) { const int g = cc >> 6, d = cc & 63; *(v4u*)(plane + ((size_t)(b * NG + g) * SEQ + t) * HD + d) = pack8(v0, v1); }
                    else if (u.pn < 8) { *(v4u*)(Q + (size_t)row * 1024 + (u.pn - 4) * 256 + cc) = pack8(v0 * 0.125f, v1 * 0.125f); }
                    else if (cc < 48) {
#pragma unroll
                        for (int j = 0; j < 4; ++j) { v0[j] = sigm(v0[j]); v1[j] = sigm(v1[j]); }
                        *(f32x4*)(GATE + (size_t)row * 48 + cc) = v0; *(f32x4*)(GATE + (size_t)row * 48 + cc + 4) = v1;
                    }
                }
            }
    }
};
struct EpiKvqS {
    static constexpr bool PERM = true, AFTER_DRAIN = false;
    const float* rinv; bf16 *VST, *VWT;
    __device__ __forceinline__ void operator()(AccRef acc, const Unit& u, int wr, int wc, int fr, int fq) const {
        bf16* plane = u.pm == 0 ? VST : VWT;
#pragma unroll
        for (int bj = 0; bj < 2; ++bj) {
            const int mg = u.pn * 256 + EPI_COL(bj); const int b = mg / SEQ, t = mg % SEQ;
            const f32x4 r0 = *(const f32x4*)(rinv + mg), r1 = *(const f32x4*)(rinv + mg + 4);
#pragma unroll
            for (int ai = 0; ai < 2; ++ai)
#pragma unroll
                for (int m = 0; m < 4; ++m) {
                    const int r256 = ai * 128 + wr * 64 + m * 16 + fr; const int g = r256 >> 6, d = r256 & 63;
                    *(v4u*)(plane + ((size_t)((b * NG + g) * HD + d)) * SEQ + t) = pack8(acc[ai][bj][m][0] * r0, acc[ai][bj][m][1] * r1);
                }
        }
    }
};
struct EpiCmp {
    static constexpr bool PERM = true, AFTER_DRAIN = false;
    const float* peb; bf16* HIDC;
    __device__ __forceinline__ void operator()(AccRef acc, const Unit& u, int wr, int wc, int fr, int fq) const {
        const int kv = u.pm >= 32 ? 1 : 0;
#pragma unroll
        for (int bj = 0; bj < 2; ++bj) {
            const int col = EPI_COL(bj);
            const f32x4 b0 = *(const f32x4*)(peb + kv * 256 + col), b1 = *(const f32x4*)(peb + kv * 256 + col + 4);
#pragma unroll
            for (int ai = 0; ai < 2; ++ai)
#pragma unroll
                for (int m = 0; m < 4; ++m) {
                    const int row = EPI_ROW(u, ai, m); f32x4 x = acc[ai][bj][m][0] + b0, y = acc[ai][bj][m][1] + b1;
#pragma unroll
                    for (int j = 0; j < 4; ++j) { x[j] = silu(x[j]); y[j] = silu(y[j]); }
                    *(v4u*)(HIDC + (size_t)row * 256 + col) = pack8(x, y);
                }
        }
    }
};
struct MapCmp { __device__ __forceinline__ void operator()(Unit& u) const { u.offA = (size_t)u.pm * 256 * 1024 * 2; u.offB = (size_t)(u.pm >= 32 ? 256 : 0) * 2048 * 2; } };

constexpr int NWAVES = 8, NTHREADS = NWAVES * 64;
constexpr int RING_OFF = 0, RING_BYTES = 131072;
constexpr int LDSCTL_OFF = RING_BYTES, MISC_OFF = LDSCTL_OFF + 320;
constexpr int LDS_BYTES = 147456;
constexpr int CW_BAR = 4096;

struct Args { const float* in[20]; float* out; unsigned char* ws; int ph, b; };
struct Frame {
    LAS unsigned char* lds; unsigned char* ws; float* out; const float* const* in;
    int tid, lane, wave, G, vcu, gw, NGW;
};

template <class DestRow>
__device__ __forceinline__ void transpose_item(const float* W, int K, int ldw, int ncols, const float* gain, bf16* WT, LAS float* scr, int k0, int n0, int lane, const DestRow& dr) {
#pragma unroll 8
    for (int i = 0; i < 32; ++i) { const int kk = 2 * i + (lane >> 5), n = n0 + (lane & 31);
        float v = 0.f; if (n < ncols) v = W[(size_t)(k0 + kk) * ldw + n]; if (gain) v *= gain[k0 + kk];
        scr[kk * 33 + (lane & 31)] = v; }
    asm volatile("s_waitcnt lgkmcnt(0)" ::: "memory");
    const int c = lane & 7;
#pragma unroll
    for (int j = 0; j < 4; ++j) { const int n = (lane >> 3) + 8 * j; const LAS float* s = scr + (8 * c) * 33 + n;
        v4u o; o.x = cvtpk(s[0 * 33], s[1 * 33]); o.y = cvtpk(s[2 * 33], s[3 * 33]); o.z = cvtpk(s[4 * 33], s[5 * 33]); o.w = cvtpk(s[6 * 33], s[7 * 33]);
        const int drow = dr(n0 + n); if (drow >= 0) *(v4u*)(WT + (size_t)drow * K + k0 + 8 * c) = o; }
    asm volatile("s_waitcnt lgkmcnt(0)" ::: "memory");
}
template <class DestRow>
__device__ __forceinline__ void transpose_matrix(const Frame& F, const float* W, int K, int ldw, int ncols, int ncols_pad, const float* gain, bf16* WT, const DestRow& dr) {
    LAS float* scr = (LAS float*)(F.lds + RING_OFF + F.wave * 16384);
    const int nblk = ncols_pad / 32, items = (K / 64) * nblk;
    for (int it = F.gw; it < items; it += F.NGW) transpose_item(W, K, ldw, ncols, gain, WT, scr, 64 * (it / nblk), 32 * (it % nblk), F.lane, dr);
}
struct DrOff { int off; __device__ __forceinline__ int operator()(int n) const { return n + off; } };
struct DrFfn { __device__ __forceinline__ int operator()(int n) const { const int up = n >= FFH, j = up ? n - FFH : n; return (j >> 7) * 256 + up * 128 + (j & 127); } };
struct DrKv { __device__ __forceinline__ int operator()(int n) const {
        const int s = n >> 8, d = n & 255; return s < 3 ? n : s == 3 ? 2304 + d : s == 4 ? 768 + d : 2304 + 256 + d; } };

__device__ __forceinline__ void row_to_bf16(const float* xrow, bf16* orow, float* rinv, int lane) {
    const f32x4* xr = (const f32x4*)xrow + lane; f32x4 v[4]; float s = 0.f;
#pragma unroll
    for (int j = 0; j < 4; ++j) { v[j] = xr[64 * j]; s += (v[j][0] * v[j][0] + v[j][1] * v[j][1]) + (v[j][2] * v[j][2] + v[j][3] * v[j][3]); }
    s = wave_sum(s);
    v2u* o8 = (v2u*)orow + lane;
#pragma unroll
    for (int j = 0; j < 4; ++j) { v2u w; w.x = cvtpk(v[j][0], v[j][1]); w.y = cvtpk(v[j][2], v[j][3]); o8[64 * j] = w; }
    if (lane == 0) *rinv = rsqrtf(s * (1.0f / DM) + RMS_EPS);
}

__device__ __forceinline__ void phase_prologue(const Frame& F) {
    unsigned char* ws = F.ws; const float* const* in = F.in;
    transpose_matrix(F, in[7], DM, RIN, RIN, RIN, in[1], (bf16*)(ws + W_RI), DrOff{0});
    transpose_matrix(F, in[8], 2048, DM, DM, DM, nullptr, (bf16*)(ws + W_RO), DrOff{0});
    transpose_matrix(F, in[5], DM, 2 * FFH, 2 * FFH, 2 * FFH, in[3], (bf16*)(ws + W_FI0), DrFfn{});
    transpose_matrix(F, in[5] + (size_t)DM * 2 * FFH, DM, 2 * FFH, 2 * FFH, 2 * FFH, in[3] + DM, (bf16*)(ws + W_FI1), DrFfn{});
    transpose_matrix(F, in[6], FFH, DM, DM, DM, nullptr, (bf16*)(ws + W_FO0), DrOff{0});
    transpose_matrix(F, in[6] + (size_t)FFH * DM, FFH, DM, DM, DM, nullptr, (bf16*)(ws + W_FO1), DrOff{0});
    transpose_matrix(F, in[10], DM, 1536, 1536, 1536, in[9], (bf16*)(ws + W_KVQ), DrKv{});
    transpose_matrix(F, in[17], DM, NSAIN, NSAIN, 1280, in[1] + DM, (bf16*)(ws + W_KVQ), DrOff{1024});
    transpose_matrix(F, in[18], DM, DM, DM, DM, nullptr, (bf16*)(ws + W_NO), DrOff{0});
    transpose_matrix(F, in[12], 2048, 256, 256, 256, nullptr, (bf16*)(ws + W_C1), DrOff{0});
    transpose_matrix(F, in[15], 2048, 256, 256, 256, nullptr, (bf16*)(ws + W_C1), DrOff{256});
    {
        f32x2_t* tabA = (f32x2_t*)(ws + WS_TABA); f32x2_t* tabB = (f32x2_t*)(ws + WS_TABB);
        for (int idx = F.vcu * NTHREADS + F.tid; idx < SEQ * 128; idx += F.G * NTHREADS) {
            const int t = idx >> 7, i = idx & 127;
            const float theta = 1.0f / powf(10000.0f, (float)i * (1.0f / 127.0f));
            const float ang = (float)t * theta; float s, c; sincosf(ang, &s, &c);
            const f32x2_t v = {c, s}; tabA[idx] = v; tabB[(size_t)i * SEQ + t] = v;
        }
    }
    for (int m = F.gw; m < MTOK; m += F.NGW) row_to_bf16(in[0] + (size_t)m * DM, (bf16*)(ws + WS_XB) + (size_t)m * DM, (float*)(ws + WS_RINV) + m, F.lane);
    if (blockIdx.x == 0) for (int i = F.tid; i < 128 * 16; i += NTHREADS) ((float*)(ws + WS_BIAST))[i] = in[19][t5_bucket(i >> 4) * 16 + (i & 15)];
    if (blockIdx.x < 32) {
        const int kv = F.tid >> 8, c = F.tid & 255; const float* pe = kv ? in[14] : in[11]; const float* w1 = kv ? in[15] : in[12]; float s = 0.f;
        for (int k = 64 * blockIdx.x; k < 64 * blockIdx.x + 64; ++k) s += pe[k] * w1[(size_t)k * 256 + c];
        ((float*)(ws + WS_PEBP))[blockIdx.x * 512 + F.tid] = s;
    }
}
__device__ __forceinline__ void phase_peb_final(const Frame& F) {
    if (blockIdx.x == 0) { float s = 0.f; for (int w = 0; w < 32; ++w) s += ((const float*)(F.ws + WS_PEBP))[w * 512 + F.tid]; ((float*)(F.ws + WS_PEB))[F.tid] = s; }
}

__device__ __forceinline__ void phase_resid(const Frame& F, const float* hold, const float* gpost, bool last) {
    const bf16* MIX = (const bf16*)(F.ws + WS_MIX); const float* oslots = (const float*)(F.ws + WS_OSLOT);
    bf16* XB = (bf16*)(F.ws + WS_XB); float* rinv = (float*)(F.ws + WS_RINV);
    f32x4 gp[4];
#pragma unroll
    for (int j = 0; j < 4; ++j) gp[j] = ((const f32x4*)gpost)[F.lane + 64 * j];
    for (int m = F.gw; m < MTOK; m += F.NGW) {
        const f32x4* sl = (const f32x4*)(oslots + (size_t)m * 16); const f32x4 s0 = sl[0], s1 = sl[1], s2 = sl[2], s3 = sl[3];
        const float ss = (((s0[0] + s0[1]) + (s0[2] + s0[3])) + ((s1[0] + s1[1]) + (s1[2] + s1[3]))) + (((s2[0] + s2[1]) + (s2[2] + s2[3])) + ((s3[0] + s3[1]) + (s3[2] + s3[3])));
        const float rs = rsqrtf(ss * (1.0f / DM) + RMS_EPS);
        const f32x4* hr = (const f32x4*)(hold + (size_t)m * DM) + F.lane; const v2u* mr = (const v2u*)(MIX + (size_t)m * DM) + F.lane;
        f32x4 hn[4]; float s = 0.f;
#pragma unroll
        for (int j = 0; j < 4; ++j) { const f32x4 hv = hr[64 * j]; const v2u mw = mr[64 * j];
            const f32x4 mx = {bflo(mw.x), bfhi(mw.x), bflo(mw.y), bfhi(mw.y)};
            hn[j] = hv + mx * rs * gp[j]; s += (hn[j][0] * hn[j][0] + hn[j][1] * hn[j][1]) + (hn[j][2] * hn[j][2] + hn[j][3] * hn[j][3]); }
        f32x4* ho = (f32x4*)(F.out + (size_t)m * DM) + F.lane;
#pragma unroll
        for (int j = 0; j < 4; ++j) ho[64 * j] = hn[j];
        if (!last) {
            s = wave_sum(s); v2u* o8 = (v2u*)(XB + (size_t)m * DM) + F.lane;
#pragma unroll
            for (int j = 0; j < 4; ++j) { v2u w; w.x = cvtpk(hn[j][0], hn[j][1]); w.y = cvtpk(hn[j][2], hn[j][3]); o8[64 * j] = w; }
            if (F.lane == 0) rinv[m] = rsqrtf(s * (1.0f / DM) + RMS_EPS);
        }
    }
}

__device__ __forceinline__ void phase_ret_naive(const Frame& F, int b) {
    const bf16* AP = (const bf16*)(F.ws + WS_AP); const bf16* BP = (const bf16*)(F.ws + WS_BP); const bf16* KN = (const bf16*)(F.ws + WS_KN);
    bf16* O = (bf16*)F.out;
    for (int item = blockIdx.x; item < RH * 8; item += F.G) {
        const int h = item >> 3, et = item & 7, el = F.tid >> 3, ds = F.tid & 7, e = et * 64 + el;
        const float cdec = exp2f((float)RCH * lg2gamma(h));
        float U[32];
#pragma unroll
        for (int i = 0; i < 32; ++i) U[i] = 0.f;
        v4u kb[4], qb[4]; bf16 vb;
#define RN_LOAD(tt, KB, QB, VB) do { const int c_ = (tt) / RCH, p_ = (tt) & (RCH - 1); \
            const v4u* kp_ = (const v4u*)(KN + (size_t)(tt) * 1024 + h * 256 + ds * 32); const v4u* qp_ = (const v4u*)(AP + ((size_t)(h * NCH + c_) * RCH + p_) * APLD + RCH + ds * 32); \
            _Pragma("unroll") for (int j_ = 0; j_ < 4; ++j_) { KB[j_] = kp_[j_]; QB[j_] = qp_[j_]; } VB = BP[((size_t)(h * NCH + c_) * RCH + e) * APLD + p_]; } while (0)
        RN_LOAD(0, kb, qb, vb);
        for (int t = 0; t < SEQ; ++t) {
            v4u kn[4], qn[4]; bf16 vn; const int tn = t + 1 < SEQ ? t + 1 : t;
            RN_LOAD(tn, kn, qn, vn);
            const float v = bf2f(vb); float acc = 0.f;
#pragma unroll
            for (int j = 0; j < 4; ++j) { float kf[8], qf[8]; unpack8(kb[j], kf); unpack8(qb[j], qf);
#pragma unroll
                for (int i = 0; i < 8; ++i) { U[8 * j + i] += kf[i] * v; acc += qf[i] * U[8 * j + i]; } }
            acc += __shfl_xor(acc, 1); acc += __shfl_xor(acc, 2); acc += __shfl_xor(acc, 4);
            if (ds == 0) O[(size_t)(b * SEQ + t) * 2048 + h * 512 + e] = f2bf(acc);
            if ((t & (RCH - 1)) == RCH - 1) {
#pragma unroll
                for (int i = 0; i < 32; ++i) U[i] *= cdec; }
#pragma unroll
            for (int j = 0; j < 4; ++j) { kb[j] = kn[j]; qb[j] = qn[j]; } vb = vn;
        }
#undef RN_LOAD
    }
}
__device__ __forceinline__ void phase_ret_ssq(const Frame& F, int b) {
    const bf16* O = (const bf16*)F.out; float* gs = (float*)(F.ws + WS_GSLOT);
    for (int r = F.gw; r < SEQ * RH; r += F.NGW) {
        const int m = b * SEQ + (r >> 2), h = r & 3; float f[8]; unpack8(((const v4u*)(O + (size_t)m * 2048 + h * 512))[F.lane], f);
        float s = 0.f;
#pragma unroll
        for (int i = 0; i < 8; ++i) s += f[i] * f[i];
        s = wave_sum(s);
        if (F.lane < 8) gs[(size_t)m * 32 + h * 8 + F.lane] = F.lane == 0 ? s : 0.f;
    }
}

__device__ __forceinline__ void phase_cmp2(const Frame& F) {
    const bf16* HIDC = (const bf16*)(F.ws + WS_HIDC); bf16* KCMP = (bf16*)(F.ws + WS_KCMP); bf16* VCT = (bf16*)(F.ws + WS_VCMPT);
    LAS float* scr = (LAS float*)(F.lds + RING_OFF + F.wave * 2048);
    for (int R = F.gw; R < 16384; R += F.NGW) {
        const int kv = R >> 13, pl = (R >> 10) & 7, n = R & 1023; const float* w2 = kv ? F.in[16] : F.in[13];
        const v2u hw = ((const v2u*)(HIDC + (size_t)R * 256))[F.lane];
        scr[4 * F.lane + 0] = bflo(hw.x); scr[4 * F.lane + 1] = bfhi(hw.x); scr[4 * F.lane + 2] = bflo(hw.y); scr[4 * F.lane + 3] = bfhi(hw.y);
        asm volatile("s_waitcnt lgkmcnt(0)" ::: "memory");
        float s = 0.f;
#pragma unroll 8
        for (int c = 0; c < 256; ++c) s += scr[c] * w2[c * 64 + F.lane];
        if (n == NCMP) s = 0.f;
        if (kv == 0) KCMP[((size_t)pl * 1024 + n) * 64 + F.lane] = f2bf(s);
        else VCT[((size_t)pl * 64 + F.lane) * 1024 + n] = f2bf(s);
        asm volatile("s_waitcnt lgkmcnt(0)" ::: "memory");
    }
}

__device__ __forceinline__ float dot64(const float* q, const bf16* krow) {
    const v4u* kp = (const v4u*)krow; float s = 0.f;
#pragma unroll
    for (int j = 0; j < 8; ++j) { float kf[8]; unpack8(kp[j], kf);
#pragma unroll
        for (int i = 0; i < 8; ++i) s += q[8 * j + i] * kf[i]; }
    return s;
}
__device__ __forceinline__ void wave_softmax(LAS float* S, int n, int n8, int ln) {
    float mx = -INFINITY;
    for (int i = ln; i < n; i += 64) mx = fmaxf(mx, S[i]);
    mx = wave_max(mx); if (!(mx > -INFINITY)) mx = 0.f;
    float sum = 0.f;
    for (int i = ln; i < n; i += 64) { const float p = __expf(S[i] - mx); S[i] = p; sum += p; }
    sum = wave_sum(sum); const float inv = 1.0f / fmaxf(sum, 1.17549435e-38f);
    for (int i = ln; i < n8; i += 64) S[i] = i < n ? S[i] * inv : 0.f;
}
__device__ __forceinline__ void phase_nsa_naive(const Frame& F) {
    const int half = F.tid >> 8, tl = F.tid & 255, r = tl >> 6, ln = tl & 63;
    LAS float* S = (LAS float*)(F.lds + RING_OFF + half * 32768);
    LAS float* IMPC = S + 4096; LAS float* IMP = IMPC + 1024; LAS int* SELF = (LAS int*)(IMP + 256); LAS int* BLK = SELF + 256;
    LAS float* Sr = S + r * 1024;
    const bf16* Q = (const bf16*)(F.ws + WS_Q); const bf16* KCMP = (const bf16*)(F.ws + WS_KCMP); const bf16* VCT = (const bf16*)(F.ws + WS_VCMPT);
    const bf16* KS = (const bf16*)(F.ws + WS_KS); const bf16* KW = (const bf16*)(F.ws + WS_KW); const bf16* VST = (const bf16*)(F.ws + WS_VST); const bf16* VWT = (const bf16*)(F.ws + WS_VWT);
    const float* GATE = (const float*)(F.ws + WS_GATE); const float* biasT = (const float*)(F.ws + WS_BIAST); bf16* ONSA = (bf16*)(F.ws + WS_ONSA);
    for (int it = blockIdx.x; it < MTOK * NG / 2; it += F.G) {
        const int item = it * 2 + half, m = item >> 2, g = item & 3, b = m / SEQ, t = m % SEQ, pl = b * NG + g, H = g * NR + r;
        float q[64];
        { const v4u* qp = (const v4u*)(Q + (size_t)m * 1024 + H * 64);
#pragma unroll
          for (int j = 0; j < 8; ++j) unpack8(qp[j], q + 8 * j); }
        const float* bT = biasT + H;
        const int nvalid = t >= 31 ? ((t - 31) / 16 + 1 < NCMP ? (t - 31) / 16 + 1 : NCMP) : 0, nv8 = (nvalid + 7) & ~7;
        for (int n = ln; n < nvalid; n += 64) { const int dist = t - 16 * n - 31; Sr[n] = dot64(q, KCMP + ((size_t)pl * 1024 + n) * 64) + bT[(dist < 127 ? dist : 127) * 16]; }
        __syncthreads();
        wave_softmax(Sr, nvalid, nv8, ln);
        __syncthreads();
        for (int n = tl; n < 1024; n += 256) IMPC[n] = n < nvalid ? (S[n] + S[1024 + n]) + (S[2048 + n] + S[3072 + n]) : 0.f;
        const int cur = t >> 6;
        SELF[tl] = (tl == 0 || tl == cur || tl == cur - 1) ? 1 : 0;
        __syncthreads();
        { float s = 0.f;
#pragma unroll
          for (int k = -1; k < 4; ++k) { const int n = 4 * tl + k; if (n >= 0 && n < NCMP) s += IMPC[n]; }
          IMP[tl] = s; }
        float oc = 0.f;
        for (int n0 = 0; n0 < nvalid; n0 += 8) { float vf[8]; unpack8(*(const v4u*)(VCT + ((size_t)pl * 64 + ln) * 1024 + n0), vf);
#pragma unroll
            for (int i = 0; i < 8; ++i) oc += Sr[n0 + i] * vf[i]; }
        __syncthreads();
        if (r == 0) {
            const int ncand = cur - 2, nf = cur + 1 < 3 ? cur + 1 : 3, need = 16 - nf;
            if (ncand <= need) { for (int j = ln; j < 256; j += 64) if (j >= 1 && j <= cur - 2) SELF[j] = 1; }
            else {
                float v[4];
#pragma unroll
                for (int i = 0; i < 4; ++i) { const int j = ln + 64 * i; v[i] = (j >= 1 && j <= cur - 2) ? IMP[j] : -INFINITY; }
                for (int round = 0; round < need; ++round) {
                    float bv = v[0]; int bj = ln;
#pragma unroll
                    for (int i = 1; i < 4; ++i) if (v[i] > bv) { bv = v[i]; bj = ln + 64 * i; }
#pragma unroll
                    for (int o = 1; o < 64; o <<= 1) { const float ov = __shfl_xor(bv, o); const int oj = __shfl_xor(bj, o); if (ov > bv || (ov == bv && oj < bj)) { bv = ov; bj = oj; } }
#pragma unroll
                    for (int i = 0; i < 4; ++i) if (bj == ln + 64 * i) { v[i] = -INFINITY; SELF[bj] = 1; }
                }
            }
        }
        __syncthreads();
        int nk = 0;
        for (int j = 0; j <= cur; ++j) {
            if (SELF[j]) {
                const int pos = 64 * j + ln, dist = t - pos;
                Sr[nk * 64 + ln] = pos <= t ? dot64(q, KS + ((size_t)pl * SEQ + pos) * 64) + bT[(dist < 127 ? dist : 127) * 16] : -INFINITY;
                if (tl == 0) BLK[nk] = j;
                ++nk;
            }
        }
        __syncthreads();
        wave_softmax(Sr, nk * 64, nk * 64, ln);
        float os = 0.f;
        for (int k = 0; k < nk; ++k) { const int j = BLK[k];
            for (int l0 = 0; l0 < 64; l0 += 8) { float vf[8]; unpack8(*(const v4u*)(VST + ((size_t)pl * 64 + ln) * SEQ + 64 * j + l0), vf);
#pragma unroll
                for (int i = 0; i < 8; ++i) os += Sr[k * 64 + l0 + i] * vf[i]; } }
        __syncthreads();
        for (int i = ln; i < 512; i += 64) { const int pos = t - 511 + i; Sr[i] = pos >= 0 ? dot64(q, KW + ((size_t)pl * SEQ + pos) * 64) + bT[((511 - i) < 127 ? (511 - i) : 127) * 16] : -INFINITY; }
        wave_softmax(Sr, 512, 512, ln);
        float ow = 0.f;
        for (int i = t >= 511 ? 0 : 511 - t; i < 512; ++i) ow += Sr[i] * bf2f(VWT[((size_t)pl * 64 + ln) * SEQ + (t - 511 + i)]);
        const float* gt = GATE + (size_t)m * 48 + H * 3;
        ONSA[(size_t)m * 1024 + H * 64 + ln] = f2bf(gt[0] * oc + gt[1] * os + gt[2] * ow);
        __syncthreads();
    }
}

template <class Epi, class Map>
__device__ __forceinline__ void run_gemm(const Frame& F, const bf16* A, const bf16* Bt, int lda, int ldb, int K, int nM, int nN, const Map& map, const Epi& E) {
    pg8::Gemm g{A, Bt, lda, ldb, K}; pg8::Order<Map> S; S.init(nM, nN, F.G, (int)blockIdx.x, map);
    pg8::gemm_phase<Epi, pg8::Order<Map>, true, true>(F.lds + RING_OFF, g, S, E, F.tid);
}
enum { PH_PRO, PH_P1N, PH_P1S, PH_RETN, PH_RSSQ, PH_G, PH_OUT, PH_RES, PH_FI, PH_KVQN, PH_KVQS, PH_CMP, PH_CMP2, PH_NSAN, PH_COUNT };

template <int PH> __device__ __forceinline__ void phase_body(const Frame& F, int b) {
    unsigned char* ws = F.ws; float* rinv = (float*)(ws + WS_RINV); bf16* XB = (bf16*)(ws + WS_XB);
    if constexpr (PH == PH_PRO) phase_prologue(F);
    if constexpr (PH == PH_P1N) { EpiP1N E{rinv + b * SEQ, (const f32x4*)(ws + WS_TABA), (bf16*)(ws + WS_AP), (bf16*)(ws + WS_KN)};
        run_gemm(F, XB + (size_t)b * SEQ * DM, (const bf16*)(ws + W_RI), DM, DM, DM, SEQ / 256, 8, pg8::MapPlain{DM, DM}, E); }
    if constexpr (PH == PH_P1S) { EpiP1S E{rinv + b * SEQ, (const f32x4*)(ws + WS_TABB), (bf16*)(ws + WS_KT), (bf16*)(ws + WS_BP)};
        run_gemm(F, (const bf16*)(ws + W_RI) + (size_t)1024 * DM, XB + (size_t)b * SEQ * DM, DM, DM, DM, 12, SEQ / 256, pg8::MapPlain{DM, DM}, E); }
    if constexpr (PH == PH_RETN) phase_ret_naive(F, b);
    if constexpr (PH == PH_RSSQ) phase_ret_ssq(F, b);
    if constexpr (PH == PH_G) { EpiG E{rinv, (const float*)(ws + WS_GSLOT), (bf16*)F.out};
        run_gemm(F, XB, (const bf16*)(ws + W_RI) + (size_t)4096 * DM, DM, DM, DM, MTOK / 256, 8, pg8::MapPlain{DM, DM}, E); }
    if constexpr (PH == PH_OUT) {
        const bf16* A = b == 0 ? (const bf16*)F.out : b == 2 ? (const bf16*)(ws + WS_ONSA) : (const bf16*)(ws + WS_HID);
        const bf16* Bt = (const bf16*)(ws + (b == 0 ? W_RO : b == 1 ? W_FO0 : b == 2 ? W_NO : W_FO1));
        const int K = b == 0 ? 2048 : b == 2 ? DM : FFH;
        EpiOut E{(bf16*)(ws + WS_MIX), (float*)(ws + WS_OSLOT)};
        run_gemm(F, A, Bt, K, K, K, MTOK / 256, 4, pg8::MapPlain{K, K}, E); }
    if constexpr (PH == PH_RES) phase_resid(F, b == 0 ? F.in[0] : F.out, (b & 1 ? F.in[4] : F.in[2]) + (b >> 1) * DM, b == 3);
    if constexpr (PH == PH_FI) { EpiFfnIn E{rinv, (bf16*)(ws + WS_HID)};
        run_gemm(F, XB, (const bf16*)(ws + (b ? W_FI1 : W_FI0)), DM, DM, DM, MTOK / 256, 22, pg8::MapPlain{DM, DM}, E); }
    if constexpr (PH == PH_KVQN) { phase_peb_final(F);
        EpiKvqN E{rinv, (bf16*)(ws + WS_KC), (bf16*)(ws + WS_VC), (bf16*)(ws + WS_KS), (bf16*)(ws + WS_KW), (bf16*)(ws + WS_Q), (float*)(ws + WS_GATE)};
        run_gemm(F, XB, (const bf16*)(ws + W_KVQ), DM, DM, DM, MTOK / 256, 9, pg8::MapPlain{DM, DM}, E); }
    if constexpr (PH == PH_KVQS) { EpiKvqS E{rinv, (bf16*)(ws + WS_VST), (bf16*)(ws + WS_VWT)};
        run_gemm(F, (const bf16*)(ws + W_KVV), XB, DM, DM, DM, 2, MTOK / 256, pg8::MapPlain{DM, DM}, E); }
    if constexpr (PH == PH_CMP) { EpiCmp E{(const float*)(ws + WS_PEB), (bf16*)(ws + WS_HIDC)};
        run_gemm(F, (const bf16*)(ws + WS_KC), (const bf16*)(ws + W_C1), 1024, 2048, 2048, 64, 1, MapCmp{}, E); }
    if constexpr (PH == PH_CMP2) phase_cmp2(F);
    if constexpr (PH == PH_NSAN) phase_nsa_naive(F);
}
__device__ __forceinline__ void make_frame(Frame& F, unsigned char* lds, const Args& args) {
    int tid = threadIdx.x; asm volatile("" : "+v"(tid));
    unsigned char* ws = args.ws; float* out = args.out; asm volatile("" : "+s"(ws), "+s"(out));
    F.lds = (LAS unsigned char*)lds; F.ws = ws; F.out = out; F.in = args.in;
    F.tid = tid; F.lane = tid & 63; F.wave = __builtin_amdgcn_readfirstlane(tid >> 6);
    F.G = gridDim.x; { const int bx = blockIdx.x; F.vcu = (F.G % 8 == 0) ? (bx % 8) * (F.G / 8) + bx / 8 : bx; }
    F.gw = F.vcu * NWAVES + F.wave; F.NGW = F.G * NWAVES;
}
__global__ void __launch_bounds__(NTHREADS, 2) fwd(Args args) {
    extern __shared__ __attribute__((aligned(16))) unsigned char lds[];
    {   LAS unsigned* ctl = (LAS unsigned*)((LAS unsigned char*)lds + LDSCTL_OFF);
        for (int u = threadIdx.x; u < (LDS_BYTES - LDSCTL_OFF) / 4; u += NTHREADS) ctl[u] = 0u; }
    __syncthreads();
    const int lo = args.ph, hi = args.b;
    XcdBarrier bar; bar.bar = (unsigned*)(args.ws + WS_CTL) + CW_BAR; bar.x = 0; bar.st = nullptr;
    if (hi - lo > 1) bar = xcd_barrier_post((unsigned*)(args.ws + WS_CTL) + CW_BAR, (volatile LAS unsigned*)((LAS unsigned char*)lds + MISC_OFF) + 8);
    int ph = 0;
#define RUN(PH, bval) do { if (ph >= lo && ph < hi) { Frame F; make_frame(F, lds, args); phase_body<PH>(F, (bval)); if (ph + 1 < hi) xcd_barrier(bar); } ++ph; } while (0)
    RUN(PH_PRO, 0);
#pragma unroll 1
    for (int layer = 0; layer < 2; ++layer) {
#pragma unroll 1
        for (int sub = 0; sub < 2; ++sub) {
            if (sub == 0) {
                if (layer == 0) {
#pragma unroll 1
                    for (int b = 0; b < NBATCH; ++b) { RUN(PH_P1N, b); RUN(PH_P1S, b); RUN(PH_RETN, b); RUN(PH_RSSQ, b); }
                    RUN(PH_G, 0);
                } else { RUN(PH_KVQN, 0); RUN(PH_KVQS, 0); RUN(PH_CMP, 0); RUN(PH_CMP2, 0); RUN(PH_NSAN, 0); }
            } else RUN(PH_FI, layer);
            RUN(PH_OUT, 2 * layer + sub);
            RUN(PH_RES, 2 * layer + sub);
        }
    }
#undef RUN
}
constexpr int NPHASES = 1 + (8 + 1 + 2) + 3 + (5 + 2) + 3;

#ifndef MK_N_LAUNCH
#define MK_N_LAUNCH 1
#endif
extern "C" void kernel_launch(void* const* d_in, const int* in_sizes, int n_in, void* d_out, int out_size, void* d_ws, size_t ws_size, hipStream_t stream) {
    static int grid = 0;
    if (grid == 0) {
        if (n_in != 20 || out_size != MTOK * DM || ws_size < WS_NEED) { fprintf(stderr, "kernel_launch: unexpected problem shape (n_in %d, out %d, ws %zu)\n", n_in, out_size, ws_size); grid = -1; return; }
        int dev = 0, cus = 0, per_cu = 0;
        if (hipGetDevice(&dev) != hipSuccess || hipDeviceGetAttribute(&cus, hipDeviceAttributeMultiprocessorCount, dev) != hipSuccess) { grid = -1; return; }
        if (hipFuncSetAttribute((const void*)fwd, hipFuncAttributeMaxDynamicSharedMemorySize, LDS_BYTES) != hipSuccess) { fprintf(stderr, "kernel_launch: hipFuncSetAttribute failed\n"); grid = -1; return; }
        if (hipOccupancyMaxActiveBlocksPerMultiprocessor(&per_cu, (const void*)fwd, NTHREADS, LDS_BYTES) != hipSuccess || per_cu < 1) { fprintf(stderr, "kernel_launch: occupancy query says %d blocks per CU\n", per_cu); }
        (void)hipGetLastError();
        grid = cus;
    }
    if (grid < 0) return;
    (void)hipMemsetAsync((char*)d_ws + WS_CTL, 0, CTL_ZERO_BYTES, stream);
    Args a{};
    for (int i = 0; i < 20; ++i) a.in[i] = (const float*)d_in[i];
    a.out = (float*)d_out; a.ws = (unsigned char*)d_ws;
    if (MK_N_LAUNCH == 1) { a.ph = 0; a.b = NPHASES; hipLaunchKernelGGL(fwd, dim3(grid), dim3(NTHREADS), LDS_BYTES, stream, a); }
    else for (int p = 0; p < NPHASES; ++p) { a.ph = p; a.b = p + 1; hipLaunchKernelGGL(fwd, dim3(grid), dim3(NTHREADS), LDS_BYTES, stream, a); }
}
```

```cpp
#include <hip/hip_runtime.h>
#include <cstdio>
#include <cstdint>
#include <utility>

namespace pg8 {
#define PG8_LAS __attribute__((address_space(3)))
typedef unsigned short bf16_t;
typedef short bf16x8 __attribute__((ext_vector_type(8)));
typedef float f32x4 __attribute__((ext_vector_type(4)));
typedef unsigned u32x4 __attribute__((ext_vector_type(4)));
constexpr int BM = 256, BK = 64, HALF = 128, HTB = HALF * BK * 2  , STAGE_BYTES = 8 * HTB, NXCD = 8, WGM = 8;

__host__ __device__ __forceinline__ int lds_byte(int r, int c) { const int st = (r >> 4) * 2 + (c >> 5), rr = r & 15, cc = c & 31, ob = rr * 64 + cc * 2; return st * 1024 + (ob ^ (((ob >> 9) & 1) << 5)); }
__host__ __device__ __forceinline__ void stage_rc(int b, int& R, int& C) { const int st = b / 1024, sb = b % 1024, swz = sb ^ (((sb >> 9) & 1) << 5); R = (st >> 1) * 16 + swz / 64; C = (st & 1) * 32 + (swz % 64) / 2; }
__host__ __device__ __forceinline__ int perm32(int rho) { const int n = rho >> 4, i = rho & 15; return 8 * (i >> 2) + 4 * n + (i & 3); }

struct Unit { int pm, pn; size_t offA, offB; };
struct Gemm { const bf16_t* A; const bf16_t* Bt; int lda, ldb, K; };

template <class Map> struct Order {
    int nM, nN, nwg, G, c; Map map;
    __device__ __forceinline__ void init(int nM_, int nN_, int G_, int c_, const Map& m) { nM = nM_; nN = nN_; nwg = nM * nN; G = G_; c = c_; map = m; }
    __device__ __forceinline__ bool next(int i, Unit& u) const {
        const long L = (long)i * G + c; if (L >= nwg) return false;
        int wgid = (int)L; { const int q = nwg / NXCD, r = nwg % NXCD, xcd = wgid % NXCD, off = wgid / NXCD; wgid = (xcd < r ? xcd * (q + 1) : r * (q + 1) + (xcd - r) * q) + off; }
        const int nig = WGM * nN, gid = wgid / nig, fm = gid * WGM, gsz = (nM - fm) < WGM ? (nM - fm) : WGM;
        u.pm = fm + ((wgid % nig) % gsz); u.pn = (wgid % nig) / gsz; map(u); return true;
    }
    __device__ __forceinline__ void a_ready(const Unit&) const {}
    __device__ __forceinline__ void done(const Unit&) const {}
};
struct MapPlain { int lda, ldb; __device__ __forceinline__ void operator()(Unit& u) const { u.offA = (size_t)u.pm * 256 * lda * 2; u.offB = (size_t)u.pn * 256 * ldb * 2; } };

template <class Epi, class Sched, bool ALIGN_EPI = false, bool SP2 = false>
__device__ __forceinline__ void gemm_phase(PG8_LAS unsigned char* lds, const Gemm g, const Sched& S, const Epi& E, const int tid) {
    const int wid = __builtin_amdgcn_readfirstlane(tid >> 6), lane = tid & 63, wr = wid >> 2, wc = wid & 3, fr = lane & 15, fq = lane >> 4;
    const int K = g.K, nt = K / BK;
    unsigned voffA[2], voffB[2];
#pragma unroll
    for (int i = 0; i < 2; ++i) { int R, C; stage_rc(tid * 16 + i * 8192, R, C); const int Rb = Epi::PERM ? ((R & ~31) + perm32(R & 31)) : R;
        voffA[i] = (unsigned)(R * g.lda + C) * 2u; voffB[i] = (unsigned)(Rb * g.ldb + C) * 2u; }
    const size_t kstep = (size_t)(BK * 2);
    const size_t hstepA = (size_t)HALF * g.lda * 2, hstepB = (size_t)HALF * g.ldb * 2;
    const unsigned ldsw = (unsigned)wid * 1024u;
    const int aoff = lds_byte(wr * 64 + fr, fq * 8), boff = lds_byte(wc * 32 + fr, fq * 8);
#define PG8_SA(b, h) (((b) * 2 + (h)) * HTB)
#define PG8_SB(b, h) ((4 + (b) * 2 + (h)) * HTB)
#define PG8_STAGE(bufoff, gbase, voff) do { _Pragma("unroll") for (int _i = 0; _i < 2; ++_i) \
        __builtin_amdgcn_global_load_lds((const unsigned*)((const char*)(gbase) + (voff)[_i]), (PG8_LAS unsigned*)(lds + (bufoff) + ldsw + _i * 8192), 16, 0, 0); } while (0)
#define PG8_LDA(dst, b, h) do { _Pragma("unroll") for (int m = 0; m < 4; ++m) _Pragma("unroll") for (int k = 0; k < 2; ++k) dst[m][k] = *(const PG8_LAS bf16x8*)(lds + PG8_SA(b, h) + aoff + m * 2048 + k * 1024); } while (0)
#define PG8_LDB(dst, b, h) do { _Pragma("unroll") for (int n = 0; n < 2; ++n) _Pragma("unroll") for (int k = 0; k < 2; ++k) dst[n][k] = *(const PG8_LAS bf16x8*)(lds + PG8_SB(b, h) + boff + n * 2048 + k * 1024); } while (0)
#define PG8_MMA(ai, bj, At, Bt) do { __builtin_amdgcn_s_setprio(1); _Pragma("unroll") for (int m = 0; m < 4; ++m) _Pragma("unroll") for (int n = 0; n < 2; ++n) _Pragma("unroll") for (int k = 0; k < 2; ++k) \
        acc[ai][bj][m][n] = __builtin_amdgcn_mfma_f32_16x16x32_bf16(Bt[n][k], At[m][k], acc[ai][bj][m][n], 0, 0, 0); __builtin_amdgcn_s_setprio(0); } while (0)
#define PG8_WAIT_V(n) asm volatile("s_waitcnt vmcnt(" #n ")" ::: "memory")
#define PG8_WAIT_L(n) asm volatile("s_waitcnt lgkmcnt(" #n ")" ::: "memory")
#define PG8_BAR __builtin_amdgcn_s_barrier()
#define PG8_SCHED __builtin_amdgcn_sched_barrier(0)
    Unit cur, nxt; int ui = 0;
    if (!S.next(0, cur)) return;
    f32x4 acc[2][2][4][2];
#pragma unroll
    for (int a = 0; a < 2; ++a)
#pragma unroll
        for (int b = 0; b < 2; ++b)
#pragma unroll
            for (int m = 0; m < 4; ++m)
#pragma unroll
                for (int n = 0; n < 2; ++n) acc[a][b][m][n] = (f32x4){0.f, 0.f, 0.f, 0.f};
    bf16x8 At[4][2], B0[2][2], B1[2][2];
    const char* cA = (const char*)g.A + cur.offA; const char* cB = (const char*)g.Bt + cur.offB;
    S.a_ready(cur);
    if constexpr (SP2) {
        PG8_STAGE(PG8_SB(0, 0), cB, voffB); PG8_STAGE(PG8_SB(0, 1), cB + hstepB, voffB); PG8_STAGE(PG8_SA(0, 0), cA, voffA); PG8_STAGE(PG8_SA(0, 1), cA + hstepA, voffA);
        if (wr == 1) PG8_BAR;
        PG8_WAIT_V(2); PG8_BAR;
        PG8_STAGE(PG8_SB(1, 0), cB + kstep, voffB); PG8_STAGE(PG8_SA(1, 0), cA + kstep, voffA); PG8_STAGE(PG8_SB(1, 1), cB + hstepB + kstep, voffB);
        PG8_WAIT_V(6); PG8_BAR;
    } else {
        PG8_STAGE(PG8_SB(0, 0), cB, voffB); PG8_STAGE(PG8_SA(0, 0), cA, voffA); PG8_STAGE(PG8_SB(0, 1), cB + hstepB, voffB); PG8_STAGE(PG8_SA(0, 1), cA + hstepA, voffA);
        if (wr == 1) PG8_BAR;
        PG8_WAIT_V(4); PG8_BAR;
        PG8_STAGE(PG8_SB(1, 0), cB + kstep, voffB); PG8_STAGE(PG8_SA(1, 0), cA + kstep, voffA); PG8_STAGE(PG8_SB(1, 1), cB + hstepB + kstep, voffB);
        PG8_WAIT_V(6); PG8_BAR;
    }
    for (;;) {
        const bool has_next = S.next(ui + 1, nxt);
        const char* nA = has_next ? (const char*)g.A + nxt.offA : cA; const char* nB = has_next ? (const char*)g.Bt + nxt.offB : cB;
#pragma unroll 1
        for (int t = 0; t < nt; t += 2) {
            const bool last = (t == nt - 2);
            const char* a1 = cA + (size_t)(t + 1) * kstep;
            const char* a2 = last ? nA : cA + (size_t)(t + 2) * kstep; const char* b2 = last ? nB : cB + (size_t)(t + 2) * kstep;
            const char* a3 = a2 + kstep; const char* b3 = b2 + kstep;
            if (last && has_next) S.a_ready(nxt);
            if constexpr (SP2) {
            PG8_LDB(B0, 0, 0); PG8_LDB(B1, 0, 1); PG8_SCHED; PG8_LDA(At, 0, 0); PG8_STAGE(PG8_SA(1, 1), a1 + hstepA, voffA);
            PG8_WAIT_V(8); PG8_WAIT_L(0); PG8_BAR; PG8_MMA(0, 0, At, B0); PG8_MMA(0, 1, At, B1); PG8_BAR; PG8_SCHED;
            PG8_LDA(At, 0, 1); PG8_STAGE(PG8_SB(0, 0), b2, voffB); PG8_STAGE(PG8_SB(0, 1), b2 + hstepB, voffB); PG8_STAGE(PG8_SA(0, 0), a2, voffA);
            PG8_WAIT_V(8); PG8_WAIT_L(0); PG8_BAR; PG8_MMA(1, 0, At, B0); PG8_MMA(1, 1, At, B1); PG8_BAR; PG8_SCHED;
            PG8_LDB(B0, 1, 0); PG8_LDB(B1, 1, 1); PG8_SCHED; PG8_LDA(At, 1, 0); PG8_STAGE(PG8_SA(0, 1), a2 + hstepA, voffA);
            PG8_WAIT_V(8); PG8_WAIT_L(0); PG8_BAR; PG8_MMA(0, 0, At, B0); PG8_MMA(0, 1, At, B1); PG8_BAR; PG8_SCHED;
            PG8_LDA(At, 1, 1); PG8_STAGE(PG8_SB(1, 0), b3, voffB); PG8_STAGE(PG8_SB(1, 1), b3 + hstepB, voffB); PG8_STAGE(PG8_SA(1, 0), a3, voffA);
            PG8_WAIT_V(8); PG8_WAIT_L(0); PG8_BAR; PG8_MMA(1, 0, At, B0); PG8_MMA(1, 1, At, B1); PG8_BAR; PG8_SCHED;
            } else {
            PG8_LDB(B0, 0, 0); PG8_SCHED; PG8_LDA(At, 0, 0); PG8_STAGE(PG8_SA(1, 1), a1 + hstepA, voffA);
            PG8_WAIT_L(8); PG8_BAR; PG8_WAIT_L(0); PG8_MMA(0, 0, At, B0); PG8_BAR; PG8_SCHED;
            PG8_LDB(B1, 0, 1); PG8_STAGE(PG8_SB(0, 0), b2, voffB);
            PG8_BAR; PG8_WAIT_L(0); PG8_MMA(0, 1, At, B1); PG8_BAR;
            PG8_LDA(At, 0, 1); PG8_STAGE(PG8_SA(0, 0), a2, voffA);
            PG8_BAR; PG8_WAIT_L(0); PG8_MMA(1, 0, At, B0); PG8_BAR; PG8_SCHED;
            PG8_STAGE(PG8_SB(0, 1), b2 + hstepB, voffB);
            PG8_WAIT_V(6); PG8_BAR; PG8_MMA(1, 1, At, B1); PG8_BAR;
            PG8_LDB(B0, 1, 0); PG8_SCHED; PG8_LDA(At, 1, 0); PG8_STAGE(PG8_SA(0, 1), a2 + hstepA, voffA);
            PG8_WAIT_L(8); PG8_BAR; PG8_WAIT_L(0); PG8_MMA(0, 0, At, B0); PG8_BAR; PG8_SCHED;
            PG8_LDB(B1, 1, 1); PG8_STAGE(PG8_SB(1, 0), b3, voffB);
            PG8_BAR; PG8_WAIT_L(0); PG8_MMA(0, 1, At, B1); PG8_BAR;
            PG8_LDA(At, 1, 1); PG8_STAGE(PG8_SA(1, 0), a3, voffA);
            PG8_BAR; PG8_WAIT_L(0); PG8_MMA(1, 0, At, B0); PG8_BAR; PG8_SCHED;
            PG8_STAGE(PG8_SB(1, 1), b3 + hstepB, voffB);
            PG8_WAIT_V(6); PG8_BAR; PG8_MMA(1, 1, At, B1); PG8_BAR;
            }
        }
        if constexpr (ALIGN_EPI) { if (wr == 0) PG8_BAR; }
        if constexpr (!Epi::AFTER_DRAIN) { E(acc, cur, wr, wc, fr, fq); S.done(cur); }
        if (!has_next) break;
#pragma unroll
        for (int a = 0; a < 2; ++a)
#pragma unroll
            for (int b = 0; b < 2; ++b)
#pragma unroll
                for (int m = 0; m < 4; ++m)
#pragma unroll
                    for (int n = 0; n < 2; ++n) acc[a][b][m][n] = (f32x4){0.f, 0.f, 0.f, 0.f};
        cur = nxt; cA = nA; cB = nB; ++ui;
        if constexpr (ALIGN_EPI) { if (wr == 1) PG8_BAR; }
    }
    PG8_WAIT_V(0);
    if constexpr (!ALIGN_EPI) { if (wr == 0) PG8_BAR; }
    PG8_BAR;
    if constexpr (Epi::AFTER_DRAIN) { E.fused(acc, cur, wr, wc, fr, fq, lds, wid, lane); S.done(cur); }
#undef PG8_SA
#undef PG8_SB
#undef PG8_STAGE
#undef PG8_LDA
#undef PG8_LDB
#undef PG8_MMA
#undef PG8_WAIT_V
#undef PG8_WAIT_L
#undef PG8_BAR
#undef PG8_SCHED
}
}

constexpr int DM = 1024, NBATCH = 2, SEQ = 16384, MTOK = NBATCH * SEQ;
constexpr int FFH = 2816;
constexpr int RH = 4, RDK = 256, RDV = 512, RCH = 512, NCH = SEQ / RCH;
constexpr int RIN = 2 * RH * RDK + 2 * RH * RDV;
constexpr int NG = 4, NR = 4, HD = 64, NCMP = 1023, NSEL = 256, NSAIN = 1072;
constexpr float RMS_EPS = 1e-6f;
constexpr int APLD = 768;

constexpr size_t MiB = 1u << 20;
constexpr size_t WS_CTL = 0, CTL_ZERO_BYTES = 1 * MiB;
constexpr size_t WS_RINV = 1 * MiB;
constexpr size_t WS_BIAST = WS_RINV + 256 * 1024;
constexpr size_t WS_PEB = WS_BIAST + 16 * 1024;
constexpr size_t WS_PEBP = WS_PEB + 4 * 1024;
constexpr size_t WS_GSLOT = 2 * MiB;
constexpr size_t WS_OSLOT = 6 * MiB;
constexpr size_t WS_W = 8 * MiB;
constexpr size_t W_RI = WS_W, W_RO = W_RI + 12 * MiB, W_FI0 = W_RO + 4 * MiB, W_FI1 = W_FI0 + 11 * MiB, W_FO0 = W_FI1 + 11 * MiB, W_FO1 = W_FO0 + 11 * MiB / 2,
                 W_KVQ = W_FO1 + 11 * MiB / 2, W_KVV = W_KVQ + 9 * MiB / 2, W_NO = W_KVV + 1 * MiB, W_C1 = W_NO + 2 * MiB, W_END = W_C1 + 2 * MiB;
static_assert(W_END <= 68 * MiB, "weights");
constexpr size_t WS_TABA = 68 * MiB, WS_TABB = 84 * MiB;
constexpr size_t WS_XB = 100 * MiB;
constexpr size_t WS_MIX = 164 * MiB;
constexpr size_t WS_KT = WS_MIX, WS_KV = WS_MIX + 32 * MiB;
constexpr size_t WS_SCR = 228 * MiB;
constexpr size_t WS_AP = WS_SCR, WS_BP = WS_AP + 96 * MiB, WS_KN = WS_BP + 96 * MiB;
static_assert(WS_KN + 32 * MiB <= 512 * MiB, "ret scratch");
constexpr size_t WS_HID = WS_SCR;
constexpr size_t WS_KC = WS_SCR, WS_VC = WS_KC + 16 * MiB, WS_KS = WS_VC + 17 * MiB, WS_KW = WS_KS + 16 * MiB, WS_VST = WS_KW + 16 * MiB, WS_VWT = WS_VST + 16 * MiB,
                 WS_Q = WS_VWT + 16 * MiB, WS_GATE = WS_Q + 64 * MiB, WS_HIDC = WS_GATE + 6 * MiB, WS_KCMP = WS_HIDC + 8 * MiB, WS_VCMPT = WS_KCMP + 1 * MiB, WS_ONSA = WS_VCMPT + 1 * MiB,
                 WS_NSA_END = WS_ONSA + 64 * MiB;
static_assert(WS_NSA_END <= 512 * MiB, "nsa scratch");
constexpr size_t WS_NEED = 512 * MiB;

#define GAS __attribute__((address_space(1)))
#define LAS __attribute__((address_space(3)))
typedef unsigned short bf16;
typedef unsigned v4u __attribute__((ext_vector_type(4)));
typedef unsigned v2u __attribute__((ext_vector_type(2)));
typedef float f32x4 __attribute__((ext_vector_type(4)));
typedef float f32x2_t __attribute__((ext_vector_type(2)));
typedef __bf16 bf16x2_t __attribute__((ext_vector_type(2)));
typedef GAS unsigned gu32;
#define RLX_AGENT __ATOMIC_RELAXED, __HIP_MEMORY_SCOPE_AGENT
__device__ __forceinline__ unsigned cvtpk(float lo, float hi) { f32x2_t v = {lo, hi}; bf16x2_t b = __builtin_convertvector(v, bf16x2_t); return __builtin_bit_cast(unsigned, b); }
__device__ __forceinline__ v4u pack8(f32x4 a, f32x4 b) { v4u w; w.x = cvtpk(a[0], a[1]); w.y = cvtpk(a[2], a[3]); w.z = cvtpk(b[0], b[1]); w.w = cvtpk(b[2], b[3]); return w; }
__device__ __forceinline__ float bflo(unsigned w) { return __uint_as_float(w << 16); }
__device__ __forceinline__ float bfhi(unsigned w) { return __uint_as_float(w & 0xffff0000u); }
__device__ __forceinline__ float bf2f(bf16 b) { return __uint_as_float(((unsigned)b) << 16); }
__device__ __forceinline__ void unpack8(v4u w, float* f) { f[0] = bflo(w.x); f[1] = bfhi(w.x); f[2] = bflo(w.y); f[3] = bfhi(w.y); f[4] = bflo(w.z); f[5] = bfhi(w.z); f[6] = bflo(w.w); f[7] = bfhi(w.w); }
__device__ __forceinline__ bf16 f2bf(float f) { return (bf16)(cvtpk(f, 0.f) & 0xffffu); }
__device__ __forceinline__ float sigm(float x) { return 1.f / (1.f + __expf(-x)); }
__device__ __forceinline__ float silu(float x) { return x / (1.f + __expf(-x)); }
__device__ __forceinline__ float lg2gamma(int h) { return log2f(1.0f - exp2f(-5.0f - (float)h)); }
__device__ __forceinline__ float wave_sum(float v) {
#pragma unroll
    for (int o = 1; o < 64; o <<= 1) v += __shfl_xor(v, o);
    return v;
}
__device__ __forceinline__ float wave_max(float v) {
#pragma unroll
    for (int o = 1; o < 64; o <<= 1) v = fmaxf(v, __shfl_xor(v, o));
    return v;
}
__device__ __forceinline__ int t5_bucket(int n) {
    if (n < 16) return n;
    if (n >= 113) return 31;
    int b = 16 + (int)(logf((float)n * 0.0625f) / 2.0794415416798357f * 16.0f);
    return b < 31 ? b : 31;
}

#define XB_TMO      128
#define XB_XCNT(j)  (256  + 64 * (j))
#define XB_XSUB(j)  (1280 + 64 * (j))
#define XB_XGEN(j)  (2304 + 64 * (j))
#define XB_TOP      3328
#define XB_TOPGEN   3392
#define XCD_BAR_WORDS 3456
#define XB_SPIN_CAP (1u << 18)
__device__ __forceinline__ unsigned xb_ld(unsigned* p)              { return __hip_atomic_load(p, __ATOMIC_RELAXED, __HIP_MEMORY_SCOPE_AGENT); }
__device__ __forceinline__ unsigned xb_add(unsigned* p, unsigned v) { return __hip_atomic_fetch_add(p, v, __ATOMIC_RELAXED, __HIP_MEMORY_SCOPE_AGENT); }
__device__ __forceinline__ unsigned xb_xcc_id() { return (unsigned)__builtin_amdgcn_s_getreg((3 << 11) | 20) & 0xFu; }
#define XB_SPIN(cond, bar) do { unsigned _sp = 0; while (cond) { __builtin_amdgcn_s_sleep(1); \
    if ((++_sp & 255u) == 0u) { if (xb_ld(&(bar)[XB_TMO])) break; if (_sp > XB_SPIN_CAP) { atomicAdd(&(bar)[XB_TMO], 1u); break; } } } } while (0)
struct XcdBarrier { unsigned* bar; unsigned x; volatile LAS unsigned* st; };
__device__ __forceinline__ XcdBarrier xcd_barrier_post(unsigned* bar, volatile LAS unsigned* st) {
    XcdBarrier b; b.bar = bar; b.x = xb_xcc_id(); b.st = st;
    if (threadIdx.x == 0) (void)xb_add(&bar[XB_XCNT(b.x)], 1u);
    return b;
}
__device__ __forceinline__ void xcd_barrier_complete(unsigned* bar, unsigned x, unsigned& nloc, unsigned& nx) {
    const unsigned G = gridDim.x * gridDim.y * gridDim.z;
    unsigned sum, cnt, mine, sp = 0u;
    for (;;) {
        sum = 0u; cnt = 0u; mine = 0u;
#pragma unroll
        for (unsigned j = 0; j < 16; ++j) { const unsigned c = xb_ld(&bar[XB_XCNT(j)]); sum += c; cnt += (c > 0u) ? 1u : 0u; mine = (j == x) ? c : mine; }
        if (sum == G) break;
        __builtin_amdgcn_s_sleep(1);
        if ((++sp & 255u) == 0u) { if (xb_ld(&bar[XB_TMO])) break; if (sp > XB_SPIN_CAP) { atomicAdd(&bar[XB_TMO], 1u); break; } }
    }
    nloc = mine > 0u ? mine : 1u; nx = cnt > 0u ? cnt : 1u;
}
__device__ __forceinline__ void xcd_barrier(const XcdBarrier& b) {
    asm volatile("s_waitcnt vmcnt(0)" ::: "memory");
    __syncthreads();
    if (threadIdx.x == 0) {
        unsigned* bar = b.bar;
        __builtin_amdgcn_s_waitcnt(0);
        unsigned nloc = b.st[0], nx = b.st[1];
        if (nloc == 0u) { xcd_barrier_complete(bar, b.x, nloc, nx); b.st[0] = nloc; b.st[1] = nx; }
        const unsigned old = xb_add(&bar[XB_XSUB(b.x)], 1u);
        const unsigned gen = old / nloc;
        if (old + 1u == (gen + 1u) * nloc) {
            __builtin_amdgcn_fence(__ATOMIC_RELEASE, "agent");
            asm volatile("s_waitcnt vmcnt(0)" ::: "memory");
            const unsigned og = xb_add(&bar[XB_TOP], 1u);
            const unsigned tg = og / nx;
            if (og + 1u == (tg + 1u) * nx) xb_add(&bar[XB_TOPGEN], 1u);
            else XB_SPIN(xb_ld(&bar[XB_TOPGEN]) == tg, bar);
            __builtin_amdgcn_fence(__ATOMIC_ACQUIRE, "agent");
            xb_add(&bar[XB_XGEN(b.x)], 1u);
            asm volatile("s_waitcnt vmcnt(0)" ::: "memory");
        } else {
            XB_SPIN(xb_ld(&bar[XB_XGEN(b.x)]) == gen, bar);
            __builtin_amdgcn_fence(__ATOMIC_ACQUIRE, "agent");
            asm volatile("s_waitcnt vmcnt(0)" ::: "memory");
        }
    }
    __syncthreads();
}

using pg8::Unit;
typedef const f32x4 (&AccRef)[2][2][4][2];
#define EPI_ROW(u, ai, m) ((u).pm * 256 + (ai) * 128 + wr * 64 + (m) * 16 + fr)
#define EPI_COL(bj) ((bj) * 128 + wc * 32 + 8 * fq)

struct EpiP1N {
    static constexpr bool PERM = true, AFTER_DRAIN = false;
    const float* rinv; const f32x4* tabA; bf16* AP; bf16* KN;
    __device__ __forceinline__ void operator()(AccRef acc, const Unit& u, int wr, int wc, int fr, int fq) const {
        const int h = u.pn & 3; const bool isk = u.pn >= 4; const float lg = lg2gamma(h);
#pragma unroll
        for (int ai = 0; ai < 2; ++ai)
#pragma unroll
            for (int m = 0; m < 4; ++m) {
                const int t = EPI_ROW(u, ai, m); const int p = t & (RCH - 1), c = t / RCH;
                const float rs = rinv[t] * (isk ? 0.0625f * exp2f(-(float)p * lg) : exp2f((float)p * lg));
#pragma unroll
                for (int bj = 0; bj < 2; ++bj) {
                    const int d0 = EPI_COL(bj);
                    const f32x4 c0 = tabA[(size_t)t * 64 + (d0 >> 2)], c1 = tabA[(size_t)t * 64 + (d0 >> 2) + 1];
                    const f32x4 v0 = acc[ai][bj][m][0] * rs, v1 = acc[ai][bj][m][1] * rs;
                    const f32x4 o0 = {v0[0] * c0[0] - v0[1] * c0[1], v0[0] * c0[1] + v0[1] * c0[0], v0[2] * c0[2] - v0[3] * c0[3], v0[2] * c0[3] + v0[3] * c0[2]};
                    const f32x4 o1 = {v1[0] * c1[0] - v1[1] * c1[1], v1[0] * c1[1] + v1[1] * c1[0], v1[2] * c1[2] - v1[3] * c1[3], v1[2] * c1[3] + v1[3] * c1[2]};
                    const v4u w = pack8(o0, o1);
                    if (isk) *(v4u*)(KN + (size_t)t * 1024 + h * 256 + d0) = w;
                    else *(v4u*)(AP + ((size_t)(h * NCH + c) * RCH + p) * APLD + RCH + d0) = w;
                }
            }
    }
};
struct EpiP1S {
    static constexpr bool PERM = true, AFTER_DRAIN = false;
    const float* rinv; const f32x4* tabB; bf16* KT; bf16* BP;
    __device__ __forceinline__ void operator()(AccRef acc, const Unit& u, int wr, int wc, int fr, int fq) const {
        const bool isk = u.pm < 4; const float lg = lg2gamma(u.pm & 3);
#pragma unroll
        for (int bj = 0; bj < 2; ++bj) {
            const int t0 = u.pn * 256 + EPI_COL(bj); const int c = t0 / RCH, p0 = t0 & (RCH - 1);
            const f32x4 r0 = *(const f32x4*)(rinv + t0), r1 = *(const f32x4*)(rinv + t0 + 4);
            f32x4 s0, s1;
#pragma unroll
            for (int j = 0; j < 4; ++j) { s0[j] = r0[j] * 0.0625f * exp2f(-(float)(p0 + j) * lg); s1[j] = r1[j] * 0.0625f * exp2f(-(float)(p0 + 4 + j) * lg); }
#pragma unroll
            for (int ai = 0; ai < 2; ++ai)
#pragma unroll
                for (int m = 0; m < 4; ++m) {
                    const int row = EPI_ROW(u, ai, m);
                    if (isk) {
                        const int d = row & 255, i = d >> 1; const bool odd = d & 1;
                        const f32x4 v0 = acc[ai][bj][m][0] * s0, v1 = acc[ai][bj][m][1] * s1; f32x4 q0, q1;
#pragma unroll
                        for (int j = 0; j < 4; ++j) { q0[j] = __shfl_xor(v0[j], 1); q1[j] = __shfl_xor(v1[j], 1); }
                        const f32x4* tb = tabB + ((size_t)i * SEQ + t0) / 2;
                        const f32x4 ca = tb[0], cb = tb[1], cc = tb[2], cd = tb[3];
                        f32x4 o0, o1;
                        if (odd) { o0 = (f32x4){q0[0] * ca[1] + v0[0] * ca[0], q0[1] * ca[3] + v0[1] * ca[2], q0[2] * cb[1] + v0[2] * cb[0], q0[3] * cb[3] + v0[3] * cb[2]};
                                   o1 = (f32x4){q1[0] * cc[1] + v1[0] * cc[0], q1[1] * cc[3] + v1[1] * cc[2], q1[2] * cd[1] + v1[2] * cd[0], q1[3] * cd[3] + v1[3] * cd[2]}; }
                        else     { o0 = (f32x4){v0[0] * ca[0] - q0[0] * ca[1], v0[1] * ca[2] - q0[1] * ca[3], v0[2] * cb[0] - q0[2] * cb[1], v0[3] * cb[2] - q0[3] * cb[3]};
                                   o1 = (f32x4){v1[0] * cc[0] - q1[0] * cc[1], v1[1] * cc[2] - q1[1] * cc[3], v1[2] * cd[0] - q1[2] * cd[1], v1[3] * cd[2] - q1[3] * cd[3]}; }
                        *(v4u*)(KT + (size_t)row * SEQ + t0) = pack8(o0, o1);
                    } else {
                        const int eg = row - 1024, h = eg >> 9, e = eg & 511;
                        *(v4u*)(BP + ((size_t)(h * NCH + c) * RCH + e) * APLD + p0) = pack8(acc[ai][bj][m][0] * r0, acc[ai][bj][m][1] * r1);
                    }
                }
        }
    }
};
struct EpiG {
    static constexpr bool PERM = true, AFTER_DRAIN = false;
    const float* rinv; const float* gslots; bf16* O;
    __device__ __forceinline__ void operator()(AccRef acc, const Unit& u, int wr, int wc, int fr, int fq) const {
        const int h = u.pn >> 1;
#pragma unroll
        for (int ai = 0; ai < 2; ++ai)
#pragma unroll
            for (int m = 0; m < 4; ++m) {
                const int row = EPI_ROW(u, ai, m); const float rin = rinv[row];
                const f32x4 sa = *(const f32x4*)(gslots + (size_t)row * 32 + h * 8), sb = *(const f32x4*)(gslots + (size_t)row * 32 + h * 8 + 4);
                const float ss = ((sa[0] + sa[1]) + (sa[2] + sa[3])) + ((sb[0] + sb[1]) + (sb[2] + sb[3]));
                const float rs = rsqrtf(ss * (1.0f / RDV) + RMS_EPS);
#pragma unroll
                for (int bj = 0; bj < 2; ++bj) {
                    bf16* op = O + (size_t)row * 2048 + u.pn * 256 + EPI_COL(bj);
                    float o[8]; unpack8(*(const v4u*)op, o);
                    const f32x4 g0 = acc[ai][bj][m][0] * rin, g1 = acc[ai][bj][m][1] * rin; f32x4 a, b;
#pragma unroll
                    for (int j = 0; j < 4; ++j) { a[j] = o[j] * rs * silu(g0[j]); b[j] = o[4 + j] * rs * silu(g1[j]); }
                    *(v4u*)op = pack8(a, b);
                }
            }
    }
};
struct EpiOut {
    static constexpr bool PERM = true, AFTER_DRAIN = false;
    bf16* MIX; float* oslots;
    __device__ __forceinline__ void operator()(AccRef acc, const Unit& u, int wr, int wc, int fr, int fq) const {
#pragma unroll
        for (int ai = 0; ai < 2; ++ai)
#pragma unroll
            for (int m = 0; m < 4; ++m) {
                const int row = EPI_ROW(u, ai, m); float ss = 0.f;
#pragma unroll
                for (int bj = 0; bj < 2; ++bj) {
                    const f32x4 v0 = acc[ai][bj][m][0], v1 = acc[ai][bj][m][1];
                    ss += (v0[0] * v0[0] + v0[1] * v0[1]) + (v0[2] * v0[2] + v0[3] * v0[3]) + (v1[0] * v1[0] + v1[1] * v1[1]) + (v1[2] * v1[2] + v1[3] * v1[3]);
                    *(v4u*)(MIX + (size_t)row * 1024 + u.pn * 256 + EPI_COL(bj)) = pack8(v0, v1);
                }
                ss += __shfl_xor(ss, 16); ss += __shfl_xor(ss, 32);
                if (fq == 0) oslots[(size_t)row * 16 + u.pn * 4 + wc] = ss;
            }
    }
};
struct EpiFfnIn {
    static constexpr bool PERM = true, AFTER_DRAIN = false;
    const float* rinv; bf16* HID;
    __device__ __forceinline__ void operator()(AccRef acc, const Unit& u, int wr, int wc, int fr, int fq) const {
#pragma unroll
        for (int ai = 0; ai < 2; ++ai)
#pragma unroll
            for (int m = 0; m < 4; ++m) {
                const int row = EPI_ROW(u, ai, m); const float rin = rinv[row];
                const f32x4 a0 = acc[ai][0][m][0] * rin, a1 = acc[ai][0][m][1] * rin, b0 = acc[ai][1][m][0] * rin, b1 = acc[ai][1][m][1] * rin; f32x4 x, y;
#pragma unroll
                for (int j = 0; j < 4; ++j) { x[j] = silu(a0[j]) * b0[j]; y[j] = silu(a1[j]) * b1[j]; }
                *(v4u*)(HID + (size_t)row * FFH + u.pn * 128 + wc * 32 + 8 * fq) = pack8(x, y);
            }
    }
};
struct EpiKvqN {
    static constexpr bool PERM = true, AFTER_DRAIN = false;
    const float* rinv; bf16 *KC, *VC, *KS, *KW, *Q; float* GATE;
    __device__ __forceinline__ void operator()(AccRef acc, const Unit& u, int wr, int wc, int fr, int fq) const {
        bf16* plane = u.pn == 0 ? KC : u.pn == 1 ? VC : u.pn == 2 ? KS : KW;
#pragma unroll
        for (int ai = 0; ai < 2; ++ai)
#pragma unroll
            for (int m = 0; m < 4; ++m) {
                const int row = EPI_ROW(u, ai, m); const float rin = rinv[row]; const int b = row / SEQ, t = row % SEQ;
#pragma unroll
                for (int bj = 0; bj < 2; ++bj) {
                    const int cc = EPI_COL(bj);
                    f32x4 v0 = acc[ai][bj][m][0] * rin, v1 = acc[ai][bj][m][1] * rin;
                    if (u.pn < 4) { const int g = cc >> 6, d = cc & 63; *(v4u*)(plane + ((size_t)(b * NG + g) * SEQ + t) * HD + d) = pack8(v0, v1); }
                    else if (u.pn < 8) { *(v4u*)(Q + (size_t)row * 1024 + (u.pn - 4) * 256 + cc) = pack8(v0 * 0.125f, v1 * 0.125f); }
                    else if (cc < 48) {
#pragma unroll
                        for (int j = 0; j < 4; ++j) { v0[j] = sigm(v0[j]); v1[j] = sigm(v1[j]); }
                        *(f32x4*)(GATE + (size_t)row * 48 + cc) = v0; *(f32x4*)(GATE + (size_t)row * 48 + cc + 4) = v1;
                    }
                }
            }
    }
};
struct EpiKvqS {
    static constexpr bool PERM = true, AFTER_DRAIN = false;
    const float* rinv; bf16 *VST, *VWT;
    __device__ __forceinline__ void operator()(AccRef acc, const Unit& u, int wr, int wc, int fr, int fq) const {
        bf16* plane = u.pm == 0 ? VST : VWT;
#pragma unroll
        for (int bj = 0; bj < 2; ++bj) {
            const int mg = u.pn * 256 + EPI_COL(bj); const int b = mg / SEQ, t = mg % SEQ;
            const f32x4 r0 = *(const f32x4*)(rinv + mg), r1 = *(const f32x4*)(rinv + mg + 4);
#pragma unroll
            for (int ai = 0; ai < 2; ++ai)
#pragma unroll
                for (int m = 0; m < 4; ++m) {
                    const int r256 = ai * 128 + wr * 64 + m * 16 + fr; const int g = r256 >> 6, d = r256 & 63;
                    *(v4u*)(plane + ((size_t)((b * NG + g) * HD + d)) * SEQ + t) = pack8(acc[ai][bj][m][0] * r0, acc[ai][bj][m][1] * r1);
                }
        }
    }
};
struct EpiCmp {
    static constexpr bool PERM = true, AFTER_DRAIN = false;
    const float* peb; bf16* HIDC;
    __device__ __forceinline__ void operator()(AccRef acc, const Unit& u, int wr, int wc, int fr, int fq) const {
        const int kv = u.pm >= 32 ? 1 : 0;
#pragma unroll
        for (int bj = 0; bj < 2; ++bj) {
            const int col = EPI_COL(bj);
            const f32x4 b0 = *(const f32x4*)(peb + kv * 256 + col), b1 = *(const f32x4*)(peb + kv * 256 + col + 4);
#pragma unroll
            for (int ai = 0; ai < 2; ++ai)
#pragma unroll
                for (int m = 0; m < 4; ++m) {
                    const int row = EPI_ROW(u, ai, m); f32x4 x = acc[ai][bj][m][0] + b0, y = acc[ai][bj][m][1] + b1;
#pragma unroll
                    for (int j = 0; j < 4; ++j) { x[j] = silu(x[j]); y[j] = silu(y[j]); }
                    *(v4u*)(HIDC + (size_t)row * 256 + col) = pack8(x, y);
                }
        }
    }
};
struct MapCmp { __device__ __forceinline__ void operator()(Unit& u) const { u.offA = (size_t)u.pm * 256 * 1024 * 2; u.offB = (size_t)(u.pm >= 32 ? 256 : 0) * 2048 * 2; } };

struct MapKV { __device__ __forceinline__ void operator()(Unit& u) const { const int hc = u.pm >> 1, eh = u.pm & 1, h = hc / NCH, c = hc % NCH;
    u.offA = ((size_t)(hc * RCH + eh * 256) * APLD) * 2; u.offB = ((size_t)(h * RDK) * SEQ + (size_t)c * RCH) * 2; } };
struct EpiKV {
    static constexpr bool PERM = true, AFTER_DRAIN = false;
    bf16* KV;
    __device__ __forceinline__ void operator()(AccRef acc, const Unit& u, int wr, int wc, int fr, int fq) const {
#pragma unroll
        for (int ai = 0; ai < 2; ++ai)
#pragma unroll
            for (int m = 0; m < 4; ++m) { const int row = EPI_ROW(u, ai, m);
#pragma unroll
                for (int bj = 0; bj < 2; ++bj) *(v4u*)(KV + (size_t)row * RDK + EPI_COL(bj)) = pack8(acc[ai][bj][m][0], acc[ai][bj][m][1]); }
    }
};
struct MapS { __device__ __forceinline__ void operator()(Unit& u) const { const int hc = u.pm >> 1, qh = u.pm & 1, h = hc / NCH, c = hc % NCH;
    u.offA = ((size_t)(hc * RCH + qh * 256) * APLD + RCH) * 2; u.offB = ((size_t)(c * RCH + u.pn * 256) * 1024 + h * RDK) * 2; } };
struct EpiS {
    static constexpr bool PERM = true, AFTER_DRAIN = false;
    bf16* AP;
    __device__ __forceinline__ void operator()(AccRef acc, const Unit& u, int wr, int wc, int fr, int fq) const {
        const int qh = u.pm & 1;
#pragma unroll
        for (int ai = 0; ai < 2; ++ai)
#pragma unroll
            for (int m = 0; m < 4; ++m) { const int row = EPI_ROW(u, ai, m); const int qi = qh * 256 + ai * 128 + wr * 64 + m * 16 + fr;
#pragma unroll
                for (int bj = 0; bj < 2; ++bj) { const int k0 = u.pn * 256 + EPI_COL(bj); f32x4 v0 = acc[ai][bj][m][0], v1 = acc[ai][bj][m][1];
#pragma unroll
                    for (int j = 0; j < 4; ++j) { if (k0 + j > qi) v0[j] = 0.f; if (k0 + 4 + j > qi) v1[j] = 0.f; }
                    *(v4u*)(AP + (size_t)row * APLD + k0) = pack8(v0, v1); } }
    }
};
struct MapO { __device__ __forceinline__ void operator()(Unit& u) const { const int hc = u.pm >> 1, qh = u.pm & 1;
    u.offA = ((size_t)(hc * RCH + qh * 256) * APLD) * 2; u.offB = ((size_t)(hc * RCH + u.pn * 256) * APLD) * 2; } };
struct EpiO {
    static constexpr bool PERM = true, AFTER_DRAIN = false;
    bf16* O; float* gslots; int b;
    __device__ __forceinline__ void operator()(AccRef acc, const Unit& u, int wr, int wc, int fr, int fq) const {
        const int hc = u.pm >> 1, qh = u.pm & 1, h = hc / NCH, c = hc % NCH;
#pragma unroll
        for (int ai = 0; ai < 2; ++ai)
#pragma unroll
            for (int m = 0; m < 4; ++m) { const size_t row = (size_t)b * SEQ + c * RCH + qh * 256 + ai * 128 + wr * 64 + m * 16 + fr; float ss = 0.f;
#pragma unroll
                for (int bj = 0; bj < 2; ++bj) { const f32x4 v0 = acc[ai][bj][m][0], v1 = acc[ai][bj][m][1];
                    ss += (v0[0] * v0[0] + v0[1] * v0[1]) + (v0[2] * v0[2] + v0[3] * v0[3]) + (v1[0] * v1[0] + v1[1] * v1[1]) + (v1[2] * v1[2] + v1[3] * v1[3]);
                    *(v4u*)(O + row * 2048 + h * RDV + u.pn * 256 + EPI_COL(bj)) = pack8(v0, v1); }
                ss += __shfl_xor(ss, 16); ss += __shfl_xor(ss, 32);
                if (fq == 0) gslots[row * 32 + h * 8 + u.pn * 4 + wc] = ss; }
    }
};

constexpr int NWAVES = 8, NTHREADS = NWAVES * 64;
constexpr int RING_OFF = 0, RING_BYTES = 131072;
constexpr int LDSCTL_OFF = RING_BYTES, MISC_OFF = LDSCTL_OFF + 320;
constexpr int LDS_BYTES = 147456;
constexpr int CW_BAR = 4096;

struct Args { const float* in[20]; float* out; unsigned char* ws; int ph, b; };
struct Frame {
    LAS unsigned char* lds; unsigned char* ws; float* out; const float* const* in;
    int tid, lane, wave, G, vcu, gw, NGW;
};

template <class DestRow>
__device__ __forceinline__ void transpose_item(const float* W, int K, int ldw, int ncols, const float* gain, bf16* WT, LAS float* scr, int k0, int n0, int lane, const DestRow& dr) {
#pragma unroll 8
    for (int i = 0; i < 32; ++i) { const int kk = 2 * i + (lane >> 5), n = n0 + (lane & 31);
        float v = 0.f; if (n < ncols) v = W[(size_t)(k0 + kk) * ldw + n]; if (gain) v *= gain[k0 + kk];
        scr[kk * 33 + (lane & 31)] = v; }
    asm volatile("s_waitcnt lgkmcnt(0)" ::: "memory");
    const int c = lane & 7;
#pragma unroll
    for (int j = 0; j < 4; ++j) { const int n = (lane >> 3) + 8 * j; const LAS float* s = scr + (8 * c) * 33 + n;
        v4u o; o.x = cvtpk(s[0 * 33], s[1 * 33]); o.y = cvtpk(s[2 * 33], s[3 * 33]); o.z = cvtpk(s[4 * 33], s[5 * 33]); o.w = cvtpk(s[6 * 33], s[7 * 33]);
        const int drow = dr(n0 + n); if (drow >= 0) *(v4u*)(WT + (size_t)drow * K + k0 + 8 * c) = o; }
    asm volatile("s_waitcnt lgkmcnt(0)" ::: "memory");
}
template <class DestRow>
__device__ __forceinline__ void transpose_matrix(const Frame& F, const float* W, int K, int ldw, int ncols, int ncols_pad, const float* gain, bf16* WT, const DestRow& dr) {
    LAS float* scr = (LAS float*)(F.lds + RING_OFF + F.wave * 16384);
    const int nblk = ncols_pad / 32, items = (K / 64) * nblk;
    for (int it = F.gw; it < items; it += F.NGW) transpose_item(W, K, ldw, ncols, gain, WT, scr, 64 * (it / nblk), 32 * (it % nblk), F.lane, dr);
}
struct DrOff { int off; __device__ __forceinline__ int operator()(int n) const { return n + off; } };
struct DrFfn { __device__ __forceinline__ int operator()(int n) const { const int up = n >= FFH, j = up ? n - FFH : n; return (j >> 7) * 256 + up * 128 + (j & 127); } };
struct DrKv { __device__ __forceinline__ int operator()(int n) const {
        const int s = n >> 8, d = n & 255; return s < 3 ? n : s == 3 ? 2304 + d : s == 4 ? 768 + d : 2304 + 256 + d; } };

__device__ __forceinline__ void row_to_bf16(const float* xrow, bf16* orow, float* rinv, int lane) {
    const f32x4* xr = (const f32x4*)xrow + lane; f32x4 v[4]; float s = 0.f;
#pragma unroll
    for (int j = 0; j < 4; ++j) { v[j] = xr[64 * j]; s += (v[j][0] * v[j][0] + v[j][1] * v[j][1]) + (v[j][2] * v[j][2] + v[j][3] * v[j][3]); }
    s = wave_sum(s);
    v2u* o8 = (v2u*)orow + lane;
#pragma unroll
    for (int j = 0; j < 4; ++j) { v2u w; w.x = cvtpk(v[j][0], v[j][1]); w.y = cvtpk(v[j][2], v[j][3]); o8[64 * j] = w; }
    if (lane == 0) *rinv = rsqrtf(s * (1.0f / DM) + RMS_EPS);
}

__device__ __forceinline__ void phase_prologue(const Frame& F) {
    unsigned char* ws = F.ws; const float* const* in = F.in;
    transpose_matrix(F, in[7], DM, RIN, RIN, RIN, in[1], (bf16*)(ws + W_RI), DrOff{0});
    transpose_matrix(F, in[8], 2048, DM, DM, DM, nullptr, (bf16*)(ws + W_RO), DrOff{0});
    transpose_matrix(F, in[5], DM, 2 * FFH, 2 * FFH, 2 * FFH, in[3], (bf16*)(ws + W_FI0), DrFfn{});
    transpose_matrix(F, in[5] + (size_t)DM * 2 * FFH, DM, 2 * FFH, 2 * FFH, 2 * FFH, in[3] + DM, (bf16*)(ws + W_FI1), DrFfn{});
    transpose_matrix(F, in[6], FFH, DM, DM, DM, nullptr, (bf16*)(ws + W_FO0), DrOff{0});
    transpose_matrix(F, in[6] + (size_t)FFH * DM, FFH, DM, DM, DM, nullptr, (bf16*)(ws + W_FO1), DrOff{0});
    transpose_matrix(F, in[10], DM, 1536, 1536, 1536, in[9], (bf16*)(ws + W_KVQ), DrKv{});
    transpose_matrix(F, in[17], DM, NSAIN, NSAIN, 1280, in[1] + DM, (bf16*)(ws + W_KVQ), DrOff{1024});
    transpose_matrix(F, in[18], DM, DM, DM, DM, nullptr, (bf16*)(ws + W_NO), DrOff{0});
    transpose_matrix(F, in[12], 2048, 256, 256, 256, nullptr, (bf16*)(ws + W_C1), DrOff{0});
    transpose_matrix(F, in[15], 2048, 256, 256, 256, nullptr, (bf16*)(ws + W_C1), DrOff{256});
    {
        f32x2_t* tabA = (f32x2_t*)(ws + WS_TABA); f32x2_t* tabB = (f32x2_t*)(ws + WS_TABB);
        for (int idx = F.vcu * NTHREADS + F.tid; idx < SEQ * 128; idx += F.G * NTHREADS) {
            const int t = idx >> 7, i = idx & 127;
            const float theta = 1.0f / powf(10000.0f, (float)i * (1.0f / 127.0f));
            const float ang = (float)t * theta; float s, c; sincosf(ang, &s, &c);
            const f32x2_t v = {c, s}; tabA[idx] = v; tabB[(size_t)i * SEQ + t] = v;
        }
    }
    for (int m = F.gw; m < MTOK; m += F.NGW) row_to_bf16(in[0] + (size_t)m * DM, (bf16*)(ws + WS_XB) + (size_t)m * DM, (float*)(ws + WS_RINV) + m, F.lane);
    if (blockIdx.x == 0) for (int i = F.tid; i < 128 * 16; i += NTHREADS) ((float*)(ws + WS_BIAST))[i] = in[19][t5_bucket(i >> 4) * 16 + (i & 15)];
    if (blockIdx.x < 32) {
        const int kv = F.tid >> 8, c = F.tid & 255; const float* pe = kv ? in[14] : in[11]; const float* w1 = kv ? in[15] : in[12]; float s = 0.f;
        for (int k = 64 * blockIdx.x; k < 64 * blockIdx.x + 64; ++k) s += pe[k] * w1[(size_t)k * 256 + c];
        ((float*)(ws + WS_PEBP))[blockIdx.x * 512 + F.tid] = s;
    }
}
__device__ __forceinline__ void phase_peb_final(const Frame& F) {
    if (blockIdx.x == 0) { float s = 0.f; for (int w = 0; w < 32; ++w) s += ((const float*)(F.ws + WS_PEBP))[w * 512 + F.tid]; ((float*)(F.ws + WS_PEB))[F.tid] = s; }
}

__device__ __forceinline__ void phase_resid(const Frame& F, const float* hold, const float* gpost, bool last) {
    const bf16* MIX = (const bf16*)(F.ws + WS_MIX); const float* oslots = (const float*)(F.ws + WS_OSLOT);
    bf16* XB = (bf16*)(F.ws + WS_XB); float* rinv = (float*)(F.ws + WS_RINV);
    f32x4 gp[4];
#pragma unroll
    for (int j = 0; j < 4; ++j) gp[j] = ((const f32x4*)gpost)[F.lane + 64 * j];
    for (int m = F.gw; m < MTOK; m += F.NGW) {
        const f32x4* sl = (const f32x4*)(oslots + (size_t)m * 16); const f32x4 s0 = sl[0], s1 = sl[1], s2 = sl[2], s3 = sl[3];
        const float ss = (((s0[0] + s0[1]) + (s0[2] + s0[3])) + ((s1[0] + s1[1]) + (s1[2] + s1[3]))) + (((s2[0] + s2[1]) + (s2[2] + s2[3])) + ((s3[0] + s3[1]) + (s3[2] + s3[3])));
        const float rs = rsqrtf(ss * (1.0f / DM) + RMS_EPS);
        const f32x4* hr = (const f32x4*)(hold + (size_t)m * DM) + F.lane; const v2u* mr = (const v2u*)(MIX + (size_t)m * DM) + F.lane;
        f32x4 hn[4]; float s = 0.f;
#pragma unroll
        for (int j = 0; j < 4; ++j) { const f32x4 hv = hr[64 * j]; const v2u mw = mr[64 * j];
            const f32x4 mx = {bflo(mw.x), bfhi(mw.x), bflo(mw.y), bfhi(mw.y)};
            hn[j] = hv + mx * rs * gp[j]; s += (hn[j][0] * hn[j][0] + hn[j][1] * hn[j][1]) + (hn[j][2] * hn[j][2] + hn[j][3] * hn[j][3]); }
        f32x4* ho = (f32x4*)(F.out + (size_t)m * DM) + F.lane;
#pragma unroll
        for (int j = 0; j < 4; ++j) ho[64 * j] = hn[j];
        if (!last) {
            s = wave_sum(s); v2u* o8 = (v2u*)(XB + (size_t)m * DM) + F.lane;
#pragma unroll
            for (int j = 0; j < 4; ++j) { v2u w; w.x = cvtpk(hn[j][0], hn[j][1]); w.y = cvtpk(hn[j][2], hn[j][3]); o8[64 * j] = w; }
            if (F.lane == 0) rinv[m] = rsqrtf(s * (1.0f / DM) + RMS_EPS);
        }
    }
}

__device__ __forceinline__ void phase_ret_naive(const Frame& F, int b) {
    const bf16* AP = (const bf16*)(F.ws + WS_AP); const bf16* BP = (const bf16*)(F.ws + WS_BP); const bf16* KN = (const bf16*)(F.ws + WS_KN);
    bf16* O = (bf16*)F.out;
    for (int item = blockIdx.x; item < RH * 8; item += F.G) {
        const int h = item >> 3, et = item & 7, el = F.tid >> 3, ds = F.tid & 7, e = et * 64 + el;
        const float cdec = exp2f((float)RCH * lg2gamma(h));
        float U[32];
#pragma unroll
        for (int i = 0; i < 32; ++i) U[i] = 0.f;
        v4u kb[4], qb[4]; bf16 vb;
#define RN_LOAD(tt, KB, QB, VB) do { const int c_ = (tt) / RCH, p_ = (tt) & (RCH - 1); \
            const v4u* kp_ = (const v4u*)(KN + (size_t)(tt) * 1024 + h * 256 + ds * 32); const v4u* qp_ = (const v4u*)(AP + ((size_t)(h * NCH + c_) * RCH + p_) * APLD + RCH + ds * 32); \
            _Pragma("unroll") for (int j_ = 0; j_ < 4; ++j_) { KB[j_] = kp_[j_]; QB[j_] = qp_[j_]; } VB = BP[((size_t)(h * NCH + c_) * RCH + e) * APLD + p_]; } while (0)
        RN_LOAD(0, kb, qb, vb);
        for (int t = 0; t < SEQ; ++t) {
            v4u kn[4], qn[4]; bf16 vn; const int tn = t + 1 < SEQ ? t + 1 : t;
            RN_LOAD(tn, kn, qn, vn);
            const float v = bf2f(vb); float acc = 0.f;
#pragma unroll
            for (int j = 0; j < 4; ++j) { float kf[8], qf[8]; unpack8(kb[j], kf); unpack8(qb[j], qf);
#pragma unroll
                for (int i = 0; i < 8; ++i) { U[8 * j + i] += kf[i] * v; acc += qf[i] * U[8 * j + i]; } }
            acc += __shfl_xor(acc, 1); acc += __shfl_xor(acc, 2); acc += __shfl_xor(acc, 4);
            if (ds == 0) O[(size_t)(b * SEQ + t) * 2048 + h * 512 + e] = f2bf(acc);
            if ((t & (RCH - 1)) == RCH - 1) {
#pragma unroll
                for (int i = 0; i < 32; ++i) U[i] *= cdec; }
#pragma unroll
            for (int j = 0; j < 4; ++j) { kb[j] = kn[j]; qb[j] = qn[j]; } vb = vn;
        }
#undef RN_LOAD
    }
}
__device__ __forceinline__ void phase_ret_ssq(const Frame& F, int b) {
    const bf16* O = (const bf16*)F.out; float* gs = (float*)(F.ws + WS_GSLOT);
    for (int r = F.gw; r < SEQ * RH; r += F.NGW) {
        const int m = b * SEQ + (r >> 2), h = r & 3; float f[8]; unpack8(((const v4u*)(O + (size_t)m * 2048 + h * 512))[F.lane], f);
        float s = 0.f;
#pragma unroll
        for (int i = 0; i < 8; ++i) s += f[i] * f[i];
        s = wave_sum(s);
        if (F.lane < 8) gs[(size_t)m * 32 + h * 8 + F.lane] = F.lane == 0 ? s : 0.f;
    }
}

__device__ __forceinline__ void phase_cmp2(const Frame& F) {
    const bf16* HIDC = (const bf16*)(F.ws + WS_HIDC); bf16* KCMP = (bf16*)(F.ws + WS_KCMP); bf16* VCT = (bf16*)(F.ws + WS_VCMPT);
    LAS float* scr = (LAS float*)(F.lds + RING_OFF + F.wave * 2048);
    for (int R = F.gw; R < 16384; R += F.NGW) {
        const int kv = R >> 13, pl = (R >> 10) & 7, n = R & 1023; const float* w2 = kv ? F.in[16] : F.in[13];
        const v2u hw = ((const v2u*)(HIDC + (size_t)R * 256))[F.lane];
        scr[4 * F.lane + 0] = bflo(hw.x); scr[4 * F.lane + 1] = bfhi(hw.x); scr[4 * F.lane + 2] = bflo(hw.y); scr[4 * F.lane + 3] = bfhi(hw.y);
        asm volatile("s_waitcnt lgkmcnt(0)" ::: "memory");
        float s = 0.f;
#pragma unroll 8
        for (int c = 0; c < 256; ++c) s += scr[c] * w2[c * 64 + F.lane];
        if (n == NCMP) s = 0.f;
        if (kv == 0) KCMP[((size_t)pl * 1024 + n) * 64 + F.lane] = f2bf(s);
        else VCT[((size_t)pl * 64 + F.lane) * 1024 + n] = f2bf(s);
        asm volatile("s_waitcnt lgkmcnt(0)" ::: "memory");
    }
}

__device__ __forceinline__ void phase_ret_scan(const Frame& F) {
    const bf16* KV = (const bf16*)(F.ws + WS_KV); bf16* BP = (bf16*)(F.ws + WS_BP);
    for (int it = F.vcu * NTHREADS + F.tid; it < RH * RDV * (RDK / 8); it += F.G * NTHREADS) {
        const int d8 = it & 31, e = (it >> 5) & 511, h = it >> 14;
        const float cdec = exp2f((float)RCH * lg2gamma(h));
        float carry[8];
#pragma unroll
        for (int i = 0; i < 8; ++i) carry[i] = 0.f;
#pragma unroll 4
        for (int c = 0; c < NCH; ++c) {
            const size_t r = (size_t)(h * NCH + c) * RCH + e;
            float kv[8]; unpack8(*(const v4u*)(KV + r * RDK + d8 * 8), kv);
            v4u w; w.x = cvtpk(carry[0], carry[1]); w.y = cvtpk(carry[2], carry[3]); w.z = cvtpk(carry[4], carry[5]); w.w = cvtpk(carry[6], carry[7]);
            *(v4u*)(BP + r * APLD + RCH + d8 * 8) = w;
#pragma unroll
            for (int i = 0; i < 8; ++i) carry[i] = cdec * (carry[i] + kv[i]);
        }
    }
}

__device__ __forceinline__ float dot64(const float* q, const bf16* krow) {
    const v4u* kp = (const v4u*)krow; float s = 0.f;
#pragma unroll
    for (int j = 0; j < 8; ++j) { float kf[8]; unpack8(kp[j], kf);
#pragma unroll
        for (int i = 0; i < 8; ++i) s += q[8 * j + i] * kf[i]; }
    return s;
}
__device__ __forceinline__ void wave_softmax(LAS float* S, int n, int n8, int ln) {
    float mx = -INFINITY;
    for (int i = ln; i < n; i += 64) mx = fmaxf(mx, S[i]);
    mx = wave_max(mx); if (!(mx > -INFINITY)) mx = 0.f;
    float sum = 0.f;
    for (int i = ln; i < n; i += 64) { const float p = __expf(S[i] - mx); S[i] = p; sum += p; }
    sum = wave_sum(sum); const float inv = 1.0f / fmaxf(sum, 1.17549435e-38f);
    for (int i = ln; i < n8; i += 64) S[i] = i < n ? S[i] * inv : 0.f;
}
__device__ __forceinline__ void phase_nsa_naive(const Frame& F) {
    const int half = F.tid >> 8, tl = F.tid & 255, r = tl >> 6, ln = tl & 63;
    LAS float* S = (LAS float*)(F.lds + RING_OFF + half * 32768);
    LAS float* IMPC = S + 4096; LAS float* IMP = IMPC + 1024; LAS int* SELF = (LAS int*)(IMP + 256); LAS int* BLK = SELF + 256;
    LAS float* Sr = S + r * 1024;
    const bf16* Q = (const bf16*)(F.ws + WS_Q); const bf16* KCMP = (const bf16*)(F.ws + WS_KCMP); const bf16* VCT = (const bf16*)(F.ws + WS_VCMPT);
    const bf16* KS = (const bf16*)(F.ws + WS_KS); const bf16* KW = (const bf16*)(F.ws + WS_KW); const bf16* VST = (const bf16*)(F.ws + WS_VST); const bf16* VWT = (const bf16*)(F.ws + WS_VWT);
    const float* GATE = (const float*)(F.ws + WS_GATE); const float* biasT = (const float*)(F.ws + WS_BIAST); bf16* ONSA = (bf16*)(F.ws + WS_ONSA);
    for (int it = blockIdx.x; it < MTOK * NG / 2; it += F.G) {
        const int item = it * 2 + half, m = item >> 2, g = item & 3, b = m / SEQ, t = m % SEQ, pl = b * NG + g, H = g * NR + r;
        float q[64];
        { const v4u* qp = (const v4u*)(Q + (size_t)m * 1024 + H * 64);
#pragma unroll
          for (int j = 0; j < 8; ++j) unpack8(qp[j], q + 8 * j); }
        const float* bT = biasT + H;
        const int nvalid = t >= 31 ? ((t - 31) / 16 + 1 < NCMP ? (t - 31) / 16 + 1 : NCMP) : 0, nv8 = (nvalid + 7) & ~7;
        for (int n = ln; n < nvalid; n += 64) { const int dist = t - 16 * n - 31; Sr[n] = dot64(q, KCMP + ((size_t)pl * 1024 + n) * 64) + bT[(dist < 127 ? dist : 127) * 16]; }
        __syncthreads();
        wave_softmax(Sr, nvalid, nv8, ln);
        __syncthreads();
        for (int n = tl; n < 1024; n += 256) IMPC[n] = n < nvalid ? (S[n] + S[1024 + n]) + (S[2048 + n] + S[3072 + n]) : 0.f;
        const int cur = t >> 6;
        SELF[tl] = (tl == 0 || tl == cur || tl == cur - 1) ? 1 : 0;
        __syncthreads();
        { float s = 0.f;
#pragma unroll
          for (int k = -1; k < 4; ++k) { const int n = 4 * tl + k; if (n >= 0 && n < NCMP) s += IMPC[n]; }
          IMP[tl] = s; }
        float oc = 0.f;
        for (int n0 = 0; n0 < nvalid; n0 += 8) { float vf[8]; unpack8(*(const v4u*)(VCT + ((size_t)pl * 64 + ln) * 1024 + n0), vf);
#pragma unroll
            for (int i = 0; i < 8; ++i) oc += Sr[n0 + i] * vf[i]; }
        __syncthreads();
        if (r == 0) {
            const int ncand = cur - 2, nf = cur + 1 < 3 ? cur + 1 : 3, need = 16 - nf;
            if (ncand <= need) { for (int j = ln; j < 256; j += 64) if (j >= 1 && j <= cur - 2) SELF[j] = 1; }
            else {
                float v[4];
#pragma unroll
                for (int i = 0; i < 4; ++i) { const int j = ln + 64 * i; v[i] = (j >= 1 && j <= cur - 2) ? IMP[j] : -INFINITY; }
                for (int round = 0; round < need; ++round) {
                    float bv = v[0]; int bj = ln;
#pragma unroll
                    for (int i = 1; i < 4; ++i) if (v[i] > bv) { bv = v[i]; bj = ln + 64 * i; }
#pragma unroll
                    for (int o = 1; o < 64; o <<= 1) { const float ov = __shfl_xor(bv, o); const int oj = __shfl_xor(bj, o); if (ov > bv || (ov == bv && oj < bj)) { bv = ov; bj = oj; } }
#pragma unroll
                    for (int i = 0; i < 4; ++i) if (bj == ln + 64 * i) { v[i] = -INFINITY; SELF[bj] = 1; }
                }
            }
        }
        __syncthreads();
        int nk = 0;
        for (int j = 0; j <= cur; ++j) {
            if (SELF[j]) {
                const int pos = 64 * j + ln, dist = t - pos;
                Sr[nk * 64 + ln] = pos <= t ? dot64(q, KS + ((size_t)pl * SEQ + pos) * 64) + bT[(dist < 127 ? dist : 127) * 16] : -INFINITY;
                if (tl == 0) BLK[nk] = j;
                ++nk;
            }
        }
        __syncthreads();
        wave_softmax(Sr, nk * 64, nk * 64, ln);
        float os = 0.f;
        for (int k = 0; k < nk; ++k) { const int j = BLK[k];
            for (int l0 = 0; l0 < 64; l0 += 8) { float vf[8]; unpack8(*(const v4u*)(VST + ((size_t)pl * 64 + ln) * SEQ + 64 * j + l0), vf);
#pragma unroll
                for (int i = 0; i < 8; ++i) os += Sr[k * 64 + l0 + i] * vf[i]; } }
        __syncthreads();
        for (int i = ln; i < 512; i += 64) { const int pos = t - 511 + i; Sr[i] = pos >= 0 ? dot64(q, KW + ((size_t)pl * SEQ + pos) * 64) + bT[((511 - i) < 127 ? (511 - i) : 127) * 16] : -INFINITY; }
        wave_softmax(Sr, 512, 512, ln);
        float ow = 0.f;
        for (int i = t >= 511 ? 0 : 511 - t; i < 512; ++i) ow += Sr[i] * bf2f(VWT[((size_t)pl * 64 + ln) * SEQ + (t - 511 + i)]);
        const float* gt = GATE + (size_t)m * 48 + H * 3;
        ONSA[(size_t)m * 1024 + H * 64 + ln] = f2bf(gt[0] * oc + gt[1] * os + gt[2] * ow);
        __syncthreads();
    }
}

template <class Epi, class Map>
__device__ __forceinline__ void run_gemm(const Frame& F, const bf16* A, const bf16* Bt, int lda, int ldb, int K, int nM, int nN, const Map& map, const Epi& E) {
    pg8::Gemm g{A, Bt, lda, ldb, K}; pg8::Order<Map> S; S.init(nM, nN, F.G, (int)blockIdx.x, map);
    int tid = F.tid; asm volatile("" : "+v"(tid));
    pg8::gemm_phase<Epi, pg8::Order<Map>, true, true>(F.lds + RING_OFF, g, S, E, tid);
}
enum { PH_PRO, PH_P1, PH_R1, PH_R2, PH_R3, PH_G, PH_OUT, PH_RES, PH_FI, PH_KVQN, PH_KVQS, PH_CMP, PH_CMP2, PH_NSAN, PH_COUNT };

template <int PH> __device__ __forceinline__ void phase_body(const Frame& F, int b) {
    unsigned char* ws = F.ws; float* rinv = (float*)(ws + WS_RINV); bf16* XB = (bf16*)(ws + WS_XB);
    if constexpr (PH == PH_PRO) phase_prologue(F);
    if constexpr (PH == PH_P1) {
        { EpiP1N E{rinv + b * SEQ, (const f32x4*)(ws + WS_TABA), (bf16*)(ws + WS_AP), (bf16*)(ws + WS_KN)};
          run_gemm(F, XB + (size_t)b * SEQ * DM, (const bf16*)(ws + W_RI), DM, DM, DM, SEQ / 256, 8, pg8::MapPlain{DM, DM}, E); }
        __syncthreads();
        { EpiP1S E{rinv + b * SEQ, (const f32x4*)(ws + WS_TABB), (bf16*)(ws + WS_KT), (bf16*)(ws + WS_BP)};
          run_gemm(F, (const bf16*)(ws + W_RI) + (size_t)1024 * DM, XB + (size_t)b * SEQ * DM, DM, DM, DM, 12, SEQ / 256, pg8::MapPlain{DM, DM}, E); }
    }
    if constexpr (PH == PH_R1) {
        { EpiKV E{(bf16*)(ws + WS_KV)};
          run_gemm(F, (const bf16*)(ws + WS_BP), (const bf16*)(ws + WS_KT), APLD, SEQ, RCH, RH * NCH * 2, 1, MapKV{}, E); }
        __syncthreads();
        { EpiS E{(bf16*)(ws + WS_AP)};
          run_gemm(F, (const bf16*)(ws + WS_AP), (const bf16*)(ws + WS_KN), APLD, 1024, RDK, RH * NCH * 2, 2, MapS{}, E); }
    }
    if constexpr (PH == PH_R2) phase_ret_scan(F);
    if constexpr (PH == PH_R3) { EpiO E{(bf16*)F.out, (float*)(ws + WS_GSLOT), b};
        run_gemm(F, (const bf16*)(ws + WS_AP), (const bf16*)(ws + WS_BP), APLD, APLD, APLD, RH * NCH * 2, 2, MapO{}, E); }
    if constexpr (PH == PH_G) { EpiG E{rinv, (const float*)(ws + WS_GSLOT), (bf16*)F.out};
        run_gemm(F, XB, (const bf16*)(ws + W_RI) + (size_t)4096 * DM, DM, DM, DM, MTOK / 256, 8, pg8::MapPlain{DM, DM}, E); }
    if constexpr (PH == PH_OUT) {
        const bf16* A = b == 0 ? (const bf16*)F.out : b == 2 ? (const bf16*)(ws + WS_ONSA) : (const bf16*)(ws + WS_HID);
        const bf16* Bt = (const bf16*)(ws + (b == 0 ? W_RO : b == 1 ? W_FO0 : b == 2 ? W_NO : W_FO1));
        const int K = b == 0 ? 2048 : b == 2 ? DM : FFH;
        EpiOut E{(bf16*)(ws + WS_MIX), (float*)(ws + WS_OSLOT)};
        run_gemm(F, A, Bt, K, K, K, MTOK / 256, 4, pg8::MapPlain{K, K}, E); }
    if constexpr (PH == PH_RES) phase_resid(F, b == 0 ? F.in[0] : F.out, (b & 1 ? F.in[4] : F.in[2]) + (b >> 1) * DM, b == 3);
    if constexpr (PH == PH_FI) { EpiFfnIn E{rinv, (bf16*)(ws + WS_HID)};
        run_gemm(F, XB, (const bf16*)(ws + (b ? W_FI1 : W_FI0)), DM, DM, DM, MTOK / 256, 22, pg8::MapPlain{DM, DM}, E); }
    if constexpr (PH == PH_KVQN) { phase_peb_final(F);
        EpiKvqN E{rinv, (bf16*)(ws + WS_KC), (bf16*)(ws + WS_VC), (bf16*)(ws + WS_KS), (bf16*)(ws + WS_KW), (bf16*)(ws + WS_Q), (float*)(ws + WS_GATE)};
        run_gemm(F, XB, (const bf16*)(ws + W_KVQ), DM, DM, DM, MTOK / 256, 9, pg8::MapPlain{DM, DM}, E); }
    if constexpr (PH == PH_KVQS) { EpiKvqS E{rinv, (bf16*)(ws + WS_VST), (bf16*)(ws + WS_VWT)};
        run_gemm(F, (const bf16*)(ws + W_KVV), XB, DM, DM, DM, 2, MTOK / 256, pg8::MapPlain{DM, DM}, E); }
    if constexpr (PH == PH_CMP) { EpiCmp E{(const float*)(ws + WS_PEB), (bf16*)(ws + WS_HIDC)};
        run_gemm(F, (const bf16*)(ws + WS_KC), (const bf16*)(ws + W_C1), 1024, 2048, 2048, 64, 1, MapCmp{}, E); }
    if constexpr (PH == PH_CMP2) phase_cmp2(F);
    if constexpr (PH == PH_NSAN) phase_nsa_naive(F);
}
__device__ __forceinline__ void make_frame(Frame& F, unsigned char* lds, const Args& args) {
    int tid = threadIdx.x; asm volatile("" : "+v"(tid));
    unsigned char* ws = args.ws; float* out = args.out; asm volatile("" : "+s"(ws), "+s"(out));
    F.lds = (LAS unsigned char*)lds; F.ws = ws; F.out = out; F.in = args.in;
    F.tid = tid; F.lane = tid & 63; F.wave = __builtin_amdgcn_readfirstlane(tid >> 6);
    F.G = gridDim.x; { const int bx = blockIdx.x; F.vcu = (F.G % 8 == 0) ? (bx % 8) * (F.G / 8) + bx / 8 : bx; }
    F.gw = F.vcu * NWAVES + F.wave; F.NGW = F.G * NWAVES;
}
__global__ void __launch_bounds__(NTHREADS, 2) fwd(Args args) {
    extern __shared__ __attribute__((aligned(16))) unsigned char lds[];
    {   LAS unsigned* ctl = (LAS unsigned*)((LAS unsigned char*)lds + LDSCTL_OFF);
        for (int u = threadIdx.x; u < (LDS_BYTES - LDSCTL_OFF) / 4; u += NTHREADS) ctl[u] = 0u; }
    __syncthreads();
    const int lo = args.ph, hi = args.b;
    XcdBarrier bar; bar.bar = (unsigned*)(args.ws + WS_CTL) + CW_BAR; bar.x = 0; bar.st = nullptr;
    if (hi - lo > 1) bar = xcd_barrier_post((unsigned*)(args.ws + WS_CTL) + CW_BAR, (volatile LAS unsigned*)((LAS unsigned char*)lds + MISC_OFF) + 8);
    int ph = 0;
#ifndef DBG_MASK
#define DBG_MASK 0xffffffffu
#endif
#define RUN(PH, bval) do { if (ph >= lo && ph < hi) { Frame F; make_frame(F, lds, args); if constexpr ((DBG_MASK >> PH) & 1u) phase_body<PH>(F, (bval)); if (ph + 1 < hi) xcd_barrier(bar); } ++ph; } while (0)
    RUN(PH_PRO, 0);
#pragma unroll 1
    for (int layer = 0; layer < 2; ++layer) {
#pragma unroll 1
        for (int sub = 0; sub < 2; ++sub) {
            if (sub == 0) {
                if (layer == 0) {
#pragma unroll 1
                    for (int b = 0; b < NBATCH; ++b) { RUN(PH_P1, b); RUN(PH_R1, b); RUN(PH_R2, b); RUN(PH_R3, b); }
                    RUN(PH_G, 0);
                } else { RUN(PH_KVQN, 0); RUN(PH_KVQS, 0); RUN(PH_CMP, 0); RUN(PH_CMP2, 0); RUN(PH_NSAN, 0); }
            } else RUN(PH_FI, layer);
            RUN(PH_OUT, 2 * layer + sub);
            RUN(PH_RES, 2 * layer + sub);
        }
    }
#undef RUN
}
constexpr int NPHASES = 1 + (8 + 1 + 2) + 3 + (5 + 2) + 3;

#ifndef MK_N_LAUNCH
#define MK_N_LAUNCH 1
#endif
extern "C" void kernel_launch(void* const* d_in, const int* in_sizes, int n_in, void* d_out, int out_size, void* d_ws, size_t ws_size, hipStream_t stream) {
    static int grid = 0;
    if (grid == 0) {
        if (n_in != 20 || out_size != MTOK * DM || ws_size < WS_NEED) { fprintf(stderr, "kernel_launch: unexpected problem shape (n_in %d, out %d, ws %zu)\n", n_in, out_size, ws_size); grid = -1; return; }
        int dev = 0, cus = 0, per_cu = 0;
        if (hipGetDevice(&dev) != hipSuccess || hipDeviceGetAttribute(&cus, hipDeviceAttributeMultiprocessorCount, dev) != hipSuccess) { grid = -1; return; }
        if (hipFuncSetAttribute((const void*)fwd, hipFuncAttributeMaxDynamicSharedMemorySize, LDS_BYTES) != hipSuccess) { fprintf(stderr, "kernel_launch: hipFuncSetAttribute failed\n"); grid = -1; return; }
        if (hipOccupancyMaxActiveBlocksPerMultiprocessor(&per_cu, (const void*)fwd, NTHREADS, LDS_BYTES) != hipSuccess || per_cu < 1) { fprintf(stderr, "kernel_launch: occupancy query says %d blocks per CU\n", per_cu); }
        (void)hipGetLastError();
        grid = cus;
    }
    if (grid < 0) return;
    (void)hipMemsetAsync((char*)d_ws + WS_CTL, 0, CTL_ZERO_BYTES, stream);
    Args a{};
    for (int i = 0; i < 20; ++i) a.in[i] = (const float*)d_in[i];
    a.out = (float*)d_out; a.ws = (unsigned char*)d_ws;
    if (MK_N_LAUNCH == 1) { a.ph = 0; a.b = NPHASES; hipLaunchKernelGGL(fwd, dim3(grid), dim3(NTHREADS), LDS_BYTES, stream, a); }
    else for (int p = 0; p < NPHASES; ++p) { a.ph = p; a.b = p + 1; hipLaunchKernelGGL(fwd, dim3(grid), dim3(NTHREADS), LDS_BYTES, stream, a); }
}
```

```cpp
#include <hip/hip_runtime.h>
#include <cstdio>
#include <cstdint>
#include <utility>

namespace pg8 {
#define PG8_LAS __attribute__((address_space(3)))
typedef unsigned short bf16_t;
typedef short bf16x8 __attribute__((ext_vector_type(8)));
typedef float f32x4 __attribute__((ext_vector_type(4)));
typedef unsigned u32x4 __attribute__((ext_vector_type(4)));
constexpr int BM = 256, BK = 64, HALF = 128, HTB = HALF * BK * 2  , STAGE_BYTES = 8 * HTB, NXCD = 8, WGM = 8;

__host__ __device__ __forceinline__ int lds_byte(int r, int c) { const int st = (r >> 4) * 2 + (c >> 5), rr = r & 15, cc = c & 31, ob = rr * 64 + cc * 2; return st * 1024 + (ob ^ (((ob >> 9) & 1) << 5)); }
__host__ __device__ __forceinline__ void stage_rc(int b, int& R, int& C) { const int st = b / 1024, sb = b % 1024, swz = sb ^ (((sb >> 9) & 1) << 5); R = (st >> 1) * 16 + swz / 64; C = (st & 1) * 32 + (swz % 64) / 2; }
__host__ __device__ __forceinline__ int perm32(int rho) { const int n = rho >> 4, i = rho & 15; return 8 * (i >> 2) + 4 * n + (i & 3); }

struct Unit { int pm, pn; size_t offA, offB; };
struct Gemm { const bf16_t* A; const bf16_t* Bt; int lda, ldb, K; };

template <class Map> struct Order {
    int nM, nN, nwg, G, c; Map map;
    __device__ __forceinline__ void init(int nM_, int nN_, int G_, int c_, const Map& m) { nM = nM_; nN = nN_; nwg = nM * nN; G = G_; c = c_; map = m; }
    __device__ __forceinline__ bool next(int i, Unit& u) const {
        const long L = (long)i * G + c; if (L >= nwg) return false;
        int wgid = (int)L; { const int q = nwg / NXCD, r = nwg % NXCD, xcd = wgid % NXCD, off = wgid / NXCD; wgid = (xcd < r ? xcd * (q + 1) : r * (q + 1) + (xcd - r) * q) + off; }
        const int nig = WGM * nN, gid = wgid / nig, fm = gid * WGM, gsz = (nM - fm) < WGM ? (nM - fm) : WGM;
        u.pm = fm + ((wgid % nig) % gsz); u.pn = (wgid % nig) / gsz; map(u); return true;
    }
    __device__ __forceinline__ void a_ready(const Unit&) const {}
    __device__ __forceinline__ void done(const Unit&) const {}
};
struct MapPlain { int lda, ldb; __device__ __forceinline__ void operator()(Unit& u) const { u.offA = (size_t)u.pm * 256 * lda * 2; u.offB = (size_t)u.pn * 256 * ldb * 2; } };

template <class Epi, class Sched, bool ALIGN_EPI = false, bool SP2 = false>
__device__ __forceinline__ void gemm_phase(PG8_LAS unsigned char* lds, const Gemm g, const Sched& S, const Epi& E, const int tid) {
    const int wid = __builtin_amdgcn_readfirstlane(tid >> 6), lane = tid & 63, wr = wid >> 2, wc = wid & 3, fr = lane & 15, fq = lane >> 4;
    const int K = g.K, nt = K / BK;
    unsigned voffA[2], voffB[2];
#pragma unroll
    for (int i = 0; i < 2; ++i) { int R, C; stage_rc(tid * 16 + i * 8192, R, C); const int Rb = Epi::PERM ? ((R & ~31) + perm32(R & 31)) : R;
        voffA[i] = (unsigned)(R * g.lda + C) * 2u; voffB[i] = (unsigned)(Rb * g.ldb + C) * 2u; }
    const size_t kstep = (size_t)(BK * 2);
    const size_t hstepA = (size_t)HALF * g.lda * 2, hstepB = (size_t)HALF * g.ldb * 2;
    const unsigned ldsw = (unsigned)wid * 1024u;
    const int aoff = lds_byte(wr * 64 + fr, fq * 8), boff = lds_byte(wc * 32 + fr, fq * 8);
#define PG8_SA(b, h) (((b) * 2 + (h)) * HTB)
#define PG8_SB(b, h) ((4 + (b) * 2 + (h)) * HTB)
#define PG8_STAGE(bufoff, gbase, voff) do { _Pragma("unroll") for (int _i = 0; _i < 2; ++_i) \
        __builtin_amdgcn_global_load_lds((const unsigned*)((const char*)(gbase) + (voff)[_i]), (PG8_LAS unsigned*)(lds + (bufoff) + ldsw + _i * 8192), 16, 0, 0); } while (0)
#define PG8_LDA(dst, b, h) do { _Pragma("unroll") for (int m = 0; m < 4; ++m) _Pragma("unroll") for (int k = 0; k < 2; ++k) dst[m][k] = *(const PG8_LAS bf16x8*)(lds + PG8_SA(b, h) + aoff + m * 2048 + k * 1024); } while (0)
#define PG8_LDB(dst, b, h) do { _Pragma("unroll") for (int n = 0; n < 2; ++n) _Pragma("unroll") for (int k = 0; k < 2; ++k) dst[n][k] = *(const PG8_LAS bf16x8*)(lds + PG8_SB(b, h) + boff + n * 2048 + k * 1024); } while (0)
#define PG8_MMA(ai, bj, At, Bt) do { __builtin_amdgcn_s_setprio(1); _Pragma("unroll") for (int m = 0; m < 4; ++m) _Pragma("unroll") for (int n = 0; n < 2; ++n) _Pragma("unroll") for (int k = 0; k < 2; ++k) \
        acc[ai][bj][m][n] = __builtin_amdgcn_mfma_f32_16x16x32_bf16(Bt[n][k], At[m][k], acc[ai][bj][m][n], 0, 0, 0); __builtin_amdgcn_s_setprio(0); } while (0)
#define PG8_WAIT_V(n) asm volatile("s_waitcnt vmcnt(" #n ")" ::: "memory")
#define PG8_WAIT_L(n) asm volatile("s_waitcnt lgkmcnt(" #n ")" ::: "memory")
#define PG8_BAR __builtin_amdgcn_s_barrier()
#define PG8_SCHED __builtin_amdgcn_sched_barrier(0)
    Unit cur, nxt; int ui = 0;
    if (!S.next(0, cur)) return;
    f32x4 acc[2][2][4][2];
#pragma unroll
    for (int a = 0; a < 2; ++a)
#pragma unroll
        for (int b = 0; b < 2; ++b)
#pragma unroll
            for (int m = 0; m < 4; ++m)
#pragma unroll
                for (int n = 0; n < 2; ++n) acc[a][b][m][n] = (f32x4){0.f, 0.f, 0.f, 0.f};
    bf16x8 At[4][2], B0[2][2], B1[2][2];
    const char* cA = (const char*)g.A + cur.offA; const char* cB = (const char*)g.Bt + cur.offB;
    S.a_ready(cur);
    if constexpr (SP2) {
        PG8_STAGE(PG8_SB(0, 0), cB, voffB); PG8_STAGE(PG8_SB(0, 1), cB + hstepB, voffB); PG8_STAGE(PG8_SA(0, 0), cA, voffA); PG8_STAGE(PG8_SA(0, 1), cA + hstepA, voffA);
        if (wr == 1) PG8_BAR;
        PG8_WAIT_V(2); PG8_BAR;
        PG8_STAGE(PG8_SB(1, 0), cB + kstep, voffB); PG8_STAGE(PG8_SA(1, 0), cA + kstep, voffA); PG8_STAGE(PG8_SB(1, 1), cB + hstepB + kstep, voffB);
        PG8_WAIT_V(6); PG8_BAR;
    } else {
        PG8_STAGE(PG8_SB(0, 0), cB, voffB); PG8_STAGE(PG8_SA(0, 0), cA, voffA); PG8_STAGE(PG8_SB(0, 1), cB + hstepB, voffB); PG8_STAGE(PG8_SA(0, 1), cA + hstepA, voffA);
        if (wr == 1) PG8_BAR;
        PG8_WAIT_V(4); PG8_BAR;
        PG8_STAGE(PG8_SB(1, 0), cB + kstep, voffB); PG8_STAGE(PG8_SA(1, 0), cA + kstep, voffA); PG8_STAGE(PG8_SB(1, 1), cB + hstepB + kstep, voffB);
        PG8_WAIT_V(6); PG8_BAR;
    }
    for (;;) {
        const bool has_next = S.next(ui + 1, nxt);
        const char* nA = has_next ? (const char*)g.A + nxt.offA : cA; const char* nB = has_next ? (const char*)g.Bt + nxt.offB : cB;
#pragma unroll 1
        for (int t = 0; t < nt; t += 2) {
            const bool last = (t == nt - 2);
            const char* a1 = cA + (size_t)(t + 1) * kstep;
            const char* a2 = last ? nA : cA + (size_t)(t + 2) * kstep; const char* b2 = last ? nB : cB + (size_t)(t + 2) * kstep;
            const char* a3 = a2 + kstep; const char* b3 = b2 + kstep;
            if (last && has_next) S.a_ready(nxt);
            if constexpr (SP2) {
            PG8_LDB(B0, 0, 0); PG8_LDB(B1, 0, 1); PG8_SCHED; PG8_LDA(At, 0, 0); PG8_STAGE(PG8_SA(1, 1), a1 + hstepA, voffA);
            PG8_WAIT_V(8); PG8_WAIT_L(0); PG8_BAR; PG8_MMA(0, 0, At, B0); PG8_MMA(0, 1, At, B1); PG8_BAR; PG8_SCHED;
            PG8_LDA(At, 0, 1); PG8_STAGE(PG8_SB(0, 0), b2, voffB); PG8_STAGE(PG8_SB(0, 1), b2 + hstepB, voffB); PG8_STAGE(PG8_SA(0, 0), a2, voffA);
            PG8_WAIT_V(8); PG8_WAIT_L(0); PG8_BAR; PG8_MMA(1, 0, At, B0); PG8_MMA(1, 1, At, B1); PG8_BAR; PG8_SCHED;
            PG8_LDB(B0, 1, 0); PG8_LDB(B1, 1, 1); PG8_SCHED; PG8_LDA(At, 1, 0); PG8_STAGE(PG8_SA(0, 1), a2 + hstepA, voffA);
            PG8_WAIT_V(8); PG8_WAIT_L(0); PG8_BAR; PG8_MMA(0, 0, At, B0); PG8_MMA(0, 1, At, B1); PG8_BAR; PG8_SCHED;
            PG8_LDA(At, 1, 1); PG8_STAGE(PG8_SB(1, 0), b3, voffB); PG8_STAGE(PG8_SB(1, 1), b3 + hstepB, voffB); PG8_STAGE(PG8_SA(1, 0), a3, voffA);
            PG8_WAIT_V(8); PG8_WAIT_L(0); PG8_BAR; PG8_MMA(1, 0, At, B0); PG8_MMA(1, 1, At, B1); PG8_BAR; PG8_SCHED;
            } else {
            PG8_LDB(B0, 0, 0); PG8_SCHED; PG8_LDA(At, 0, 0); PG8_STAGE(PG8_SA(1, 1), a1 + hstepA, voffA);
            PG8_WAIT_L(8); PG8_BAR; PG8_WAIT_L(0); PG8_MMA(0, 0, At, B0); PG8_BAR; PG8_SCHED;
            PG8_LDB(B1, 0, 1); PG8_STAGE(PG8_SB(0, 0), b2, voffB);
            PG8_BAR; PG8_WAIT_L(0); PG8_MMA(0, 1, At, B1); PG8_BAR;
            PG8_LDA(At, 0, 1); PG8_STAGE(PG8_SA(0, 0), a2, voffA);
            PG8_BAR; PG8_WAIT_L(0); PG8_MMA(1, 0, At, B0); PG8_BAR; PG8_SCHED;
            PG8_STAGE(PG8_SB(0, 1), b2 + hstepB, voffB);
            PG8_WAIT_V(6); PG8_BAR; PG8_MMA(1, 1, At, B1); PG8_BAR;
            PG8_LDB(B0, 1, 0); PG8_SCHED; PG8_LDA(At, 1, 0); PG8_STAGE(PG8_SA(0, 1), a2 + hstepA, voffA);
            PG8_WAIT_L(8); PG8_BAR; PG8_WAIT_L(0); PG8_MMA(0, 0, At, B0); PG8_BAR; PG8_SCHED;
            PG8_LDB(B1, 1, 1); PG8_STAGE(PG8_SB(1, 0), b3, voffB);
            PG8_BAR; PG8_WAIT_L(0); PG8_MMA(0, 1, At, B1); PG8_BAR;
            PG8_LDA(At, 1, 1); PG8_STAGE(PG8_SA(1, 0), a3, voffA);
            PG8_BAR; PG8_WAIT_L(0); PG8_MMA(1, 0, At, B0); PG8_BAR; PG8_SCHED;
            PG8_STAGE(PG8_SB(1, 1), b3 + hstepB, voffB);
            PG8_WAIT_V(6); PG8_BAR; PG8_MMA(1, 1, At, B1); PG8_BAR;
            }
        }
        if constexpr (ALIGN_EPI) { if (wr == 0) PG8_BAR; }
        if constexpr (!Epi::AFTER_DRAIN) { E(acc, cur, wr, wc, fr, fq); S.done(cur); }
        if (!has_next) break;
#pragma unroll
        for (int a = 0; a < 2; ++a)
#pragma unroll
            for (int b = 0; b < 2; ++b)
#pragma unroll
                for (int m = 0; m < 4; ++m)
#pragma unroll
                    for (int n = 0; n < 2; ++n) acc[a][b][m][n] = (f32x4){0.f, 0.f, 0.f, 0.f};
        cur = nxt; cA = nA; cB = nB; ++ui;
        if constexpr (ALIGN_EPI) { if (wr == 1) PG8_BAR; }
    }
    PG8_WAIT_V(0);
    if constexpr (!ALIGN_EPI) { if (wr == 0) PG8_BAR; }
    PG8_BAR;
    if constexpr (Epi::AFTER_DRAIN) { E.fused(acc, cur, wr, wc, fr, fq, lds, wid, lane); S.done(cur); }
#undef PG8_SA
#undef PG8_SB
#undef PG8_STAGE
#undef PG8_LDA
#undef PG8_LDB
#undef PG8_MMA
#undef PG8_WAIT_V
#undef PG8_WAIT_L
#undef PG8_BAR
#undef PG8_SCHED
}
}

constexpr int DM = 1024, NBATCH = 2, SEQ = 16384, MTOK = NBATCH * SEQ;
constexpr int FFH = 2816;
constexpr int RH = 4, RDK = 256, RDV = 512, RCH = 512, NCH = SEQ / RCH;
constexpr int RIN = 2 * RH * RDK + 2 * RH * RDV;
constexpr int NG = 4, NR = 4, HD = 64, NCMP = 1023, NSEL = 256, NSAIN = 1072;
constexpr float RMS_EPS = 1e-6f;
constexpr int APLD = 768;

constexpr size_t MiB = 1u << 20;
constexpr size_t WS_CTL = 0, CTL_ZERO_BYTES = 1 * MiB;
constexpr size_t WS_RINV = 1 * MiB;
constexpr size_t WS_BIAST = WS_RINV + 256 * 1024;
constexpr size_t WS_PEB = WS_BIAST + 16 * 1024;
constexpr size_t WS_PEBP = WS_PEB + 4 * 1024;
constexpr size_t WS_GSLOT = 2 * MiB;
constexpr size_t WS_OSLOT = 6 * MiB;
constexpr size_t WS_W = 8 * MiB;
constexpr size_t W_RI = WS_W, W_RO = W_RI + 12 * MiB, W_FI0 = W_RO + 4 * MiB, W_FI1 = W_FI0 + 11 * MiB, W_FO0 = W_FI1 + 11 * MiB, W_FO1 = W_FO0 + 11 * MiB / 2,
                 W_KVQ = W_FO1 + 11 * MiB / 2, W_KVV = W_KVQ + 9 * MiB / 2, W_NO = W_KVV + 1 * MiB, W_C1 = W_NO + 2 * MiB, W_END = W_C1 + 2 * MiB;
static_assert(W_END <= 68 * MiB, "weights");
constexpr size_t WS_TABA = 68 * MiB, WS_TABB = 84 * MiB;
constexpr size_t WS_XB = 100 * MiB;
constexpr size_t WS_MIX = 164 * MiB;
constexpr size_t WS_KT = WS_MIX, WS_KV = WS_MIX + 32 * MiB;
constexpr size_t WS_SCR = 228 * MiB;
constexpr size_t WS_AP = WS_SCR, WS_BP = WS_AP + 96 * MiB, WS_KN = WS_BP + 96 * MiB;
static_assert(WS_KN + 32 * MiB <= 512 * MiB, "ret scratch");
constexpr size_t WS_HID = WS_SCR;
constexpr size_t WS_KC = WS_SCR, WS_VC = WS_KC + 16 * MiB, WS_KS = WS_VC + 17 * MiB, WS_KW = WS_KS + 16 * MiB, WS_VST = WS_KW + 16 * MiB, WS_VWT = WS_VST + 16 * MiB,
                 WS_Q = WS_VWT + 16 * MiB, WS_GATE = WS_Q + 64 * MiB, WS_HIDC = WS_GATE + 6 * MiB, WS_KCMP = WS_HIDC + 8 * MiB, WS_VCMPT = WS_KCMP + 1 * MiB, WS_ONSA = WS_VCMPT + 1 * MiB,
                 WS_NSA_END = WS_ONSA + 64 * MiB;
static_assert(WS_NSA_END <= 512 * MiB, "nsa scratch");
constexpr size_t WS_NEED = 512 * MiB;

#define GAS __attribute__((address_space(1)))
#define LAS __attribute__((address_space(3)))
typedef unsigned short bf16;
typedef unsigned v4u __attribute__((ext_vector_type(4)));
typedef unsigned v2u __attribute__((ext_vector_type(2)));
typedef float f32x4 __attribute__((ext_vector_type(4)));
typedef float f32x2_t __attribute__((ext_vector_type(2)));
typedef __bf16 bf16x2_t __attribute__((ext_vector_type(2)));
typedef GAS unsigned gu32;
#define RLX_AGENT __ATOMIC_RELAXED, __HIP_MEMORY_SCOPE_AGENT
__device__ __forceinline__ unsigned cvtpk(float lo, float hi) { f32x2_t v = {lo, hi}; bf16x2_t b = __builtin_convertvector(v, bf16x2_t); return __builtin_bit_cast(unsigned, b); }
__device__ __forceinline__ v4u pack8(f32x4 a, f32x4 b) { v4u w; w.x = cvtpk(a[0], a[1]); w.y = cvtpk(a[2], a[3]); w.z = cvtpk(b[0], b[1]); w.w = cvtpk(b[2], b[3]); return w; }
__device__ __forceinline__ float bflo(unsigned w) { return __uint_as_float(w << 16); }
__device__ __forceinline__ float bfhi(unsigned w) { return __uint_as_float(w & 0xffff0000u); }
__device__ __forceinline__ float bf2f(bf16 b) { return __uint_as_float(((unsigned)b) << 16); }
__device__ __forceinline__ void unpack8(v4u w, float* f) { f[0] = bflo(w.x); f[1] = bfhi(w.x); f[2] = bflo(w.y); f[3] = bfhi(w.y); f[4] = bflo(w.z); f[5] = bfhi(w.z); f[6] = bflo(w.w); f[7] = bfhi(w.w); }
__device__ __forceinline__ bf16 f2bf(float f) { return (bf16)(cvtpk(f, 0.f) & 0xffffu); }
__device__ __forceinline__ float sigm(float x) { return 1.f / (1.f + __expf(-x)); }
__device__ __forceinline__ float silu(float x) { return x / (1.f + __expf(-x)); }
__device__ __forceinline__ float lg2gamma(int h) { return log2f(1.0f - exp2f(-5.0f - (float)h)); }
__device__ __forceinline__ float wave_sum(float v) {
#pragma unroll
    for (int o = 1; o < 64; o <<= 1) v += __shfl_xor(v, o);
    return v;
}
__device__ __forceinline__ float wave_max(float v) {
#pragma unroll
    for (int o = 1; o < 64; o <<= 1) v = fmaxf(v, __shfl_xor(v, o));
    return v;
}
__device__ __forceinline__ int t5_bucket(int n) {
    if (n < 16) return n;
    if (n >= 113) return 31;
    int b = 16 + (int)(logf((float)n * 0.0625f) / 2.0794415416798357f * 16.0f);
    return b < 31 ? b : 31;
}

#define XB_TMO      128
#define XB_XCNT(j)  (256  + 64 * (j))
#define XB_XSUB(j)  (1280 + 64 * (j))
#define XB_XGEN(j)  (2304 + 64 * (j))
#define XB_TOP      3328
#define XB_TOPGEN   3392
#define XCD_BAR_WORDS 3456
#define XB_SPIN_CAP (1u << 18)
__device__ __forceinline__ unsigned xb_ld(unsigned* p)              { return __hip_atomic_load(p, __ATOMIC_RELAXED, __HIP_MEMORY_SCOPE_AGENT); }
__device__ __forceinline__ unsigned xb_add(unsigned* p, unsigned v) { return __hip_atomic_fetch_add(p, v, __ATOMIC_RELAXED, __HIP_MEMORY_SCOPE_AGENT); }
__device__ __forceinline__ unsigned xb_xcc_id() { return (unsigned)__builtin_amdgcn_s_getreg((3 << 11) | 20) & 0xFu; }
#define XB_SPIN(cond, bar) do { unsigned _sp = 0; while (cond) { __builtin_amdgcn_s_sleep(1); \
    if ((++_sp & 255u) == 0u) { if (xb_ld(&(bar)[XB_TMO])) break; if (_sp > XB_SPIN_CAP) { atomicAdd(&(bar)[XB_TMO], 1u); break; } } } } while (0)
struct XcdBarrier { unsigned* bar; unsigned x; volatile LAS unsigned* st; };
__device__ __forceinline__ XcdBarrier xcd_barrier_post(unsigned* bar, volatile LAS unsigned* st) {
    XcdBarrier b; b.bar = bar; b.x = xb_xcc_id(); b.st = st;
    if (threadIdx.x == 0) (void)xb_add(&bar[XB_XCNT(b.x)], 1u);
    return b;
}
__device__ __forceinline__ void xcd_barrier_complete(unsigned* bar, unsigned x, unsigned& nloc, unsigned& nx) {
    const unsigned G = gridDim.x * gridDim.y * gridDim.z;
    unsigned sum, cnt, mine, sp = 0u;
    for (;;) {
        sum = 0u; cnt = 0u; mine = 0u;
#pragma unroll
        for (unsigned j = 0; j < 16; ++j) { const unsigned c = xb_ld(&bar[XB_XCNT(j)]); sum += c; cnt += (c > 0u) ? 1u : 0u; mine = (j == x) ? c : mine; }
        if (sum == G) break;
        __builtin_amdgcn_s_sleep(1);
        if ((++sp & 255u) == 0u) { if (xb_ld(&bar[XB_TMO])) break; if (sp > XB_SPIN_CAP) { atomicAdd(&bar[XB_TMO], 1u); break; } }
    }
    nloc = mine > 0u ? mine : 1u; nx = cnt > 0u ? cnt : 1u;
}
__device__ __forceinline__ void xcd_barrier(const XcdBarrier& b) {
    asm volatile("s_waitcnt vmcnt(0)" ::: "memory");
    __syncthreads();
    if (threadIdx.x == 0) {
        unsigned* bar = b.bar;
        __builtin_amdgcn_s_waitcnt(0);
        unsigned nloc = b.st[0], nx = b.st[1];
        if (nloc == 0u) { xcd_barrier_complete(bar, b.x, nloc, nx); b.st[0] = nloc; b.st[1] = nx; }
        const unsigned old = xb_add(&bar[XB_XSUB(b.x)], 1u);
        const unsigned gen = old / nloc;
        if (old + 1u == (gen + 1u) * nloc) {
            __builtin_amdgcn_fence(__ATOMIC_RELEASE, "agent");
            asm volatile("s_waitcnt vmcnt(0)" ::: "memory");
            const unsigned og = xb_add(&bar[XB_TOP], 1u);
            const unsigned tg = og / nx;
            if (og + 1u == (tg + 1u) * nx) xb_add(&bar[XB_TOPGEN], 1u);
            else XB_SPIN(xb_ld(&bar[XB_TOPGEN]) == tg, bar);
            __builtin_amdgcn_fence(__ATOMIC_ACQUIRE, "agent");
            xb_add(&bar[XB_XGEN(b.x)], 1u);
            asm volatile("s_waitcnt vmcnt(0)" ::: "memory");
        } else {
            XB_SPIN(xb_ld(&bar[XB_XGEN(b.x)]) == gen, bar);
            __builtin_amdgcn_fence(__ATOMIC_ACQUIRE, "agent");
            asm volatile("s_waitcnt vmcnt(0)" ::: "memory");
        }
    }
    __syncthreads();
}

using pg8::Unit;
typedef const f32x4 (&AccRef)[2][2][4][2];
#define EPI_ROW(u, ai, m) ((u).pm * 256 + (ai) * 128 + wr * 64 + (m) * 16 + fr)
#define EPI_COL(bj) ((bj) * 128 + wc * 32 + 8 * fq)

struct EpiP1N {
    static constexpr bool PERM = true, AFTER_DRAIN = false;
    const float* rinv; const f32x4* tabA; bf16* AP; bf16* KN;
    __device__ __forceinline__ void operator()(AccRef acc, const Unit& u, int wr, int wc, int fr, int fq) const {
        const int h = u.pn & 3; const bool isk = u.pn >= 4; const float lg = lg2gamma(h);
#pragma unroll
        for (int ai = 0; ai < 2; ++ai)
#pragma unroll
            for (int m = 0; m < 4; ++m) {
                const int t = EPI_ROW(u, ai, m); const int p = t & (RCH - 1), c = t / RCH;
                const float rs = rinv[t] * (isk ? 0.0625f * exp2f(-(float)p * lg) : exp2f((float)p * lg));
#pragma unroll
                for (int bj = 0; bj < 2; ++bj) {
                    const int d0 = EPI_COL(bj);
                    const f32x4 c0 = tabA[(size_t)t * 64 + (d0 >> 2)], c1 = tabA[(size_t)t * 64 + (d0 >> 2) + 1];
                    const f32x4 v0 = acc[ai][bj][m][0] * rs, v1 = acc[ai][bj][m][1] * rs;
                    const f32x4 o0 = {v0[0] * c0[0] - v0[1] * c0[1], v0[0] * c0[1] + v0[1] * c0[0], v0[2] * c0[2] - v0[3] * c0[3], v0[2] * c0[3] + v0[3] * c0[2]};
                    const f32x4 o1 = {v1[0] * c1[0] - v1[1] * c1[1], v1[0] * c1[1] + v1[1] * c1[0], v1[2] * c1[2] - v1[3] * c1[3], v1[2] * c1[3] + v1[3] * c1[2]};
                    const v4u w = pack8(o0, o1);
                    if (isk) *(v4u*)(KN + (size_t)t * 1024 + h * 256 + d0) = w;
                    else *(v4u*)(AP + ((size_t)(h * NCH + c) * RCH + p) * APLD + RCH + d0) = w;
                }
            }
    }
};
struct EpiP1S {
    static constexpr bool PERM = true, AFTER_DRAIN = false;
    const float* rinv; const f32x4* tabB; bf16* KT; bf16* BP;
    __device__ __forceinline__ void operator()(AccRef acc, const Unit& u, int wr, int wc, int fr, int fq) const {
        const bool isk = u.pm < 4; const float lg = lg2gamma(u.pm & 3);
#pragma unroll
        for (int bj = 0; bj < 2; ++bj) {
            const int t0 = u.pn * 256 + EPI_COL(bj); const int c = t0 / RCH, p0 = t0 & (RCH - 1);
            const f32x4 r0 = *(const f32x4*)(rinv + t0), r1 = *(const f32x4*)(rinv + t0 + 4);
            f32x4 s0, s1;
#pragma unroll
            for (int j = 0; j < 4; ++j) { s0[j] = r0[j] * 0.0625f * exp2f(-(float)(p0 + j) * lg); s1[j] = r1[j] * 0.0625f * exp2f(-(float)(p0 + 4 + j) * lg); }
#pragma unroll
            for (int ai = 0; ai < 2; ++ai)
#pragma unroll
                for (int m = 0; m < 4; ++m) {
                    const int row = EPI_ROW(u, ai, m);
                    if (isk) {
                        const int d = row & 255, i = d >> 1; const bool odd = d & 1;
                        const f32x4 v0 = acc[ai][bj][m][0] * s0, v1 = acc[ai][bj][m][1] * s1; f32x4 q0, q1;
#pragma unroll
                        for (int j = 0; j < 4; ++j) { q0[j] = __shfl_xor(v0[j], 1); q1[j] = __shfl_xor(v1[j], 1); }
                        const f32x4* tb = tabB + ((size_t)i * SEQ + t0) / 2;
                        const f32x4 ca = tb[0], cb = tb[1], cc = tb[2], cd = tb[3];
                        f32x4 o0, o1;
                        if (odd) { o0 = (f32x4){q0[0] * ca[1] + v0[0] * ca[0], q0[1] * ca[3] + v0[1] * ca[2], q0[2] * cb[1] + v0[2] * cb[0], q0[3] * cb[3] + v0[3] * cb[2]};
                                   o1 = (f32x4){q1[0] * cc[1] + v1[0] * cc[0], q1[1] * cc[3] + v1[1] * cc[2], q1[2] * cd[1] + v1[2] * cd[0], q1[3] * cd[3] + v1[3] * cd[2]}; }
                        else     { o0 = (f32x4){v0[0] * ca[0] - q0[0] * ca[1], v0[1] * ca[2] - q0[1] * ca[3], v0[2] * cb[0] - q0[2] * cb[1], v0[3] * cb[2] - q0[3] * cb[3]};
                                   o1 = (f32x4){v1[0] * cc[0] - q1[0] * cc[1], v1[1] * cc[2] - q1[1] * cc[3], v1[2] * cd[0] - q1[2] * cd[1], v1[3] * cd[2] - q1[3] * cd[3]}; }
                        *(v4u*)(KT + (size_t)row * SEQ + t0) = pack8(o0, o1);
                    } else {
                        const int eg = row - 1024, h = eg >> 9, e = eg & 511;
                        *(v4u*)(BP + ((size_t)(h * NCH + c) * RCH + e) * APLD + p0) = pack8(acc[ai][bj][m][0] * r0, acc[ai][bj][m][1] * r1);
                    }
                }
        }
    }
};
struct EpiG {
    static constexpr bool PERM = true, AFTER_DRAIN = false;
    const float* rinv; const float* gslots; bf16* O;
    __device__ __forceinline__ void operator()(AccRef acc, const Unit& u, int wr, int wc, int fr, int fq) const {
        const int h = u.pn >> 1;
#pragma unroll
        for (int ai = 0; ai < 2; ++ai)
#pragma unroll
            for (int m = 0; m < 4; ++m) {
                const int row = EPI_ROW(u, ai, m); const float rin = rinv[row];
                const f32x4 sa = *(const f32x4*)(gslots + (size_t)row * 32 + h * 8), sb = *(const f32x4*)(gslots + (size_t)row * 32 + h * 8 + 4);
                const float ss = ((sa[0] + sa[1]) + (sa[2] + sa[3])) + ((sb[0] + sb[1]) + (sb[2] + sb[3]));
                const float rs = rsqrtf(ss * (1.0f / RDV) + RMS_EPS);
#pragma unroll
                for (int bj = 0; bj < 2; ++bj) {
                    bf16* op = O + (size_t)row * 2048 + u.pn * 256 + EPI_COL(bj);
                    float o[8]; unpack8(*(const v4u*)op, o);
                    const f32x4 g0 = acc[ai][bj][m][0] * rin, g1 = acc[ai][bj][m][1] * rin; f32x4 a, b;
#pragma unroll
                    for (int j = 0; j < 4; ++j) { a[j] = o[j] * rs * silu(g0[j]); b[j] = o[4 + j] * rs * silu(g1[j]); }
                    *(v4u*)op = pack8(a, b);
                }
            }
    }
};
struct EpiOut {
    static constexpr bool PERM = true, AFTER_DRAIN = false;
    bf16* MIX; float* oslots;
    __device__ __forceinline__ void operator()(AccRef acc, const Unit& u, int wr, int wc, int fr, int fq) const {
#pragma unroll
        for (int ai = 0; ai < 2; ++ai)
#pragma unroll
            for (int m = 0; m < 4; ++m) {
                const int row = EPI_ROW(u, ai, m); float ss = 0.f;
#pragma unroll
                for (int bj = 0; bj < 2; ++bj) {
                    const f32x4 v0 = acc[ai][bj][m][0], v1 = acc[ai][bj][m][1];
                    ss += (v0[0] * v0[0] + v0[1] * v0[1]) + (v0[2] * v0[2] + v0[3] * v0[3]) + (v1[0] * v1[0] + v1[1] * v1[1]) + (v1[2] * v1[2] + v1[3] * v1[3]);
                    *(v4u*)(MIX + (size_t)row * 1024 + u.pn * 256 + EPI_COL(bj)) = pack8(v0, v1);
                }
                ss += __shfl_xor(ss, 16); ss += __shfl_xor(ss, 32);
                if (fq == 0) oslots[(size_t)row * 16 + u.pn * 4 + wc] = ss;
            }
    }
};
struct EpiFfnIn {
    static constexpr bool PERM = true, AFTER_DRAIN = false;
    const float* rinv; bf16* HID;
    __device__ __forceinline__ void operator()(AccRef acc, const Unit& u, int wr, int wc, int fr, int fq) const {
#pragma unroll
        for (int ai = 0; ai < 2; ++ai)
#pragma unroll
            for (int m = 0; m < 4; ++m) {
                const int row = EPI_ROW(u, ai, m); const float rin = rinv[row];
                const f32x4 a0 = acc[ai][0][m][0] * rin, a1 = acc[ai][0][m][1] * rin, b0 = acc[ai][1][m][0] * rin, b1 = acc[ai][1][m][1] * rin; f32x4 x, y;
#pragma unroll
                for (int j = 0; j < 4; ++j) { x[j] = silu(a0[j]) * b0[j]; y[j] = silu(a1[j]) * b1[j]; }
                *(v4u*)(HID + (size_t)row * FFH + u.pn * 128 + wc * 32 + 8 * fq) = pack8(x, y);
            }
    }
};
struct EpiKvqN {
    static constexpr bool PERM = true, AFTER_DRAIN = false;
    const float* rinv; bf16 *KC, *VC, *KS, *KW, *Q; float* GATE;
    __device__ __forceinline__ void operator()(AccRef acc, const Unit& u, int wr, int wc, int fr, int fq) const {
        bf16* plane = u.pn == 0 ? KC : u.pn == 1 ? VC : u.pn == 2 ? KS : KW;
#pragma unroll
        for (int ai = 0; ai < 2; ++ai)
#pragma unroll
            for (int m = 0; m < 4; ++m) {
                const int row = EPI_ROW(u, ai, m); const float rin = rinv[row]; const int b = row / SEQ, t = row % SEQ;
#pragma unroll
                for (int bj = 0; bj < 2; ++bj) {
                    const int cc = EPI_COL(bj);
                    f32x4 v0 = acc[ai][bj][m][0] * rin, v1 = acc[ai][bj][m][1] * rin;
                    if (u.pn < 4) { const int g = cc >> 6, d = cc & 63; *(v4u*)(plane + ((size_t)(b * NG + g) * SEQ + t) * HD + d) = pack8(v0, v1); }
                    else if (u.pn < 8) { *(v4u*)(Q + (size_t)row * 1024 + (u.pn - 4) * 256 + cc) = pack8(v0 * 0.125f, v1 * 0.125f); }
                    else if (cc < 48) {
#pragma unroll
                        for (int j = 0; j < 4; ++j) { v0[j] = sigm(v0[j]); v1[j] = sigm(v1[j]); }
                        *(f32x4*)(GATE + (size_t)row * 48 + cc) = v0; *(f32x4*)(GATE + (size_t)row * 48 + cc + 4) = v1;
                    }
                }
            }
    }
};
struct EpiKvqS {
    static constexpr bool PERM = true, AFTER_DRAIN = false;
    const float* rinv; bf16 *VST, *VWT;
    __device__ __forceinline__ void operator()(AccRef acc, const Unit& u, int wr, int wc, int fr, int fq) const {
        bf16* plane = u.pm == 0 ? VST : VWT;
#pragma unroll
        for (int bj = 0; bj < 2; ++bj) {
            const int mg = u.pn * 256 + EPI_COL(bj); const int b = mg / SEQ, t = mg % SEQ;
            const f32x4 r0 = *(const f32x4*)(rinv + mg), r1 = *(const f32x4*)(rinv + mg + 4);
#pragma unroll
            for (int ai = 0; ai < 2; ++ai)
#pragma unroll
                for (int m = 0; m < 4; ++m) {
                    const int r256 = ai * 128 + wr * 64 + m * 16 + fr; const int g = r256 >> 6, d = r256 & 63;
                    *(v4u*)(plane + ((size_t)((b * NG + g) * HD + d)) * SEQ + t) = pack8(acc[ai][bj][m][0] * r0, acc[ai][bj][m][1] * r1);
                }
        }
    }
};
struct EpiCmp {
    static constexpr bool PERM = true, AFTER_DRAIN = false;
    const float* peb; bf16* HIDC;
    __device__ __forceinline__ void operator()(AccRef acc, const Unit& u, int wr, int wc, int fr, int fq) const {
        const int kv = u.pm >= 32 ? 1 : 0;
#pragma unroll
        for (int bj = 0; bj < 2; ++bj) {
            const int col = EPI_COL(bj);
            const f32x4 b0 = *(const f32x4*)(peb + kv * 256 + col), b1 = *(const f32x4*)(peb + kv * 256 + col + 4);
#pragma unroll
            for (int ai = 0; ai < 2; ++ai)
#pragma unroll
                for (int m = 0; m < 4; ++m) {
                    const int row = EPI_ROW(u, ai, m); f32x4 x = acc[ai][bj][m][0] + b0, y = acc[ai][bj][m][1] + b1;
#pragma unroll
                    for (int j = 0; j < 4; ++j) { x[j] = silu(x[j]); y[j] = silu(y[j]); }
                    *(v4u*)(HIDC + (size_t)row * 256 + col) = pack8(x, y);
                }
        }
    }
};
struct MapCmp { __device__ __forceinline__ void operator()(Unit& u) const { u.offA = (size_t)u.pm * 256 * 1024 * 2; u.offB = (size_t)(u.pm >= 32 ? 256 : 0) * 2048 * 2; } };

struct MapKV { __device__ __forceinline__ void operator()(Unit& u) const { const int hc = u.pm >> 1, eh = u.pm & 1, h = hc / NCH, c = hc % NCH;
    u.offA = ((size_t)(hc * RCH + eh * 256) * APLD) * 2; u.offB = ((size_t)(h * RDK) * SEQ + (size_t)c * RCH) * 2; } };
struct EpiKV {
    static constexpr bool PERM = true, AFTER_DRAIN = false;
    bf16* KV;
    __device__ __forceinline__ void operator()(AccRef acc, const Unit& u, int wr, int wc, int fr, int fq) const {
#pragma unroll
        for (int ai = 0; ai < 2; ++ai)
#pragma unroll
            for (int m = 0; m < 4; ++m) { const int row = EPI_ROW(u, ai, m);
#pragma unroll
                for (int bj = 0; bj < 2; ++bj) *(v4u*)(KV + (size_t)row * RDK + EPI_COL(bj)) = pack8(acc[ai][bj][m][0], acc[ai][bj][m][1]); }
    }
};
struct MapS { __device__ __forceinline__ void operator()(Unit& u) const { const int hc = u.pm >> 1, qh = u.pm & 1, h = hc / NCH, c = hc % NCH;
    u.offA = ((size_t)(hc * RCH + qh * 256) * APLD + RCH) * 2; u.offB = ((size_t)(c * RCH + u.pn * 256) * 1024 + h * RDK) * 2; } };
struct EpiS {
    static constexpr bool PERM = true, AFTER_DRAIN = false;
    bf16* AP;
    __device__ __forceinline__ void operator()(AccRef acc, const Unit& u, int wr, int wc, int fr, int fq) const {
        const int qh = u.pm & 1;
#pragma unroll
        for (int ai = 0; ai < 2; ++ai)
#pragma unroll
            for (int m = 0; m < 4; ++m) { const int row = EPI_ROW(u, ai, m); const int qi = qh * 256 + ai * 128 + wr * 64 + m * 16 + fr;
#pragma unroll
                for (int bj = 0; bj < 2; ++bj) { const int k0 = u.pn * 256 + EPI_COL(bj); f32x4 v0 = acc[ai][bj][m][0], v1 = acc[ai][bj][m][1];
#pragma unroll
                    for (int j = 0; j < 4; ++j) { if (k0 + j > qi) v0[j] = 0.f; if (k0 + 4 + j > qi) v1[j] = 0.f; }
                    *(v4u*)(AP + (size_t)row * APLD + k0) = pack8(v0, v1); } }
    }
};
struct MapO { __device__ __forceinline__ void operator()(Unit& u) const { const int hc = u.pm >> 1, qh = u.pm & 1;
    u.offA = ((size_t)(hc * RCH + qh * 256) * APLD) * 2; u.offB = ((size_t)(hc * RCH + u.pn * 256) * APLD) * 2; } };
struct EpiO {
    static constexpr bool PERM = true, AFTER_DRAIN = false;
    bf16* O; float* gslots; int b;
    __device__ __forceinline__ void operator()(AccRef acc, const Unit& u, int wr, int wc, int fr, int fq) const {
        const int hc = u.pm >> 1, qh = u.pm & 1, h = hc / NCH, c = hc % NCH;
#pragma unroll
        for (int ai = 0; ai < 2; ++ai)
#pragma unroll
            for (int m = 0; m < 4; ++m) { const size_t row = (size_t)b * SEQ + c * RCH + qh * 256 + ai * 128 + wr * 64 + m * 16 + fr; float ss = 0.f;
#pragma unroll
                for (int bj = 0; bj < 2; ++bj) { const f32x4 v0 = acc[ai][bj][m][0], v1 = acc[ai][bj][m][1];
                    ss += (v0[0] * v0[0] + v0[1] * v0[1]) + (v0[2] * v0[2] + v0[3] * v0[3]) + (v1[0] * v1[0] + v1[1] * v1[1]) + (v1[2] * v1[2] + v1[3] * v1[3]);
                    *(v4u*)(O + row * 2048 + h * RDV + u.pn * 256 + EPI_COL(bj)) = pack8(v0, v1); }
                ss += __shfl_xor(ss, 16); ss += __shfl_xor(ss, 32);
                if (fq == 0) gslots[row * 32 + h * 8 + u.pn * 4 + wc] = ss; }
    }
};

constexpr int NWAVES = 8, NTHREADS = NWAVES * 64;
constexpr int RING_OFF = 0, RING_BYTES = 131072;
constexpr int LDSCTL_OFF = RING_BYTES, MISC_OFF = LDSCTL_OFF + 320;
constexpr int LDS_BYTES = 147456;
constexpr int CW_BAR = 4096;

struct Args { const float* in[20]; float* out; unsigned char* ws; int ph, b; };
struct Frame {
    LAS unsigned char* lds; unsigned char* ws; float* out; const float* const* in;
    int tid, lane, wave, G, vcu, gw, NGW;
};

template <class DestRow>
__device__ __forceinline__ void transpose_item(const float* W, int K, int ldw, int ncols, const float* gain, bf16* WT, LAS float* scr, int k0, int n0, int lane, const DestRow& dr) {
#pragma unroll 8
    for (int i = 0; i < 32; ++i) { const int kk = 2 * i + (lane >> 5), n = n0 + (lane & 31);
        float v = 0.f; if (n < ncols) v = W[(size_t)(k0 + kk) * ldw + n]; if (gain) v *= gain[k0 + kk];
        scr[kk * 33 + (lane & 31)] = v; }
    asm volatile("s_waitcnt lgkmcnt(0)" ::: "memory");
    const int c = lane & 7;
#pragma unroll
    for (int j = 0; j < 4; ++j) { const int n = (lane >> 3) + 8 * j; const LAS float* s = scr + (8 * c) * 33 + n;
        v4u o; o.x = cvtpk(s[0 * 33], s[1 * 33]); o.y = cvtpk(s[2 * 33], s[3 * 33]); o.z = cvtpk(s[4 * 33], s[5 * 33]); o.w = cvtpk(s[6 * 33], s[7 * 33]);
        const int drow = dr(n0 + n); if (drow >= 0) *(v4u*)(WT + (size_t)drow * K + k0 + 8 * c) = o; }
    asm volatile("s_waitcnt lgkmcnt(0)" ::: "memory");
}
template <class DestRow>
__device__ __forceinline__ void transpose_matrix(const Frame& F, const float* W, int K, int ldw, int ncols, int ncols_pad, const float* gain, bf16* WT, const DestRow& dr) {
    LAS float* scr = (LAS float*)(F.lds + RING_OFF + F.wave * 16384);
    const int nblk = ncols_pad / 32, items = (K / 64) * nblk;
    for (int it = F.gw; it < items; it += F.NGW) transpose_item(W, K, ldw, ncols, gain, WT, scr, 64 * (it / nblk), 32 * (it % nblk), F.lane, dr);
}
struct DrOff { int off; __device__ __forceinline__ int operator()(int n) const { return n + off; } };
struct DrFfn { __device__ __forceinline__ int operator()(int n) const { const int up = n >= FFH, j = up ? n - FFH : n; return (j >> 7) * 256 + up * 128 + (j & 127); } };
struct DrKv { __device__ __forceinline__ int operator()(int n) const {
        const int s = n >> 8, d = n & 255; return s < 3 ? n : s == 3 ? 2304 + d : s == 4 ? 768 + d : 2304 + 256 + d; } };

__device__ __forceinline__ void row_to_bf16(const float* xrow, bf16* orow, float* rinv, int lane) {
    const f32x4* xr = (const f32x4*)xrow + lane; f32x4 v[4]; float s = 0.f;
#pragma unroll
    for (int j = 0; j < 4; ++j) { v[j] = xr[64 * j]; s += (v[j][0] * v[j][0] + v[j][1] * v[j][1]) + (v[j][2] * v[j][2] + v[j][3] * v[j][3]); }
    s = wave_sum(s);
    v2u* o8 = (v2u*)orow + lane;
#pragma unroll
    for (int j = 0; j < 4; ++j) { v2u w; w.x = cvtpk(v[j][0], v[j][1]); w.y = cvtpk(v[j][2], v[j][3]); o8[64 * j] = w; }
    if (lane == 0) *rinv = rsqrtf(s * (1.0f / DM) + RMS_EPS);
}

__device__ __forceinline__ void phase_prologue(const Frame& F) {
    unsigned char* ws = F.ws; const float* const* in = F.in;
    transpose_matrix(F, in[7], DM, RIN, RIN, RIN, in[1], (bf16*)(ws + W_RI), DrOff{0});
    transpose_matrix(F, in[8], 2048, DM, DM, DM, nullptr, (bf16*)(ws + W_RO), DrOff{0});
    transpose_matrix(F, in[5], DM, 2 * FFH, 2 * FFH, 2 * FFH, in[3], (bf16*)(ws + W_FI0), DrFfn{});
    transpose_matrix(F, in[5] + (size_t)DM * 2 * FFH, DM, 2 * FFH, 2 * FFH, 2 * FFH, in[3] + DM, (bf16*)(ws + W_FI1), DrFfn{});
    transpose_matrix(F, in[6], FFH, DM, DM, DM, nullptr, (bf16*)(ws + W_FO0), DrOff{0});
    transpose_matrix(F, in[6] + (size_t)FFH * DM, FFH, DM, DM, DM, nullptr, (bf16*)(ws + W_FO1), DrOff{0});
    transpose_matrix(F, in[10], DM, 1536, 1536, 1536, in[9], (bf16*)(ws + W_KVQ), DrKv{});
    transpose_matrix(F, in[17], DM, NSAIN, NSAIN, 1280, in[1] + DM, (bf16*)(ws + W_KVQ), DrOff{1024});
    transpose_matrix(F, in[18], DM, DM, DM, DM, nullptr, (bf16*)(ws + W_NO), DrOff{0});
    transpose_matrix(F, in[12], 2048, 256, 256, 256, nullptr, (bf16*)(ws + W_C1), DrOff{0});
    transpose_matrix(F, in[15], 2048, 256, 256, 256, nullptr, (bf16*)(ws + W_C1), DrOff{256});
    {
        f32x2_t* tabA = (f32x2_t*)(ws + WS_TABA); f32x2_t* tabB = (f32x2_t*)(ws + WS_TABB);
        for (int idx = F.vcu * NTHREADS + F.tid; idx < SEQ * 128; idx += F.G * NTHREADS) {
            const int t = idx >> 7, i = idx & 127;
            const float theta = 1.0f / powf(10000.0f, (float)i * (1.0f / 127.0f));
            const float ang = (float)t * theta; float s, c; sincosf(ang, &s, &c);
            const f32x2_t v = {c, s}; tabA[idx] = v; tabB[(size_t)i * SEQ + t] = v;
        }
    }
    for (int m = F.gw; m < MTOK; m += F.NGW) row_to_bf16(in[0] + (size_t)m * DM, (bf16*)(ws + WS_XB) + (size_t)m * DM, (float*)(ws + WS_RINV) + m, F.lane);
    if (blockIdx.x == 0) for (int i = F.tid; i < 128 * 16; i += NTHREADS) ((float*)(ws + WS_BIAST))[i] = in[19][t5_bucket(i >> 4) * 16 + (i & 15)];
    if (blockIdx.x < 32) {
        const int kv = F.tid >> 8, c = F.tid & 255; const float* pe = kv ? in[14] : in[11]; const float* w1 = kv ? in[15] : in[12]; float s = 0.f;
        for (int k = 64 * blockIdx.x; k < 64 * blockIdx.x + 64; ++k) s += pe[k] * w1[(size_t)k * 256 + c];
        ((float*)(ws + WS_PEBP))[blockIdx.x * 512 + F.tid] = s;
    }
}
__device__ __forceinline__ void phase_peb_final(const Frame& F) {
    if (blockIdx.x == 0) { float s = 0.f; for (int w = 0; w < 32; ++w) s += ((const float*)(F.ws + WS_PEBP))[w * 512 + F.tid]; ((float*)(F.ws + WS_PEB))[F.tid] = s; }
}

__device__ __forceinline__ void phase_resid(const Frame& F, const float* hold, const float* gpost, bool last) {
    const bf16* MIX = (const bf16*)(F.ws + WS_MIX); const float* oslots = (const float*)(F.ws + WS_OSLOT);
    bf16* XB = (bf16*)(F.ws + WS_XB); float* rinv = (float*)(F.ws + WS_RINV);
    f32x4 gp[4];
#pragma unroll
    for (int j = 0; j < 4; ++j) gp[j] = ((const f32x4*)gpost)[F.lane + 64 * j];
    for (int m = F.gw; m < MTOK; m += F.NGW) {
        const f32x4* sl = (const f32x4*)(oslots + (size_t)m * 16); const f32x4 s0 = sl[0], s1 = sl[1], s2 = sl[2], s3 = sl[3];
        const float ss = (((s0[0] + s0[1]) + (s0[2] + s0[3])) + ((s1[0] + s1[1]) + (s1[2] + s1[3]))) + (((s2[0] + s2[1]) + (s2[2] + s2[3])) + ((s3[0] + s3[1]) + (s3[2] + s3[3])));
        const float rs = rsqrtf(ss * (1.0f / DM) + RMS_EPS);
        const f32x4* hr = (const f32x4*)(hold + (size_t)m * DM) + F.lane; const v2u* mr = (const v2u*)(MIX + (size_t)m * DM) + F.lane;
        f32x4 hn[4]; float s = 0.f;
#pragma unroll
        for (int j = 0; j < 4; ++j) { const f32x4 hv = hr[64 * j]; const v2u mw = mr[64 * j];
            const f32x4 mx = {bflo(mw.x), bfhi(mw.x), bflo(mw.y), bfhi(mw.y)};
            hn[j] = hv + mx * rs * gp[j]; s += (hn[j][0] * hn[j][0] + hn[j][1] * hn[j][1]) + (hn[j][2] * hn[j][2] + hn[j][3] * hn[j][3]); }
        f32x4* ho = (f32x4*)(F.out + (size_t)m * DM) + F.lane;
#pragma unroll
        for (int j = 0; j < 4; ++j) ho[64 * j] = hn[j];
        if (!last) {
            s = wave_sum(s); v2u* o8 = (v2u*)(XB + (size_t)m * DM) + F.lane;
#pragma unroll
            for (int j = 0; j < 4; ++j) { v2u w; w.x = cvtpk(hn[j][0], hn[j][1]); w.y = cvtpk(hn[j][2], hn[j][3]); o8[64 * j] = w; }
            if (F.lane == 0) rinv[m] = rsqrtf(s * (1.0f / DM) + RMS_EPS);
        }
    }
}

__device__ __forceinline__ void phase_ret_naive(const Frame& F, int b) {
    const bf16* AP = (const bf16*)(F.ws + WS_AP); const bf16* BP = (const bf16*)(F.ws + WS_BP); const bf16* KN = (const bf16*)(F.ws + WS_KN);
    bf16* O = (bf16*)F.out;
    for (int item = blockIdx.x; item < RH * 8; item += F.G) {
        const int h = item >> 3, et = item & 7, el = F.tid >> 3, ds = F.tid & 7, e = et * 64 + el;
        const float cdec = exp2f((float)RCH * lg2gamma(h));
        float U[32];
#pragma unroll
        for (int i = 0; i < 32; ++i) U[i] = 0.f;
        v4u kb[4], qb[4]; bf16 vb;
#define RN_LOAD(tt, KB, QB, VB) do { const int c_ = (tt) / RCH, p_ = (tt) & (RCH - 1); \
            const v4u* kp_ = (const v4u*)(KN + (size_t)(tt) * 1024 + h * 256 + ds * 32); const v4u* qp_ = (const v4u*)(AP + ((size_t)(h * NCH + c_) * RCH + p_) * APLD + RCH + ds * 32); \
            _Pragma("unroll") for (int j_ = 0; j_ < 4; ++j_) { KB[j_] = kp_[j_]; QB[j_] = qp_[j_]; } VB = BP[((size_t)(h * NCH + c_) * RCH + e) * APLD + p_]; } while (0)
        RN_LOAD(0, kb, qb, vb);
        for (int t = 0; t < SEQ; ++t) {
            v4u kn[4], qn[4]; bf16 vn; const int tn = t + 1 < SEQ ? t + 1 : t;
            RN_LOAD(tn, kn, qn, vn);
            const float v = bf2f(vb); float acc = 0.f;
#pragma unroll
            for (int j = 0; j < 4; ++j) { float kf[8], qf[8]; unpack8(kb[j], kf); unpack8(qb[j], qf);
#pragma unroll
                for (int i = 0; i < 8; ++i) { U[8 * j + i] += kf[i] * v; acc += qf[i] * U[8 * j + i]; } }
            acc += __shfl_xor(acc, 1); acc += __shfl_xor(acc, 2); acc += __shfl_xor(acc, 4);
            if (ds == 0) O[(size_t)(b * SEQ + t) * 2048 + h * 512 + e] = f2bf(acc);
            if ((t & (RCH - 1)) == RCH - 1) {
#pragma unroll
                for (int i = 0; i < 32; ++i) U[i] *= cdec; }
#pragma unroll
            for (int j = 0; j < 4; ++j) { kb[j] = kn[j]; qb[j] = qn[j]; } vb = vn;
        }
#undef RN_LOAD
    }
}
__device__ __forceinline__ void phase_ret_ssq(const Frame& F, int b) {
    const bf16* O = (const bf16*)F.out; float* gs = (float*)(F.ws + WS_GSLOT);
    for (int r = F.gw; r < SEQ * RH; r += F.NGW) {
        const int m = b * SEQ + (r >> 2), h = r & 3; float f[8]; unpack8(((const v4u*)(O + (size_t)m * 2048 + h * 512))[F.lane], f);
        float s = 0.f;
#pragma unroll
        for (int i = 0; i < 8; ++i) s += f[i] * f[i];
        s = wave_sum(s);
        if (F.lane < 8) gs[(size_t)m * 32 + h * 8 + F.lane] = F.lane == 0 ? s : 0.f;
    }
}

__device__ __forceinline__ void phase_cmp2(const Frame& F) {
    const bf16* HIDC = (const bf16*)(F.ws + WS_HIDC); bf16* KCMP = (bf16*)(F.ws + WS_KCMP); bf16* VCT = (bf16*)(F.ws + WS_VCMPT);
    LAS float* scr = (LAS float*)(F.lds + RING_OFF + F.wave * 2048);
    for (int R = F.gw; R < 16384; R += F.NGW) {
        const int kv = R >> 13, pl = (R >> 10) & 7, n = R & 1023; const float* w2 = kv ? F.in[16] : F.in[13];
        const v2u hw = ((const v2u*)(HIDC + (size_t)R * 256))[F.lane];
        scr[4 * F.lane + 0] = bflo(hw.x); scr[4 * F.lane + 1] = bfhi(hw.x); scr[4 * F.lane + 2] = bflo(hw.y); scr[4 * F.lane + 3] = bfhi(hw.y);
        asm volatile("s_waitcnt lgkmcnt(0)" ::: "memory");
        float s = 0.f;
#pragma unroll 8
        for (int c = 0; c < 256; ++c) s += scr[c] * w2[c * 64 + F.lane];
        if (n == NCMP) s = 0.f;
        if (kv == 0) KCMP[((size_t)pl * 1024 + n) * 64 + F.lane] = f2bf(s);
        else VCT[((size_t)pl * 64 + F.lane) * 1024 + n] = f2bf(s);
        asm volatile("s_waitcnt lgkmcnt(0)" ::: "memory");
    }
}

__device__ __forceinline__ void phase_ret_scan(const Frame& F) {
    const bf16* KV = (const bf16*)(F.ws + WS_KV); bf16* BP = (bf16*)(F.ws + WS_BP);
    for (int it = F.vcu * NTHREADS + F.tid; it < RH * RDV * (RDK / 8); it += F.G * NTHREADS) {
        const int d8 = it & 31, e = (it >> 5) & 511, h = it >> 14;
        const float cdec = exp2f((float)RCH * lg2gamma(h));
        float carry[8];
#pragma unroll
        for (int i = 0; i < 8; ++i) carry[i] = 0.f;
#pragma unroll 4
        for (int c = 0; c < NCH; ++c) {
            const size_t r = (size_t)(h * NCH + c) * RCH + e;
            float kv[8]; unpack8(*(const v4u*)(KV + r * RDK + d8 * 8), kv);
            v4u w; w.x = cvtpk(carry[0], carry[1]); w.y = cvtpk(carry[2], carry[3]); w.z = cvtpk(carry[4], carry[5]); w.w = cvtpk(carry[6], carry[7]);
            *(v4u*)(BP + r * APLD + RCH + d8 * 8) = w;
#pragma unroll
            for (int i = 0; i < 8; ++i) carry[i] = cdec * (carry[i] + kv[i]);
        }
    }
}

namespace nsa {
typedef float f32x16 __attribute__((ext_vector_type(16)));
typedef short s16x8 __attribute__((ext_vector_type(8)));
constexpr int KP = 72;
constexpr float LOG2E = 1.4426950408889634f, NEGB = -1.0e30f;
constexpr int L_K = 0, L_V = 2 * 64 * KP * 2, L_IMP = 2 * L_V, IMP_P = 260, L_SELM = L_IMP + 64 * IMP_P * 4, L_BT = L_SELM + 2048, L_UNI = L_BT + 2048, L_LIST = L_UNI + 64, L_END = L_LIST + 1024 + 16;
static_assert(L_END <= RING_BYTES, "nsa lds");
__device__ __forceinline__ constexpr int krow(int r) { return (r & 3) + 8 * (r >> 2); }

struct TileRegs { v4u k, v; };
__device__ __forceinline__ void tile_load(TileRegs& R, const bf16* Kg, const bf16* Vg, int ldv, int tid) {
    asm volatile("" : "+v"(tid)); const int row = tid >> 3, ch = tid & 7;
    R.k = *(const v4u*)(Kg + (size_t)row * 64 + ch * 8); R.v = *(const v4u*)(Vg + (size_t)row * ldv + ch * 8);
}
__device__ __forceinline__ void tile_store(const TileRegs& R, LAS bf16* Kl, LAS bf16* Vl, int tid) {
    asm volatile("" : "+v"(tid)); const int row = tid >> 3, ch = tid & 7;
    *(LAS v4u*)(Kl + row * KP + ch * 8) = R.k; *(LAS v4u*)(Vl + row * KP + ch * 8) = R.v;
}
__device__ __forceinline__ f32x16 qk_tile(const LAS bf16* Kl, int kt, const s16x8 (&qf)[4], int r32, int h, float cinit) {
    f32x16 p;
#pragma unroll
    for (int r = 0; r < 16; ++r) p[r] = cinit;
#pragma unroll
    for (int s = 0; s < 4; ++s) { const s16x8 a = *(const LAS s16x8*)(Kl + (32 * kt + r32) * KP + 16 * s + 8 * h); p = __builtin_amdgcn_mfma_f32_32x32x16_bf16(a, qf[s], p, 0, 0, 0); }
    return p;
}
__device__ __forceinline__ void pv_tile(f32x16 (&o)[2], const LAS bf16* Vl, const f32x16& p0, const f32x16& p1, int r32, int h) {
#pragma unroll
    for (int kt = 0; kt < 2; ++kt)
#pragma unroll
        for (int s2 = 0; s2 < 2; ++s2) {
            const f32x16& p = kt ? p1 : p0;
            v4u pw; pw.x = cvtpk(p[8 * s2 + 0], p[8 * s2 + 1]); pw.y = cvtpk(p[8 * s2 + 2], p[8 * s2 + 3]); pw.z = cvtpk(p[8 * s2 + 4], p[8 * s2 + 5]); pw.w = cvtpk(p[8 * s2 + 6], p[8 * s2 + 7]);
            const s16x8 pb = __builtin_bit_cast(s16x8, pw);
#pragma unroll
            for (int dt = 0; dt < 2; ++dt) {
                const LAS bf16* vp = Vl + (32 * dt + r32) * KP + 32 * kt + 16 * s2 + 4 * h;
                const v2u lo = *(const LAS v2u*)vp, hi = *(const LAS v2u*)(vp + 8);
                v4u aw; aw.x = lo.x; aw.y = lo.y; aw.z = hi.x; aw.w = hi.y;
                o[dt] = __builtin_amdgcn_mfma_f32_32x32x16_bf16(__builtin_bit_cast(s16x8, aw), pb, o[dt], 0, 0, 0);
            }
        }
}
template <int MODE> __device__ __forceinline__ unsigned post_tile(f32x16& p, int kbase, int t, int lim, bool colok, const LAS float* bT) {
    unsigned vm = 0u;
#pragma unroll
    for (int r = 0; r < 16; ++r) {
        const int key = kbase + krow(r);
        const int dist = MODE == 0 ? t - 31 - 16 * key : t - key;
        const bool ok = colok && dist >= 0 && (MODE == 0 ? key < NCMP : dist < lim);
        const int di = dist < 0 ? 0 : (dist > 127 ? 127 : dist);
        p[r] = (p[r] + bT[di * 4]) * LOG2E;
        vm |= ok ? (1u << r) : 0u;
    }
    return vm;
}
__device__ __forceinline__ void softmax_update(f32x16& p0, f32x16& p1, unsigned vm0, unsigned vm1, float& m, float& l, f32x16 (&o)[2], bool has_o) {
    float mx = NEGB;
#pragma unroll
    for (int r = 0; r < 16; ++r) { if ((vm0 >> r) & 1u) mx = fmaxf(mx, p0[r]); if ((vm1 >> r) & 1u) mx = fmaxf(mx, p1[r]); }
    mx = fmaxf(mx, __shfl_xor(mx, 32));
    const float mn = fmaxf(m, mx), alpha = __builtin_amdgcn_exp2f(m - mn);
    m = mn; float ls = 0.f;
#pragma unroll
    for (int r = 0; r < 16; ++r) { p0[r] = ((vm0 >> r) & 1u) ? __builtin_amdgcn_exp2f(p0[r] - mn) : 0.f; p1[r] = ((vm1 >> r) & 1u) ? __builtin_amdgcn_exp2f(p1[r] - mn) : 0.f; ls += p0[r] + p1[r]; }
    l = l * alpha + ls;
    if (has_o && !__all(alpha == 1.0f)) {
#pragma unroll
        for (int r = 0; r < 16; ++r) { o[0][r] *= alpha; o[1][r] *= alpha; } }
}
}

__device__ __forceinline__ void phase_nsa(const Frame& F) {
    using namespace nsa;
    const int tid = F.tid, lane = F.lane, w = F.wave, r32_ = lane & 31, h_ = lane >> 5, r32 = r32_, h = h_, tl = r32 >> 2, rr = r32 & 3;
    LAS unsigned char* L = F.lds + RING_OFF;
    LAS bf16* Kb = (LAS bf16*)(L + L_K); LAS bf16* Vb = (LAS bf16*)(L + L_V);
    LAS float* IMP = (LAS float*)(L + L_IMP); LAS unsigned* SELM = (LAS unsigned*)(L + L_SELM); LAS float* BT = (LAS float*)(L + L_BT);
    LAS unsigned long long* UNI = (LAS unsigned long long*)(L + L_UNI); LAS int* LIST = (LAS int*)(L + L_LIST);
    const bf16* Q = (const bf16*)(F.ws + WS_Q); const bf16* KCMP = (const bf16*)(F.ws + WS_KCMP); const bf16* VCT = (const bf16*)(F.ws + WS_VCMPT);
    const bf16* KS = (const bf16*)(F.ws + WS_KS); const bf16* KW = (const bf16*)(F.ws + WS_KW); const bf16* VST = (const bf16*)(F.ws + WS_VST); const bf16* VWT = (const bf16*)(F.ws + WS_VWT);
    const float* GATE = (const float*)(F.ws + WS_GATE); const float* biasT = (const float*)(F.ws + WS_BIAST); bf16* ONSA = (bf16*)(F.ws + WS_ONSA);
    const int pl = F.vcu >> 5, wi = F.vcu & 31, b = pl >> 2, g = pl & 3;
    for (int i = tid; i < 512; i += NTHREADS) BT[i] = biasT[(i >> 2) * 16 + g * 4 + (i & 3)];
    __syncthreads();
    const LAS float* bTl = BT + rr;
#pragma unroll 1
    for (int ui = 0; ui < 8; ++ui) {
        const int qt = (ui & 1) ? 64 * (ui >> 1) + 63 - wi : 64 * (ui >> 1) + wi;
        const int t0 = qt * 64, cur = qt, m0 = b * SEQ + t0, tok = t0 + 8 * w + tl, mrow = m0 + 8 * w + tl, H = g * NR + rr;
        s16x8 qf[4];
#pragma unroll
        for (int s = 0; s < 4; ++s) qf[s] = *(const s16x8*)(Q + (size_t)mrow * 1024 + H * 64 + 16 * s + 8 * h);
        const float b31 = bTl[127 * 4];
        f32x16 oacc[2];
#pragma unroll
        for (int r = 0; r < 16; ++r) { oacc[0][r] = 0.f; oacc[1][r] = 0.f; }
        const float* gt = GATE + (size_t)mrow * 48 + H * 3; const float g0 = gt[0], g1 = gt[1], g2 = gt[2];
        for (int i = tid; i < 64 * IMP_P; i += NTHREADS) IMP[i] = 0.f;
        for (int i = tid; i < 512; i += NTHREADS) SELM[i] = 0u;
        __syncthreads();
        const int ncb = t0 >= 0 ? ((t0 + 63 - 31) / 16) / 64 + 1 : 0;
        const bf16* Kc = KCMP + (size_t)pl * 1024 * 64; const bf16* Vc = VCT + (size_t)pl * 64 * 1024;
        float mc = NEGB, lc = 0.f; f32x16 oc[2];
#pragma unroll
        for (int r = 0; r < 16; ++r) { oc[0][r] = 0.f; oc[1][r] = 0.f; }
#pragma unroll 1
        for (int pass = 0; pass < 2; ++pass) {
            float invl = 0.f;
            if (pass == 1) { const float lt = lc + __shfl_xor(lc, 32); invl = lt > 0.f ? 1.0f / lt : 0.f; }
            TileRegs R; tile_load(R, Kc, Vc, 1024, tid);
#pragma unroll 1
            for (int i = 0; i < ncb; ++i) {
                LAS bf16* Kl = Kb + (i & 1) * 64 * KP; LAS bf16* Vl = Vb + (i & 1) * 64 * KP;
                tile_store(R, Kl, Vl, tid);
                if (i + 1 < ncb) tile_load(R, Kc + (size_t)(i + 1) * 64 * 64, Vc + (i + 1) * 64, 1024, tid);
                __syncthreads();
                int r32 = r32_, h = h_; asm volatile("" : "+v"(r32), "+v"(h));
                f32x16 p0 = qk_tile(Kl, 0, qf, r32, h, 0.f), p1 = qk_tile(Kl, 1, qf, r32, h, 0.f);
                const unsigned vm0 = post_tile<0>(p0, i * 64 + 4 * h, tok, 0, true, bTl), vm1 = post_tile<0>(p1, i * 64 + 32 + 4 * h, tok, 0, true, bTl);
                if (pass == 0) { f32x16 dummy[2]; softmax_update(p0, p1, vm0, vm1, mc, lc, dummy, false); }
                else {
#pragma unroll
                    for (int r = 0; r < 16; ++r) { p0[r] = ((vm0 >> r) & 1u) ? __builtin_amdgcn_exp2f(p0[r] - mc) * invl : 0.f; p1[r] = ((vm1 >> r) & 1u) ? __builtin_amdgcn_exp2f(p1[r] - mc) * invl : 0.f; }
#pragma unroll
                    for (int kt = 0; kt < 2; ++kt)
#pragma unroll
                        for (int a = 0; a < 4; ++a) {
                            const f32x16& p = kt ? p1 : p0;
                            float s4 = (p[4 * a] + p[4 * a + 1]) + (p[4 * a + 2] + p[4 * a + 3]), s1 = p[4 * a + 3];
                            s4 += __shfl_xor(s4, 1); s4 += __shfl_xor(s4, 2); s1 += __shfl_xor(s1, 1); s1 += __shfl_xor(s1, 2);
                            const int j = i * 16 + kt * 8 + 2 * a + h;
                            if (rr == 0) { LAS float* ip = IMP + (8 * w + tl) * IMP_P + j; (void)__hip_atomic_fetch_add(ip, s4, __ATOMIC_RELAXED, __HIP_MEMORY_SCOPE_WORKGROUP); (void)__hip_atomic_fetch_add(ip + 1, s1, __ATOMIC_RELAXED, __HIP_MEMORY_SCOPE_WORKGROUP); }
                        }
                    pv_tile(oc, Vl, p0, p1, r32, h);
                }
            }
            __syncthreads();
        }
#pragma unroll
        for (int r = 0; r < 16; ++r) { oacc[0][r] += g0 * oc[0][r]; oacc[1][r] += g0 * oc[1][r]; }
        {
            int lane_o = lane; asm volatile("" : "+v"(lane_o));
            const int tk = lane_o >> 3, sub = lane_o & 7; LAS unsigned* sm = SELM + (8 * w + tk) * 8;
            const int ncand = cur - 2, nf = cur + 1 < 3 ? cur + 1 : 3, need = 16 - nf;
            asm volatile("s_waitcnt lgkmcnt(0)" ::: "memory");
            if (sub == 0) { (void)__hip_atomic_fetch_or(sm, 1u, __ATOMIC_RELAXED, __HIP_MEMORY_SCOPE_WORKGROUP); (void)__hip_atomic_fetch_or(sm + (cur >> 5), 1u << (cur & 31), __ATOMIC_RELAXED, __HIP_MEMORY_SCOPE_WORKGROUP); if (cur >= 1) (void)__hip_atomic_fetch_or(sm + ((cur - 1) >> 5), 1u << ((cur - 1) & 31), __ATOMIC_RELAXED, __HIP_MEMORY_SCOPE_WORKGROUP); }
            if (ncand <= need) {
                if (sub == 0) for (int j = 1; j <= cur - 2; ++j) (void)__hip_atomic_fetch_or(sm + (j >> 5), 1u << (j & 31), __ATOMIC_RELAXED, __HIP_MEMORY_SCOPE_WORKGROUP);
            } else {
                const LAS float* ip = IMP + (8 * w + tk) * IMP_P;
                float v[32];
#pragma unroll
                for (int i = 0; i < 32; ++i) { const int j = sub + 8 * i; v[i] = (j >= 1 && j <= cur - 2) ? ip[j] : -INFINITY; }
                float pv = INFINITY; int pj = -1;
#pragma unroll 1
                for (int round = 0; round < need; ++round) {
                    float bv = -INFINITY; int bj = 1 << 20;
#pragma unroll
                    for (int i = 0; i < 32; ++i) { const int j = sub + 8 * i; const bool elig = v[i] < pv || (v[i] == pv && j > pj); if (elig && (v[i] > bv || (v[i] == bv && j < bj))) { bv = v[i]; bj = j; } }
#pragma unroll
                    for (int o = 1; o < 8; o <<= 1) { const float ov = __shfl_xor(bv, o); const int oj = __shfl_xor(bj, o); if (ov > bv || (ov == bv && oj < bj)) { bv = ov; bj = oj; } }
                    pv = bv; pj = bj;
                    if (sub == 0 && bj < 256) (void)__hip_atomic_fetch_or(sm + (bj >> 5), 1u << (bj & 31), __ATOMIC_RELAXED, __HIP_MEMORY_SCOPE_WORKGROUP);
                }
            }
        }
        __syncthreads();
        {
            bool any = false; const int j = tid;
            if (j < 256) { unsigned acc = 0u; for (int t = 0; t < 64; ++t) acc |= SELM[t * 8 + (j >> 5)]; any = (acc >> (j & 31)) & 1u; any = any && j <= cur; }
            const unsigned long long bal = __ballot(any);
            if (lane == 0 && w < 4) UNI[w] = bal;
            __syncthreads();
            if (j < 256) { int pos = 0; for (int ww = 0; ww < w; ++ww) pos += __popcll(UNI[ww]); pos += __popcll(bal & ((1ull << lane) - 1ull)); if (any) LIST[1 + pos] = j; }
            if (tid == 0) LIST[0] = __popcll(UNI[0]) + __popcll(UNI[1]) + __popcll(UNI[2]) + __popcll(UNI[3]);
            __syncthreads();
        }
        unsigned wsel = SELM[(8 * w + (lane >> 3)) * 8 + (lane & 7)];
        wsel |= __shfl_xor(wsel, 8); wsel |= __shfl_xor(wsel, 16); wsel |= __shfl_xor(wsel, 32);
        {
            const int nsb = LIST[0];
            const bf16* Kg = KS + (size_t)pl * SEQ * 64; const bf16* Vg = VST + (size_t)pl * 64 * SEQ;
            float ms = NEGB, ls = 0.f; f32x16 os[2];
#pragma unroll
            for (int r = 0; r < 16; ++r) { os[0][r] = 0.f; os[1][r] = 0.f; }
            TileRegs R; { const int j0 = LIST[1]; tile_load(R, Kg + (size_t)j0 * 64 * 64, Vg + j0 * 64, SEQ, tid); }
#pragma unroll 1
            for (int i = 0; i < nsb; ++i) {
                const int j = LIST[1 + i];
                LAS bf16* Kl = Kb + (i & 1) * 64 * KP; LAS bf16* Vl = Vb + (i & 1) * 64 * KP;
                tile_store(R, Kl, Vl, tid);
                if (i + 1 < nsb) { const int jn = LIST[2 + i]; tile_load(R, Kg + (size_t)jn * 64 * 64, Vg + jn * 64, SEQ, tid); }
                __syncthreads();
                const bool wave_has = (__builtin_amdgcn_readlane(wsel, j >> 5) >> (j & 31)) & 1u;
                if (wave_has) {
                    int r32 = r32_, h = h_; asm volatile("" : "+v"(r32), "+v"(h));
                    const bool colok = (SELM[(8 * w + tl) * 8 + (j >> 5)] >> (j & 31)) & 1u;
                    const bool far = j <= cur - 3;
                    f32x16 p0 = qk_tile(Kl, 0, qf, r32, h, far ? b31 : 0.f), p1 = qk_tile(Kl, 1, qf, r32, h, far ? b31 : 0.f);
                    unsigned vm0, vm1;
                    if (far) {
#pragma unroll
                        for (int r = 0; r < 16; ++r) { p0[r] *= LOG2E; p1[r] *= LOG2E; }
                        vm0 = vm1 = colok ? 0xffffu : 0u;
                    } else { vm0 = post_tile<1>(p0, j * 64 + 4 * h, tok, 1 << 30, colok, bTl); vm1 = post_tile<1>(p1, j * 64 + 32 + 4 * h, tok, 1 << 30, colok, bTl); }
                    softmax_update(p0, p1, vm0, vm1, ms, ls, os, true);
                    pv_tile(os, Vl, p0, p1, r32, h);
                }
            }
            __syncthreads();
            const float lt = ls + __shfl_xor(ls, 32), sc = lt > 0.f ? g1 / lt : 0.f;
#pragma unroll
            for (int r = 0; r < 16; ++r) { oacc[0][r] += sc * os[0][r]; oacc[1][r] += sc * os[1][r]; }
        }
        {
            const int jb0 = cur >= 8 ? cur - 8 : 0, nwb = cur - jb0 + 1;
            const bf16* Kg = KW + (size_t)pl * SEQ * 64; const bf16* Vg = VWT + (size_t)pl * 64 * SEQ;
            float mw = NEGB, lw = 0.f; f32x16 ow[2];
#pragma unroll
            for (int r = 0; r < 16; ++r) { ow[0][r] = 0.f; ow[1][r] = 0.f; }
            TileRegs R; tile_load(R, Kg + (size_t)jb0 * 64 * 64, Vg + jb0 * 64, SEQ, tid);
#pragma unroll 1
            for (int i = 0; i < nwb; ++i) {
                const int j = jb0 + i;
                LAS bf16* Kl = Kb + (i & 1) * 64 * KP; LAS bf16* Vl = Vb + (i & 1) * 64 * KP;
                tile_store(R, Kl, Vl, tid);
                if (i + 1 < nwb) tile_load(R, Kg + (size_t)(j + 1) * 64 * 64, Vg + (j + 1) * 64, SEQ, tid);
                __syncthreads();
                const bool far = j <= cur - 3 && j >= cur - 7;
                int r32 = r32_, h = h_; asm volatile("" : "+v"(r32), "+v"(h));
                f32x16 p0 = qk_tile(Kl, 0, qf, r32, h, far ? b31 : 0.f), p1 = qk_tile(Kl, 1, qf, r32, h, far ? b31 : 0.f);
                unsigned vm0, vm1;
                if (far) {
#pragma unroll
                    for (int r = 0; r < 16; ++r) { p0[r] *= LOG2E; p1[r] *= LOG2E; }
                    vm0 = vm1 = 0xffffu;
                } else { vm0 = post_tile<1>(p0, j * 64 + 4 * h, tok, 512, true, bTl); vm1 = post_tile<1>(p1, j * 64 + 32 + 4 * h, tok, 512, true, bTl); }
                softmax_update(p0, p1, vm0, vm1, mw, lw, ow, true);
                pv_tile(ow, Vl, p0, p1, r32, h);
            }
            __syncthreads();
            const float lt = lw + __shfl_xor(lw, 32), sc = lt > 0.f ? g2 / lt : 0.f;
#pragma unroll
            for (int r = 0; r < 16; ++r) { oacc[0][r] += sc * ow[0][r]; oacc[1][r] += sc * ow[1][r]; }
        }
        {
            bf16* op = ONSA + (size_t)mrow * 1024 + H * 64 + 4 * h;
#pragma unroll
            for (int dt = 0; dt < 2; ++dt)
#pragma unroll
                for (int a = 0; a < 4; ++a) { v2u wv; wv.x = cvtpk(oacc[dt][4 * a], oacc[dt][4 * a + 1]); wv.y = cvtpk(oacc[dt][4 * a + 2], oacc[dt][4 * a + 3]); *(v2u*)(op + 32 * dt + 8 * a) = wv; }
        }
    }
}

__device__ __forceinline__ float dot64(const float* q, const bf16* krow) {
    const v4u* kp = (const v4u*)krow; float s = 0.f;
#pragma unroll
    for (int j = 0; j < 8; ++j) { float kf[8]; unpack8(kp[j], kf);
#pragma unroll
        for (int i = 0; i < 8; ++i) s += q[8 * j + i] * kf[i]; }
    return s;
}
__device__ __forceinline__ void wave_softmax(LAS float* S, int n, int n8, int ln) {
    float mx = -INFINITY;
    for (int i = ln; i < n; i += 64) mx = fmaxf(mx, S[i]);
    mx = wave_max(mx); if (!(mx > -INFINITY)) mx = 0.f;
    float sum = 0.f;
    for (int i = ln; i < n; i += 64) { const float p = __expf(S[i] - mx); S[i] = p; sum += p; }
    sum = wave_sum(sum); const float inv = 1.0f / fmaxf(sum, 1.17549435e-38f);
    for (int i = ln; i < n8; i += 64) S[i] = i < n ? S[i] * inv : 0.f;
}
__device__ __forceinline__ void phase_nsa_naive(const Frame& F) {
    const int half = F.tid >> 8, tl = F.tid & 255, r = tl >> 6, ln = tl & 63;
    LAS float* S = (LAS float*)(F.lds + RING_OFF + half * 32768);
    LAS float* IMPC = S + 4096; LAS float* IMP = IMPC + 1024; LAS int* SELF = (LAS int*)(IMP + 256); LAS int* BLK = SELF + 256;
    LAS float* Sr = S + r * 1024;
    const bf16* Q = (const bf16*)(F.ws + WS_Q); const bf16* KCMP = (const bf16*)(F.ws + WS_KCMP); const bf16* VCT = (const bf16*)(F.ws + WS_VCMPT);
    const bf16* KS = (const bf16*)(F.ws + WS_KS); const bf16* KW = (const bf16*)(F.ws + WS_KW); const bf16* VST = (const bf16*)(F.ws + WS_VST); const bf16* VWT = (const bf16*)(F.ws + WS_VWT);
    const float* GATE = (const float*)(F.ws + WS_GATE); const float* biasT = (const float*)(F.ws + WS_BIAST); bf16* ONSA = (bf16*)(F.ws + WS_ONSA);
    for (int it = blockIdx.x; it < MTOK * NG / 2; it += F.G) {
        const int item = it * 2 + half, m = item >> 2, g = item & 3, b = m / SEQ, t = m % SEQ, pl = b * NG + g, H = g * NR + r;
        float q[64];
        { const v4u* qp = (const v4u*)(Q + (size_t)m * 1024 + H * 64);
#pragma unroll
          for (int j = 0; j < 8; ++j) unpack8(qp[j], q + 8 * j); }
        const float* bT = biasT + H;
        const int nvalid = t >= 31 ? ((t - 31) / 16 + 1 < NCMP ? (t - 31) / 16 + 1 : NCMP) : 0, nv8 = (nvalid + 7) & ~7;
        for (int n = ln; n < nvalid; n += 64) { const int dist = t - 16 * n - 31; Sr[n] = dot64(q, KCMP + ((size_t)pl * 1024 + n) * 64) + bT[(dist < 127 ? dist : 127) * 16]; }
        __syncthreads();
        wave_softmax(Sr, nvalid, nv8, ln);
        __syncthreads();
        for (int n = tl; n < 1024; n += 256) IMPC[n] = n < nvalid ? (S[n] + S[1024 + n]) + (S[2048 + n] + S[3072 + n]) : 0.f;
        const int cur = t >> 6;
        SELF[tl] = (tl == 0 || tl == cur || tl == cur - 1) ? 1 : 0;
        __syncthreads();
        { float s = 0.f;
#pragma unroll
          for (int k = -1; k < 4; ++k) { const int n = 4 * tl + k; if (n >= 0 && n < NCMP) s += IMPC[n]; }
          IMP[tl] = s; }
        float oc = 0.f;
        for (int n0 = 0; n0 < nvalid; n0 += 8) { float vf[8]; unpack8(*(const v4u*)(VCT + ((size_t)pl * 64 + ln) * 1024 + n0), vf);
#pragma unroll
            for (int i = 0; i < 8; ++i) oc += Sr[n0 + i] * vf[i]; }
        __syncthreads();
        if (r == 0) {
            const int ncand = cur - 2, nf = cur + 1 < 3 ? cur + 1 : 3, need = 16 - nf;
            if (ncand <= need) { for (int j = ln; j < 256; j += 64) if (j >= 1 && j <= cur - 2) SELF[j] = 1; }
            else {
                float v[4];
#pragma unroll
                for (int i = 0; i < 4; ++i) { const int j = ln + 64 * i; v[i] = (j >= 1 && j <= cur - 2) ? IMP[j] : -INFINITY; }
                for (int round = 0; round < need; ++round) {
                    float bv = v[0]; int bj = ln;
#pragma unroll
                    for (int i = 1; i < 4; ++i) if (v[i] > bv) { bv = v[i]; bj = ln + 64 * i; }
#pragma unroll
                    for (int o = 1; o < 64; o <<= 1) { const float ov = __shfl_xor(bv, o); const int oj = __shfl_xor(bj, o); if (ov > bv || (ov == bv && oj < bj)) { bv = ov; bj = oj; } }
#pragma unroll
                    for (int i = 0; i < 4; ++i) if (bj == ln + 64 * i) { v[i] = -INFINITY; SELF[bj] = 1; }
                }
            }
        }
        __syncthreads();
        int nk = 0;
        for (int j = 0; j <= cur; ++j) {
            if (SELF[j]) {
                const int pos = 64 * j + ln, dist = t - pos;
                Sr[nk * 64 + ln] = pos <= t ? dot64(q, KS + ((size_t)pl * SEQ + pos) * 64) + bT[(dist < 127 ? dist : 127) * 16] : -INFINITY;
                if (tl == 0) BLK[nk] = j;
                ++nk;
            }
        }
        __syncthreads();
        wave_softmax(Sr, nk * 64, nk * 64, ln);
        float os = 0.f;
        for (int k = 0; k < nk; ++k) { const int j = BLK[k];
            for (int l0 = 0; l0 < 64; l0 += 8) { float vf[8]; unpack8(*(const v4u*)(VST + ((size_t)pl * 64 + ln) * SEQ + 64 * j + l0), vf);
#pragma unroll
                for (int i = 0; i < 8; ++i) os += Sr[k * 64 + l0 + i] * vf[i]; } }
        __syncthreads();
        for (int i = ln; i < 512; i += 64) { const int pos = t - 511 + i; Sr[i] = pos >= 0 ? dot64(q, KW + ((size_t)pl * SEQ + pos) * 64) + bT[((511 - i) < 127 ? (511 - i) : 127) * 16] : -INFINITY; }
        wave_softmax(Sr, 512, 512, ln);
        float ow = 0.f;
        for (int i = t >= 511 ? 0 : 511 - t; i < 512; ++i) ow += Sr[i] * bf2f(VWT[((size_t)pl * 64 + ln) * SEQ + (t - 511 + i)]);
        const float* gt = GATE + (size_t)m * 48 + H * 3;
        ONSA[(size_t)m * 1024 + H * 64 + ln] = f2bf(gt[0] * oc + gt[1] * os + gt[2] * ow);
        __syncthreads();
    }
}

template <class Epi, class Map>
__device__ __forceinline__ void run_gemm(const Frame& F, const bf16* A, const bf16* Bt, int lda, int ldb, int K, int nM, int nN, const Map& map, const Epi& E) {
    pg8::Gemm g{A, Bt, lda, ldb, K}; pg8::Order<Map> S; S.init(nM, nN, F.G, (int)blockIdx.x, map);
    int tid = F.tid; asm volatile("" : "+v"(tid));
    pg8::gemm_phase<Epi, pg8::Order<Map>, true, true>(F.lds + RING_OFF, g, S, E, tid);
}
enum { PH_PRO, PH_P1, PH_R1, PH_R2, PH_R3, PH_G, PH_OUT, PH_RES, PH_FI, PH_KVQN, PH_KVQS, PH_CMP, PH_CMP2, PH_NSAN, PH_NSA, PH_COUNT };

template <int PH> __device__ __forceinline__ void phase_body(const Frame& F, int b) {
    unsigned char* ws = F.ws; float* rinv = (float*)(ws + WS_RINV); bf16* XB = (bf16*)(ws + WS_XB);
    if constexpr (PH == PH_PRO) phase_prologue(F);
    if constexpr (PH == PH_P1) {
        { EpiP1N E{rinv + b * SEQ, (const f32x4*)(ws + WS_TABA), (bf16*)(ws + WS_AP), (bf16*)(ws + WS_KN)};
          run_gemm(F, XB + (size_t)b * SEQ * DM, (const bf16*)(ws + W_RI), DM, DM, DM, SEQ / 256, 8, pg8::MapPlain{DM, DM}, E); }
        __syncthreads();
        { EpiP1S E{rinv + b * SEQ, (const f32x4*)(ws + WS_TABB), (bf16*)(ws + WS_KT), (bf16*)(ws + WS_BP)};
          run_gemm(F, (const bf16*)(ws + W_RI) + (size_t)1024 * DM, XB + (size_t)b * SEQ * DM, DM, DM, DM, 12, SEQ / 256, pg8::MapPlain{DM, DM}, E); }
    }
    if constexpr (PH == PH_R1) {
        { EpiKV E{(bf16*)(ws + WS_KV)};
          run_gemm(F, (const bf16*)(ws + WS_BP), (const bf16*)(ws + WS_KT), APLD, SEQ, RCH, RH * NCH * 2, 1, MapKV{}, E); }
        __syncthreads();
        { EpiS E{(bf16*)(ws + WS_AP)};
          run_gemm(F, (const bf16*)(ws + WS_AP), (const bf16*)(ws + WS_KN), APLD, 1024, RDK, RH * NCH * 2, 2, MapS{}, E); }
    }
    if constexpr (PH == PH_R2) phase_ret_scan(F);
    if constexpr (PH == PH_R3) { EpiO E{(bf16*)F.out, (float*)(ws + WS_GSLOT), b};
        run_gemm(F, (const bf16*)(ws + WS_AP), (const bf16*)(ws + WS_BP), APLD, APLD, APLD, RH * NCH * 2, 2, MapO{}, E); }
    if constexpr (PH == PH_G) { EpiG E{rinv, (const float*)(ws + WS_GSLOT), (bf16*)F.out};
        run_gemm(F, XB, (const bf16*)(ws + W_RI) + (size_t)4096 * DM, DM, DM, DM, MTOK / 256, 8, pg8::MapPlain{DM, DM}, E); }
    if constexpr (PH == PH_OUT) {
        const bf16* A = b == 0 ? (const bf16*)F.out : b == 2 ? (const bf16*)(ws + WS_ONSA) : (const bf16*)(ws + WS_HID);
        const bf16* Bt = (const bf16*)(ws + (b == 0 ? W_RO : b == 1 ? W_FO0 : b == 2 ? W_NO : W_FO1));
        const int K = b == 0 ? 2048 : b == 2 ? DM : FFH;
        EpiOut E{(bf16*)(ws + WS_MIX), (float*)(ws + WS_OSLOT)};
        run_gemm(F, A, Bt, K, K, K, MTOK / 256, 4, pg8::MapPlain{K, K}, E); }
    if constexpr (PH == PH_RES) phase_resid(F, b == 0 ? F.in[0] : F.out, (b & 1 ? F.in[4] : F.in[2]) + (b >> 1) * DM, b == 3);
    if constexpr (PH == PH_FI) { EpiFfnIn E{rinv, (bf16*)(ws + WS_HID)};
        run_gemm(F, XB, (const bf16*)(ws + (b ? W_FI1 : W_FI0)), DM, DM, DM, MTOK / 256, 22, pg8::MapPlain{DM, DM}, E); }
    if constexpr (PH == PH_KVQN) { phase_peb_final(F);
        EpiKvqN E{rinv, (bf16*)(ws + WS_KC), (bf16*)(ws + WS_VC), (bf16*)(ws + WS_KS), (bf16*)(ws + WS_KW), (bf16*)(ws + WS_Q), (float*)(ws + WS_GATE)};
        run_gemm(F, XB, (const bf16*)(ws + W_KVQ), DM, DM, DM, MTOK / 256, 9, pg8::MapPlain{DM, DM}, E); }
    if constexpr (PH == PH_KVQS) { EpiKvqS E{rinv, (bf16*)(ws + WS_VST), (bf16*)(ws + WS_VWT)};
        run_gemm(F, (const bf16*)(ws + W_KVV), XB, DM, DM, DM, 2, MTOK / 256, pg8::MapPlain{DM, DM}, E); }
    if constexpr (PH == PH_CMP) { EpiCmp E{(const float*)(ws + WS_PEB), (bf16*)(ws + WS_HIDC)};
        run_gemm(F, (const bf16*)(ws + WS_KC), (const bf16*)(ws + W_C1), 1024, 2048, 2048, 64, 1, MapCmp{}, E); }
    if constexpr (PH == PH_CMP2) phase_cmp2(F);
    if constexpr (PH == PH_NSAN) phase_nsa_naive(F);
    if constexpr (PH == PH_NSA) phase_nsa(F);
}
__device__ __forceinline__ void make_frame(Frame& F, unsigned char* lds, const Args& args) {
    int tid = threadIdx.x; asm volatile("" : "+v"(tid));
    unsigned char* ws = args.ws; float* out = args.out; asm volatile("" : "+s"(ws), "+s"(out));
    F.lds = (LAS unsigned char*)lds; F.ws = ws; F.out = out; F.in = args.in;
    F.tid = tid; F.lane = tid & 63; F.wave = __builtin_amdgcn_readfirstlane(tid >> 6);
    F.G = gridDim.x; { const int bx = blockIdx.x; F.vcu = (F.G % 8 == 0) ? (bx % 8) * (F.G / 8) + bx / 8 : bx; }
    F.gw = F.vcu * NWAVES + F.wave; F.NGW = F.G * NWAVES;
}
#ifndef NSA_PHASE
#define NSA_PHASE PH_NSA
#endif
__global__ void __launch_bounds__(NTHREADS, 2) fwd(Args args) {
    extern __shared__ __attribute__((aligned(16))) unsigned char lds[];
    {   LAS unsigned* ctl = (LAS unsigned*)((LAS unsigned char*)lds + LDSCTL_OFF);
        for (int u = threadIdx.x; u < (LDS_BYTES - LDSCTL_OFF) / 4; u += NTHREADS) ctl[u] = 0u; }
    __syncthreads();
    const int lo = args.ph, hi = args.b;
    XcdBarrier bar; bar.bar = (unsigned*)(args.ws + WS_CTL) + CW_BAR; bar.x = 0; bar.st = nullptr;
    if (hi - lo > 1) bar = xcd_barrier_post((unsigned*)(args.ws + WS_CTL) + CW_BAR, (volatile LAS unsigned*)((LAS unsigned char*)lds + MISC_OFF) + 8);
    int ph = 0;
#ifndef DBG_MASK
#define DBG_MASK 0xffffffffu
#endif
#define RUN(PH, bval) do { if (ph >= lo && ph < hi) { Frame F; make_frame(F, lds, args); if constexpr ((DBG_MASK >> PH) & 1u) phase_body<PH>(F, (bval)); if (ph + 1 < hi) xcd_barrier(bar); } ++ph; } while (0)
    RUN(PH_PRO, 0);
#pragma unroll 1
    for (int layer = 0; layer < 2; ++layer) {
#pragma unroll 1
        for (int sub = 0; sub < 2; ++sub) {
            if (sub == 0) {
                if (layer == 0) {
#pragma unroll 1
                    for (int b = 0; b < NBATCH; ++b) { RUN(PH_P1, b); RUN(PH_R1, b); RUN(PH_R2, b); RUN(PH_R3, b); }
                    RUN(PH_G, 0);
                } else { RUN(PH_KVQN, 0); RUN(PH_KVQS, 0); RUN(PH_CMP, 0); RUN(PH_CMP2, 0); RUN(NSA_PHASE, 0); }
            } else RUN(PH_FI, layer);
            RUN(PH_OUT, 2 * layer + sub);
            RUN(PH_RES, 2 * layer + sub);
        }
    }
#undef RUN
}
constexpr int NPHASES = 1 + (8 + 1 + 2) + 3 + (5 + 2) + 3;

#ifndef MK_N_LAUNCH
#define MK_N_LAUNCH 1
#endif
extern "C" void kernel_launch(void* const* d_in, const int* in_sizes, int n_in, void* d_out, int out_size, void* d_ws, size_t ws_size, hipStream_t stream) {
    static int grid = 0;
    if (grid == 0) {
        if (n_in != 20 || out_size != MTOK * DM || ws_size < WS_NEED) { fprintf(stderr, "kernel_launch: unexpected problem shape (n_in %d, out %d, ws %zu)\n", n_in, out_size, ws_size); grid = -1; return; }
        int dev = 0, cus = 0, per_cu = 0;
        if (hipGetDevice(&dev) != hipSuccess || hipDeviceGetAttribute(&cus, hipDeviceAttributeMultiprocessorCount, dev) != hipSuccess) { grid = -1; return; }
        if (hipFuncSetAttribute((const void*)fwd, hipFuncAttributeMaxDynamicSharedMemorySize, LDS_BYTES) != hipSuccess) { fprintf(stderr, "kernel_launch: hipFuncSetAttribute failed\n"); grid = -1; return; }
        if (hipOccupancyMaxActiveBlocksPerMultiprocessor(&per_cu, (const void*)fwd, NTHREADS, LDS_BYTES) != hipSuccess || per_cu < 1) { fprintf(stderr, "kernel_launch: occupancy query says %d blocks per CU\n", per_cu); }
        (void)hipGetLastError();
        grid = cus;
    }
    if (grid < 0) return;
#ifdef DBG_ZERO_WS
    (void)hipMemsetAsync((char*)d_ws, 0, WS_NEED, stream);
#endif
    (void)hipMemsetAsync((char*)d_ws + WS_CTL, 0, CTL_ZERO_BYTES, stream);
    Args a{};
    for (int i = 0; i < 20; ++i) a.in[i] = (const float*)d_in[i];
    a.out = (float*)d_out; a.ws = (unsigned char*)d_ws;
    if (MK_N_LAUNCH == 1) { a.ph = 0; a.b = NPHASES; hipLaunchKernelGGL(fwd, dim3(grid), dim3(NTHREADS), LDS_BYTES, stream, a); }
    else for (int p = 0; p < NPHASES; ++p) { a.ph = p; a.b = p + 1; hipLaunchKernelGGL(fwd, dim3(grid), dim3(NTHREADS), LDS_BYTES, stream, a); }
}
```

```cpp
#include <hip/hip_runtime.h>
#include <cstdio>
#include <cstdint>
#include <utility>

namespace pg8 {
#define PG8_LAS __attribute__((address_space(3)))
typedef unsigned short bf16_t;
typedef short bf16x8 __attribute__((ext_vector_type(8)));
typedef float f32x4 __attribute__((ext_vector_type(4)));
typedef unsigned u32x4 __attribute__((ext_vector_type(4)));
constexpr int BM = 256, BK = 64, HALF = 128, HTB = HALF * BK * 2  , STAGE_BYTES = 8 * HTB, NXCD = 8, WGM = 8;

__host__ __device__ __forceinline__ int lds_byte(int r, int c) { const int st = (r >> 4) * 2 + (c >> 5), rr = r & 15, cc = c & 31, ob = rr * 64 + cc * 2; return st * 1024 + (ob ^ (((ob >> 9) & 1) << 5)); }
__host__ __device__ __forceinline__ void stage_rc(int b, int& R, int& C) { const int st = b / 1024, sb = b % 1024, swz = sb ^ (((sb >> 9) & 1) << 5); R = (st >> 1) * 16 + swz / 64; C = (st & 1) * 32 + (swz % 64) / 2; }
__host__ __device__ __forceinline__ int perm32(int rho) { const int n = rho >> 4, i = rho & 15; return 8 * (i >> 2) + 4 * n + (i & 3); }

struct Unit { int pm, pn; size_t offA, offB; };
struct Gemm { const bf16_t* A; const bf16_t* Bt; int lda, ldb, K; };

template <class Map> struct Order {
    int nM, nN, nwg, G, c; Map map;
    __device__ __forceinline__ void init(int nM_, int nN_, int G_, int c_, const Map& m) { nM = nM_; nN = nN_; nwg = nM * nN; G = G_; c = c_; map = m; }
    __device__ __forceinline__ bool next(int i, Unit& u) const {
        const long L = (long)i * G + c; if (L >= nwg) return false;
        int wgid = (int)L; { const int q = nwg / NXCD, r = nwg % NXCD, xcd = wgid % NXCD, off = wgid / NXCD; wgid = (xcd < r ? xcd * (q + 1) : r * (q + 1) + (xcd - r) * q) + off; }
        const int nig = WGM * nN, gid = wgid / nig, fm = gid * WGM, gsz = (nM - fm) < WGM ? (nM - fm) : WGM;
        u.pm = fm + ((wgid % nig) % gsz); u.pn = (wgid % nig) / gsz; map(u); return true;
    }
    __device__ __forceinline__ void a_ready(const Unit&) const {}
    __device__ __forceinline__ void done(const Unit&) const {}
};
struct MapPlain { int lda, ldb; __device__ __forceinline__ void operator()(Unit& u) const { u.offA = (size_t)u.pm * 256 * lda * 2; u.offB = (size_t)u.pn * 256 * ldb * 2; } };

template <class Epi, class Sched, bool ALIGN_EPI = false, bool SP2 = false>
__device__ __forceinline__ void gemm_phase(PG8_LAS unsigned char* lds, const Gemm g, const Sched& S, const Epi& E, const int tid) {
    const int wid = __builtin_amdgcn_readfirstlane(tid >> 6), lane = tid & 63, wr = wid >> 2, wc = wid & 3, fr = lane & 15, fq = lane >> 4;
    const int K = g.K, nt = K / BK;
    unsigned voffA[2], voffB[2];
#pragma unroll
    for (int i = 0; i < 2; ++i) { int R, C; stage_rc(tid * 16 + i * 8192, R, C); const int Rb = Epi::PERM ? ((R & ~31) + perm32(R & 31)) : R;
        voffA[i] = (unsigned)(R * g.lda + C) * 2u; voffB[i] = (unsigned)(Rb * g.ldb + C) * 2u; }
    const size_t kstep = (size_t)(BK * 2);
    const size_t hstepA = (size_t)HALF * g.lda * 2, hstepB = (size_t)HALF * g.ldb * 2;
    const unsigned ldsw = (unsigned)wid * 1024u;
    const int aoff = lds_byte(wr * 64 + fr, fq * 8), boff = lds_byte(wc * 32 + fr, fq * 8);
#define PG8_SA(b, h) (((b) * 2 + (h)) * HTB)
#define PG8_SB(b, h) ((4 + (b) * 2 + (h)) * HTB)
#define PG8_STAGE(bufoff, gbase, voff) do { _Pragma("unroll") for (int _i = 0; _i < 2; ++_i) \
        __builtin_amdgcn_global_load_lds((const unsigned*)((const char*)(gbase) + (voff)[_i]), (PG8_LAS unsigned*)(lds + (bufoff) + ldsw + _i * 8192), 16, 0, 0); } while (0)
#define PG8_LDA(dst, b, h) do { _Pragma("unroll") for (int m = 0; m < 4; ++m) _Pragma("unroll") for (int k = 0; k < 2; ++k) dst[m][k] = *(const PG8_LAS bf16x8*)(lds + PG8_SA(b, h) + aoff + m * 2048 + k * 1024); } while (0)
#define PG8_LDB(dst, b, h) do { _Pragma("unroll") for (int n = 0; n < 2; ++n) _Pragma("unroll") for (int k = 0; k < 2; ++k) dst[n][k] = *(const PG8_LAS bf16x8*)(lds + PG8_SB(b, h) + boff + n * 2048 + k * 1024); } while (0)
#define PG8_MMA(ai, bj, At, Bt) do { __builtin_amdgcn_s_setprio(1); _Pragma("unroll") for (int m = 0; m < 4; ++m) _Pragma("unroll") for (int n = 0; n < 2; ++n) _Pragma("unroll") for (int k = 0; k < 2; ++k) \
        acc[ai][bj][m][n] = __builtin_amdgcn_mfma_f32_16x16x32_bf16(Bt[n][k], At[m][k], acc[ai][bj][m][n], 0, 0, 0); __builtin_amdgcn_s_setprio(0); } while (0)
#define PG8_WAIT_V(n) asm volatile("s_waitcnt vmcnt(" #n ")" ::: "memory")
#define PG8_WAIT_L(n) asm volatile("s_waitcnt lgkmcnt(" #n ")" ::: "memory")
#define PG8_BAR __builtin_amdgcn_s_barrier()
#define PG8_SCHED __builtin_amdgcn_sched_barrier(0)
    Unit cur, nxt; int ui = 0;
    if (!S.next(0, cur)) return;
    f32x4 acc[2][2][4][2];
#pragma unroll
    for (int a = 0; a < 2; ++a)
#pragma unroll
        for (int b = 0; b < 2; ++b)
#pragma unroll
            for (int m = 0; m < 4; ++m)
#pragma unroll
                for (int n = 0; n < 2; ++n) acc[a][b][m][n] = (f32x4){0.f, 0.f, 0.f, 0.f};
    bf16x8 At[4][2], B0[2][2], B1[2][2];
    const char* cA = (const char*)g.A + cur.offA; const char* cB = (const char*)g.Bt + cur.offB;
    S.a_ready(cur);
    if constexpr (SP2) {
        PG8_STAGE(PG8_SB(0, 0), cB, voffB); PG8_STAGE(PG8_SB(0, 1), cB + hstepB, voffB); PG8_STAGE(PG8_SA(0, 0), cA, voffA); PG8_STAGE(PG8_SA(0, 1), cA + hstepA, voffA);
        if (wr == 1) PG8_BAR;
        PG8_WAIT_V(2); PG8_BAR;
        PG8_STAGE(PG8_SB(1, 0), cB + kstep, voffB); PG8_STAGE(PG8_SA(1, 0), cA + kstep, voffA); PG8_STAGE(PG8_SB(1, 1), cB + hstepB + kstep, voffB);
        PG8_WAIT_V(6); PG8_BAR;
    } else {
        PG8_STAGE(PG8_SB(0, 0), cB, voffB); PG8_STAGE(PG8_SA(0, 0), cA, voffA); PG8_STAGE(PG8_SB(0, 1), cB + hstepB, voffB); PG8_STAGE(PG8_SA(0, 1), cA + hstepA, voffA);
        if (wr == 1) PG8_BAR;
        PG8_WAIT_V(4); PG8_BAR;
        PG8_STAGE(PG8_SB(1, 0), cB + kstep, voffB); PG8_STAGE(PG8_SA(1, 0), cA + kstep, voffA); PG8_STAGE(PG8_SB(1, 1), cB + hstepB + kstep, voffB);
        PG8_WAIT_V(6); PG8_BAR;
    }
    for (;;) {
        const bool has_next = S.next(ui + 1, nxt);
        const char* nA = has_next ? (const char*)g.A + nxt.offA : cA; const char* nB = has_next ? (const char*)g.Bt + nxt.offB : cB;
#pragma unroll 1
        for (int t = 0; t < nt; t += 2) {
            const bool last = (t == nt - 2);
            const char* a1 = cA + (size_t)(t + 1) * kstep;
            const char* a2 = last ? nA : cA + (size_t)(t + 2) * kstep; const char* b2 = last ? nB : cB + (size_t)(t + 2) * kstep;
            const char* a3 = a2 + kstep; const char* b3 = b2 + kstep;
            if (last && has_next) S.a_ready(nxt);
            if constexpr (SP2) {
            PG8_LDB(B0, 0, 0); PG8_LDB(B1, 0, 1); PG8_SCHED; PG8_LDA(At, 0, 0); PG8_STAGE(PG8_SA(1, 1), a1 + hstepA, voffA);
            PG8_WAIT_V(8); PG8_WAIT_L(0); PG8_BAR; PG8_MMA(0, 0, At, B0); PG8_MMA(0, 1, At, B1); PG8_BAR; PG8_SCHED;
            PG8_LDA(At, 0, 1); PG8_STAGE(PG8_SB(0, 0), b2, voffB); PG8_STAGE(PG8_SB(0, 1), b2 + hstepB, voffB); PG8_STAGE(PG8_SA(0, 0), a2, voffA);
            PG8_WAIT_V(8); PG8_WAIT_L(0); PG8_BAR; PG8_MMA(1, 0, At, B0); PG8_MMA(1, 1, At, B1); PG8_BAR; PG8_SCHED;
            PG8_LDB(B0, 1, 0); PG8_LDB(B1, 1, 1); PG8_SCHED; PG8_LDA(At, 1, 0); PG8_STAGE(PG8_SA(0, 1), a2 + hstepA, voffA);
            PG8_WAIT_V(8); PG8_WAIT_L(0); PG8_BAR; PG8_MMA(0, 0, At, B0); PG8_MMA(0, 1, At, B1); PG8_BAR; PG8_SCHED;
            PG8_LDA(At, 1, 1); PG8_STAGE(PG8_SB(1, 0), b3, voffB); PG8_STAGE(PG8_SB(1, 1), b3 + hstepB, voffB); PG8_STAGE(PG8_SA(1, 0), a3, voffA);
            PG8_WAIT_V(8); PG8_WAIT_L(0); PG8_BAR; PG8_MMA(1, 0, At, B0); PG8_MMA(1, 1, At, B1); PG8_BAR; PG8_SCHED;
            } else {
            PG8_LDB(B0, 0, 0); PG8_SCHED; PG8_LDA(At, 0, 0); PG8_STAGE(PG8_SA(1, 1), a1 + hstepA, voffA);
            PG8_WAIT_L(8); PG8_BAR; PG8_WAIT_L(0); PG8_MMA(0, 0, At, B0); PG8_BAR; PG8_SCHED;
            PG8_LDB(B1, 0, 1); PG8_STAGE(PG8_SB(0, 0), b2, voffB);
            PG8_BAR; PG8_WAIT_L(0); PG8_MMA(0, 1, At, B1); PG8_BAR;
            PG8_LDA(At, 0, 1); PG8_STAGE(PG8_SA(0, 0), a2, voffA);
            PG8_BAR; PG8_WAIT_L(0); PG8_MMA(1, 0, At, B0); PG8_BAR; PG8_SCHED;
            PG8_STAGE(PG8_SB(0, 1), b2 + hstepB, voffB);
            PG8_WAIT_V(6); PG8_BAR; PG8_MMA(1, 1, At, B1); PG8_BAR;
            PG8_LDB(B0, 1, 0); PG8_SCHED; PG8_LDA(At, 1, 0); PG8_STAGE(PG8_SA(0, 1), a2 + hstepA, voffA);
            PG8_WAIT_L(8); PG8_BAR; PG8_WAIT_L(0); PG8_MMA(0, 0, At, B0); PG8_BAR; PG8_SCHED;
            PG8_LDB(B1, 1, 1); PG8_STAGE(PG8_SB(1, 0), b3, voffB);
            PG8_BAR; PG8_WAIT_L(0); PG8_MMA(0, 1, At, B1); PG8_BAR;
            PG8_LDA(At, 1, 1); PG8_STAGE(PG8_SA(1, 0), a3, voffA);
            PG8_BAR; PG8_WAIT_L(0); PG8_MMA(1, 0, At, B0); PG8_BAR; PG8_SCHED;
            PG8_STAGE(PG8_SB(1, 1), b3 + hstepB, voffB);
            PG8_WAIT_V(6); PG8_BAR; PG8_MMA(1, 1, At, B1); PG8_BAR;
            }
        }
        if constexpr (ALIGN_EPI) { if (wr == 0) PG8_BAR; }
        if constexpr (!Epi::AFTER_DRAIN) { E(acc, cur, wr, wc, fr, fq); S.done(cur); }
        if (!has_next) break;
#pragma unroll
        for (int a = 0; a < 2; ++a)
#pragma unroll
            for (int b = 0; b < 2; ++b)
#pragma unroll
                for (int m = 0; m < 4; ++m)
#pragma unroll
                    for (int n = 0; n < 2; ++n) acc[a][b][m][n] = (f32x4){0.f, 0.f, 0.f, 0.f};
        cur = nxt; cA = nA; cB = nB; ++ui;
        if constexpr (ALIGN_EPI) { if (wr == 1) PG8_BAR; }
    }
    PG8_WAIT_V(0);
    if constexpr (!ALIGN_EPI) { if (wr == 0) PG8_BAR; }
    PG8_BAR;
    if constexpr (Epi::AFTER_DRAIN) { E.fused(acc, cur, wr, wc, fr, fq, lds, wid, lane); S.done(cur); }
#undef PG8_SA
#undef PG8_SB
#undef PG8_STAGE
#undef PG8_LDA
#undef PG8_LDB
#undef PG8_MMA
#undef PG8_WAIT_V
#undef PG8_WAIT_L
#undef PG8_BAR
#undef PG8_SCHED
}
}

constexpr int DM = 1024, NBATCH = 2, SEQ = 16384, MTOK = NBATCH * SEQ;
constexpr int FFH = 2816;
constexpr int RH = 4, RDK = 256, RDV = 512, RCH = 512, NCH = SEQ / RCH;
constexpr int RIN = 2 * RH * RDK + 2 * RH * RDV;
constexpr int NG = 4, NR = 4, HD = 64, NCMP = 1023, NSEL = 256, NSAIN = 1072;
constexpr float RMS_EPS = 1e-6f;
constexpr int APLD = 768;

constexpr size_t MiB = 1u << 20;
constexpr size_t WS_CTL = 0, CTL_ZERO_BYTES = 1 * MiB;
constexpr size_t WS_RINV = 1 * MiB;
constexpr size_t WS_BIAST = WS_RINV + 256 * 1024;
constexpr size_t WS_PEB = WS_BIAST + 16 * 1024;
constexpr size_t WS_PEBP = WS_PEB + 4 * 1024;
constexpr size_t WS_GSLOT = 2 * MiB;
constexpr size_t WS_OSLOT = 6 * MiB;
constexpr size_t WS_W = 8 * MiB;
constexpr size_t W_RI = WS_W, W_RO = W_RI + 12 * MiB, W_FI0 = W_RO + 4 * MiB, W_FI1 = W_FI0 + 11 * MiB, W_FO0 = W_FI1 + 11 * MiB, W_FO1 = W_FO0 + 11 * MiB / 2,
                 W_KVQ = W_FO1 + 11 * MiB / 2, W_KVV = W_KVQ + 9 * MiB / 2, W_NO = W_KVV + 1 * MiB, W_C1 = W_NO + 2 * MiB, W_END = W_C1 + 2 * MiB;
static_assert(W_END <= 68 * MiB, "weights");
constexpr size_t WS_TABA = 68 * MiB, WS_TABB = 84 * MiB;
constexpr size_t WS_XB = 100 * MiB;
constexpr size_t WS_MIX = 164 * MiB;
constexpr size_t WS_KT = WS_MIX, WS_KV = WS_MIX + 32 * MiB;
constexpr size_t WS_SCR = 228 * MiB;
constexpr size_t WS_AP = WS_SCR, WS_BP = WS_AP + 96 * MiB, WS_KN = WS_BP + 96 * MiB;
static_assert(WS_KN + 32 * MiB <= 512 * MiB, "ret scratch");
constexpr size_t WS_HID = WS_SCR;
constexpr size_t WS_KC = WS_SCR, WS_VC = WS_KC + 16 * MiB, WS_KS = WS_VC + 17 * MiB, WS_KW = WS_KS + 16 * MiB, WS_VST = WS_KW + 16 * MiB, WS_VWT = WS_VST + 16 * MiB,
                 WS_Q = WS_VWT + 16 * MiB, WS_GATE = WS_Q + 64 * MiB, WS_HIDC = WS_GATE + 6 * MiB, WS_KCMP = WS_HIDC + 8 * MiB, WS_VCMPT = WS_KCMP + 1 * MiB, WS_ONSA = WS_VCMPT + 1 * MiB,
                 WS_NSA_END = WS_ONSA + 64 * MiB;
static_assert(WS_NSA_END <= 512 * MiB, "nsa scratch");
constexpr size_t WS_NEED = 512 * MiB;

#define GAS __attribute__((address_space(1)))
#define LAS __attribute__((address_space(3)))
typedef unsigned short bf16;
typedef unsigned v4u __attribute__((ext_vector_type(4)));
typedef unsigned v2u __attribute__((ext_vector_type(2)));
typedef float f32x4 __attribute__((ext_vector_type(4)));
typedef float f32x2_t __attribute__((ext_vector_type(2)));
typedef __bf16 bf16x2_t __attribute__((ext_vector_type(2)));
typedef GAS unsigned gu32;
#define RLX_AGENT __ATOMIC_RELAXED, __HIP_MEMORY_SCOPE_AGENT
__device__ __forceinline__ unsigned cvtpk(float lo, float hi) { f32x2_t v = {lo, hi}; bf16x2_t b = __builtin_convertvector(v, bf16x2_t); return __builtin_bit_cast(unsigned, b); }
__device__ __forceinline__ v4u pack8(f32x4 a, f32x4 b) { v4u w; w.x = cvtpk(a[0], a[1]); w.y = cvtpk(a[2], a[3]); w.z = cvtpk(b[0], b[1]); w.w = cvtpk(b[2], b[3]); return w; }
__device__ __forceinline__ float bflo(unsigned w) { return __uint_as_float(w << 16); }
__device__ __forceinline__ float bfhi(unsigned w) { return __uint_as_float(w & 0xffff0000u); }
__device__ __forceinline__ float bf2f(bf16 b) { return __uint_as_float(((unsigned)b) << 16); }
__device__ __forceinline__ void unpack8(v4u w, float* f) { f[0] = bflo(w.x); f[1] = bfhi(w.x); f[2] = bflo(w.y); f[3] = bfhi(w.y); f[4] = bflo(w.z); f[5] = bfhi(w.z); f[6] = bflo(w.w); f[7] = bfhi(w.w); }
__device__ __forceinline__ bf16 f2bf(float f) { return (bf16)(cvtpk(f, 0.f) & 0xffffu); }
__device__ __forceinline__ float sigm(float x) { return 1.f / (1.f + __expf(-x)); }
__device__ __forceinline__ float silu(float x) { return x / (1.f + __expf(-x)); }
__device__ __forceinline__ float lg2gamma(int h) { return log2f(1.0f - exp2f(-5.0f - (float)h)); }
__device__ __forceinline__ float wave_sum(float v) {
#pragma unroll
    for (int o = 1; o < 64; o <<= 1) v += __shfl_xor(v, o);
    return v;
}
__device__ __forceinline__ float wave_max(float v) {
#pragma unroll
    for (int o = 1; o < 64; o <<= 1) v = fmaxf(v, __shfl_xor(v, o));
    return v;
}
__device__ __forceinline__ int t5_bucket(int n) {
    if (n < 16) return n;
    if (n >= 113) return 31;
    int b = 16 + (int)(logf((float)n * 0.0625f) / 2.0794415416798357f * 16.0f);
    return b < 31 ? b : 31;
}

#define XB_TMO      128
#define XB_XCNT(j)  (256  + 64 * (j))
#define XB_XSUB(j)  (1280 + 64 * (j))
#define XB_XGEN(j)  (2304 + 64 * (j))
#define XB_TOP      3328
#define XB_TOPGEN   3392
#define XCD_BAR_WORDS 3456
#define XB_SPIN_CAP (1u << 18)
__device__ __forceinline__ unsigned xb_ld(unsigned* p)              { return __hip_atomic_load(p, __ATOMIC_RELAXED, __HIP_MEMORY_SCOPE_AGENT); }
__device__ __forceinline__ unsigned xb_add(unsigned* p, unsigned v) { return __hip_atomic_fetch_add(p, v, __ATOMIC_RELAXED, __HIP_MEMORY_SCOPE_AGENT); }
__device__ __forceinline__ unsigned xb_xcc_id() { return (unsigned)__builtin_amdgcn_s_getreg((3 << 11) | 20) & 0xFu; }
#define XB_SPIN(cond, bar) do { unsigned _sp = 0; while (cond) { __builtin_amdgcn_s_sleep(1); \
    if ((++_sp & 255u) == 0u) { if (xb_ld(&(bar)[XB_TMO])) break; if (_sp > XB_SPIN_CAP) { atomicAdd(&(bar)[XB_TMO], 1u); break; } } } } while (0)
struct XcdBarrier { unsigned* bar; unsigned x; volatile LAS unsigned* st; };
__device__ __forceinline__ XcdBarrier xcd_barrier_post(unsigned* bar, volatile LAS unsigned* st) {
    XcdBarrier b; b.bar = bar; b.x = xb_xcc_id(); b.st = st;
    if (threadIdx.x == 0) (void)xb_add(&bar[XB_XCNT(b.x)], 1u);
    return b;
}
__device__ __forceinline__ void xcd_barrier_complete(unsigned* bar, unsigned x, unsigned& nloc, unsigned& nx) {
    const unsigned G = gridDim.x * gridDim.y * gridDim.z;
    unsigned sum, cnt, mine, sp = 0u;
    for (;;) {
        sum = 0u; cnt = 0u; mine = 0u;
#pragma unroll
        for (unsigned j = 0; j < 16; ++j) { const unsigned c = xb_ld(&bar[XB_XCNT(j)]); sum += c; cnt += (c > 0u) ? 1u : 0u; mine = (j == x) ? c : mine; }
        if (sum == G) break;
        __builtin_amdgcn_s_sleep(1);
        if ((++sp & 255u) == 0u) { if (xb_ld(&bar[XB_TMO])) break; if (sp > XB_SPIN_CAP) { atomicAdd(&bar[XB_TMO], 1u); break; } }
    }
    nloc = mine > 0u ? mine : 1u; nx = cnt > 0u ? cnt : 1u;
}
__device__ __forceinline__ void xcd_barrier(const XcdBarrier& b) {
    asm volatile("s_waitcnt vmcnt(0)" ::: "memory");
    __syncthreads();
    if (threadIdx.x == 0) {
        unsigned* bar = b.bar;
        __builtin_amdgcn_s_waitcnt(0);
        unsigned nloc = b.st[0], nx = b.st[1];
        if (nloc == 0u) { xcd_barrier_complete(bar, b.x, nloc, nx); b.st[0] = nloc; b.st[1] = nx; }
        const unsigned old = xb_add(&bar[XB_XSUB(b.x)], 1u);
        const unsigned gen = old / nloc;
        if (old + 1u == (gen + 1u) * nloc) {
            __builtin_amdgcn_fence(__ATOMIC_RELEASE, "agent");
            asm volatile("s_waitcnt vmcnt(0)" ::: "memory");
            const unsigned og = xb_add(&bar[XB_TOP], 1u);
            const unsigned tg = og / nx;
            if (og + 1u == (tg + 1u) * nx) xb_add(&bar[XB_TOPGEN], 1u);
            else XB_SPIN(xb_ld(&bar[XB_TOPGEN]) == tg, bar);
            __builtin_amdgcn_fence(__ATOMIC_ACQUIRE, "agent");
            xb_add(&bar[XB_XGEN(b.x)], 1u);
            asm volatile("s_waitcnt vmcnt(0)" ::: "memory");
        } else {
            XB_SPIN(xb_ld(&bar[XB_XGEN(b.x)]) == gen, bar);
            __builtin_amdgcn_fence(__ATOMIC_ACQUIRE, "agent");
            asm volatile("s_waitcnt vmcnt(0)" ::: "memory");
        }
    }
    __syncthreads();
}

using pg8::Unit;
typedef const f32x4 (&AccRef)[2][2][4][2];
#define EPI_ROW(u, ai, m) ((u).pm * 256 + (ai) * 128 + wr * 64 + (m) * 16 + fr)
#define EPI_COL(bj) ((bj) * 128 + wc * 32 + 8 * fq)

struct EpiP1N {
    static constexpr bool PERM = true, AFTER_DRAIN = false;
    const float* rinv; const f32x4* tabA; bf16* AP; bf16* KN;
    __device__ __forceinline__ void operator()(AccRef acc, const Unit& u, int wr, int wc, int fr, int fq) const {
        const int h = u.pn & 3; const bool isk = u.pn >= 4; const float lg = lg2gamma(h);
#pragma unroll
        for (int ai = 0; ai < 2; ++ai)
#pragma unroll
            for (int m = 0; m < 4; ++m) {
                const int t = EPI_ROW(u, ai, m); const int p = t & (RCH - 1), c = t / RCH;
                const float rs = rinv[t] * (isk ? 0.0625f * exp2f(-(float)p * lg) : exp2f((float)p * lg));
#pragma unroll
                for (int bj = 0; bj < 2; ++bj) {
                    const int d0 = EPI_COL(bj);
                    const f32x4 c0 = tabA[(size_t)t * 64 + (d0 >> 2)], c1 = tabA[(size_t)t * 64 + (d0 >> 2) + 1];
                    const f32x4 v0 = acc[ai][bj][m][0] * rs, v1 = acc[ai][bj][m][1] * rs;
                    const f32x4 o0 = {v0[0] * c0[0] - v0[1] * c0[1], v0[0] * c0[1] + v0[1] * c0[0], v0[2] * c0[2] - v0[3] * c0[3], v0[2] * c0[3] + v0[3] * c0[2]};
                    const f32x4 o1 = {v1[0] * c1[0] - v1[1] * c1[1], v1[0] * c1[1] + v1[1] * c1[0], v1[2] * c1[2] - v1[3] * c1[3], v1[2] * c1[3] + v1[3] * c1[2]};
                    const v4u w = pack8(o0, o1);
                    if (isk) *(v4u*)(KN + (size_t)t * 1024 + h * 256 + d0) = w;
                    else *(v4u*)(AP + ((size_t)(h * NCH + c) * RCH + p) * APLD + RCH + d0) = w;
                }
            }
    }
};
struct EpiP1S {
    static constexpr bool PERM = true, AFTER_DRAIN = false;
    const float* rinv; const f32x4* tabB; bf16* KT; bf16* BP;
    __device__ __forceinline__ void operator()(AccRef acc, const Unit& u, int wr, int wc, int fr, int fq) const {
        const bool isk = u.pm < 4; const float lg = lg2gamma(u.pm & 3);
#pragma unroll
        for (int bj = 0; bj < 2; ++bj) {
            const int t0 = u.pn * 256 + EPI_COL(bj); const int c = t0 / RCH, p0 = t0 & (RCH - 1);
            const f32x4 r0 = *(const f32x4*)(rinv + t0), r1 = *(const f32x4*)(rinv + t0 + 4);
            f32x4 s0, s1;
#pragma unroll
            for (int j = 0; j < 4; ++j) { s0[j] = r0[j] * 0.0625f * exp2f(-(float)(p0 + j) * lg); s1[j] = r1[j] * 0.0625f * exp2f(-(float)(p0 + 4 + j) * lg); }
#pragma unroll
            for (int ai = 0; ai < 2; ++ai)
#pragma unroll
                for (int m = 0; m < 4; ++m) {
                    const int row = EPI_ROW(u, ai, m);
                    if (isk) {
                        const int d = row & 255, i = d >> 1; const bool odd = d & 1;
                        const f32x4 v0 = acc[ai][bj][m][0] * s0, v1 = acc[ai][bj][m][1] * s1; f32x4 q0, q1;
#pragma unroll
                        for (int j = 0; j < 4; ++j) { q0[j] = __shfl_xor(v0[j], 1); q1[j] = __shfl_xor(v1[j], 1); }
                        const f32x4* tb = tabB + ((size_t)i * SEQ + t0) / 2;
                        const f32x4 ca = tb[0], cb = tb[1], cc = tb[2], cd = tb[3];
                        f32x4 o0, o1;
                        if (odd) { o0 = (f32x4){q0[0] * ca[1] + v0[0] * ca[0], q0[1] * ca[3] + v0[1] * ca[2], q0[2] * cb[1] + v0[2] * cb[0], q0[3] * cb[3] + v0[3] * cb[2]};
                                   o1 = (f32x4){q1[0] * cc[1] + v1[0] * cc[0], q1[1] * cc[3] + v1[1] * cc[2], q1[2] * cd[1] + v1[2] * cd[0], q1[3] * cd[3] + v1[3] * cd[2]}; }
                        else     { o0 = (f32x4){v0[0] * ca[0] - q0[0] * ca[1], v0[1] * ca[2] - q0[1] * ca[3], v0[2] * cb[0] - q0[2] * cb[1], v0[3] * cb[2] - q0[3] * cb[3]};
                                   o1 = (f32x4){v1[0] * cc[0] - q1[0] * cc[1], v1[1] * cc[2] - q1[1] * cc[3], v1[2] * cd[0] - q1[2] * cd[1], v1[3] * cd[2] - q1[3] * cd[3]}; }
                        *(v4u*)(KT + (size_t)row * SEQ + t0) = pack8(o0, o1);
                    } else {
                        const int eg = row - 1024, h = eg >> 9, e = eg & 511;
                        *(v4u*)(BP + ((size_t)(h * NCH + c) * RCH + e) * APLD + p0) = pack8(acc[ai][bj][m][0] * r0, acc[ai][bj][m][1] * r1);
                    }
                }
        }
    }
};
struct EpiG {
    static constexpr bool PERM = true, AFTER_DRAIN = false;
    const float* rinv; const float* gslots; bf16* O;
    __device__ __forceinline__ void operator()(AccRef acc, const Unit& u, int wr, int wc, int fr, int fq) const {
        const int h = u.pn >> 1;
#pragma unroll
        for (int ai = 0; ai < 2; ++ai)
#pragma unroll
            for (int m = 0; m < 4; ++m) {
                const int row = EPI_ROW(u, ai, m); const float rin = rinv[row];
                const f32x4 sa = *(const f32x4*)(gslots + (size_t)row * 32 + h * 8), sb = *(const f32x4*)(gslots + (size_t)row * 32 + h * 8 + 4);
                const float ss = ((sa[0] + sa[1]) + (sa[2] + sa[3])) + ((sb[0] + sb[1]) + (sb[2] + sb[3]));
                const float rs = rsqrtf(ss * (1.0f / RDV) + RMS_EPS);
#pragma unroll
                for (int bj = 0; bj < 2; ++bj) {
                    bf16* op = O + (size_t)row * 2048 + u.pn * 256 + EPI_COL(bj);
                    float o[8]; unpack8(*(const v4u*)op, o);
                    const f32x4 g0 = acc[ai][bj][m][0] * rin, g1 = acc[ai][bj][m][1] * rin; f32x4 a, b;
#pragma unroll
                    for (int j = 0; j < 4; ++j) { a[j] = o[j] * rs * silu(g0[j]); b[j] = o[4 + j] * rs * silu(g1[j]); }
                    *(v4u*)op = pack8(a, b);
                }
            }
    }
};
struct EpiOut {
    static constexpr bool PERM = true, AFTER_DRAIN = false;
    bf16* MIX; float* oslots;
    __device__ __forceinline__ void operator()(AccRef acc, const Unit& u, int wr, int wc, int fr, int fq) const {
#pragma unroll
        for (int ai = 0; ai < 2; ++ai)
#pragma unroll
            for (int m = 0; m < 4; ++m) {
                const int row = EPI_ROW(u, ai, m); float ss = 0.f;
#pragma unroll
                for (int bj = 0; bj < 2; ++bj) {
                    const f32x4 v0 = acc[ai][bj][m][0], v1 = acc[ai][bj][m][1];
                    ss += (v0[0] * v0[0] + v0[1] * v0[1]) + (v0[2] * v0[2] + v0[3] * v0[3]) + (v1[0] * v1[0] + v1[1] * v1[1]) + (v1[2] * v1[2] + v1[3] * v1[3]);
                    *(v4u*)(MIX + (size_t)row * 1024 + u.pn * 256 + EPI_COL(bj)) = pack8(v0, v1);
                }
                ss += __shfl_xor(ss, 16); ss += __shfl_xor(ss, 32);
                if (fq == 0) oslots[(size_t)row * 16 + u.pn * 4 + wc] = ss;
            }
    }
};
struct EpiFfnIn {
    static constexpr bool PERM = true, AFTER_DRAIN = false;
    const float* rinv; bf16* HID;
    __device__ __forceinline__ void operator()(AccRef acc, const Unit& u, int wr, int wc, int fr, int fq) const {
#pragma unroll
        for (int ai = 0; ai < 2; ++ai)
#pragma unroll
            for (int m = 0; m < 4; ++m) {
                const int row = EPI_ROW(u, ai, m); const float rin = rinv[row];
                const f32x4 a0 = acc[ai][0][m][0] * rin, a1 = acc[ai][0][m][1] * rin, b0 = acc[ai][1][m][0] * rin, b1 = acc[ai][1][m][1] * rin; f32x4 x, y;
#pragma unroll
                for (int j = 0; j < 4; ++j) { x[j] = silu(a0[j]) * b0[j]; y[j] = silu(a1[j]) * b1[j]; }
                *(v4u*)(HID + (size_t)row * FFH + u.pn * 128 + wc * 32 + 8 * fq) = pack8(x, y);
            }
    }
};
struct EpiKvqN {
    static constexpr bool PERM = true, AFTER_DRAIN = false;
    const float* rinv; bf16 *KC, *VC, *KS, *KW, *Q; float* GATE;
    __device__ __forceinline__ void operator()(AccRef acc, const Unit& u, int wr, int wc, int fr, int fq) const {
        bf16* plane = u.pn == 0 ? KC : u.pn == 1 ? VC : u.pn == 2 ? KS : KW;
#pragma unroll
        for (int ai = 0; ai < 2; ++ai)
#pragma unroll
            for (int m = 0; m < 4; ++m) {
                const int row = EPI_ROW(u, ai, m); const float rin = rinv[row]; const int b = row / SEQ, t = row % SEQ;
#pragma unroll
                for (int bj = 0; bj < 2; ++bj) {
                    const int cc = EPI_COL(bj);
                    f32x4 v0 = acc[ai][bj][m][0] * rin, v1 = acc[ai][bj][m][1] * rin;
                    if (u.pn < 4) { const int g = cc >> 6, d = cc & 63; *(v4u*)(plane + ((size_t)(b * NG + g) * SEQ + t) * HD + d) = pack8(v0, v1); }
                    else if (u.pn < 8) { *(v4u*)(Q + (size_t)row * 1024 + (u.pn - 4) * 256 + cc) = pack8(v0 * (0.125f * 1.4426950408889634f), v1 * (0.125f * 1.4426950408889634f)); }
                    else if (cc < 48) {
#pragma unroll
                        for (int j = 0; j < 4; ++j) { v0[j] = sigm(v0[j]); v1[j] = sigm(v1[j]); }
                        *(f32x4*)(GATE + (size_t)row * 48 + cc) = v0; *(f32x4*)(GATE + (size_t)row * 48 + cc + 4) = v1;
                    }
                }
            }
    }
};
struct EpiKvqS {
    static constexpr bool PERM = true, AFTER_DRAIN = false;
    const float* rinv; bf16 *VST, *VWT;
    __device__ __forceinline__ void operator()(AccRef acc, const Unit& u, int wr, int wc, int fr, int fq) const {
        bf16* plane = u.pm == 0 ? VST : VWT;
#pragma unroll
        for (int bj = 0; bj < 2; ++bj) {
            const int mg = u.pn * 256 + EPI_COL(bj); const int b = mg / SEQ, t = mg % SEQ;
            const f32x4 r0 = *(const f32x4*)(rinv + mg), r1 = *(const f32x4*)(rinv + mg + 4);
#pragma unroll
            for (int ai = 0; ai < 2; ++ai)
#pragma unroll
                for (int m = 0; m < 4; ++m) {
                    const int r256 = ai * 128 + wr * 64 + m * 16 + fr; const int g = r256 >> 6, d = r256 & 63;
                    *(v4u*)(plane + ((size_t)((b * NG + g) * HD + d)) * SEQ + t) = pack8(acc[ai][bj][m][0] * r0, acc[ai][bj][m][1] * r1);
                }
        }
    }
};
struct EpiCmp {
    static constexpr bool PERM = true, AFTER_DRAIN = false;
    const float* peb; bf16* HIDC;
    __device__ __forceinline__ void operator()(AccRef acc, const Unit& u, int wr, int wc, int fr, int fq) const {
        const int kv = u.pm >= 32 ? 1 : 0;
#pragma unroll
        for (int bj = 0; bj < 2; ++bj) {
            const int col = EPI_COL(bj);
            const f32x4 b0 = *(const f32x4*)(peb + kv * 256 + col), b1 = *(const f32x4*)(peb + kv * 256 + col + 4);
#pragma unroll
            for (int ai = 0; ai < 2; ++ai)
#pragma unroll
                for (int m = 0; m < 4; ++m) {
                    const int row = EPI_ROW(u, ai, m); f32x4 x = acc[ai][bj][m][0] + b0, y = acc[ai][bj][m][1] + b1;
#pragma unroll
                    for (int j = 0; j < 4; ++j) { x[j] = silu(x[j]); y[j] = silu(y[j]); }
                    *(v4u*)(HIDC + (size_t)row * 256 + col) = pack8(x, y);
                }
        }
    }
};
struct MapCmp { __device__ __forceinline__ void operator()(Unit& u) const { u.offA = (size_t)u.pm * 256 * 1024 * 2; u.offB = (size_t)(u.pm >= 32 ? 256 : 0) * 2048 * 2; } };

struct MapKV { __device__ __forceinline__ void operator()(Unit& u) const { const int hc = u.pm >> 1, eh = u.pm & 1, h = hc / NCH, c = hc % NCH;
    u.offA = ((size_t)(hc * RCH + eh * 256) * APLD) * 2; u.offB = ((size_t)(h * RDK) * SEQ + (size_t)c * RCH) * 2; } };
struct EpiKV {
    static constexpr bool PERM = true, AFTER_DRAIN = false;
    bf16* KV;
    __device__ __forceinline__ void operator()(AccRef acc, const Unit& u, int wr, int wc, int fr, int fq) const {
#pragma unroll
        for (int ai = 0; ai < 2; ++ai)
#pragma unroll
            for (int m = 0; m < 4; ++m) { const int row = EPI_ROW(u, ai, m);
#pragma unroll
                for (int bj = 0; bj < 2; ++bj) *(v4u*)(KV + (size_t)row * RDK + EPI_COL(bj)) = pack8(acc[ai][bj][m][0], acc[ai][bj][m][1]); }
    }
};
struct MapS { __device__ __forceinline__ void operator()(Unit& u) const { const int hc = u.pm >> 1, qh = u.pm & 1, h = hc / NCH, c = hc % NCH;
    u.offA = ((size_t)(hc * RCH + qh * 256) * APLD + RCH) * 2; u.offB = ((size_t)(c * RCH + u.pn * 256) * 1024 + h * RDK) * 2; } };
struct EpiS {
    static constexpr bool PERM = true, AFTER_DRAIN = false;
    bf16* AP;
    __device__ __forceinline__ void operator()(AccRef acc, const Unit& u, int wr, int wc, int fr, int fq) const {
        const int qh = u.pm & 1;
#pragma unroll
        for (int ai = 0; ai < 2; ++ai)
#pragma unroll
            for (int m = 0; m < 4; ++m) { const int row = EPI_ROW(u, ai, m); const int qi = qh * 256 + ai * 128 + wr * 64 + m * 16 + fr;
#pragma unroll
                for (int bj = 0; bj < 2; ++bj) { const int k0 = u.pn * 256 + EPI_COL(bj); f32x4 v0 = acc[ai][bj][m][0], v1 = acc[ai][bj][m][1];
#pragma unroll
                    for (int j = 0; j < 4; ++j) { if (k0 + j > qi) v0[j] = 0.f; if (k0 + 4 + j > qi) v1[j] = 0.f; }
                    *(v4u*)(AP + (size_t)row * APLD + k0) = pack8(v0, v1); } }
    }
};
struct MapO { __device__ __forceinline__ void operator()(Unit& u) const { const int hc = u.pm >> 1, qh = u.pm & 1;
    u.offA = ((size_t)(hc * RCH + qh * 256) * APLD) * 2; u.offB = ((size_t)(hc * RCH + u.pn * 256) * APLD) * 2; } };
struct EpiO {
    static constexpr bool PERM = true, AFTER_DRAIN = false;
    bf16* O; float* gslots; int b;
    __device__ __forceinline__ void operator()(AccRef acc, const Unit& u, int wr, int wc, int fr, int fq) const {
        const int hc = u.pm >> 1, qh = u.pm & 1, h = hc / NCH, c = hc % NCH;
#pragma unroll
        for (int ai = 0; ai < 2; ++ai)
#pragma unroll
            for (int m = 0; m < 4; ++m) { const size_t row = (size_t)b * SEQ + c * RCH + qh * 256 + ai * 128 + wr * 64 + m * 16 + fr; float ss = 0.f;
#pragma unroll
                for (int bj = 0; bj < 2; ++bj) { const f32x4 v0 = acc[ai][bj][m][0], v1 = acc[ai][bj][m][1];
                    ss += (v0[0] * v0[0] + v0[1] * v0[1]) + (v0[2] * v0[2] + v0[3] * v0[3]) + (v1[0] * v1[0] + v1[1] * v1[1]) + (v1[2] * v1[2] + v1[3] * v1[3]);
                    *(v4u*)(O + row * 2048 + h * RDV + u.pn * 256 + EPI_COL(bj)) = pack8(v0, v1); }
                ss += __shfl_xor(ss, 16); ss += __shfl_xor(ss, 32);
                if (fq == 0) gslots[row * 32 + h * 8 + u.pn * 4 + wc] = ss; }
    }
};

constexpr int NWAVES = 8, NTHREADS = NWAVES * 64;
constexpr int RING_OFF = 0, RING_BYTES = 131072;
constexpr int LDSCTL_OFF = RING_BYTES, MISC_OFF = LDSCTL_OFF + 320;
constexpr int LDS_BYTES = 147456;
constexpr int CW_BAR = 4096;

struct Args { const float* in[20]; float* out; unsigned char* ws; int ph, b; };
struct Frame {
    LAS unsigned char* lds; unsigned char* ws; float* out; const float* const* in;
    int tid, lane, wave, G, vcu, gw, NGW;
};

template <class T> __device__ __forceinline__ T* gp(T* p) { return (T*)(GAS T*)p; }
template <class DestRow>
__device__ __forceinline__ void transpose_item(const float* W, int K, int ldw, int ncols, const float* gain, bf16* WT, LAS float* scr, int k0, int n0, int lane, const DestRow& dr) {
#pragma unroll 8
    for (int i = 0; i < 32; ++i) { const int kk = 2 * i + (lane >> 5), n = n0 + (lane & 31);
        float v = 0.f; if (n < ncols) v = W[(size_t)(k0 + kk) * ldw + n]; if (gain) v *= gain[k0 + kk];
        scr[kk * 33 + (lane & 31)] = v; }
    asm volatile("s_waitcnt lgkmcnt(0)" ::: "memory");
    const int c = lane & 7;
#pragma unroll
    for (int j = 0; j < 4; ++j) { const int n = (lane >> 3) + 8 * j; const LAS float* s = scr + (8 * c) * 33 + n;
        v4u o; o.x = cvtpk(s[0 * 33], s[1 * 33]); o.y = cvtpk(s[2 * 33], s[3 * 33]); o.z = cvtpk(s[4 * 33], s[5 * 33]); o.w = cvtpk(s[6 * 33], s[7 * 33]);
        const int drow = dr(n0 + n); if (drow >= 0) *(v4u*)(WT + (size_t)drow * K + k0 + 8 * c) = o; }
    asm volatile("s_waitcnt lgkmcnt(0)" ::: "memory");
}
template <class DestRow>
__device__ __forceinline__ void transpose_matrix(const Frame& F, const float* W, int K, int ldw, int ncols, int ncols_pad, const float* gain, bf16* WT, const DestRow& dr) {
    LAS float* scr = (LAS float*)(F.lds + RING_OFF + F.wave * 16384);
    const int nblk = ncols_pad / 32, items = (K / 64) * nblk;
    for (int it = F.gw; it < items; it += F.NGW) transpose_item(W, K, ldw, ncols, gain, WT, scr, 64 * (it / nblk), 32 * (it % nblk), F.lane, dr);
}
struct DrOff { int off; __device__ __forceinline__ int operator()(int n) const { return n + off; } };
struct DrFfn { __device__ __forceinline__ int operator()(int n) const { const int up = n >= FFH, j = up ? n - FFH : n; return (j >> 7) * 256 + up * 128 + (j & 127); } };
struct DrKv { __device__ __forceinline__ int operator()(int n) const {
        const int s = n >> 8, d = n & 255; return s < 3 ? n : s == 3 ? 2304 + d : s == 4 ? 768 + d : 2304 + 256 + d; } };

__device__ __forceinline__ void row_to_bf16(const float* xrow, bf16* orow, float* rinv, int lane) {
    const f32x4* xr = (const f32x4*)xrow + lane; f32x4 v[4]; float s = 0.f;
#pragma unroll
    for (int j = 0; j < 4; ++j) { v[j] = xr[64 * j]; s += (v[j][0] * v[j][0] + v[j][1] * v[j][1]) + (v[j][2] * v[j][2] + v[j][3] * v[j][3]); }
    s = wave_sum(s);
    v2u* o8 = (v2u*)orow + lane;
#pragma unroll
    for (int j = 0; j < 4; ++j) { v2u w; w.x = cvtpk(v[j][0], v[j][1]); w.y = cvtpk(v[j][2], v[j][3]); o8[64 * j] = w; }
    if (lane == 0) *rinv = rsqrtf(s * (1.0f / DM) + RMS_EPS);
}

__device__ __forceinline__ void phase_prologue(const Frame& F) {
    unsigned char* ws = F.ws; const float* in[20];
#pragma unroll
    for (int i = 0; i < 20; ++i) in[i] = gp(F.in[i]);
    transpose_matrix(F, in[7], DM, RIN, RIN, RIN, in[1], (bf16*)(ws + W_RI), DrOff{0});
    transpose_matrix(F, in[8], 2048, DM, DM, DM, nullptr, (bf16*)(ws + W_RO), DrOff{0});
    transpose_matrix(F, in[5], DM, 2 * FFH, 2 * FFH, 2 * FFH, in[3], (bf16*)(ws + W_FI0), DrFfn{});
    transpose_matrix(F, in[5] + (size_t)DM * 2 * FFH, DM, 2 * FFH, 2 * FFH, 2 * FFH, in[3] + DM, (bf16*)(ws + W_FI1), DrFfn{});
    transpose_matrix(F, in[6], FFH, DM, DM, DM, nullptr, (bf16*)(ws + W_FO0), DrOff{0});
    transpose_matrix(F, in[6] + (size_t)FFH * DM, FFH, DM, DM, DM, nullptr, (bf16*)(ws + W_FO1), DrOff{0});
    transpose_matrix(F, in[10], DM, 1536, 1536, 1536, in[9], (bf16*)(ws + W_KVQ), DrKv{});
    transpose_matrix(F, in[17], DM, NSAIN, NSAIN, 1280, in[1] + DM, (bf16*)(ws + W_KVQ), DrOff{1024});
    transpose_matrix(F, in[18], DM, DM, DM, DM, nullptr, (bf16*)(ws + W_NO), DrOff{0});
    transpose_matrix(F, in[12], 2048, 256, 256, 256, nullptr, (bf16*)(ws + W_C1), DrOff{0});
    transpose_matrix(F, in[15], 2048, 256, 256, 256, nullptr, (bf16*)(ws + W_C1), DrOff{256});
    {
        f32x2_t* tabA = (f32x2_t*)(ws + WS_TABA); f32x2_t* tabB = (f32x2_t*)(ws + WS_TABB);
        for (int idx = F.vcu * NTHREADS + F.tid; idx < SEQ * 128; idx += F.G * NTHREADS) {
            const int t = idx >> 7, i = idx & 127;
            const float theta = 1.0f / powf(10000.0f, (float)i * (1.0f / 127.0f));
            const float ang = (float)t * theta; float s, c; sincosf(ang, &s, &c);
            const f32x2_t v = {c, s}; tabA[idx] = v; tabB[(size_t)i * SEQ + t] = v;
        }
    }
    for (int m = F.gw; m < MTOK; m += F.NGW) row_to_bf16(in[0] + (size_t)m * DM, (bf16*)(ws + WS_XB) + (size_t)m * DM, (float*)(ws + WS_RINV) + m, F.lane);
    if (blockIdx.x == 0) for (int i = F.tid; i < 128 * 16; i += NTHREADS) ((float*)(ws + WS_BIAST))[i] = in[19][t5_bucket(i >> 4) * 16 + (i & 15)];
    if (blockIdx.x < 32) {
        const int kv = F.tid >> 8, c = F.tid & 255; const float* pe = kv ? in[14] : in[11]; const float* w1 = kv ? in[15] : in[12]; float s = 0.f;
        for (int k = 64 * blockIdx.x; k < 64 * blockIdx.x + 64; ++k) s += pe[k] * w1[(size_t)k * 256 + c];
        ((float*)(ws + WS_PEBP))[blockIdx.x * 512 + F.tid] = s;
    }
}
__device__ __forceinline__ void phase_peb_final(const Frame& F) {
    if (blockIdx.x == 0) { float s = 0.f; for (int w = 0; w < 32; ++w) s += ((const float*)(F.ws + WS_PEBP))[w * 512 + F.tid]; ((float*)(F.ws + WS_PEB))[F.tid] = s; }
}

__device__ __forceinline__ void phase_resid(const Frame& F, const float* hold, const float* gpost, bool last) {
    const bf16* MIX = (const bf16*)(F.ws + WS_MIX); const float* oslots = (const float*)(F.ws + WS_OSLOT);
    bf16* XB = (bf16*)(F.ws + WS_XB); float* rinv = (float*)(F.ws + WS_RINV);
    f32x4 gp[4];
#pragma unroll
    for (int j = 0; j < 4; ++j) gp[j] = ((const f32x4*)gpost)[F.lane + 64 * j];
    for (int m = F.gw; m < MTOK; m += F.NGW) {
        const f32x4* sl = (const f32x4*)(oslots + (size_t)m * 16); const f32x4 s0 = sl[0], s1 = sl[1], s2 = sl[2], s3 = sl[3];
        const float ss = (((s0[0] + s0[1]) + (s0[2] + s0[3])) + ((s1[0] + s1[1]) + (s1[2] + s1[3]))) + (((s2[0] + s2[1]) + (s2[2] + s2[3])) + ((s3[0] + s3[1]) + (s3[2] + s3[3])));
        const float rs = rsqrtf(ss * (1.0f / DM) + RMS_EPS);
        const f32x4* hr = (const f32x4*)(hold + (size_t)m * DM) + F.lane; const v2u* mr = (const v2u*)(MIX + (size_t)m * DM) + F.lane;
        f32x4 hn[4]; float s = 0.f;
#pragma unroll
        for (int j = 0; j < 4; ++j) { const f32x4 hv = hr[64 * j]; const v2u mw = mr[64 * j];
            const f32x4 mx = {bflo(mw.x), bfhi(mw.x), bflo(mw.y), bfhi(mw.y)};
            hn[j] = hv + mx * rs * gp[j]; s += (hn[j][0] * hn[j][0] + hn[j][1] * hn[j][1]) + (hn[j][2] * hn[j][2] + hn[j][3] * hn[j][3]); }
        f32x4* ho = (f32x4*)(F.out + (size_t)m * DM) + F.lane;
#pragma unroll
        for (int j = 0; j < 4; ++j) ho[64 * j] = hn[j];
        if (!last) {
            s = wave_sum(s); v2u* o8 = (v2u*)(XB + (size_t)m * DM) + F.lane;
#pragma unroll
            for (int j = 0; j < 4; ++j) { v2u w; w.x = cvtpk(hn[j][0], hn[j][1]); w.y = cvtpk(hn[j][2], hn[j][3]); o8[64 * j] = w; }
            if (F.lane == 0) rinv[m] = rsqrtf(s * (1.0f / DM) + RMS_EPS);
        }
    }
}

__device__ __forceinline__ void phase_ret_naive(const Frame& F, int b) {
    const bf16* AP = (const bf16*)(F.ws + WS_AP); const bf16* BP = (const bf16*)(F.ws + WS_BP); const bf16* KN = (const bf16*)(F.ws + WS_KN);
    bf16* O = (bf16*)F.out;
    for (int item = blockIdx.x; item < RH * 8; item += F.G) {
        const int h = item >> 3, et = item & 7, el = F.tid >> 3, ds = F.tid & 7, e = et * 64 + el;
        const float cdec = exp2f((float)RCH * lg2gamma(h));
        float U[32];
#pragma unroll
        for (int i = 0; i < 32; ++i) U[i] = 0.f;
        v4u kb[4], qb[4]; bf16 vb;
#define RN_LOAD(tt, KB, QB, VB) do { const int c_ = (tt) / RCH, p_ = (tt) & (RCH - 1); \
            const v4u* kp_ = (const v4u*)(KN + (size_t)(tt) * 1024 + h * 256 + ds * 32); const v4u* qp_ = (const v4u*)(AP + ((size_t)(h * NCH + c_) * RCH + p_) * APLD + RCH + ds * 32); \
            _Pragma("unroll") for (int j_ = 0; j_ < 4; ++j_) { KB[j_] = kp_[j_]; QB[j_] = qp_[j_]; } VB = BP[((size_t)(h * NCH + c_) * RCH + e) * APLD + p_]; } while (0)
        RN_LOAD(0, kb, qb, vb);
        for (int t = 0; t < SEQ; ++t) {
            v4u kn[4], qn[4]; bf16 vn; const int tn = t + 1 < SEQ ? t + 1 : t;
            RN_LOAD(tn, kn, qn, vn);
            const float v = bf2f(vb); float acc = 0.f;
#pragma unroll
            for (int j = 0; j < 4; ++j) { float kf[8], qf[8]; unpack8(kb[j], kf); unpack8(qb[j], qf);
#pragma unroll
                for (int i = 0; i < 8; ++i) { U[8 * j + i] += kf[i] * v; acc += qf[i] * U[8 * j + i]; } }
            acc += __shfl_xor(acc, 1); acc += __shfl_xor(acc, 2); acc += __shfl_xor(acc, 4);
            if (ds == 0) O[(size_t)(b * SEQ + t) * 2048 + h * 512 + e] = f2bf(acc);
            if ((t & (RCH - 1)) == RCH - 1) {
#pragma unroll
                for (int i = 0; i < 32; ++i) U[i] *= cdec; }
#pragma unroll
            for (int j = 0; j < 4; ++j) { kb[j] = kn[j]; qb[j] = qn[j]; } vb = vn;
        }
#undef RN_LOAD
    }
}
__device__ __forceinline__ void phase_ret_ssq(const Frame& F, int b) {
    const bf16* O = (const bf16*)F.out; float* gs = (float*)(F.ws + WS_GSLOT);
    for (int r = F.gw; r < SEQ * RH; r += F.NGW) {
        const int m = b * SEQ + (r >> 2), h = r & 3; float f[8]; unpack8(((const v4u*)(O + (size_t)m * 2048 + h * 512))[F.lane], f);
        float s = 0.f;
#pragma unroll
        for (int i = 0; i < 8; ++i) s += f[i] * f[i];
        s = wave_sum(s);
        if (F.lane < 8) gs[(size_t)m * 32 + h * 8 + F.lane] = F.lane == 0 ? s : 0.f;
    }
}

__device__ __forceinline__ void phase_cmp2(const Frame& F) {
    const bf16* HIDC = (const bf16*)(F.ws + WS_HIDC); bf16* KCMP = (bf16*)(F.ws + WS_KCMP); bf16* VCT = (bf16*)(F.ws + WS_VCMPT);
    LAS float* scr = (LAS float*)(F.lds + RING_OFF + F.wave * 2048);
    for (int R = F.gw; R < 16384; R += F.NGW) {
        const int kv = R >> 13, pl = (R >> 10) & 7, n = R & 1023; const float* w2 = gp(kv ? F.in[16] : F.in[13]);
        const v2u hw = ((const v2u*)(HIDC + (size_t)R * 256))[F.lane];
        scr[4 * F.lane + 0] = bflo(hw.x); scr[4 * F.lane + 1] = bfhi(hw.x); scr[4 * F.lane + 2] = bflo(hw.y); scr[4 * F.lane + 3] = bfhi(hw.y);
        asm volatile("s_waitcnt lgkmcnt(0)" ::: "memory");
        float s = 0.f;
#pragma unroll 8
        for (int c = 0; c < 256; ++c) s += scr[c] * w2[c * 64 + F.lane];
        if (n == NCMP) s = 0.f;
        if (kv == 0) KCMP[((size_t)pl * 1024 + n) * 64 + F.lane] = f2bf(s);
        else VCT[((size_t)pl * 64 + F.lane) * 1024 + n] = f2bf(s);
        asm volatile("s_waitcnt lgkmcnt(0)" ::: "memory");
    }
}

__device__ __forceinline__ void phase_ret_scan(const Frame& F) {
    const bf16* KV = (const bf16*)(F.ws + WS_KV); bf16* BP = (bf16*)(F.ws + WS_BP);
    for (int it = F.vcu * NTHREADS + F.tid; it < RH * RDV * (RDK / 8); it += F.G * NTHREADS) {
        const int d8 = it & 31, e = (it >> 5) & 511, h = it >> 14;
        const float cdec = exp2f((float)RCH * lg2gamma(h));
        float carry[8];
#pragma unroll
        for (int i = 0; i < 8; ++i) carry[i] = 0.f;
#pragma unroll 4
        for (int c = 0; c < NCH; ++c) {
            const size_t r = (size_t)(h * NCH + c) * RCH + e;
            float kv[8]; unpack8(*(const v4u*)(KV + r * RDK + d8 * 8), kv);
            v4u w; w.x = cvtpk(carry[0], carry[1]); w.y = cvtpk(carry[2], carry[3]); w.z = cvtpk(carry[4], carry[5]); w.w = cvtpk(carry[6], carry[7]);
            *(v4u*)(BP + r * APLD + RCH + d8 * 8) = w;
#pragma unroll
            for (int i = 0; i < 8; ++i) carry[i] = cdec * (carry[i] + kv[i]);
        }
    }
}

namespace nsa {
typedef float f32x16 __attribute__((ext_vector_type(16)));
typedef short s16x8 __attribute__((ext_vector_type(8)));
constexpr int KP = 64, NSLOT = 3, SLOTB = 8192;
constexpr float LOG2E = 1.4426950408889634f, NEGB = -1.0e30f;
constexpr int L_K = 0, L_V = NSLOT * SLOTB, L_IMP = 2 * L_V, IMP_P = 260, L_SELM = L_IMP + 64 * IMP_P * 4, L_BT = L_SELM + 2048, L_UNI = L_BT + 2048, L_LIST = L_UNI + 64, L_END = L_LIST + 1024 + 16;
static_assert(L_END <= RING_BYTES, "nsa lds");
__device__ __forceinline__ constexpr int krow(int r) { return (r & 3) + 8 * (r >> 2); }

__device__ __forceinline__ void tile_issue(LAS unsigned char* L, int slot, const bf16* Kg, const bf16* Vg, int ldv, int w, int lane) {
    asm volatile("" : "+v"(lane));
    const int row = 8 * w + (lane >> 3), c = (lane & 7) ^ (row & 7);
    __builtin_amdgcn_global_load_lds((const unsigned*)(Kg + (size_t)row * 64 + c * 8), (LAS unsigned*)(L + L_K + slot * SLOTB + w * 1024), 16, 0, 0);
    __builtin_amdgcn_global_load_lds((const unsigned*)(Vg + (size_t)row * ldv + c * 8), (LAS unsigned*)(L + L_V + slot * SLOTB + w * 1024), 16, 0, 0);
}
struct KVFrag { s16x8 k[4]; v2u vlo[2][2], vhi[2][2]; };
__device__ __forceinline__ void frag_load(KVFrag& f, const LAS bf16* Kl, const LAS bf16* Vl, int kt, int r32, int h) {
    const int kr = 32 * kt + r32;
#pragma unroll
    for (int s = 0; s < 4; ++s) f.k[s] = *(const LAS s16x8*)(Kl + kr * KP + 8 * ((2 * s + h) ^ (kr & 7)));
#pragma unroll
    for (int s2 = 0; s2 < 2; ++s2)
#pragma unroll
        for (int dt = 0; dt < 2; ++dt) { const int d = 32 * dt + r32; const LAS bf16* vp = Vl + d * KP + 4 * h;
            f.vlo[s2][dt] = *(const LAS v2u*)(vp + 8 * ((4 * kt + 2 * s2) ^ (d & 7))); f.vhi[s2][dt] = *(const LAS v2u*)(vp + 8 * ((4 * kt + 2 * s2 + 1) ^ (d & 7))); }
    __builtin_amdgcn_sched_barrier(0);
}
__device__ __forceinline__ f32x16 qk_tile(const KVFrag& f, const s16x8 (&qf)[4], float cinit) {
    f32x16 p;
#pragma unroll
    for (int r = 0; r < 16; ++r) p[r] = cinit;
#pragma unroll
    for (int s = 0; s < 4; ++s) p = __builtin_amdgcn_mfma_f32_32x32x16_bf16(f.k[s], qf[s], p, 0, 0, 0);
    return p;
}
__device__ __forceinline__ void pv_tile(f32x16 (&o)[2], const KVFrag& f, const f32x16& p) {
#pragma unroll
    for (int s2 = 0; s2 < 2; ++s2) {
        v4u pw; pw.x = cvtpk(p[8 * s2 + 0], p[8 * s2 + 1]); pw.y = cvtpk(p[8 * s2 + 2], p[8 * s2 + 3]); pw.z = cvtpk(p[8 * s2 + 4], p[8 * s2 + 5]); pw.w = cvtpk(p[8 * s2 + 6], p[8 * s2 + 7]);
        const s16x8 pb = __builtin_bit_cast(s16x8, pw);
#pragma unroll
        for (int dt = 0; dt < 2; ++dt) {
            v4u aw; aw.x = f.vlo[s2][dt].x; aw.y = f.vlo[s2][dt].y; aw.z = f.vhi[s2][dt].x; aw.w = f.vhi[s2][dt].y;
            o[dt] = __builtin_amdgcn_mfma_f32_32x32x16_bf16(__builtin_bit_cast(s16x8, aw), pb, o[dt], 0, 0, 0);
        }
    }
}
__device__ __forceinline__ float xhalf_max(float v) { auto rr = __builtin_amdgcn_permlane32_swap(__float_as_uint(v), __float_as_uint(v), false, false); return fmaxf(__uint_as_float(rr[0]), __uint_as_float(rr[1])); }
template <int MODE> __device__ __forceinline__ unsigned post_tile(f32x16& p, int kbase, int t, int lim, bool colok, const LAS float* bT) {
    unsigned vm = 0u;
#pragma unroll
    for (int r = 0; r < 16; ++r) {
        const int key = kbase + krow(r);
        const int dist = MODE == 0 ? t - 31 - 16 * key : t - key;
        const bool ok = colok && dist >= 0 && (MODE == 0 ? key < NCMP : dist < lim);
        const int di = dist < 0 ? 0 : (dist > 127 ? 127 : dist);
        p[r] = p[r] + bT[di * 4];
        vm |= ok ? (1u << r) : 0u;
    }
    return vm;
}
__device__ __forceinline__ void softmax_update(f32x16& p, unsigned vm, float& m, float& l, f32x16 (&o)[2], bool has_o) {
    float mx = NEGB;
#pragma unroll
    for (int r = 0; r < 16; ++r) if ((vm >> r) & 1u) mx = fmaxf(mx, p[r]);
    mx = xhalf_max(mx);
    const float mn = fmaxf(m, mx), alpha = __builtin_amdgcn_exp2f(m - mn);
    m = mn; float ls = 0.f;
#pragma unroll
    for (int r = 0; r < 16; ++r) { p[r] = ((vm >> r) & 1u) ? __builtin_amdgcn_exp2f(p[r] - mn) : 0.f; ls += p[r]; }
    l = l * alpha + ls;
    if (has_o && !__all(alpha == 1.0f)) {
#pragma unroll
        for (int r = 0; r < 16; ++r) { o[0][r] *= alpha; o[1][r] *= alpha; } }
}
__device__ __forceinline__ void softmax_update_fast(f32x16& p, float& m, float& l, f32x16 (&o)[2]) {
    float mx = p[0];
#pragma unroll
    for (int r = 1; r < 16; ++r) mx = fmaxf(mx, p[r]);
    mx = xhalf_max(mx);
    const float mn = fmaxf(m, mx), alpha = __builtin_amdgcn_exp2f(m - mn);
    m = mn; float ls = 0.f;
#pragma unroll
    for (int r = 0; r < 16; ++r) { p[r] = __builtin_amdgcn_exp2f(p[r] - mn); ls += p[r]; }
    l = l * alpha + ls;
    if (!__all(alpha == 1.0f)) {
#pragma unroll
        for (int r = 0; r < 16; ++r) { o[0][r] *= alpha; o[1][r] *= alpha; } }
}
#define DPP_XOR1 0xB1
#define DPP_XOR2 0x4E
#define DPP_HMIR 0x141
__device__ __forceinline__ float quad_sum(float v) { v += __int_as_float(__builtin_amdgcn_update_dpp(0, __float_as_int(v), DPP_XOR1, 0xf, 0xf, true)); v += __int_as_float(__builtin_amdgcn_update_dpp(0, __float_as_int(v), DPP_XOR2, 0xf, 0xf, true)); return v; }
__device__ __forceinline__ unsigned oct_umax(unsigned v) {
    unsigned o = (unsigned)__builtin_amdgcn_update_dpp(0, (int)v, DPP_XOR1, 0xf, 0xf, true); v = v > o ? v : o;
    o = (unsigned)__builtin_amdgcn_update_dpp(0, (int)v, DPP_XOR2, 0xf, 0xf, true); v = v > o ? v : o;
    o = (unsigned)__builtin_amdgcn_update_dpp(0, (int)v, DPP_HMIR, 0xf, 0xf, true); return v > o ? v : o;
}
__device__ __forceinline__ void lds_add_f32(LAS float* p, float v) { asm volatile("ds_add_f32 %0, %1" :: "v"((unsigned)(uintptr_t)p), "v"(v) : "memory"); }
__device__ __forceinline__ void stats_update_fast(const f32x16& p, float& m, float& l) {
    float mx = p[0];
#pragma unroll
    for (int r = 1; r < 16; ++r) mx = fmaxf(mx, p[r]);
    mx = xhalf_max(mx);
    const float mn = fmaxf(m, mx), alpha = __builtin_amdgcn_exp2f(m - mn);
    m = mn; float ls = 0.f;
#pragma unroll
    for (int r = 0; r < 16; ++r) ls += __builtin_amdgcn_exp2f(p[r] - mn);
    l = l * alpha + ls;
}
#define NSA_BAR() do { asm volatile("s_waitcnt lgkmcnt(0)" ::: "memory"); __builtin_amdgcn_s_barrier(); asm volatile("" ::: "memory"); } while (0)
}

__device__ __forceinline__ void phase_nsa(const Frame& F) {
    using namespace nsa;
    const int tid = F.tid, lane = F.lane, w = F.wave, r32_ = lane & 31, h_ = lane >> 5, r32 = r32_, h = h_, tl = r32 >> 2, rr = r32 & 3;
    LAS unsigned char* L = F.lds + RING_OFF;
    LAS float* IMP = (LAS float*)(L + L_IMP); LAS unsigned* SELM = (LAS unsigned*)(L + L_SELM); LAS float* BT = (LAS float*)(L + L_BT);
    LAS unsigned long long* UNI = (LAS unsigned long long*)(L + L_UNI); LAS int* LIST = (LAS int*)(L + L_LIST);
    const bf16* Q = (const bf16*)(F.ws + WS_Q); const bf16* KCMP = (const bf16*)(F.ws + WS_KCMP); const bf16* VCT = (const bf16*)(F.ws + WS_VCMPT);
    const bf16* KS = (const bf16*)(F.ws + WS_KS); const bf16* KW = (const bf16*)(F.ws + WS_KW); const bf16* VST = (const bf16*)(F.ws + WS_VST); const bf16* VWT = (const bf16*)(F.ws + WS_VWT);
    const float* GATE = (const float*)(F.ws + WS_GATE); const float* biasT = (const float*)(F.ws + WS_BIAST); bf16* ONSA = (bf16*)(F.ws + WS_ONSA);
    const int pl = F.vcu >> 5, wi = F.vcu & 31, b = pl >> 2, g = pl & 3;
    for (int i = tid; i < 512; i += NTHREADS) BT[i] = biasT[(i >> 2) * 16 + g * 4 + (i & 3)] * LOG2E;
    __syncthreads();
    const LAS float* bTl = BT + rr;
#pragma unroll 1
    for (int ui = 0; ui < 8; ++ui) {
        const int qt = (ui & 1) ? 64 * (ui >> 1) + 63 - wi : 64 * (ui >> 1) + wi;
        const int t0 = qt * 64, cur = qt, m0 = b * SEQ + t0, tok = t0 + 8 * w + tl, mrow = m0 + 8 * w + tl, H = g * NR + rr;
        s16x8 qf[4];
#pragma unroll
        for (int s = 0; s < 4; ++s) qf[s] = *(const s16x8*)(Q + (size_t)mrow * 1024 + H * 64 + 16 * s + 8 * h);
        const float b31 = bTl[127 * 4];
        LAS float* OACC = IMP + 8 * w * IMP_P + lane;
        const float* gt = GATE + (size_t)mrow * 48 + H * 3; const float g0 = gt[0], g1 = gt[1], g2 = gt[2];
        for (int i = lane; i < 8 * IMP_P; i += 64) IMP[8 * w * IMP_P + i] = 0.f;
        for (int i = tid; i < 512; i += NTHREADS) SELM[i] = 0u;
        __syncthreads();
        const int ncb = t0 >= 0 ? ((t0 + 63 - 31) / 16) / 64 + 1 : 0;
        const int icut = t0 >= 1152 ? (((t0 - 144) >> 4) - 63) / 64 + 1 : 0;
        const bf16* Kc = KCMP + (size_t)pl * 1024 * 64; const bf16* Vc = VCT + (size_t)pl * 64 * 1024;
        float mc = NEGB, lc = 0.f; f32x16 oc[2];
#pragma unroll
        for (int r = 0; r < 16; ++r) { oc[0][r] = 0.f; oc[1][r] = 0.f; }
#pragma unroll 1
        for (int pass = 0; pass < 2; ++pass) {
            float invl = 0.f;
            if (pass == 1) { const float lt = lc + __shfl_xor(lc, 32); invl = lt > 0.f ? 1.0f / lt : 0.f; }
            auto body = [&](int i, const LAS bf16* Kl, const LAS bf16* Vl) __attribute__((always_inline)) {
                int r32 = r32_, h = h_; asm volatile("" : "+v"(r32), "+v"(h));
#pragma unroll
                for (int kt = 0; kt < 2; ++kt) {
                    KVFrag fr; frag_load(fr, Kl, Vl, kt, r32, h);
                    const bool far = i < icut;
                    f32x16 pp = qk_tile(fr, qf, far ? b31 : 0.f);
                    unsigned vm = 0xffffu;
                    if (!far) vm = post_tile<0>(pp, i * 64 + 32 * kt + 4 * h, tok, 0, true, bTl);
                    if (pass == 0) { if (far) stats_update_fast(pp, mc, lc); else { f32x16 dummy[2]; softmax_update(pp, vm, mc, lc, dummy, false); } }
                    else {
#pragma unroll
                        for (int r = 0; r < 16; ++r) pp[r] = ((vm >> r) & 1u) ? __builtin_amdgcn_exp2f(pp[r] - mc) * invl : 0.f;
#pragma unroll
                        for (int a = 0; a < 4; ++a) {
                            const float s4 = quad_sum((pp[4 * a] + pp[4 * a + 1]) + (pp[4 * a + 2] + pp[4 * a + 3])), s1 = quad_sum(pp[4 * a + 3]);
                            const int j = i * 16 + kt * 8 + 2 * a + h;
                            if (rr == 0) { LAS float* ip = IMP + (8 * w + tl) * IMP_P + j; lds_add_f32(ip, s4); lds_add_f32(ip + 1, s1); }
                        }
                        pv_tile(oc, fr, pp);
                    }
                }
            };
#define NSA_STEP(i, n, KPTR, VPTR, LDV) do { if ((i) + 1 < (n)) asm volatile("s_waitcnt vmcnt(2)" ::: "memory"); else asm volatile("s_waitcnt vmcnt(0)" ::: "memory"); \
                NSA_BAR(); if ((i) + 2 < (n)) tile_issue(L, ((i) + 2) % NSLOT, KPTR((i) + 2), VPTR((i) + 2), LDV, w, lane); \
                body((i), (const LAS bf16*)(L + L_K + ((i) % NSLOT) * SLOTB), (const LAS bf16*)(L + L_V + ((i) % NSLOT) * SLOTB)); } while (0)
#define NSA_LOOP(n, KPTR, VPTR, LDV) do { tile_issue(L, 0, KPTR(0), VPTR(0), LDV, w, lane); if ((n) > 1) tile_issue(L, 1, KPTR(1), VPTR(1), LDV, w, lane); \
                _Pragma("unroll 1") for (int i_ = 0; i_ < (n); ++i_) NSA_STEP(i_, (n), KPTR, VPTR, LDV); NSA_BAR(); } while (0)
#define CK(ii) (Kc + (size_t)(ii) * 64 * 64)
#define CV(ii) (Vc + (ii) * 64)
            NSA_LOOP(ncb, CK, CV, 1024);
#undef CK
#undef CV
        }
        {
            int lane_o = lane; asm volatile("" : "+v"(lane_o));
            const int tk = lane_o >> 3, sub = lane_o & 7; LAS unsigned* sm = SELM + (8 * w + tk) * 8;
            const int ncand = cur - 2, nf = cur + 1 < 3 ? cur + 1 : 3, need = 16 - nf;
            asm volatile("s_waitcnt lgkmcnt(0)" ::: "memory");
            if (sub == 0) { (void)__hip_atomic_fetch_or(sm, 1u, __ATOMIC_RELAXED, __HIP_MEMORY_SCOPE_WORKGROUP); (void)__hip_atomic_fetch_or(sm + (cur >> 5), 1u << (cur & 31), __ATOMIC_RELAXED, __HIP_MEMORY_SCOPE_WORKGROUP); if (cur >= 1) (void)__hip_atomic_fetch_or(sm + ((cur - 1) >> 5), 1u << ((cur - 1) & 31), __ATOMIC_RELAXED, __HIP_MEMORY_SCOPE_WORKGROUP); }
            if (ncand <= need) {
                if (sub == 0) for (int j = 1; j <= cur - 2; ++j) (void)__hip_atomic_fetch_or(sm + (j >> 5), 1u << (j & 31), __ATOMIC_RELAXED, __HIP_MEMORY_SCOPE_WORKGROUP);
            } else {
                const LAS float* ip = IMP + (8 * w + tk) * IMP_P;
                unsigned key[32];
#pragma unroll
                for (int i = 0; i < 32; ++i) { const int j = sub + 8 * i; key[i] = (j >= 1 && j <= cur - 2) ? ((__float_as_uint(ip[j]) & 0xffffff00u) | (unsigned)(255 - j)) : 0u; }
#pragma unroll 1
                for (int round = 0; round < need; ++round) {
                    unsigned bk = key[0];
#pragma unroll
                    for (int i = 1; i < 32; ++i) bk = bk > key[i] ? bk : key[i];
                    bk = oct_umax(bk);
#pragma unroll
                    for (int i = 0; i < 32; ++i) key[i] = key[i] == bk ? 0u : key[i];
                    const int bj = 255 - (int)(bk & 0xffu);
                    if (sub == 0 && bk != 0u) (void)__hip_atomic_fetch_or(sm + (bj >> 5), 1u << (bj & 31), __ATOMIC_RELAXED, __HIP_MEMORY_SCOPE_WORKGROUP);
                }
            }
        }
        asm volatile("s_waitcnt lgkmcnt(0)" ::: "memory");
#pragma unroll
        for (int r = 0; r < 16; ++r) { OACC[r * 64] = g0 * oc[0][r]; OACC[(16 + r) * 64] = g0 * oc[1][r]; }
        __syncthreads();
        {
            bool any = false; const int j = tid;
            if (j < 256) { unsigned acc = 0u; for (int t = 0; t < 64; ++t) acc |= SELM[t * 8 + (j >> 5)]; any = (acc >> (j & 31)) & 1u; any = any && j <= cur; }
            const unsigned long long bal = __ballot(any);
            if (lane == 0 && w < 4) UNI[w] = bal;
            __syncthreads();
            if (j < 256) { int pos = 0; for (int ww = 0; ww < w; ++ww) pos += __popcll(UNI[ww]); pos += __popcll(bal & ((1ull << lane) - 1ull)); if (any) LIST[1 + pos] = j; }
            if (tid == 0) LIST[0] = __popcll(UNI[0]) + __popcll(UNI[1]) + __popcll(UNI[2]) + __popcll(UNI[3]);
            __syncthreads();
        }
        unsigned wsel = SELM[(8 * w + (lane >> 3)) * 8 + (lane & 7)];
        wsel |= __shfl_xor(wsel, 8); wsel |= __shfl_xor(wsel, 16); wsel |= __shfl_xor(wsel, 32);
        {
            const int nsb = LIST[0];
            const bf16* Kg = KS + (size_t)pl * SEQ * 64; const bf16* Vg = VST + (size_t)pl * 64 * SEQ;
            float ms = NEGB, ls = 0.f; f32x16 os[2];
#pragma unroll
            for (int r = 0; r < 16; ++r) { os[0][r] = 0.f; os[1][r] = 0.f; }
            auto body = [&](int i, const LAS bf16* Kl, const LAS bf16* Vl) __attribute__((always_inline)) {
                const int j = LIST[1 + i];
                const bool wave_has = (__builtin_amdgcn_readlane(wsel, j >> 5) >> (j & 31)) & 1u;
                if (wave_has) {
                    int r32 = r32_, h = h_; asm volatile("" : "+v"(r32), "+v"(h));
                    const bool colok = (SELM[(8 * w + tl) * 8 + (j >> 5)] >> (j & 31)) & 1u;
                    const bool far = j <= cur - 3;
                    const float ci = far ? (colok ? b31 : NEGB) : 0.f;
#pragma unroll
                    for (int kt = 0; kt < 2; ++kt) {
                        KVFrag fr; frag_load(fr, Kl, Vl, kt, r32, h);
                        f32x16 pp = qk_tile(fr, qf, ci);
                        if (far) softmax_update_fast(pp, ms, ls, os);
                        else { const unsigned vm = post_tile<1>(pp, j * 64 + 32 * kt + 4 * h, tok, 1 << 30, colok, bTl); softmax_update(pp, vm, ms, ls, os, true); }
                        pv_tile(os, fr, pp);
                    }
                }
            };
#define SK(ii) (Kg + (size_t)LIST[1 + (ii)] * 64 * 64)
#define SV(ii) (Vg + LIST[1 + (ii)] * 64)
            NSA_LOOP(nsb, SK, SV, SEQ);
#undef SK
#undef SV
            const float lt = ls + __shfl_xor(ls, 32), sc = lt > 0.f ? g1 / lt : 0.f;
#pragma unroll
            for (int r = 0; r < 16; ++r) { OACC[r * 64] += sc * os[0][r]; OACC[(16 + r) * 64] += sc * os[1][r]; }
        }
        {
            const int jb0 = cur >= 8 ? cur - 8 : 0, nwb = cur - jb0 + 1;
            const bf16* Kg = KW + (size_t)pl * SEQ * 64; const bf16* Vg = VWT + (size_t)pl * 64 * SEQ;
            float mw = NEGB, lw = 0.f; f32x16 ow[2];
#pragma unroll
            for (int r = 0; r < 16; ++r) { ow[0][r] = 0.f; ow[1][r] = 0.f; }
            auto body = [&](int i, const LAS bf16* Kl, const LAS bf16* Vl) __attribute__((always_inline)) {
                const int j = jb0 + i;
                const bool far = j <= cur - 3 && j >= cur - 7;
                int r32 = r32_, h = h_; asm volatile("" : "+v"(r32), "+v"(h));
#pragma unroll
                for (int kt = 0; kt < 2; ++kt) {
                    KVFrag fr; frag_load(fr, Kl, Vl, kt, r32, h);
                    f32x16 pp = qk_tile(fr, qf, far ? b31 : 0.f);
                    if (far) softmax_update_fast(pp, mw, lw, ow);
                    else { const unsigned vm = post_tile<1>(pp, j * 64 + 32 * kt + 4 * h, tok, 512, true, bTl); softmax_update(pp, vm, mw, lw, ow, true); }
                    pv_tile(ow, fr, pp);
                }
            };
#define WK(ii) (Kg + (size_t)(jb0 + (ii)) * 64 * 64)
#define WV(ii) (Vg + (jb0 + (ii)) * 64)
            NSA_LOOP(nwb, WK, WV, SEQ);
#undef WK
#undef WV
            const float lt = lw + __shfl_xor(lw, 32), sc = lt > 0.f ? g2 / lt : 0.f;
#pragma unroll
            for (int r = 0; r < 16; ++r) { ow[0][r] = OACC[r * 64] + sc * ow[0][r]; ow[1][r] = OACC[(16 + r) * 64] + sc * ow[1][r]; }
            bf16* op = ONSA + (size_t)mrow * 1024 + H * 64 + 4 * h;
#pragma unroll
            for (int dt = 0; dt < 2; ++dt)
#pragma unroll
                for (int a = 0; a < 4; ++a) { v2u wv; wv.x = cvtpk(ow[dt][4 * a], ow[dt][4 * a + 1]); wv.y = cvtpk(ow[dt][4 * a + 2], ow[dt][4 * a + 3]); *(v2u*)(op + 32 * dt + 8 * a) = wv; }
            asm volatile("s_waitcnt lgkmcnt(0)" ::: "memory");
        }
    }
#undef NSA_STEP
#undef NSA_LOOP
}

__device__ __forceinline__ float dot64(const float* q, const bf16* krow) {
    const v4u* kp = (const v4u*)krow; float s = 0.f;
#pragma unroll
    for (int j = 0; j < 8; ++j) { float kf[8]; unpack8(kp[j], kf);
#pragma unroll
        for (int i = 0; i < 8; ++i) s += q[8 * j + i] * kf[i]; }
    return s;
}
__device__ __forceinline__ void wave_softmax(LAS float* S, int n, int n8, int ln) {
    float mx = -INFINITY;
    for (int i = ln; i < n; i += 64) mx = fmaxf(mx, S[i]);
    mx = wave_max(mx); if (!(mx > -INFINITY)) mx = 0.f;
    float sum = 0.f;
    for (int i = ln; i < n; i += 64) { const float p = __expf(S[i] - mx); S[i] = p; sum += p; }
    sum = wave_sum(sum); const float inv = 1.0f / fmaxf(sum, 1.17549435e-38f);
    for (int i = ln; i < n8; i += 64) S[i] = i < n ? S[i] * inv : 0.f;
}
__device__ __forceinline__ void phase_nsa_naive(const Frame& F) {
    const int half = F.tid >> 8, tl = F.tid & 255, r = tl >> 6, ln = tl & 63;
    LAS float* S = (LAS float*)(F.lds + RING_OFF + half * 32768);
    LAS float* IMPC = S + 4096; LAS float* IMP = IMPC + 1024; LAS int* SELF = (LAS int*)(IMP + 256); LAS int* BLK = SELF + 256;
    LAS float* Sr = S + r * 1024;
    const bf16* Q = (const bf16*)(F.ws + WS_Q); const bf16* KCMP = (const bf16*)(F.ws + WS_KCMP); const bf16* VCT = (const bf16*)(F.ws + WS_VCMPT);
    const bf16* KS = (const bf16*)(F.ws + WS_KS); const bf16* KW = (const bf16*)(F.ws + WS_KW); const bf16* VST = (const bf16*)(F.ws + WS_VST); const bf16* VWT = (const bf16*)(F.ws + WS_VWT);
    const float* GATE = (const float*)(F.ws + WS_GATE); const float* biasT = (const float*)(F.ws + WS_BIAST); bf16* ONSA = (bf16*)(F.ws + WS_ONSA);
    for (int it = blockIdx.x; it < MTOK * NG / 2; it += F.G) {
        const int item = it * 2 + half, m = item >> 2, g = item & 3, b = m / SEQ, t = m % SEQ, pl = b * NG + g, H = g * NR + r;
        float q[64];
        { const v4u* qp = (const v4u*)(Q + (size_t)m * 1024 + H * 64);
#pragma unroll
          for (int j = 0; j < 8; ++j) unpack8(qp[j], q + 8 * j); }
        const float* bT = biasT + H;
        const int nvalid = t >= 31 ? ((t - 31) / 16 + 1 < NCMP ? (t - 31) / 16 + 1 : NCMP) : 0, nv8 = (nvalid + 7) & ~7;
        for (int n = ln; n < nvalid; n += 64) { const int dist = t - 16 * n - 31; Sr[n] = dot64(q, KCMP + ((size_t)pl * 1024 + n) * 64) * 0.6931471805599453f + bT[(dist < 127 ? dist : 127) * 16]; }
        __syncthreads();
        wave_softmax(Sr, nvalid, nv8, ln);
        __syncthreads();
        for (int n = tl; n < 1024; n += 256) IMPC[n] = n < nvalid ? (S[n] + S[1024 + n]) + (S[2048 + n] + S[3072 + n]) : 0.f;
        const int cur = t >> 6;
        SELF[tl] = (tl == 0 || tl == cur || tl == cur - 1) ? 1 : 0;
        __syncthreads();
        { float s = 0.f;
#pragma unroll
          for (int k = -1; k < 4; ++k) { const int n = 4 * tl + k; if (n >= 0 && n < NCMP) s += IMPC[n]; }
          IMP[tl] = s; }
        float oc = 0.f;
        for (int n0 = 0; n0 < nvalid; n0 += 8) { float vf[8]; unpack8(*(const v4u*)(VCT + ((size_t)pl * 64 + ln) * 1024 + n0), vf);
#pragma unroll
            for (int i = 0; i < 8; ++i) oc += Sr[n0 + i] * vf[i]; }
        __syncthreads();
        if (r == 0) {
            const int ncand = cur - 2, nf = cur + 1 < 3 ? cur + 1 : 3, need = 16 - nf;
            if (ncand <= need) { for (int j = ln; j < 256; j += 64) if (j >= 1 && j <= cur - 2) SELF[j] = 1; }
            else {
                float v[4];
#pragma unroll
                for (int i = 0; i < 4; ++i) { const int j = ln + 64 * i; v[i] = (j >= 1 && j <= cur - 2) ? IMP[j] : -INFINITY; }
                for (int round = 0; round < need; ++round) {
                    float bv = v[0]; int bj = ln;
#pragma unroll
                    for (int i = 1; i < 4; ++i) if (v[i] > bv) { bv = v[i]; bj = ln + 64 * i; }
#pragma unroll
                    for (int o = 1; o < 64; o <<= 1) { const float ov = __shfl_xor(bv, o); const int oj = __shfl_xor(bj, o); if (ov > bv || (ov == bv && oj < bj)) { bv = ov; bj = oj; } }
#pragma unroll
                    for (int i = 0; i < 4; ++i) if (bj == ln + 64 * i) { v[i] = -INFINITY; SELF[bj] = 1; }
                }
            }
        }
        __syncthreads();
        int nk = 0;
        for (int j = 0; j <= cur; ++j) {
            if (SELF[j]) {
                const int pos = 64 * j + ln, dist = t - pos;
                Sr[nk * 64 + ln] = pos <= t ? dot64(q, KS + ((size_t)pl * SEQ + pos) * 64) * 0.6931471805599453f + bT[(dist < 127 ? dist : 127) * 16] : -INFINITY;
                if (tl == 0) BLK[nk] = j;
                ++nk;
            }
        }
        __syncthreads();
        wave_softmax(Sr, nk * 64, nk * 64, ln);
        float os = 0.f;
        for (int k = 0; k < nk; ++k) { const int j = BLK[k];
            for (int l0 = 0; l0 < 64; l0 += 8) { float vf[8]; unpack8(*(const v4u*)(VST + ((size_t)pl * 64 + ln) * SEQ + 64 * j + l0), vf);
#pragma unroll
                for (int i = 0; i < 8; ++i) os += Sr[k * 64 + l0 + i] * vf[i]; } }
        __syncthreads();
        for (int i = ln; i < 512; i += 64) { const int pos = t - 511 + i; Sr[i] = pos >= 0 ? dot64(q, KW + ((size_t)pl * SEQ + pos) * 64) * 0.6931471805599453f + bT[((511 - i) < 127 ? (511 - i) : 127) * 16] : -INFINITY; }
        wave_softmax(Sr, 512, 512, ln);
        float ow = 0.f;
        for (int i = t >= 511 ? 0 : 511 - t; i < 512; ++i) ow += Sr[i] * bf2f(VWT[((size_t)pl * 64 + ln) * SEQ + (t - 511 + i)]);
        const float* gt = GATE + (size_t)m * 48 + H * 3;
        ONSA[(size_t)m * 1024 + H * 64 + ln] = f2bf(gt[0] * oc + gt[1] * os + gt[2] * ow);
        __syncthreads();
    }
}

template <class Epi, class Map>
__device__ __forceinline__ void run_gemm(const Frame& F, const bf16* A, const bf16* Bt, int lda, int ldb, int K, int nM, int nN, const Map& map, const Epi& E) {
    pg8::Gemm g{A, Bt, lda, ldb, K}; pg8::Order<Map> S; S.init(nM, nN, F.G, (int)blockIdx.x, map);
    int tid = F.tid; asm volatile("" : "+v"(tid));
    pg8::gemm_phase<Epi, pg8::Order<Map>, true, true>(F.lds + RING_OFF, g, S, E, tid);
}
enum { PH_PRO, PH_P1, PH_R1, PH_R2, PH_R3, PH_G, PH_OUT, PH_RES, PH_FI, PH_KVQN, PH_KVQS, PH_CMP, PH_CMP2, PH_NSAN, PH_NSA, PH_COUNT };

template <int PH> __device__ __forceinline__ void phase_body(const Frame& F, int b) {
    unsigned char* ws = F.ws; float* rinv = (float*)(ws + WS_RINV); bf16* XB = (bf16*)(ws + WS_XB);
    if constexpr (PH == PH_PRO) phase_prologue(F);
    if constexpr (PH == PH_P1) {
        { EpiP1N E{rinv + b * SEQ, (const f32x4*)(ws + WS_TABA), (bf16*)(ws + WS_AP), (bf16*)(ws + WS_KN)};
          run_gemm(F, XB + (size_t)b * SEQ * DM, (const bf16*)(ws + W_RI), DM, DM, DM, SEQ / 256, 8, pg8::MapPlain{DM, DM}, E); }
        __syncthreads();
        { EpiP1S E{rinv + b * SEQ, (const f32x4*)(ws + WS_TABB), (bf16*)(ws + WS_KT), (bf16*)(ws + WS_BP)};
          run_gemm(F, (const bf16*)(ws + W_RI) + (size_t)1024 * DM, XB + (size_t)b * SEQ * DM, DM, DM, DM, 12, SEQ / 256, pg8::MapPlain{DM, DM}, E); }
    }
    if constexpr (PH == PH_R1) {
        { EpiKV E{(bf16*)(ws + WS_KV)};
          run_gemm(F, (const bf16*)(ws + WS_BP), (const bf16*)(ws + WS_KT), APLD, SEQ, RCH, RH * NCH * 2, 1, MapKV{}, E); }
        __syncthreads();
        { EpiS E{(bf16*)(ws + WS_AP)};
          run_gemm(F, (const bf16*)(ws + WS_AP), (const bf16*)(ws + WS_KN), APLD, 1024, RDK, RH * NCH * 2, 2, MapS{}, E); }
    }
    if constexpr (PH == PH_R2) phase_ret_scan(F);
    if constexpr (PH == PH_R3) { EpiO E{(bf16*)F.out, (float*)(ws + WS_GSLOT), b};
        run_gemm(F, (const bf16*)(ws + WS_AP), (const bf16*)(ws + WS_BP), APLD, APLD, APLD, RH * NCH * 2, 2, MapO{}, E); }
    if constexpr (PH == PH_G) { EpiG E{rinv, (const float*)(ws + WS_GSLOT), (bf16*)F.out};
        run_gemm(F, XB, (const bf16*)(ws + W_RI) + (size_t)4096 * DM, DM, DM, DM, MTOK / 256, 8, pg8::MapPlain{DM, DM}, E); }
    if constexpr (PH == PH_OUT) {
        const bf16* A = b == 0 ? (const bf16*)F.out : b == 2 ? (const bf16*)(ws + WS_ONSA) : (const bf16*)(ws + WS_HID);
        const bf16* Bt = (const bf16*)(ws + (b == 0 ? W_RO : b == 1 ? W_FO0 : b == 2 ? W_NO : W_FO1));
        const int K = b == 0 ? 2048 : b == 2 ? DM : FFH;
        EpiOut E{(bf16*)(ws + WS_MIX), (float*)(ws + WS_OSLOT)};
        run_gemm(F, A, Bt, K, K, K, MTOK / 256, 4, pg8::MapPlain{K, K}, E); }
    if constexpr (PH == PH_RES) phase_resid(F, b == 0 ? gp(F.in[0]) : F.out, gp(b & 1 ? F.in[4] : F.in[2]) + (b >> 1) * DM, b == 3);
    if constexpr (PH == PH_FI) { EpiFfnIn E{rinv, (bf16*)(ws + WS_HID)};
        run_gemm(F, XB, (const bf16*)(ws + (b ? W_FI1 : W_FI0)), DM, DM, DM, MTOK / 256, 22, pg8::MapPlain{DM, DM}, E); }
    if constexpr (PH == PH_KVQN) { phase_peb_final(F);
        EpiKvqN E{rinv, (bf16*)(ws + WS_KC), (bf16*)(ws + WS_VC), (bf16*)(ws + WS_KS), (bf16*)(ws + WS_KW), (bf16*)(ws + WS_Q), (float*)(ws + WS_GATE)};
        run_gemm(F, XB, (const bf16*)(ws + W_KVQ), DM, DM, DM, MTOK / 256, 9, pg8::MapPlain{DM, DM}, E); }
    if constexpr (PH == PH_KVQS) { EpiKvqS E{rinv, (bf16*)(ws + WS_VST), (bf16*)(ws + WS_VWT)};
        run_gemm(F, (const bf16*)(ws + W_KVV), XB, DM, DM, DM, 2, MTOK / 256, pg8::MapPlain{DM, DM}, E); }
    if constexpr (PH == PH_CMP) { EpiCmp E{(const float*)(ws + WS_PEB), (bf16*)(ws + WS_HIDC)};
        run_gemm(F, (const bf16*)(ws + WS_KC), (const bf16*)(ws + W_C1), 1024, 2048, 2048, 64, 1, MapCmp{}, E); }
    if constexpr (PH == PH_CMP2) phase_cmp2(F);
    if constexpr (PH == PH_NSAN) phase_nsa_naive(F);
    if constexpr (PH == PH_NSA) phase_nsa(F);
}
__device__ __forceinline__ void make_frame(Frame& F, unsigned char* lds, const Args& args) {
    int tid = threadIdx.x; asm volatile("" : "+v"(tid));
    GAS unsigned char* wsg = (GAS unsigned char*)args.ws; GAS float* outg = (GAS float*)args.out; asm volatile("" : "+s"(wsg), "+s"(outg));
    F.lds = (LAS unsigned char*)lds; F.ws = (unsigned char*)wsg; F.out = (float*)outg; F.in = args.in;
    F.tid = tid; F.lane = tid & 63; F.wave = __builtin_amdgcn_readfirstlane(tid >> 6);
    F.G = gridDim.x; { const int bx = blockIdx.x; F.vcu = (F.G % 8 == 0) ? (bx % 8) * (F.G / 8) + bx / 8 : bx; }
    F.gw = F.vcu * NWAVES + F.wave; F.NGW = F.G * NWAVES;
}
#ifndef NSA_PHASE
#define NSA_PHASE PH_NSA
#endif
__global__ void __launch_bounds__(NTHREADS, 2) fwd(Args args) {
    extern __shared__ __attribute__((aligned(16))) unsigned char lds[];
    {   LAS unsigned* ctl = (LAS unsigned*)((LAS unsigned char*)lds + LDSCTL_OFF);
        for (int u = threadIdx.x; u < (LDS_BYTES - LDSCTL_OFF) / 4; u += NTHREADS) ctl[u] = 0u; }
    __syncthreads();
    const int lo = args.ph, hi = args.b;
    XcdBarrier bar; bar.bar = (unsigned*)(args.ws + WS_CTL) + CW_BAR; bar.x = 0; bar.st = nullptr;
    if (hi - lo > 1) bar = xcd_barrier_post((unsigned*)(args.ws + WS_CTL) + CW_BAR, (volatile LAS unsigned*)((LAS unsigned char*)lds + MISC_OFF) + 8);
    int ph = 0;
#ifndef DBG_MASK
#define DBG_MASK 0xffffffffu
#endif
#define RUN(PH, bval) do { if (ph >= lo && ph < hi) { Frame F; make_frame(F, lds, args); if constexpr ((DBG_MASK >> PH) & 1u) phase_body<PH>(F, (bval)); if (ph + 1 < hi) xcd_barrier(bar); } ++ph; } while (0)
    RUN(PH_PRO, 0);
#pragma unroll 1
    for (int layer = 0; layer < 2; ++layer) {
#pragma unroll 1
        for (int sub = 0; sub < 2; ++sub) {
            if (sub == 0) {
                if (layer == 0) {
#pragma unroll 1
                    for (int b = 0; b < NBATCH; ++b) { RUN(PH_P1, b); RUN(PH_R1, b); RUN(PH_R2, b); RUN(PH_R3, b); }
                    RUN(PH_G, 0);
                } else { RUN(PH_KVQN, 0); RUN(PH_KVQS, 0); RUN(PH_CMP, 0); RUN(PH_CMP2, 0); RUN(NSA_PHASE, 0); }
            } else RUN(PH_FI, layer);
            RUN(PH_OUT, 2 * layer + sub);
            RUN(PH_RES, 2 * layer + sub);
        }
    }
#undef RUN
}
constexpr int NPHASES = 1 + (8 + 1 + 2) + 3 + (5 + 2) + 3;

#ifndef MK_N_LAUNCH
#define MK_N_LAUNCH 1
#endif
extern "C" void kernel_launch(void* const* d_in, const int* in_sizes, int n_in, void* d_out, int out_size, void* d_ws, size_t ws_size, hipStream_t stream) {
    static int grid = 0;
    if (grid == 0) {
        if (n_in != 20 || out_size != MTOK * DM || ws_size < WS_NEED) { fprintf(stderr, "kernel_launch: unexpected problem shape (n_in %d, out %d, ws %zu)\n", n_in, out_size, ws_size); grid = -1; return; }
        int dev = 0, cus = 0, per_cu = 0;
        if (hipGetDevice(&dev) != hipSuccess || hipDeviceGetAttribute(&cus, hipDeviceAttributeMultiprocessorCount, dev) != hipSuccess) { grid = -1; return; }
        if (hipFuncSetAttribute((const void*)fwd, hipFuncAttributeMaxDynamicSharedMemorySize, LDS_BYTES) != hipSuccess) { fprintf(stderr, "kernel_launch: hipFuncSetAttribute failed\n"); grid = -1; return; }
        if (hipOccupancyMaxActiveBlocksPerMultiprocessor(&per_cu, (const void*)fwd, NTHREADS, LDS_BYTES) != hipSuccess || per_cu < 1) { fprintf(stderr, "kernel_launch: occupancy query says %d blocks per CU\n", per_cu); }
        (void)hipGetLastError();
        grid = cus;
    }
    if (grid < 0) return;
#ifdef DBG_ZERO_WS
    (void)hipMemsetAsync((char*)d_ws, 0, WS_NEED, stream);
#endif
    (void)hipMemsetAsync((char*)d_ws + WS_CTL, 0, CTL_ZERO_BYTES, stream);
    Args a{};
    for (int i = 0; i < 20; ++i) a.in[i] = (const float*)d_in[i];
    a.out = (float*)d_out; a.ws = (unsigned char*)d_ws;
    if (MK_N_LAUNCH == 1) { a.ph = 0; a.b = NPHASES; hipLaunchKernelGGL(fwd, dim3(grid), dim3(NTHREADS), LDS_BYTES, stream, a); }
    else for (int p = 0; p < NPHASES; ++p) { a.ph = p; a.b = p + 1; hipLaunchKernelGGL(fwd, dim3(grid), dim3(NTHREADS), LDS_BYTES, stream, a); }
}
```

```cpp
#include <hip/hip_runtime.h>
#include <cstdio>
#include <cstdint>
#include <utility>

namespace pg8 {
#define PG8_LAS __attribute__((address_space(3)))
typedef unsigned short bf16_t;
typedef short bf16x8 __attribute__((ext_vector_type(8)));
typedef float f32x4 __attribute__((ext_vector_type(4)));
typedef unsigned u32x4 __attribute__((ext_vector_type(4)));
constexpr int BM = 256, BK = 64, HALF = 128, HTB = HALF * BK * 2  , STAGE_BYTES = 8 * HTB, NXCD = 8, WGM = 8;

__host__ __device__ __forceinline__ int lds_byte(int r, int c) { const int st = (r >> 4) * 2 + (c >> 5), rr = r & 15, cc = c & 31, ob = rr * 64 + cc * 2; return st * 1024 + (ob ^ (((ob >> 9) & 1) << 5)); }
__host__ __device__ __forceinline__ void stage_rc(int b, int& R, int& C) { const int st = b / 1024, sb = b % 1024, swz = sb ^ (((sb >> 9) & 1) << 5); R = (st >> 1) * 16 + swz / 64; C = (st & 1) * 32 + (swz % 64) / 2; }
__host__ __device__ __forceinline__ int perm32(int rho) { const int n = rho >> 4, i = rho & 15; return 8 * (i >> 2) + 4 * n + (i & 3); }

struct Unit { int pm, pn; size_t offA, offB; };
struct Gemm { const bf16_t* A; const bf16_t* Bt; int lda, ldb, K; };

template <class Map> struct Order {
    int nM, nN, nwg, G, c; Map map;
    __device__ __forceinline__ void init(int nM_, int nN_, int G_, int c_, const Map& m) { nM = nM_; nN = nN_; nwg = nM * nN; G = G_; c = c_; map = m; }
    __device__ __forceinline__ bool next(int i, Unit& u) const {
        const long L = (long)i * G + c; if (L >= nwg) return false;
        int wgid = (int)L; { const int q = nwg / NXCD, r = nwg % NXCD, xcd = wgid % NXCD, off = wgid / NXCD; wgid = (xcd < r ? xcd * (q + 1) : r * (q + 1) + (xcd - r) * q) + off; }
        const int nig = WGM * nN, gid = wgid / nig, fm = gid * WGM, gsz = (nM - fm) < WGM ? (nM - fm) : WGM;
        u.pm = fm + ((wgid % nig) % gsz); u.pn = (wgid % nig) / gsz; map(u); return true;
    }
    __device__ __forceinline__ void a_ready(const Unit&) const {}
    __device__ __forceinline__ void done(const Unit&) const {}
};
struct MapPlain { int lda, ldb; __device__ __forceinline__ void operator()(Unit& u) const { u.offA = (size_t)u.pm * 256 * lda * 2; u.offB = (size_t)u.pn * 256 * ldb * 2; } };

template <class Epi, class Sched, bool ALIGN_EPI = false, bool SP2 = false>
__device__ __forceinline__ void gemm_phase(PG8_LAS unsigned char* lds, const Gemm g, const Sched& S, const Epi& E, const int tid) {
    const int wid = __builtin_amdgcn_readfirstlane(tid >> 6), lane = tid & 63, wr = wid >> 2, wc = wid & 3, fr = lane & 15, fq = lane >> 4;
    const int K = g.K, nt = K / BK;
    unsigned voffA[2], voffB[2];
#pragma unroll
    for (int i = 0; i < 2; ++i) { int R, C; stage_rc(tid * 16 + i * 8192, R, C); const int Rb = Epi::PERM ? ((R & ~31) + perm32(R & 31)) : R;
        voffA[i] = (unsigned)(R * g.lda + C) * 2u; voffB[i] = (unsigned)(Rb * g.ldb + C) * 2u; }
    const size_t kstep = (size_t)(BK * 2);
    const size_t hstepA = (size_t)HALF * g.lda * 2, hstepB = (size_t)HALF * g.ldb * 2;
    const unsigned ldsw = (unsigned)wid * 1024u;
    const int aoff = lds_byte(wr * 64 + fr, fq * 8), boff = lds_byte(wc * 32 + fr, fq * 8);
#define PG8_SA(b, h) (((b) * 2 + (h)) * HTB)
#define PG8_SB(b, h) ((4 + (b) * 2 + (h)) * HTB)
#define PG8_STAGE(bufoff, gbase, voff) do { _Pragma("unroll") for (int _i = 0; _i < 2; ++_i) \
        __builtin_amdgcn_global_load_lds((const unsigned*)((const char*)(gbase) + (voff)[_i]), (PG8_LAS unsigned*)(lds + (bufoff) + ldsw + _i * 8192), 16, 0, 0); } while (0)
#define PG8_LDA(dst, b, h) do { _Pragma("unroll") for (int m = 0; m < 4; ++m) _Pragma("unroll") for (int k = 0; k < 2; ++k) dst[m][k] = *(const PG8_LAS bf16x8*)(lds + PG8_SA(b, h) + aoff + m * 2048 + k * 1024); } while (0)
#define PG8_LDB(dst, b, h) do { _Pragma("unroll") for (int n = 0; n < 2; ++n) _Pragma("unroll") for (int k = 0; k < 2; ++k) dst[n][k] = *(const PG8_LAS bf16x8*)(lds + PG8_SB(b, h) + boff + n * 2048 + k * 1024); } while (0)
#define PG8_MMA(ai, bj, At, Bt) do { __builtin_amdgcn_s_setprio(1); _Pragma("unroll") for (int m = 0; m < 4; ++m) _Pragma("unroll") for (int n = 0; n < 2; ++n) _Pragma("unroll") for (int k = 0; k < 2; ++k) \
        acc[ai][bj][m][n] = __builtin_amdgcn_mfma_f32_16x16x32_bf16(Bt[n][k], At[m][k], acc[ai][bj][m][n], 0, 0, 0); __builtin_amdgcn_s_setprio(0); } while (0)
#define PG8_WAIT_V(n) asm volatile("s_waitcnt vmcnt(" #n ")" ::: "memory")
#define PG8_WAIT_L(n) asm volatile("s_waitcnt lgkmcnt(" #n ")" ::: "memory")
#define PG8_BAR __builtin_amdgcn_s_barrier()
#define PG8_SCHED __builtin_amdgcn_sched_barrier(0)
    Unit cur, nxt; int ui = 0;
    if (!S.next(0, cur)) return;
    f32x4 acc[2][2][4][2];
#pragma unroll
    for (int a = 0; a < 2; ++a)
#pragma unroll
        for (int b = 0; b < 2; ++b)
#pragma unroll
            for (int m = 0; m < 4; ++m)
#pragma unroll
                for (int n = 0; n < 2; ++n) acc[a][b][m][n] = (f32x4){0.f, 0.f, 0.f, 0.f};
    bf16x8 At[4][2], B0[2][2], B1[2][2];
    const char* cA = (const char*)g.A + cur.offA; const char* cB = (const char*)g.Bt + cur.offB;
    S.a_ready(cur);
    if constexpr (SP2) {
        PG8_STAGE(PG8_SB(0, 0), cB, voffB); PG8_STAGE(PG8_SB(0, 1), cB + hstepB, voffB); PG8_STAGE(PG8_SA(0, 0), cA, voffA); PG8_STAGE(PG8_SA(0, 1), cA + hstepA, voffA);
        if (wr == 1) PG8_BAR;
        PG8_WAIT_V(2); PG8_BAR;
        PG8_STAGE(PG8_SB(1, 0), cB + kstep, voffB); PG8_STAGE(PG8_SA(1, 0), cA + kstep, voffA); PG8_STAGE(PG8_SB(1, 1), cB + hstepB + kstep, voffB);
        PG8_WAIT_V(6); PG8_BAR;
    } else {
        PG8_STAGE(PG8_SB(0, 0), cB, voffB); PG8_STAGE(PG8_SA(0, 0), cA, voffA); PG8_STAGE(PG8_SB(0, 1), cB + hstepB, voffB); PG8_STAGE(PG8_SA(0, 1), cA + hstepA, voffA);
        if (wr == 1) PG8_BAR;
        PG8_WAIT_V(4); PG8_BAR;
        PG8_STAGE(PG8_SB(1, 0), cB + kstep, voffB); PG8_STAGE(PG8_SA(1, 0), cA + kstep, voffA); PG8_STAGE(PG8_SB(1, 1), cB + hstepB + kstep, voffB);
        PG8_WAIT_V(6); PG8_BAR;
    }
    for (;;) {
        const bool has_next = S.next(ui + 1, nxt);
        const char* nA = has_next ? (const char*)g.A + nxt.offA : cA; const char* nB = has_next ? (const char*)g.Bt + nxt.offB : cB;
#pragma unroll 1
        for (int t = 0; t < nt; t += 2) {
            const bool last = (t == nt - 2);
            const char* a1 = cA + (size_t)(t + 1) * kstep;
            const char* a2 = last ? nA : cA + (size_t)(t + 2) * kstep; const char* b2 = last ? nB : cB + (size_t)(t + 2) * kstep;
            const char* a3 = a2 + kstep; const char* b3 = b2 + kstep;
            if (last && has_next) S.a_ready(nxt);
            if constexpr (SP2) {
            PG8_LDB(B0, 0, 0); PG8_LDB(B1, 0, 1); PG8_SCHED; PG8_LDA(At, 0, 0); PG8_STAGE(PG8_SA(1, 1), a1 + hstepA, voffA);
            PG8_WAIT_V(8); PG8_WAIT_L(0); PG8_BAR; PG8_MMA(0, 0, At, B0); PG8_MMA(0, 1, At, B1); PG8_BAR; PG8_SCHED;
            PG8_LDA(At, 0, 1); PG8_STAGE(PG8_SB(0, 0), b2, voffB); PG8_STAGE(PG8_SB(0, 1), b2 + hstepB, voffB); PG8_STAGE(PG8_SA(0, 0), a2, voffA);
            PG8_WAIT_V(8); PG8_WAIT_L(0); PG8_BAR; PG8_MMA(1, 0, At, B0); PG8_MMA(1, 1, At, B1); PG8_BAR; PG8_SCHED;
            PG8_LDB(B0, 1, 0); PG8_LDB(B1, 1, 1); PG8_SCHED; PG8_LDA(At, 1, 0); PG8_STAGE(PG8_SA(0, 1), a2 + hstepA, voffA);
            PG8_WAIT_V(8); PG8_WAIT_L(0); PG8_BAR; PG8_MMA(0, 0, At, B0); PG8_MMA(0, 1, At, B1); PG8_BAR; PG8_SCHED;
            PG8_LDA(At, 1, 1); PG8_STAGE(PG8_SB(1, 0), b3, voffB); PG8_STAGE(PG8_SB(1, 1), b3 + hstepB, voffB); PG8_STAGE(PG8_SA(1, 0), a3, voffA);
            PG8_WAIT_V(8); PG8_WAIT_L(0); PG8_BAR; PG8_MMA(1, 0, At, B0); PG8_MMA(1, 1, At, B1); PG8_BAR; PG8_SCHED;
            } else {
            PG8_LDB(B0, 0, 0); PG8_SCHED; PG8_LDA(At, 0, 0); PG8_STAGE(PG8_SA(1, 1), a1 + hstepA, voffA);
            PG8_WAIT_L(8); PG8_BAR; PG8_WAIT_L(0); PG8_MMA(0, 0, At, B0); PG8_BAR; PG8_SCHED;
            PG8_LDB(B1, 0, 1); PG8_STAGE(PG8_SB(0, 0), b2, voffB);
            PG8_BAR; PG8_WAIT_L(0); PG8_MMA(0, 1, At, B1); PG8_BAR;
            PG8_LDA(At, 0, 1); PG8_STAGE(PG8_SA(0, 0), a2, voffA);
            PG8_BAR; PG8_WAIT_L(0); PG8_MMA(1, 0, At, B0); PG8_BAR; PG8_SCHED;
            PG8_STAGE(PG8_SB(0, 1), b2 + hstepB, voffB);
            PG8_WAIT_V(6); PG8_BAR; PG8_MMA(1, 1, At, B1); PG8_BAR;
            PG8_LDB(B0, 1, 0); PG8_SCHED; PG8_LDA(At, 1, 0); PG8_STAGE(PG8_SA(0, 1), a2 + hstepA, voffA);
            PG8_WAIT_L(8); PG8_BAR; PG8_WAIT_L(0); PG8_MMA(0, 0, At, B0); PG8_BAR; PG8_SCHED;
            PG8_LDB(B1, 1, 1); PG8_STAGE(PG8_SB(1, 0), b3, voffB);
            PG8_BAR; PG8_WAIT_L(0); PG8_MMA(0, 1, At, B1); PG8_BAR;
            PG8_LDA(At, 1, 1); PG8_STAGE(PG8_SA(1, 0), a3, voffA);
            PG8_BAR; PG8_WAIT_L(0); PG8_MMA(1, 0, At, B0); PG8_BAR; PG8_SCHED;
            PG8_STAGE(PG8_SB(1, 1), b3 + hstepB, voffB);
            PG8_WAIT_V(6); PG8_BAR; PG8_MMA(1, 1, At, B1); PG8_BAR;
            }
        }
        if constexpr (ALIGN_EPI) { if (wr == 0) PG8_BAR; }
        if constexpr (!Epi::AFTER_DRAIN) { E(acc, cur, wr, wc, fr, fq); S.done(cur); }
        if (!has_next) break;
#pragma unroll
        for (int a = 0; a < 2; ++a)
#pragma unroll
            for (int b = 0; b < 2; ++b)
#pragma unroll
                for (int m = 0; m < 4; ++m)
#pragma unroll
                    for (int n = 0; n < 2; ++n) acc[a][b][m][n] = (f32x4){0.f, 0.f, 0.f, 0.f};
        cur = nxt; cA = nA; cB = nB; ++ui;
        if constexpr (ALIGN_EPI) { if (wr == 1) PG8_BAR; }
    }
    PG8_WAIT_V(0);
    if constexpr (!ALIGN_EPI) { if (wr == 0) PG8_BAR; }
    PG8_BAR;
    if constexpr (Epi::AFTER_DRAIN) { E.fused(acc, cur, wr, wc, fr, fq, lds, wid, lane); S.done(cur); }
#undef PG8_SA
#undef PG8_SB
#undef PG8_STAGE
#undef PG8_LDA
#undef PG8_LDB
#undef PG8_MMA
#undef PG8_WAIT_V
#undef PG8_WAIT_L
#undef PG8_BAR
#undef PG8_SCHED
}
}

constexpr int DM = 1024, NBATCH = 2, SEQ = 16384, MTOK = NBATCH * SEQ;
constexpr int FFH = 2816;
constexpr int RH = 4, RDK = 256, RDV = 512, RCH = 512, NCH = SEQ / RCH;
constexpr int RIN = 2 * RH * RDK + 2 * RH * RDV;
constexpr int NG = 4, NR = 4, HD = 64, NCMP = 1023, NSEL = 256, NSAIN = 1072;
constexpr float RMS_EPS = 1e-6f;
constexpr int APLD = 768;

constexpr size_t MiB = 1u << 20;
constexpr size_t WS_CTL = 0, CTL_ZERO_BYTES = 1 * MiB;
constexpr int CW_VMAX = 16384;
constexpr size_t WS_RINV = 1 * MiB;
constexpr size_t WS_BIAST = WS_RINV + 256 * 1024;
constexpr size_t WS_PEB = WS_BIAST + 16 * 1024;
constexpr size_t WS_PEBP = WS_PEB + 4 * 1024;
constexpr size_t WS_GSLOT = 2 * MiB;
constexpr size_t WS_OSLOT = 6 * MiB;
constexpr size_t WS_W = 8 * MiB;
constexpr size_t W_RI = WS_W, W_RO = W_RI + 12 * MiB, W_FI0 = W_RO + 4 * MiB, W_FI1 = W_FI0 + 11 * MiB, W_FO0 = W_FI1 + 11 * MiB, W_FO1 = W_FO0 + 11 * MiB / 2,
                 W_KVQ = W_FO1 + 11 * MiB / 2, W_KVV = W_KVQ + 9 * MiB / 2, W_NO = W_KVV + 1 * MiB, W_C1 = W_NO + 2 * MiB, W_C2 = W_C1 + 2 * MiB, W_END = W_C2 + 1 * MiB;
static_assert(W_END <= 68 * MiB, "weights");
constexpr size_t WS_TABA = 68 * MiB, WS_TABB = 84 * MiB;
constexpr size_t WS_XB = 100 * MiB;
constexpr size_t WS_MIX = 164 * MiB;
constexpr size_t WS_KT = WS_MIX, WS_KV = WS_MIX + 32 * MiB;
constexpr size_t WS_SCR = 228 * MiB;
constexpr size_t WS_AP = WS_SCR, WS_BP = WS_AP + 96 * MiB, WS_KN = WS_BP + 96 * MiB;
static_assert(WS_KN + 32 * MiB <= 512 * MiB, "ret scratch");
constexpr size_t WS_HID = WS_SCR;
constexpr size_t WS_KC = WS_SCR, WS_VC = WS_KC + 16 * MiB, WS_KS = WS_VC + 17 * MiB, WS_KW = WS_KS + 16 * MiB, WS_VST = WS_KW + 16 * MiB, WS_VWT = WS_VST + 16 * MiB,
                 WS_Q = WS_VWT + 16 * MiB, WS_GATE = WS_Q + 64 * MiB, WS_HIDC = WS_GATE + 6 * MiB, WS_KCMP = WS_HIDC + 8 * MiB, WS_VCMPT = WS_KCMP + 1 * MiB, WS_ONSA = WS_VCMPT + 1 * MiB,
                 WS_NSA_END = WS_ONSA + 64 * MiB;
static_assert(WS_NSA_END <= 512 * MiB, "nsa scratch");
constexpr size_t WS_NEED = 512 * MiB;

#define GAS __attribute__((address_space(1)))
#define LAS __attribute__((address_space(3)))
typedef unsigned short bf16;
typedef unsigned v4u __attribute__((ext_vector_type(4)));
typedef unsigned v2u __attribute__((ext_vector_type(2)));
typedef float f32x4 __attribute__((ext_vector_type(4)));
typedef float f32x2_t __attribute__((ext_vector_type(2)));
typedef __bf16 bf16x2_t __attribute__((ext_vector_type(2)));
typedef GAS unsigned gu32;
#define RLX_AGENT __ATOMIC_RELAXED, __HIP_MEMORY_SCOPE_AGENT
__device__ __forceinline__ unsigned cvtpk(float lo, float hi) { f32x2_t v = {lo, hi}; bf16x2_t b = __builtin_convertvector(v, bf16x2_t); return __builtin_bit_cast(unsigned, b); }
__device__ __forceinline__ v4u pack8(f32x4 a, f32x4 b) { v4u w; w.x = cvtpk(a[0], a[1]); w.y = cvtpk(a[2], a[3]); w.z = cvtpk(b[0], b[1]); w.w = cvtpk(b[2], b[3]); return w; }
__device__ __forceinline__ float bflo(unsigned w) { return __uint_as_float(w << 16); }
__device__ __forceinline__ float bfhi(unsigned w) { return __uint_as_float(w & 0xffff0000u); }
__device__ __forceinline__ float bf2f(bf16 b) { return __uint_as_float(((unsigned)b) << 16); }
__device__ __forceinline__ void unpack8(v4u w, float* f) { f[0] = bflo(w.x); f[1] = bfhi(w.x); f[2] = bflo(w.y); f[3] = bfhi(w.y); f[4] = bflo(w.z); f[5] = bfhi(w.z); f[6] = bflo(w.w); f[7] = bfhi(w.w); }
__device__ __forceinline__ bf16 f2bf(float f) { return (bf16)(cvtpk(f, 0.f) & 0xffffu); }
__device__ __forceinline__ int vperm(int t) { return (t & ~12) | ((t & 4) << 1) | ((t & 8) >> 1); }
__device__ __forceinline__ float sigm(float x) { return 1.f / (1.f + __expf(-x)); }
__device__ __forceinline__ float silu(float x) { return x / (1.f + __expf(-x)); }
__device__ __forceinline__ float lg2gamma(int h) { return log2f(1.0f - exp2f(-5.0f - (float)h)); }
__device__ __forceinline__ float wave_sum(float v) {
#pragma unroll
    for (int o = 1; o < 64; o <<= 1) v += __shfl_xor(v, o);
    return v;
}
__device__ __forceinline__ float wave_max(float v) {
#pragma unroll
    for (int o = 1; o < 64; o <<= 1) v = fmaxf(v, __shfl_xor(v, o));
    return v;
}
__device__ __forceinline__ int t5_bucket(int n) {
    if (n < 16) return n;
    if (n >= 113) return 31;
    int b = 16 + (int)(logf((float)n * 0.0625f) / 2.0794415416798357f * 16.0f);
    return b < 31 ? b : 31;
}

#define XB_TMO      128
#define XB_XCNT(j)  (256  + 64 * (j))
#define XB_XSUB(j)  (1280 + 64 * (j))
#define XB_XGEN(j)  (2304 + 64 * (j))
#define XB_TOP      3328
#define XB_TOPGEN   3392
#define XCD_BAR_WORDS 3456
#define XB_SPIN_CAP (1u << 18)
__device__ __forceinline__ unsigned xb_ld(unsigned* p)              { return __hip_atomic_load(p, __ATOMIC_RELAXED, __HIP_MEMORY_SCOPE_AGENT); }
__device__ __forceinline__ unsigned xb_add(unsigned* p, unsigned v) { return __hip_atomic_fetch_add(p, v, __ATOMIC_RELAXED, __HIP_MEMORY_SCOPE_AGENT); }
__device__ __forceinline__ unsigned xb_xcc_id() { return (unsigned)__builtin_amdgcn_s_getreg((3 << 11) | 20) & 0xFu; }
#define XB_SPIN(cond, bar) do { unsigned _sp = 0; while (cond) { __builtin_amdgcn_s_sleep(1); \
    if ((++_sp & 255u) == 0u) { if (xb_ld(&(bar)[XB_TMO])) break; if (_sp > XB_SPIN_CAP) { atomicAdd(&(bar)[XB_TMO], 1u); break; } } } } while (0)
struct XcdBarrier { unsigned* bar; unsigned x; volatile LAS unsigned* st; };
__device__ __forceinline__ XcdBarrier xcd_barrier_post(unsigned* bar, volatile LAS unsigned* st) {
    XcdBarrier b; b.bar = bar; b.x = xb_xcc_id(); b.st = st;
    if (threadIdx.x == 0) { const unsigned rank = xb_add(&bar[XB_XCNT(b.x)], 1u); st[2] = rank; st[3] = b.x; }
    return b;
}
__device__ __forceinline__ void xcd_barrier_complete(unsigned* bar, unsigned x, unsigned& nloc, unsigned& nx) {
    const unsigned G = gridDim.x * gridDim.y * gridDim.z;
    unsigned sum, cnt, mine, sp = 0u;
    for (;;) {
        sum = 0u; cnt = 0u; mine = 0u;
#pragma unroll
        for (unsigned j = 0; j < 16; ++j) { const unsigned c = xb_ld(&bar[XB_XCNT(j)]); sum += c; cnt += (c > 0u) ? 1u : 0u; mine = (j == x) ? c : mine; }
        if (sum == G) break;
        __builtin_amdgcn_s_sleep(1);
        if ((++sp & 255u) == 0u) { if (xb_ld(&bar[XB_TMO])) break; if (sp > XB_SPIN_CAP) { atomicAdd(&bar[XB_TMO], 1u); break; } }
    }
    nloc = mine > 0u ? mine : 1u; nx = cnt > 0u ? cnt : 1u;
}
__device__ __forceinline__ void xcd_barrier(const XcdBarrier& b) {
    asm volatile("s_waitcnt vmcnt(0)" ::: "memory");
    __syncthreads();
    if (threadIdx.x == 0) {
        unsigned* bar = b.bar;
        __builtin_amdgcn_s_waitcnt(0);
        unsigned nloc = b.st[0], nx = b.st[1];
        if (nloc == 0u) { xcd_barrier_complete(bar, b.x, nloc, nx); b.st[0] = nloc; b.st[1] = nx; }
        const unsigned old = xb_add(&bar[XB_XSUB(b.x)], 1u);
        const unsigned gen = old / nloc;
        if (old + 1u == (gen + 1u) * nloc) {
            __builtin_amdgcn_fence(__ATOMIC_RELEASE, "agent");
            asm volatile("s_waitcnt vmcnt(0)" ::: "memory");
            const unsigned og = xb_add(&bar[XB_TOP], 1u);
            const unsigned tg = og / nx;
            if (og + 1u == (tg + 1u) * nx) xb_add(&bar[XB_TOPGEN], 1u);
            else XB_SPIN(xb_ld(&bar[XB_TOPGEN]) == tg, bar);
            __builtin_amdgcn_fence(__ATOMIC_ACQUIRE, "agent");
            xb_add(&bar[XB_XGEN(b.x)], 1u);
            asm volatile("s_waitcnt vmcnt(0)" ::: "memory");
        } else {
            XB_SPIN(xb_ld(&bar[XB_XGEN(b.x)]) == gen, bar);
            __builtin_amdgcn_fence(__ATOMIC_ACQUIRE, "agent");
            asm volatile("s_waitcnt vmcnt(0)" ::: "memory");
        }
    }
    __syncthreads();
}

using pg8::Unit;
typedef const f32x4 (&AccRef)[2][2][4][2];
#define EPI_ROW(u, ai, m) ((u).pm * 256 + (ai) * 128 + wr * 64 + (m) * 16 + fr)
#define EPI_COL(bj) ((bj) * 128 + wc * 32 + 8 * fq)

struct EpiP1N {
    static constexpr bool PERM = true, AFTER_DRAIN = false;
    const float* rinv; const f32x4* tabA; bf16* AP; bf16* KN;
    __device__ __forceinline__ void operator()(AccRef acc, const Unit& u, int wr, int wc, int fr, int fq) const {
        const int h = u.pn & 3; const bool isk = u.pn >= 4; const float lg = lg2gamma(h);
#pragma unroll
        for (int ai = 0; ai < 2; ++ai)
#pragma unroll
            for (int m = 0; m < 4; ++m) {
                const int t = EPI_ROW(u, ai, m); const int p = t & (RCH - 1), c = t / RCH;
                const float rs = rinv[t] * (isk ? 0.0625f * exp2f(-(float)p * lg) : exp2f((float)p * lg));
#pragma unroll
                for (int bj = 0; bj < 2; ++bj) {
                    const int d0 = EPI_COL(bj);
                    const f32x4 c0 = tabA[(size_t)t * 64 + (d0 >> 2)], c1 = tabA[(size_t)t * 64 + (d0 >> 2) + 1];
                    const f32x4 v0 = acc[ai][bj][m][0] * rs, v1 = acc[ai][bj][m][1] * rs;
                    const f32x4 o0 = {v0[0] * c0[0] - v0[1] * c0[1], v0[0] * c0[1] + v0[1] * c0[0], v0[2] * c0[2] - v0[3] * c0[3], v0[2] * c0[3] + v0[3] * c0[2]};
                    const f32x4 o1 = {v1[0] * c1[0] - v1[1] * c1[1], v1[0] * c1[1] + v1[1] * c1[0], v1[2] * c1[2] - v1[3] * c1[3], v1[2] * c1[3] + v1[3] * c1[2]};
                    const v4u w = pack8(o0, o1);
                    if (isk) *(v4u*)(KN + (size_t)t * 1024 + h * 256 + d0) = w;
                    else *(v4u*)(AP + ((size_t)(h * NCH + c) * RCH + p) * APLD + RCH + d0) = w;
                }
            }
    }
};
struct EpiP1S {
    static constexpr bool PERM = true, AFTER_DRAIN = false;
    const float* rinv; const f32x4* tabB; bf16* KT; bf16* BP;
    __device__ __forceinline__ void operator()(AccRef acc, const Unit& u, int wr, int wc, int fr, int fq) const {
        const bool isk = u.pm < 4; const float lg = lg2gamma(u.pm & 3);
#pragma unroll
        for (int bj = 0; bj < 2; ++bj) {
            const int t0 = u.pn * 256 + EPI_COL(bj); const int c = t0 / RCH, p0 = t0 & (RCH - 1);
            const f32x4 r0 = *(const f32x4*)(rinv + t0), r1 = *(const f32x4*)(rinv + t0 + 4);
            f32x4 s0, s1;
#pragma unroll
            for (int j = 0; j < 4; ++j) { s0[j] = r0[j] * 0.0625f * exp2f(-(float)(p0 + j) * lg); s1[j] = r1[j] * 0.0625f * exp2f(-(float)(p0 + 4 + j) * lg); }
#pragma unroll
            for (int ai = 0; ai < 2; ++ai)
#pragma unroll
                for (int m = 0; m < 4; ++m) {
                    const int row = EPI_ROW(u, ai, m);
                    if (isk) {
                        const int d = row & 255, i = d >> 1; const bool odd = d & 1;
                        const f32x4 v0 = acc[ai][bj][m][0] * s0, v1 = acc[ai][bj][m][1] * s1; f32x4 q0, q1;
#pragma unroll
                        for (int j = 0; j < 4; ++j) { q0[j] = __shfl_xor(v0[j], 1); q1[j] = __shfl_xor(v1[j], 1); }
                        const f32x4* tb = tabB + ((size_t)i * SEQ + t0) / 2;
                        const f32x4 ca = tb[0], cb = tb[1], cc = tb[2], cd = tb[3];
                        f32x4 o0, o1;
                        if (odd) { o0 = (f32x4){q0[0] * ca[1] + v0[0] * ca[0], q0[1] * ca[3] + v0[1] * ca[2], q0[2] * cb[1] + v0[2] * cb[0], q0[3] * cb[3] + v0[3] * cb[2]};
                                   o1 = (f32x4){q1[0] * cc[1] + v1[0] * cc[0], q1[1] * cc[3] + v1[1] * cc[2], q1[2] * cd[1] + v1[2] * cd[0], q1[3] * cd[3] + v1[3] * cd[2]}; }
                        else     { o0 = (f32x4){v0[0] * ca[0] - q0[0] * ca[1], v0[1] * ca[2] - q0[1] * ca[3], v0[2] * cb[0] - q0[2] * cb[1], v0[3] * cb[2] - q0[3] * cb[3]};
                                   o1 = (f32x4){v1[0] * cc[0] - q1[0] * cc[1], v1[1] * cc[2] - q1[1] * cc[3], v1[2] * cd[0] - q1[2] * cd[1], v1[3] * cd[2] - q1[3] * cd[3]}; }
                        *(v4u*)(KT + (size_t)row * SEQ + t0) = pack8(o0, o1);
                    } else {
                        const int eg = row - 1024, h = eg >> 9, e = eg & 511;
                        *(v4u*)(BP + ((size_t)(h * NCH + c) * RCH + e) * APLD + p0) = pack8(acc[ai][bj][m][0] * r0, acc[ai][bj][m][1] * r1);
                    }
                }
        }
    }
};
struct EpiG {
    static constexpr bool PERM = true, AFTER_DRAIN = false;
    const float* rinv; const float* gslots; bf16* O;
    __device__ __forceinline__ void operator()(AccRef acc, const Unit& u, int wr, int wc, int fr, int fq) const {
        const int h = u.pn >> 1;
#pragma unroll
        for (int ai = 0; ai < 2; ++ai)
#pragma unroll
            for (int m = 0; m < 4; ++m) {
                const int row = EPI_ROW(u, ai, m); const float rin = rinv[row];
                const f32x4 sa = *(const f32x4*)(gslots + (size_t)row * 32 + h * 8), sb = *(const f32x4*)(gslots + (size_t)row * 32 + h * 8 + 4);
                const float ss = ((sa[0] + sa[1]) + (sa[2] + sa[3])) + ((sb[0] + sb[1]) + (sb[2] + sb[3]));
                const float rs = rsqrtf(ss * (1.0f / RDV) + RMS_EPS);
#pragma unroll
                for (int bj = 0; bj < 2; ++bj) {
                    bf16* op = O + (size_t)row * 2048 + u.pn * 256 + EPI_COL(bj);
                    float o[8]; unpack8(*(const v4u*)op, o);
                    const f32x4 g0 = acc[ai][bj][m][0] * rin, g1 = acc[ai][bj][m][1] * rin; f32x4 a, b;
#pragma unroll
                    for (int j = 0; j < 4; ++j) { a[j] = o[j] * rs * silu(g0[j]); b[j] = o[4 + j] * rs * silu(g1[j]); }
                    *(v4u*)op = pack8(a, b);
                }
            }
    }
};
struct EpiOut {
    static constexpr bool PERM = true, AFTER_DRAIN = false;
    bf16* MIX; float* oslots;
    __device__ __forceinline__ void operator()(AccRef acc, const Unit& u, int wr, int wc, int fr, int fq) const {
#pragma unroll
        for (int ai = 0; ai < 2; ++ai)
#pragma unroll
            for (int m = 0; m < 4; ++m) {
                const int row = EPI_ROW(u, ai, m); float ss = 0.f;
#pragma unroll
                for (int bj = 0; bj < 2; ++bj) {
                    const f32x4 v0 = acc[ai][bj][m][0], v1 = acc[ai][bj][m][1];
                    ss += (v0[0] * v0[0] + v0[1] * v0[1]) + (v0[2] * v0[2] + v0[3] * v0[3]) + (v1[0] * v1[0] + v1[1] * v1[1]) + (v1[2] * v1[2] + v1[3] * v1[3]);
                    *(v4u*)(MIX + (size_t)row * 1024 + u.pn * 256 + EPI_COL(bj)) = pack8(v0, v1);
                }
                ss += __shfl_xor(ss, 16); ss += __shfl_xor(ss, 32);
                if (fq == 0) oslots[(size_t)row * 16 + u.pn * 4 + wc] = ss;
            }
    }
};
struct EpiFfnIn {
    static constexpr bool PERM = true, AFTER_DRAIN = false;
    const float* rinv; bf16* HID;
    __device__ __forceinline__ void operator()(AccRef acc, const Unit& u, int wr, int wc, int fr, int fq) const {
#pragma unroll
        for (int ai = 0; ai < 2; ++ai)
#pragma unroll
            for (int m = 0; m < 4; ++m) {
                const int row = EPI_ROW(u, ai, m); const float rin = rinv[row];
                const f32x4 a0 = acc[ai][0][m][0] * rin, a1 = acc[ai][0][m][1] * rin, b0 = acc[ai][1][m][0] * rin, b1 = acc[ai][1][m][1] * rin; f32x4 x, y;
#pragma unroll
                for (int j = 0; j < 4; ++j) { x[j] = silu(a0[j]) * b0[j]; y[j] = silu(a1[j]) * b1[j]; }
                *(v4u*)(HID + (size_t)row * FFH + u.pn * 128 + wc * 32 + 8 * fq) = pack8(x, y);
            }
    }
};
struct EpiKvqN {
    static constexpr bool PERM = true, AFTER_DRAIN = false;
    const float* rinv; bf16 *KC, *VC, *KS, *KW, *Q; float* GATE;
    __device__ __forceinline__ void operator()(AccRef acc, const Unit& u, int wr, int wc, int fr, int fq) const {
        bf16* plane = u.pn == 0 ? KC : u.pn == 1 ? VC : u.pn == 2 ? KS : KW;
#pragma unroll
        for (int ai = 0; ai < 2; ++ai)
#pragma unroll
            for (int m = 0; m < 4; ++m) {
                const int row = EPI_ROW(u, ai, m); const float rin = rinv[row]; const int b = row / SEQ, t = row % SEQ;
#pragma unroll
                for (int bj = 0; bj < 2; ++bj) {
                    const int cc = EPI_COL(bj);
                    f32x4 v0 = acc[ai][bj][m][0] * rin, v1 = acc[ai][bj][m][1] * rin;
                    if (u.pn < 4) { const int g = cc >> 6, d = cc & 63;
                        const int o = u.pn == 2 ? (t & ~63) * HD + ((((t >> 5) & 1) * 4 + (d >> 4)) * 64 + ((d >> 3) & 1) * 32 + (t & 31)) * 8 : t * HD + d;
                        *(v4u*)(plane + (size_t)(b * NG + g) * SEQ * HD + o) = pack8(v0, v1); }
                    else { *(v4u*)(Q + (size_t)row * 1024 + (u.pn - 4) * 256 + cc) = pack8(v0 * (0.125f * 1.4426950408889634f), v1 * (0.125f * 1.4426950408889634f)); }
                }
            }
    }
};
struct EpiGate {
    static constexpr bool PERM = true, AFTER_DRAIN = false;
    const float* rinv; float* GATE;
    __device__ __forceinline__ void operator()(AccRef acc, const Unit& u, int wr, int wc, int fr, int fq) const {
#pragma unroll
        for (int ai = 0; ai < 2; ++ai)
#pragma unroll
            for (int m = 0; m < 4; ++m) {
                const int row = EPI_ROW(u, ai, m); const float rin = rinv[row]; const int cc = EPI_COL(0);
                if (cc < 48) { f32x4 v0 = acc[ai][0][m][0] * rin, v1 = acc[ai][0][m][1] * rin;
#pragma unroll
                    for (int j = 0; j < 4; ++j) { v0[j] = sigm(v0[j]); v1[j] = sigm(v1[j]); }
                    *(f32x4*)(GATE + (size_t)row * 48 + cc) = v0; *(f32x4*)(GATE + (size_t)row * 48 + cc + 4) = v1; }
            }
    }
};
struct EpiKvqS {
    static constexpr bool PERM = true, AFTER_DRAIN = false;
    const float* rinv; bf16 *VST, *VWT; unsigned* vmx;
    __device__ __forceinline__ void operator()(AccRef acc, const Unit& u, int wr, int wc, int fr, int fq) const {
        bf16* plane = u.pm == 0 ? VST : VWT;
        float vm[2] = {0.f, 0.f};
#pragma unroll
        for (int bj = 0; bj < 2; ++bj) {
            const int mg = u.pn * 256 + EPI_COL(bj); const int b = mg / SEQ, t = mg % SEQ;
            const f32x4 r0 = *(const f32x4*)(rinv + mg), r1 = *(const f32x4*)(rinv + mg + 4);
#pragma unroll
            for (int ai = 0; ai < 2; ++ai)
#pragma unroll
                for (int m = 0; m < 4; ++m) {
                    const int r256 = ai * 128 + wr * 64 + m * 16 + fr; const int g = r256 >> 6, d = r256 & 63;
                    const f32x4 w0 = acc[ai][bj][m][0] * r0, w1 = acc[ai][bj][m][1] * r1;
                    const v4u pk = pack8(w0, w1);
                    v2u lo; lo.x = pk.x; lo.y = pk.y; v2u hi; hi.x = pk.z; hi.y = pk.w;
                    if (u.pm == 0) {
                        vm[ai] = fmaxf(vm[ai], fmaxf(fmaxf(fmaxf(fabsf(w0[0]), fabsf(w0[1])), fmaxf(fabsf(w0[2]), fabsf(w0[3]))), fmaxf(fmaxf(fabsf(w1[0]), fabsf(w1[1])), fmaxf(fabsf(w1[2]), fabsf(w1[3])))));
                        bf16* fp = plane + (size_t)(b * NG + g) * HD * SEQ + (size_t)(t >> 6) * 4096 + ((((t >> 4) & 3) * 2 + (d >> 5)) * 64 + (d & 31)) * 8 + 4 * ((t >> 3) & 1);
                        *(v2u*)fp = lo; *(v2u*)(fp + 256) = hi;
                    } else { bf16* rowp = plane + ((size_t)((b * NG + g) * HD + d)) * SEQ; *(v2u*)(rowp + vperm(t)) = lo; *(v2u*)(rowp + vperm(t + 4)) = hi; }
                }
        }
        if (u.pm == 0) {
#pragma unroll
            for (int ai = 0; ai < 2; ++ai) { const float mx = wave_max(vm[ai]);
                if ((fr | fq) == 0) __hip_atomic_fetch_max(vmx + ((u.pn * 256) / SEQ) * NG + 2 * ai + wr, __float_as_uint(mx), __ATOMIC_RELAXED, __HIP_MEMORY_SCOPE_AGENT); }
        }
    }
};
struct EpiCmp {
    static constexpr bool PERM = true, AFTER_DRAIN = false;
    const float* peb; bf16* HIDC;
    __device__ __forceinline__ void operator()(AccRef acc, const Unit& u, int wr, int wc, int fr, int fq) const {
        const int kv = u.pm >= 32 ? 1 : 0;
#pragma unroll
        for (int bj = 0; bj < 2; ++bj) {
            const int col = EPI_COL(bj);
            const f32x4 b0 = *(const f32x4*)(peb + kv * 256 + col), b1 = *(const f32x4*)(peb + kv * 256 + col + 4);
#pragma unroll
            for (int ai = 0; ai < 2; ++ai)
#pragma unroll
                for (int m = 0; m < 4; ++m) {
                    const int row = EPI_ROW(u, ai, m); f32x4 x = acc[ai][bj][m][0] + b0, y = acc[ai][bj][m][1] + b1;
#pragma unroll
                    for (int j = 0; j < 4; ++j) { x[j] = silu(x[j]); y[j] = silu(y[j]); }
                    *(v4u*)(HIDC + (size_t)row * 256 + col) = pack8(x, y);
                }
        }
    }
};
struct MapCmp { __device__ __forceinline__ void operator()(Unit& u) const { u.offA = (size_t)u.pm * 256 * 1024 * 2; u.offB = (size_t)(u.pm >= 32 ? 256 : 0) * 2048 * 2; } };

struct MapKV { __device__ __forceinline__ void operator()(Unit& u) const { const int hc = u.pm >> 1, eh = u.pm & 1, h = hc / NCH, c = hc % NCH;
    u.offA = ((size_t)(hc * RCH + eh * 256) * APLD) * 2; u.offB = ((size_t)(h * RDK) * SEQ + (size_t)c * RCH) * 2; } };
struct EpiKV {
    static constexpr bool PERM = true, AFTER_DRAIN = false;
    bf16* KV;
    __device__ __forceinline__ void operator()(AccRef acc, const Unit& u, int wr, int wc, int fr, int fq) const {
#pragma unroll
        for (int ai = 0; ai < 2; ++ai)
#pragma unroll
            for (int m = 0; m < 4; ++m) { const int row = EPI_ROW(u, ai, m);
#pragma unroll
                for (int bj = 0; bj < 2; ++bj) *(v4u*)(KV + (size_t)row * RDK + EPI_COL(bj)) = pack8(acc[ai][bj][m][0], acc[ai][bj][m][1]); }
    }
};
struct MapS { __device__ __forceinline__ void operator()(Unit& u) const { const int hc = u.pm >> 1, qh = u.pm & 1, h = hc / NCH, c = hc % NCH;
    u.offA = ((size_t)(hc * RCH + qh * 256) * APLD + RCH) * 2; u.offB = ((size_t)(c * RCH + u.pn * 256) * 1024 + h * RDK) * 2; } };
struct EpiS {
    static constexpr bool PERM = true, AFTER_DRAIN = false;
    bf16* AP;
    __device__ __forceinline__ void operator()(AccRef acc, const Unit& u, int wr, int wc, int fr, int fq) const {
        const int qh = u.pm & 1;
#pragma unroll
        for (int ai = 0; ai < 2; ++ai)
#pragma unroll
            for (int m = 0; m < 4; ++m) { const int row = EPI_ROW(u, ai, m); const int qi = qh * 256 + ai * 128 + wr * 64 + m * 16 + fr;
#pragma unroll
                for (int bj = 0; bj < 2; ++bj) { const int k0 = u.pn * 256 + EPI_COL(bj); f32x4 v0 = acc[ai][bj][m][0], v1 = acc[ai][bj][m][1];
#pragma unroll
                    for (int j = 0; j < 4; ++j) { if (k0 + j > qi) v0[j] = 0.f; if (k0 + 4 + j > qi) v1[j] = 0.f; }
                    *(v4u*)(AP + (size_t)row * APLD + k0) = pack8(v0, v1); } }
    }
};
struct MapO { __device__ __forceinline__ void operator()(Unit& u) const { const int hc = u.pm >> 1, qh = u.pm & 1;
    u.offA = ((size_t)(hc * RCH + qh * 256) * APLD) * 2; u.offB = ((size_t)(hc * RCH + u.pn * 256) * APLD) * 2; } };
struct EpiO {
    static constexpr bool PERM = true, AFTER_DRAIN = false;
    bf16* O; float* gslots; int b;
    __device__ __forceinline__ void operator()(AccRef acc, const Unit& u, int wr, int wc, int fr, int fq) const {
        const int hc = u.pm >> 1, qh = u.pm & 1, h = hc / NCH, c = hc % NCH;
#pragma unroll
        for (int ai = 0; ai < 2; ++ai)
#pragma unroll
            for (int m = 0; m < 4; ++m) { const size_t row = (size_t)b * SEQ + c * RCH + qh * 256 + ai * 128 + wr * 64 + m * 16 + fr; float ss = 0.f;
#pragma unroll
                for (int bj = 0; bj < 2; ++bj) { const f32x4 v0 = acc[ai][bj][m][0], v1 = acc[ai][bj][m][1];
                    ss += (v0[0] * v0[0] + v0[1] * v0[1]) + (v0[2] * v0[2] + v0[3] * v0[3]) + (v1[0] * v1[0] + v1[1] * v1[1]) + (v1[2] * v1[2] + v1[3] * v1[3]);
                    *(v4u*)(O + row * 2048 + h * RDV + u.pn * 256 + EPI_COL(bj)) = pack8(v0, v1); }
                ss += __shfl_xor(ss, 16); ss += __shfl_xor(ss, 32);
                if (fq == 0) gslots[row * 32 + h * 8 + u.pn * 4 + wc] = ss; }
    }
};

constexpr int NWAVES = 8, NTHREADS = NWAVES * 64;
constexpr int RING_OFF = 0, RING_BYTES = 131072;
constexpr int LDS_BYTES = 163840;
constexpr int LDSCTL_OFF = LDS_BYTES - 1024, MISC_OFF = LDSCTL_OFF + 320;
constexpr int CW_BAR = 4096;

struct Args { const float* in[20]; float* out; unsigned char* ws; int ph, b; };
struct Frame {
    LAS unsigned char* lds; unsigned char* ws; float* out; const float* const* in;
    int tid, lane, wave, G, vcu, gw, NGW;
};

template <class T> __device__ __forceinline__ T* gp(T* p) { return (T*)(GAS T*)p; }
struct TDesc { const float* W; const float* gain; bf16* WT; int K, ldw, ncols, nblk, mode, off, start, pad; };
__device__ __forceinline__ int dest_row(int mode, int off, int n) {
    if (mode == 1) { const int up = n >= FFH, j = up ? n - FFH : n; return (j >> 7) * 256 + up * 128 + (j & 127); }
    if (mode == 2) { const int s = n >> 8, d = n & 255; return s < 3 ? n : s == 3 ? 2304 + d : s == 4 ? 768 + d : 2304 + 256 + d; }
    return n + off;
}
__device__ __forceinline__ void transpose_item(const LAS TDesc& D, LAS float* scr, int it, int lane) {
    const float* W = D.W; const float* gain = D.gain; const int K = D.K, ldw = D.ldw, ncols = D.ncols, nblk = D.nblk;
    const int k0 = 64 * (it / nblk), n0 = 32 * (it % nblk);
    const int q = lane & 7, kr = lane >> 3;
#pragma unroll
    for (int i = 0; i < 8; ++i) { const int kk = 8 * i + kr, n = n0 + 4 * q;
        f32x4 v = {0.f, 0.f, 0.f, 0.f}; if (n < ncols) v = *(const f32x4*)(W + (size_t)(k0 + kk) * ldw + n);
        if (gain) v *= gain[k0 + kk];
        LAS float* s = scr + kk * 33 + 4 * q; s[0] = v[0]; s[1] = v[1]; s[2] = v[2]; s[3] = v[3]; }
    asm volatile("s_waitcnt lgkmcnt(0)" ::: "memory");
    const int c = lane & 7;
#pragma unroll
    for (int j = 0; j < 4; ++j) { const int n = (lane >> 3) + 8 * j; const LAS float* s = scr + (8 * c) * 33 + n;
        v4u o; o.x = cvtpk(s[0 * 33], s[1 * 33]); o.y = cvtpk(s[2 * 33], s[3 * 33]); o.z = cvtpk(s[4 * 33], s[5 * 33]); o.w = cvtpk(s[6 * 33], s[7 * 33]);
        *(v4u*)(D.WT + (size_t)dest_row(D.mode, D.off, n0 + n) * K + k0 + 8 * c) = o; }
    asm volatile("s_waitcnt lgkmcnt(0)" ::: "memory");
}

__device__ __forceinline__ void row_to_bf16(const float* xrow, bf16* orow, float* rinv, int lane) {
    const f32x4* xr = (const f32x4*)xrow + lane; f32x4 v[4]; float s = 0.f;
#pragma unroll
    for (int j = 0; j < 4; ++j) { v[j] = xr[64 * j]; s += (v[j][0] * v[j][0] + v[j][1] * v[j][1]) + (v[j][2] * v[j][2] + v[j][3] * v[j][3]); }
    s = wave_sum(s);
    v2u* o8 = (v2u*)orow + lane;
#pragma unroll
    for (int j = 0; j < 4; ++j) { v2u w; w.x = cvtpk(v[j][0], v[j][1]); w.y = cvtpk(v[j][2], v[j][3]); o8[64 * j] = w; }
    if (lane == 0) *rinv = rsqrtf(s * (1.0f / DM) + RMS_EPS);
}

constexpr int NTD = 13;
__device__ __forceinline__ void phase_prologue(const Frame& F) {
    unsigned char* ws = F.ws; const float* in[20];
#pragma unroll
    for (int i = 0; i < 20; ++i) in[i] = gp(F.in[i]);
    LAS TDesc* TD = (LAS TDesc*)(F.lds + RING_OFF + 8 * 16384);
    if (F.tid == 0) {
        int st = 0;
#define TDSET(k, W_, K_, ldw_, nc_, ncp_, gain_, WT_, mode_, off_) do { TD[k].W = (W_); TD[k].gain = (gain_); TD[k].WT = (bf16*)(WT_); TD[k].K = (K_); TD[k].ldw = (ldw_); TD[k].ncols = (nc_); \
            TD[k].nblk = (ncp_) / 32; TD[k].mode = (mode_); TD[k].off = (off_); TD[k].start = st; st += ((K_) / 64) * ((ncp_) / 32); } while (0)
        TDSET(0, in[7], DM, RIN, RIN, RIN, in[1], ws + W_RI, 0, 0);
        TDSET(1, in[8], 2048, DM, DM, DM, (const float*)nullptr, ws + W_RO, 0, 0);
        TDSET(2, in[5], DM, 2 * FFH, 2 * FFH, 2 * FFH, in[3], ws + W_FI0, 1, 0);
        TDSET(3, in[5] + (size_t)DM * 2 * FFH, DM, 2 * FFH, 2 * FFH, 2 * FFH, in[3] + DM, ws + W_FI1, 1, 0);
        TDSET(4, in[6], FFH, DM, DM, DM, (const float*)nullptr, ws + W_FO0, 0, 0);
        TDSET(5, in[6] + (size_t)FFH * DM, FFH, DM, DM, DM, (const float*)nullptr, ws + W_FO1, 0, 0);
        TDSET(6, in[10], DM, 1536, 1536, 1536, in[9], ws + W_KVQ, 2, 0);
        TDSET(7, in[17], DM, NSAIN, NSAIN, 1280, in[1] + DM, ws + W_KVQ, 0, 1024);
        TDSET(8, in[18], DM, DM, DM, DM, (const float*)nullptr, ws + W_NO, 0, 0);
        TDSET(9, in[12], 2048, 256, 256, 256, (const float*)nullptr, ws + W_C1, 0, 0);
        TDSET(10, in[15], 2048, 256, 256, 256, (const float*)nullptr, ws + W_C1, 0, 256);
        TDSET(11, in[13], 256, 64, 64, 64, (const float*)nullptr, ws + W_C2, 0, 0);
        TDSET(12, in[16], 256, 64, 64, 64, (const float*)nullptr, ws + W_C2, 0, 64);
#undef TDSET
        TD[NTD].start = st;
    }
    __syncthreads();
    const int NT = TD[NTD].start, NJ = NT + MTOK + SEQ * 128 / 64;
    LAS float* scr = (LAS float*)(F.lds + RING_OFF + F.wave * 16384);
    f32x2_t* tabA = (f32x2_t*)(ws + WS_TABA); f32x2_t* tabB = (f32x2_t*)(ws + WS_TABB);
    for (int jb = F.gw; jb < NJ; jb += F.NGW) {
        const int it = (int)(((long long)jb * 7919) % NJ);
        if (it < NT) {
            int k = 0;
#pragma unroll
            for (int q = 1; q < NTD; ++q) k = it >= TD[q].start ? q : k;
            transpose_item(TD[k], scr, it - TD[k].start, F.lane);
        } else if (it < NT + MTOK) {
            const int m = it - NT; row_to_bf16(in[0] + (size_t)m * DM, (bf16*)(ws + WS_XB) + (size_t)m * DM, (float*)(ws + WS_RINV) + m, F.lane);
        } else {
            const int idx = (it - NT - MTOK) * 64 + F.lane, t = idx >> 7, i = idx & 127;
            const float theta = 1.0f / powf(10000.0f, (float)i * (1.0f / 127.0f));
            const float ang = (float)t * theta; float s, c; sincosf(ang, &s, &c);
            const f32x2_t v = {c, s}; tabA[idx] = v; tabB[(size_t)i * SEQ + t] = v;
        }
    }
    if (blockIdx.x == 0) for (int i = F.tid; i < 128 * 16; i += NTHREADS) ((float*)(ws + WS_BIAST))[i] = in[19][t5_bucket(i >> 4) * 16 + (i & 15)];
    if (blockIdx.x < 32) {
        const int kv = F.tid >> 8, c = F.tid & 255; const float* pe = kv ? in[14] : in[11]; const float* w1 = kv ? in[15] : in[12]; float s = 0.f;
        for (int k = 64 * blockIdx.x; k < 64 * blockIdx.x + 64; ++k) s += pe[k] * w1[(size_t)k * 256 + c];
        ((float*)(ws + WS_PEBP))[blockIdx.x * 512 + F.tid] = s;
    }
}
__device__ __forceinline__ void phase_peb_final(const Frame& F) {
    if (blockIdx.x == 0) { float s = 0.f; for (int w = 0; w < 32; ++w) s += ((const float*)(F.ws + WS_PEBP))[w * 512 + F.tid]; ((float*)(F.ws + WS_PEB))[F.tid] = s; }
}

__device__ __forceinline__ void phase_resid(const Frame& F, const float* hold_f32, const float* gpost, bool last) {
    const bf16* MIX = (const bf16*)(F.ws + WS_MIX); const float* oslots = (const float*)(F.ws + WS_OSLOT);
    bf16* XB = (bf16*)(F.ws + WS_XB); float* rinv = (float*)(F.ws + WS_RINV);
    f32x4 gp[4];
#pragma unroll
    for (int j = 0; j < 4; ++j) gp[j] = ((const f32x4*)gpost)[F.lane + 64 * j];
    for (int m0 = F.gw; m0 < MTOK; m0 += 2 * F.NGW) {
        f32x4 hn[2][4]; float sq[2]; float rs[2];
#pragma unroll
        for (int r = 0; r < 2; ++r) { const int m = m0 + r * F.NGW < MTOK ? m0 + r * F.NGW : m0;
            const f32x4* sl = (const f32x4*)(oslots + (size_t)m * 16); const f32x4 s0 = sl[0], s1 = sl[1], s2 = sl[2], s3 = sl[3];
            const float ss = (((s0[0] + s0[1]) + (s0[2] + s0[3])) + ((s1[0] + s1[1]) + (s1[2] + s1[3]))) + (((s2[0] + s2[1]) + (s2[2] + s2[3])) + ((s3[0] + s3[1]) + (s3[2] + s3[3])));
            rs[r] = rsqrtf(ss * (1.0f / DM) + RMS_EPS);
            const v2u* mr = (const v2u*)(MIX + (size_t)m * DM) + F.lane; const v2u* xr = (const v2u*)(XB + (size_t)m * DM) + F.lane;
            sq[r] = 0.f;
#pragma unroll
            for (int j = 0; j < 4; ++j) { f32x4 hv;
                if (hold_f32) hv = ((const f32x4*)(hold_f32 + (size_t)m * DM) + F.lane)[64 * j];
                else { const v2u hw = xr[64 * j]; hv = (f32x4){bflo(hw.x), bfhi(hw.x), bflo(hw.y), bfhi(hw.y)}; }
                const v2u mw = mr[64 * j]; const f32x4 mx = {bflo(mw.x), bfhi(mw.x), bflo(mw.y), bfhi(mw.y)};
                hn[r][j] = hv + mx * rs[r] * gp[j]; sq[r] += (hn[r][j][0] * hn[r][j][0] + hn[r][j][1] * hn[r][j][1]) + (hn[r][j][2] * hn[r][j][2] + hn[r][j][3] * hn[r][j][3]); } }
#pragma unroll
        for (int r = 0; r < 2; ++r) { const int m = m0 + r * F.NGW; if (m >= MTOK) break;
            if (last) { f32x4* ho = (f32x4*)(F.out + (size_t)m * DM) + F.lane;
#pragma unroll
                for (int j = 0; j < 4; ++j) ho[64 * j] = hn[r][j];
            } else {
                const float s = wave_sum(sq[r]); v2u* xw = (v2u*)(XB + (size_t)m * DM) + F.lane;
#pragma unroll
                for (int j = 0; j < 4; ++j) { v2u w; w.x = cvtpk(hn[r][j][0], hn[r][j][1]); w.y = cvtpk(hn[r][j][2], hn[r][j][3]); xw[64 * j] = w; }
                if (F.lane == 0) rinv[m] = rsqrtf(s * (1.0f / DM) + RMS_EPS);
            } }
    }
}

__device__ __forceinline__ void phase_cmp2(const Frame& F) {
    typedef short s8_t __attribute__((ext_vector_type(8))); typedef float f16_t __attribute__((ext_vector_type(16)));
    const bf16* HIDC = (const bf16*)(F.ws + WS_HIDC); bf16* KCMP = (bf16*)(F.ws + WS_KCMP); bf16* VCT = (bf16*)(F.ws + WS_VCMPT); const bf16* W2T = (const bf16*)(F.ws + W_C2);
    const int r32 = F.lane & 31, h = F.lane >> 5;
    for (int task = F.gw; task < 1024; task += F.NGW) {
        const int R0 = (task >> 1) * 32, ch = task & 1, kv = R0 >> 13, pl = (R0 >> 10) & 7, n0 = R0 & 1023;
        const GAS s8_t* xp = (const GAS s8_t*)(GAS bf16*)(HIDC + (size_t)(R0 + r32) * 256 + 8 * h);
        const GAS s8_t* wp = (const GAS s8_t*)(GAS bf16*)(W2T + (size_t)(kv * 64 + ch * 32 + r32) * 256 + 8 * h);
        s8_t x[16], wv[16];
#pragma unroll
        for (int s = 0; s < 16; ++s) { x[s] = xp[2 * s]; wv[s] = wp[2 * s]; }
        f16_t acc;
#pragma unroll
        for (int r = 0; r < 16; ++r) acc[r] = 0.f;
        if (kv == 0) {
#pragma unroll
            for (int s = 0; s < 16; ++s) acc = __builtin_amdgcn_mfma_f32_32x32x16_bf16(wv[s], x[s], acc, 0, 0, 0);
            const int n = n0 + r32; const float z = n == NCMP ? 0.f : 1.f;
#pragma unroll
            for (int a = 0; a < 4; ++a) { v2u pk; pk.x = cvtpk(acc[4 * a] * z, acc[4 * a + 1] * z); pk.y = cvtpk(acc[4 * a + 2] * z, acc[4 * a + 3] * z);
                *(v2u*)(KCMP + ((size_t)pl * 1024 + n) * 64 + ch * 32 + 8 * a + 4 * h) = pk; }
        } else {
#pragma unroll
            for (int s = 0; s < 16; ++s) acc = __builtin_amdgcn_mfma_f32_32x32x16_bf16(x[s], wv[s], acc, 0, 0, 0);
            if (n0 == 992 && h == 1) acc[15] = 0.f;
            const int d = ch * 32 + r32;
#pragma unroll
            for (int a = 0; a < 4; ++a) { v2u pk; pk.x = cvtpk(acc[4 * a], acc[4 * a + 1]); pk.y = cvtpk(acc[4 * a + 2], acc[4 * a + 3]);
                *(v2u*)(VCT + ((size_t)pl * 64 + d) * 1024 + vperm(n0 + 8 * a + 4 * h)) = pk; }
        }
    }
}

__device__ __forceinline__ void phase_ret_scan(const Frame& F) {
    const bf16* KV = (const bf16*)(F.ws + WS_KV); bf16* BP = (bf16*)(F.ws + WS_BP);
    for (int it = F.vcu * NTHREADS + F.tid; it < RH * RDV * (RDK / 8); it += F.G * NTHREADS) {
        const int d8 = it & 31, e = (it >> 5) & 511, h = it >> 14;
        const float cdec = exp2f((float)RCH * lg2gamma(h));
        float carry[8];
#pragma unroll
        for (int i = 0; i < 8; ++i) carry[i] = 0.f;
#pragma unroll 4
        for (int c = 0; c < NCH; ++c) {
            const size_t r = (size_t)(h * NCH + c) * RCH + e;
            float kv[8]; unpack8(*(const v4u*)(KV + r * RDK + d8 * 8), kv);
            v4u w; w.x = cvtpk(carry[0], carry[1]); w.y = cvtpk(carry[2], carry[3]); w.z = cvtpk(carry[4], carry[5]); w.w = cvtpk(carry[6], carry[7]);
            *(v4u*)(BP + r * APLD + RCH + d8 * 8) = w;
#pragma unroll
            for (int i = 0; i < 8; ++i) carry[i] = cdec * (carry[i] + kv[i]);
        }
    }
}

namespace nsa {
typedef float f32x16 __attribute__((ext_vector_type(16)));
typedef short s16x8 __attribute__((ext_vector_type(8)));
constexpr int KP = 64, SLOTB = 8192, GC = 2, GS = 4;
constexpr float LOG2E = 1.4426950408889634f, NEGB = -1.0e30f;
constexpr int L_IMP = 4 * GC * SLOTB, IMP_P = 260, L_SELM = L_IMP + 64 * IMP_P * 4, L_BT = L_SELM + 2048, L_UNI = L_BT + 2048, L_LIST = L_UNI + 64, L_END = L_LIST + 1024 + 16;
static_assert(L_END <= LDSCTL_OFF, "nsa lds");
constexpr int NB_P = 264, L_NB = 137344;
static_assert(L_NB >= L_END && L_NB % 16 == 0 && L_NB + 16 * NB_P * 4 <= LDSCTL_OFF, "bias table");
constexpr float IMP_SC = 67108864.f;
constexpr int L_SQ = 0, L_SM = 32768, L_SL = L_SM + 1024, L_TL = L_SL + 1024, TL_CAP = 320, L_TC = L_TL + TL_CAP * 4, L_TOK = L_TC + 64, L_SEND = L_TOK + TL_CAP * 32, SO_P = 66, L_SO = 64000;
static_assert(L_SEND <= L_SO && L_TOK % 32 == 0 && L_SO + 256 * SO_P * 4 <= L_SELM && L_SO % 16 == 0 && (256 * SO_P * 4) % 16 == 0, "sel lds");
__device__ __forceinline__ constexpr int krow(int r) { return (r & 3) + 8 * (r >> 2); }

__device__ __forceinline__ void tile_issue(LAS unsigned char* L, int koff, int voff, const bf16* Kg, const bf16* Vg, int ldv, int w, int lane) {
    asm volatile("" : "+v"(lane));
    const int row = 8 * w + (lane >> 3), c = (lane & 7) ^ ((row ^ (row >> 3)) & 7);
    __builtin_amdgcn_global_load_lds((const unsigned*)(Kg + (size_t)row * 64 + c * 8), (LAS unsigned*)(L + koff + w * 1024), 16, 0, 0);
    __builtin_amdgcn_global_load_lds((const unsigned*)(Vg + (size_t)row * ldv + c * 8), (LAS unsigned*)(L + voff + w * 1024), 16, 0, 0);
}
__device__ __forceinline__ void ktile_issue(LAS unsigned char* L, int koff, const bf16* Kg, int w, int lane) {
    asm volatile("" : "+v"(lane));
    const int row = 8 * w + (lane >> 3), c = (lane & 7) ^ ((row ^ (row >> 3)) & 7);
    __builtin_amdgcn_global_load_lds((const unsigned*)(Kg + (size_t)row * 64 + c * 8), (LAS unsigned*)(L + koff + w * 1024), 16, 0, 0);
}
struct KVFrag { s16x8 k[4], v[2][2]; };
__device__ __forceinline__ void frag_load(KVFrag& f, const LAS bf16* Kl, const LAS bf16* Vl, int kt, int r32, int h) {
    const int kr = 32 * kt + r32;
#pragma unroll
    for (int s = 0; s < 4; ++s) f.k[s] = *(const LAS s16x8*)(Kl + kr * KP + 8 * ((2 * s + h) ^ ((kr ^ (kr >> 3)) & 7)));
#pragma unroll
    for (int s2 = 0; s2 < 2; ++s2)
#pragma unroll
        for (int dt = 0; dt < 2; ++dt) { const int d = 32 * dt + r32; f.v[s2][dt] = *(const LAS s16x8*)(Vl + d * KP + 8 * ((4 * kt + 2 * s2 + h) ^ ((d ^ (d >> 3)) & 7))); }
    __builtin_amdgcn_sched_barrier(0);
}
__device__ __forceinline__ f32x16 qk_tile(const KVFrag& f, const s16x8 (&qf)[4], float cinit) {
    f32x16 p;
#pragma unroll
    for (int r = 0; r < 16; ++r) p[r] = cinit;
#pragma unroll
    for (int s = 0; s < 4; ++s) p = __builtin_amdgcn_mfma_f32_32x32x16_bf16(f.k[s], qf[s], p, 0, 0, 0);
    return p;
}
__device__ __forceinline__ void pv_tile(f32x16 (&o)[2], const KVFrag& f, const f32x16& p) {
#pragma unroll
    for (int s2 = 0; s2 < 2; ++s2) {
        v4u pw; pw.x = cvtpk(p[8 * s2 + 0], p[8 * s2 + 1]); pw.y = cvtpk(p[8 * s2 + 2], p[8 * s2 + 3]); pw.z = cvtpk(p[8 * s2 + 4], p[8 * s2 + 5]); pw.w = cvtpk(p[8 * s2 + 6], p[8 * s2 + 7]);
        const s16x8 pb = __builtin_bit_cast(s16x8, pw);
#pragma unroll
        for (int dt = 0; dt < 2; ++dt) {
            o[dt] = __builtin_amdgcn_mfma_f32_32x32x16_bf16(f.v[s2][dt], pb, o[dt], 0, 0, 0);
        }
    }
}
__device__ __forceinline__ float xhalf_max(float v) { auto rr = __builtin_amdgcn_permlane32_swap(__float_as_uint(v), __float_as_uint(v), false, false); return fmaxf(__uint_as_float(rr[0]), __uint_as_float(rr[1])); }
template <int MODE> __device__ __forceinline__ unsigned post_tile(f32x16& p, int kbase, int t, int lim, bool colok, const LAS float* bT) {
    unsigned vm = 0u;
#pragma unroll
    for (int r = 0; r < 16; ++r) {
        const int key = kbase + krow(r);
        const int dist = MODE == 0 ? t - 31 - 16 * key : t - key;
        const bool ok = colok && dist >= 0 && (MODE == 0 ? key < NCMP : dist < lim);
        const int di = dist < 0 ? 0 : (dist > 127 ? 127 : dist);
        p[r] = p[r] + bT[di * 4];
        vm |= ok ? (1u << r) : 0u;
    }
    return vm;
}
__device__ __forceinline__ void bias_tile(f32x16& p, const LAS float* NB, int kb, int t, int hd) {
    const int idx = 191 - t + kb, c = idx & 3;
    const LAS f32x4* b = (const LAS f32x4*)(NB + (c * 4 + hd) * NB_P + (idx - c));
#pragma unroll
    for (int a = 0; a < 4; ++a) { const f32x4 v = b[2 * a]; p[4 * a] += v[0]; p[4 * a + 1] += v[1]; p[4 * a + 2] += v[2]; p[4 * a + 3] += v[3]; }
}
__device__ __forceinline__ void cmp_bias(f32x16& p, int d0, const LAS float* bT) {
#pragma unroll
    for (int r = 0; r < 16; ++r) {
        const int dist = d0 - 16 * krow(r), di = dist < 0 ? 0 : (dist > 127 ? 127 : dist);
        const float b = bT[di * 4];
        p[r] = dist < 0 ? NEGB : p[r] + b;
    }
}
__device__ __forceinline__ void softmax_update(f32x16& p, unsigned vm, float& m, float& l, f32x16 (&o)[2], bool has_o) {
    float mx = NEGB;
#pragma unroll
    for (int r = 0; r < 16; ++r) if ((vm >> r) & 1u) mx = fmaxf(mx, p[r]);
    mx = xhalf_max(mx);
    const float mn = fmaxf(m, mx), alpha = __builtin_amdgcn_exp2f(m - mn);
    m = mn; float ls = 0.f;
#pragma unroll
    for (int r = 0; r < 16; ++r) { p[r] = ((vm >> r) & 1u) ? __builtin_amdgcn_exp2f(p[r] - mn) : 0.f; ls += p[r]; }
    l = l * alpha + ls;
    if (has_o && !__all(alpha == 1.0f)) {
#pragma unroll
        for (int r = 0; r < 16; ++r) { o[0][r] *= alpha; o[1][r] *= alpha; } }
}
__device__ __forceinline__ void softmax_update_fast(f32x16& p, float& m, float& l, f32x16 (&o)[2]) {
    float mx = p[0];
#pragma unroll
    for (int r = 1; r < 16; ++r) mx = fmaxf(mx, p[r]);
    mx = xhalf_max(mx);
    const float mn = fmaxf(m, mx), alpha = __builtin_amdgcn_exp2f(m - mn);
    m = mn; float ls = 0.f;
#pragma unroll
    for (int r = 0; r < 16; ++r) { p[r] = __builtin_amdgcn_exp2f(p[r] - mn); ls += p[r]; }
    l = l * alpha + ls;
    if (!__all(alpha == 1.0f)) {
#pragma unroll
        for (int r = 0; r < 16; ++r) { o[0][r] *= alpha; o[1][r] *= alpha; } }
}
#define DPP_XOR1 0xB1
#define DPP_XOR2 0x4E
#define DPP_HMIR 0x141
__device__ __forceinline__ float quad_sum(float v) { v += __int_as_float(__builtin_amdgcn_update_dpp(0, __float_as_int(v), DPP_XOR1, 0xf, 0xf, true)); v += __int_as_float(__builtin_amdgcn_update_dpp(0, __float_as_int(v), DPP_XOR2, 0xf, 0xf, true)); return v; }
__device__ __forceinline__ unsigned oct_umax(unsigned v) {
    unsigned o = (unsigned)__builtin_amdgcn_update_dpp(0, (int)v, DPP_XOR1, 0xf, 0xf, true); v = v > o ? v : o;
    o = (unsigned)__builtin_amdgcn_update_dpp(0, (int)v, DPP_XOR2, 0xf, 0xf, true); v = v > o ? v : o;
    o = (unsigned)__builtin_amdgcn_update_dpp(0, (int)v, DPP_HMIR, 0xf, 0xf, true); return v > o ? v : o;
}
__device__ __forceinline__ void lds_add_f32(LAS float* p, float v) { asm volatile("ds_add_f32 %0, %1" :: "v"((unsigned)(uintptr_t)p), "v"(v) : "memory"); }
__device__ __forceinline__ float max3f(float a, float b, float c) { float d; asm("v_max3_f32 %0, %1, %2, %3" : "=v"(d) : "v"(a), "v"(b), "v"(c)); return d; }
template <int OFF> __device__ __forceinline__ void lds_add_2i32_off(LAS int* p, int lo, int hi) {
    const unsigned long long v = ((unsigned long long)(unsigned)(hi + (lo >> 31)) << 32) | (unsigned)lo;
    asm volatile("ds_add_u64 %0, %1 offset:%2" :: "v"((unsigned)(uintptr_t)p), "v"(v), "n"(OFF) : "memory"); }
__device__ __forceinline__ void lds_max_i32(LAS int* p, int v) { asm volatile("ds_max_i32 %0, %1" :: "v"((unsigned)(uintptr_t)p), "v"(v) : "memory"); }
__device__ __forceinline__ void lds_add_i32(LAS int* p, int v) { asm volatile("ds_add_u32 %0, %1" :: "v"((unsigned)(uintptr_t)p), "v"(v) : "memory"); }
__device__ __forceinline__ int f2ord(float f) { const int b = __float_as_int(f); return b ^ ((b >> 31) & 0x7fffffff); }
__device__ __forceinline__ float ord2f(int o) { return __int_as_float(o ^ ((o >> 31) & 0x7fffffff)); }
struct KF { s16x8 k[2][4]; };
struct VF { s16x8 v[2][2][2]; };
__device__ __forceinline__ void kf_load(KF& f, const bf16* blk, int lane) {
    const GAS s16x8* p = (const GAS s16x8*)(GAS bf16*)blk + lane;
#pragma unroll
    for (int kt = 0; kt < 2; ++kt)
#pragma unroll
        for (int s = 0; s < 4; ++s) f.k[kt][s] = p[(kt * 4 + s) * 64];
}
__device__ __forceinline__ void vf_load(VF& f, const bf16* blk, int lane) {
    const GAS s16x8* p = (const GAS s16x8*)(GAS bf16*)blk + lane;
#pragma unroll
    for (int kt = 0; kt < 2; ++kt)
#pragma unroll
        for (int s2 = 0; s2 < 2; ++s2)
#pragma unroll
            for (int dt = 0; dt < 2; ++dt) f.v[kt][s2][dt] = p[((kt * 2 + s2) * 2 + dt) * 64];
}
__device__ __forceinline__ f32x16 qk_frag(const s16x8 (&kf)[4], const s16x8 (&qf)[4], float cinit) {
    f32x16 p;
#pragma unroll
    for (int r = 0; r < 16; ++r) p[r] = cinit;
#pragma unroll
    for (int s = 0; s < 4; ++s) p = __builtin_amdgcn_mfma_f32_32x32x16_bf16(kf[s], qf[s], p, 0, 0, 0);
    return p;
}
__device__ __forceinline__ void pv_frag(f32x16 (&o)[2], const s16x8 (&vf)[2][2], const f32x16& p) {
#pragma unroll
    for (int s2 = 0; s2 < 2; ++s2) {
        v4u pw; pw.x = cvtpk(p[8 * s2 + 0], p[8 * s2 + 1]); pw.y = cvtpk(p[8 * s2 + 2], p[8 * s2 + 3]); pw.z = cvtpk(p[8 * s2 + 4], p[8 * s2 + 5]); pw.w = cvtpk(p[8 * s2 + 6], p[8 * s2 + 7]);
        const s16x8 pb = __builtin_bit_cast(s16x8, pw);
#pragma unroll
        for (int dt = 0; dt < 2; ++dt) o[dt] = __builtin_amdgcn_mfma_f32_32x32x16_bf16(vf[s2][dt], pb, o[dt], 0, 0, 0);
    }
}
__device__ __forceinline__ void pvl_frag(f32x16 (&o)[3], const s16x8 (&vf)[2][2], const f32x16& p, const s16x8& ones) {
#pragma unroll
    for (int s2 = 0; s2 < 2; ++s2) {
        v4u pw; pw.x = cvtpk(p[8 * s2 + 0], p[8 * s2 + 1]); pw.y = cvtpk(p[8 * s2 + 2], p[8 * s2 + 3]); pw.z = cvtpk(p[8 * s2 + 4], p[8 * s2 + 5]); pw.w = cvtpk(p[8 * s2 + 6], p[8 * s2 + 7]);
        const s16x8 pb = __builtin_bit_cast(s16x8, pw);
#pragma unroll
        for (int dt = 0; dt < 2; ++dt) o[dt] = __builtin_amdgcn_mfma_f32_32x32x16_bf16(vf[s2][dt], pb, o[dt], 0, 0, 0);
        o[2] = __builtin_amdgcn_mfma_f32_32x32x16_bf16(ones, pb, o[2], 0, 0, 0);
    }
}
__device__ __forceinline__ void stats_update_fast(const f32x16& p, float& m, float& l) {
    float mx = p[0];
#pragma unroll
    for (int r = 1; r < 16; ++r) mx = fmaxf(mx, p[r]);
    mx = xhalf_max(mx);
    const float mn = fmaxf(m, mx), alpha = __builtin_amdgcn_exp2f(m - mn);
    m = mn; float ls = 0.f;
#pragma unroll
    for (int r = 0; r < 16; ++r) ls += __builtin_amdgcn_exp2f(p[r] - mn);
    l = l * alpha + ls;
}
#define NSA_BAR() do { asm volatile("s_waitcnt lgkmcnt(0)" ::: "memory"); __builtin_amdgcn_s_barrier(); asm volatile("" ::: "memory"); } while (0)
}

__device__ __forceinline__ void phase_nsa(const Frame& F) {
    using namespace nsa;
    const int tid = F.tid, lane = F.lane, w = F.wave, r32_ = lane & 31, h_ = lane >> 5, r32 = r32_, h = h_, tl = r32 >> 2, rr = r32 & 3;
    LAS unsigned char* L = F.lds + RING_OFF;
    LAS float* IMP = (LAS float*)(L + L_IMP); LAS unsigned* SELM = (LAS unsigned*)(L + L_SELM); LAS float* BT = (LAS float*)(L + L_BT);
    LAS float* NBT = (LAS float*)(L + L_NB);
    const bf16* Q = (const bf16*)(F.ws + WS_Q); const bf16* KCMP = (const bf16*)(F.ws + WS_KCMP); const bf16* VCT = (const bf16*)(F.ws + WS_VCMPT);
    const bf16* KS = (const bf16*)(F.ws + WS_KS); const bf16* KW = (const bf16*)(F.ws + WS_KW); const bf16* VST = (const bf16*)(F.ws + WS_VST); const bf16* VWT = (const bf16*)(F.ws + WS_VWT);
    const float* GATE = (const float*)(F.ws + WS_GATE); const float* biasT = (const float*)(F.ws + WS_BIAST); bf16* ONSA = (bf16*)(F.ws + WS_ONSA);
#if defined(PROBE_SPIN_SEC)
    unsigned long long tacc[8] = {0, 0, 0, 0, 0, 0, 0, 0}, tlast = wall_clock64(); const unsigned long long tstart = tlast;
#define STAMP(k) do { const unsigned long long tn_ = wall_clock64(); tacc[k] += tn_ - tlast; tlast = tn_; } while (0)
#else
#define STAMP(k) do {} while (0)
#endif
    const LAS float* bTl = BT + rr;
    int g_bt = -1;
#pragma unroll 1
    for (int e = F.vcu; e < 2048; e += F.G) {
        const int ui = e >> 8, pl = (e >> 5) & 7, wi = e & 31, b = pl >> 2, g = pl & 3;
        if (g != g_bt) {
            __syncthreads();
            for (int i = tid; i < 512; i += NTHREADS) BT[i] = biasT[(i >> 2) * 16 + g * 4 + (i & 3)] * LOG2E;
            for (int i = tid; i < 16 * NB_P; i += NTHREADS) { const int c = i / (4 * NB_P), hd = (i / NB_P) & 3, dist = 127 - ((i % NB_P) + c - 64);
                NBT[i] = dist < 0 ? NEGB : biasT[(dist > 127 ? 127 : dist) * 16 + g * 4 + hd] * LOG2E; }
            g_bt = g;
            __syncthreads();
        }
        const int qt = 32 * ui + ((wi + 4 * ui) & 31);
        const int t0 = qt * 64, cur = qt, m0 = b * SEQ + t0, tok = t0 + 8 * w + tl, mrow = m0 + 8 * w + tl, H = g * NR + rr;
        const float b31 = bTl[127 * 4];
#define LOAD_QF() s16x8 qf[4]; { int h_o = h_; asm volatile("" : "+v"(h_o)); _Pragma("unroll") for (int s = 0; s < 4; ++s) qf[s] = *(const GAS s16x8*)(GAS bf16*)(Q + (size_t)mrow * 1024 + H * 64 + 16 * s + 8 * h_o); }
        f32x4* OACC = (f32x4*)((float*)(F.ws + WS_MIX) + ((size_t)blockIdx.x * NTHREADS + tid) * 64);
        const float* gt = GATE + (size_t)mrow * 48 + H * 3;
        for (int i = lane; i < 8 * IMP_P; i += 64) IMP[8 * w * IMP_P + i] = 0.f;
        for (int i = tid; i < 512; i += NTHREADS) SELM[i] = 0u;
        __syncthreads();
        STAMP(0);
        const int ncb = t0 >= 0 ? ((t0 + 63 - 31) / 16) / 64 + 1 : 0;
        const int icut = t0 >= 1152 ? (((t0 - 144) >> 4) - 63) / 64 + 1 : 0;
        const bf16* Kc = KCMP + (size_t)pl * 1024 * 64; const bf16* Vc = VCT + (size_t)pl * 64 * 1024;
        LOAD_QF()
        f32x16 oc[2];
#pragma unroll
        for (int r = 0; r < 16; ++r) { oc[0][r] = 0.f; oc[1][r] = 0.f; }
#define CK(ii) (Kc + (size_t)(ii) * 64 * 64)
#define CV(ii) (Vc + (ii) * 64)
        float mref = 0.f, lc = 0.f; bool first = true;
        {
            auto body0 = [&](int i, const LAS bf16* Kl) __attribute__((always_inline)) {
                int r32 = r32_, h = h_; asm volatile("" : "+v"(r32), "+v"(h));
                const bool far = i < icut;
#pragma unroll
                for (int kt = 0; kt < 2; ++kt) {
                    const int kr = 32 * kt + r32; s16x8 kf[4];
#pragma unroll
                    for (int s = 0; s < 4; ++s) kf[s] = *(const LAS s16x8*)(Kl + kr * KP + 8 * ((2 * s + h) ^ ((kr ^ (kr >> 3)) & 7)));
                    f32x16 pp = qk_frag(kf, qf, far ? b31 - mref : -mref);
                    if (!far) cmp_bias(pp, tok - 31 - 16 * (i * 64 + 32 * kt + 4 * h), bTl);
                    float tmax = max3f(pp[0], pp[1], pp[2]);
#pragma unroll
                    for (int r = 3; r < 15; r += 2) tmax = max3f(tmax, pp[r], pp[r + 1]);
                    tmax = fmaxf(tmax, pp[15]); tmax = xhalf_max(tmax);
                    const float d = first ? tmax : fmaxf(tmax, 0.f);
                    if (__any(d != 0.f)) {
                        mref += d; lc = first ? 0.f : lc * __builtin_amdgcn_exp2f(-d);
#pragma unroll
                        for (int r = 0; r < 16; ++r) pp[r] -= d;
                    }
                    first = false;
#pragma unroll
                    for (int r = 0; r < 16; ++r) lc += __builtin_amdgcn_exp2f(pp[r]);
                }
            };
            const int ng0 = (ncb + 3) >> 2;
#define K0_ISSUE(g) do { _Pragma("unroll") for (int q_ = 0; q_ < 4; ++q_) { const int b_ = (g) * 4 + q_; if (b_ < ncb) ktile_issue(L, (((g) & 1) * 4 + q_) * SLOTB, CK(b_), w, lane); } } while (0)
            K0_ISSUE(0);
#pragma unroll 1
            for (int g_ = 0; g_ < ng0; ++g_) {
                asm volatile("s_waitcnt vmcnt(0)" ::: "memory"); NSA_BAR(); if (g_ + 1 < ng0) K0_ISSUE(g_ + 1);
#pragma unroll 1
                for (int q_ = 0; q_ < 4; ++q_) { const int b_ = g_ * 4 + q_; if (b_ < ncb) body0(b_, (const LAS bf16*)(L + ((g_ & 1) * 4 + q_) * SLOTB)); }
            }
            NSA_BAR();
#undef K0_ISSUE
        }
        {
            const float lt = lc + __shfl_xor(lc, 32);
            const float mcl = (mref > -1.0e29f && lt > 0.f) ? mref + __builtin_amdgcn_logf(lt) - 26.0f : 1.0e30f;
            auto body = [&](int i, const LAS bf16* Kl, const LAS bf16* Vl) __attribute__((always_inline)) {
                int r32 = r32_, h = h_; asm volatile("" : "+v"(r32), "+v"(h));
                const bool far = i < icut;
#pragma unroll
                for (int kt = 0; kt < 2; ++kt) {
                    KVFrag fr; frag_load(fr, Kl, Vl, kt, r32, h);
                    f32x16 pp = qk_tile(fr, qf, far ? b31 - mcl : -mcl);
                    if (!far) cmp_bias(pp, tok - 31 - 16 * (i * 64 + 32 * kt + 4 * h), bTl);
#pragma unroll
                    for (int r = 0; r < 16; ++r) pp[r] = __builtin_amdgcn_exp2f(pp[r]);
#pragma unroll
                    for (int a = 0; a < 4; ++a) {
                        const float s4 = quad_sum((pp[4 * a] + pp[4 * a + 1]) + (pp[4 * a + 2] + pp[4 * a + 3])), s1 = quad_sum(pp[4 * a + 3]);
                        const int j = i * 16 + kt * 8 + 2 * a + h;
                        if (rr == 0) { LAS int* ip = (LAS int*)IMP + (8 * w + tl) * IMP_P + j; lds_add_i32(ip, (int)s4); lds_add_i32(ip + 1, (int)s1); }
                    }
                    pv_tile(oc, fr, pp);
                }
            };
#define NSA_ISSUE(G, g, n, KPTR, VPTR, LDV) do { _Pragma("unroll") for (int q_ = 0; q_ < G; ++q_) { const int b_ = (g) * G + q_, s_ = ((g) & 1) * G + q_; \
                if (b_ < (n)) tile_issue(L, s_ * SLOTB, (2 * G + s_) * SLOTB, KPTR(b_), VPTR(b_), LDV, w, lane); } } while (0)
#define NSA_LOOP(G, n, KPTR, VPTR, LDV) do { const int ng_ = ((n) + G - 1) / G; NSA_ISSUE(G, 0, (n), KPTR, VPTR, LDV); \
                _Pragma("unroll 1") for (int g_ = 0; g_ < ng_; ++g_) { asm volatile("s_waitcnt vmcnt(0)" ::: "memory"); NSA_BAR(); if (g_ + 1 < ng_) NSA_ISSUE(G, g_ + 1, (n), KPTR, VPTR, LDV); \
                    _Pragma("unroll 1") for (int q_ = 0; q_ < G; ++q_) { const int b_ = g_ * G + q_; const int s_ = (g_ & 1) * G + q_; \
                        if (b_ < (n)) body(b_, (const LAS bf16*)(L + s_ * SLOTB), (const LAS bf16*)(L + (2 * G + s_) * SLOTB)); } } \
                NSA_BAR(); } while (0)
            NSA_LOOP(GC, ncb, CK, CV, 1024);
        }
#undef CK
#undef CV
        const float g0 = gt[0] * 1.4901161193847656e-08f;
#pragma unroll
        for (int q = 0; q < 4; ++q) { OACC[q] = (f32x4){oc[0][4 * q], oc[0][4 * q + 1], oc[0][4 * q + 2], oc[0][4 * q + 3]} * g0; OACC[4 + q] = (f32x4){oc[1][4 * q], oc[1][4 * q + 1], oc[1][4 * q + 2], oc[1][4 * q + 3]} * g0; }
        STAMP(1);
        {
            int lane_q = lane; asm volatile("" : "+v"(lane_q));
#pragma unroll
            for (int q = 0; q < 4; ++q) { const int row = 32 * w + 8 * q + (lane_q >> 3), c = (lane_q & 7) ^ (row & 7);
                __builtin_amdgcn_global_load_lds((const unsigned*)(Q + (size_t)(m0 + (row >> 2)) * 1024 + (g * NR + (row & 3)) * 64 + c * 8), (LAS unsigned*)(L + L_SQ + (32 * w + 8 * q) * 128), 16, 0, 0); }
        }
        {
            int lane_o = lane; asm volatile("" : "+v"(lane_o));
            const int tk = lane_o >> 3, sub = lane_o & 7; LAS unsigned* sm = SELM + (8 * w + tk) * 8;
            const int ncand = cur - 2, nf = cur + 1 < 3 ? cur + 1 : 3, need = 16 - nf;
            asm volatile("s_waitcnt lgkmcnt(0)" ::: "memory");
            if (sub == 0) { (void)__hip_atomic_fetch_or(sm, 1u, __ATOMIC_RELAXED, __HIP_MEMORY_SCOPE_WORKGROUP); (void)__hip_atomic_fetch_or(sm + (cur >> 5), 1u << (cur & 31), __ATOMIC_RELAXED, __HIP_MEMORY_SCOPE_WORKGROUP); if (cur >= 1) (void)__hip_atomic_fetch_or(sm + ((cur - 1) >> 5), 1u << ((cur - 1) & 31), __ATOMIC_RELAXED, __HIP_MEMORY_SCOPE_WORKGROUP); }
            if (ncand <= need) {
                if (sub == 0) for (int j = 1; j <= cur - 2; ++j) (void)__hip_atomic_fetch_or(sm + (j >> 5), 1u << (j & 31), __ATOMIC_RELAXED, __HIP_MEMORY_SCOPE_WORKGROUP);
            } else {
                const LAS int* ip = (const LAS int*)IMP + (8 * w + tk) * IMP_P;
                unsigned key[32];
#pragma unroll
                for (int i = 0; i < 32; ++i) { const int j = sub + 8 * i; key[i] = (j >= 1 && j <= cur - 2) ? ((((unsigned)ip[j] >> 5) << 8) | (unsigned)(255 - j)) : 0u; }
#pragma unroll 1
                for (int round = 0; round < need; ++round) {
                    unsigned bk = key[0];
#pragma unroll
                    for (int i = 1; i < 32; ++i) bk = bk > key[i] ? bk : key[i];
                    bk = oct_umax(bk);
#pragma unroll
                    for (int i = 0; i < 32; ++i) key[i] = key[i] == bk ? 0u : key[i];
                    const int bj = 255 - (int)(bk & 0xffu);
                    if (sub == 0 && bk != 0u) (void)__hip_atomic_fetch_or(sm + (bj >> 5), 1u << (bj & 31), __ATOMIC_RELAXED, __HIP_MEMORY_SCOPE_WORKGROUP);
                }
            }
        }
        asm volatile("s_waitcnt vmcnt(0)" ::: "memory");
        __syncthreads();
        STAMP(2);
        {
            LAS int* SO = (LAS int*)(L + L_SO); LAS int* SM = (LAS int*)(L + L_SM); LAS int* SL = (LAS int*)(L + L_SL);
            LAS unsigned char* SQ = L + L_SQ; LAS unsigned* TL = (LAS unsigned*)(L + L_TL); LAS unsigned* TC = (LAS unsigned*)(L + L_TC); LAS unsigned char* TOKB = L + L_TOK;
            {
                int tid_o = tid; asm volatile("" : "+v"(tid_o));
                const int ln = tid_o & 63;
                const unsigned word = SELM[ln * 8 + w];
                unsigned long long tm = 0ull;
#pragma unroll
                for (int bt = 0; bt < 32; ++bt) { const unsigned long long mk = __ballot((word >> bt) & 1u); tm = ln == bt ? mk : tm; }
                const int cnt = ln < 32 ? __popcll(tm) : 0, nt = (cnt + 31) >> 5;
                int sc = nt;
#pragma unroll
                for (int o = 1; o < 32; o <<= 1) { const int v = __shfl_up(sc, o); if (ln >= o) sc += v; }
                if (ln == 31) TC[4 + w] = (unsigned)sc;
                { unsigned zz = 0u; asm volatile("" : "+v"(zz));
                  const v4u z4 = {zz, zz, zz, zz};
                  for (int i = tid_o; i < 256 * SO_P / 4; i += NTHREADS) ((LAS v4u*)SO)[i] = z4; }
                if (tid_o < 256) { SM[tid_o] = f2ord(NEGB); SL[tid_o] = 0; }
                __syncthreads();
                if (nt > 0) {
                    const int j = 32 * w + ln;
                    int pos = sc - nt; for (int ww = 0; ww < w; ++ww) pos += (int)TC[4 + ww];
                    LAS unsigned char* tb = TOKB + pos * 32;
                    if (tm == ~0ull) {
                        unsigned pat = 0x03020100u; asm volatile("" : "+v"(pat));
#pragma unroll 1
                        for (int q = 0; q < 16; ++q) { ((LAS unsigned*)tb)[q] = pat; pat += 0x04040404u; }
                        TL[pos] = (unsigned)j | (32u << 8); TL[pos + 1] = (unsigned)j | (32u << 8);
                    } else {
                        unsigned long long rem = tm; int c = 0;
                        for (; rem != 0ull; ++c) { const int t = __ffsll((long long)rem) - 1; rem &= rem - 1ull; tb[c] = (unsigned char)t; }
                        for (; (c & 7) != 0; ++c) tb[c] = (unsigned char)0xff;
                        for (int k = 0; k < nt; ++k) TL[pos + k] = (unsigned)j | ((unsigned)(cnt - 32 * k < 32 ? cnt - 32 * k : 32) << 8);
                    }
                }
                __syncthreads();
            }
            STAMP(5);
            const int ntl = (int)(TC[4] + TC[5] + TC[6] + TC[7] + TC[8] + TC[9] + TC[10] + TC[11]);
            const int nmine = (ntl - w + 7) >> 3;
            const float vmax = __uint_as_float(((const unsigned*)(F.ws + WS_CTL))[CW_VMAX + pl]);
            const float kexp = fminf(20.f, floorf(19.f - log2f(fmaxf(vmax, 1.0e-30f))));
            const bf16* Kg = KS + (size_t)pl * SEQ * 64; const bf16* Vg = VST + (size_t)pl * 64 * SEQ;
#define SEL_DESC(k_) ({ int kk_ = (k_) < nmine ? (k_) : nmine - 1; kk_ = kk_ < 0 ? 0 : kk_; (unsigned)__builtin_amdgcn_readfirstlane(TL[w + 8 * kk_]); })
#define SEL_COLS(tb_, grp_) int r32 = r32_, h = h_; asm volatile("" : "+v"(r32), "+v"(h)); \
                    const unsigned tokb = (tb_)[8 * (grp_) + (r32 >> 2)]; \
                    const bool valid = tokb != 0xffu; const int tokl = valid ? (int)tokb : 0, row = tokl * 4 + (r32 & 3); \
                    s16x8 qg[4]; const unsigned qa = (unsigned)(uintptr_t)(SQ + row * 128) + (unsigned)((h ^ (row & 7)) << 4);     \
                    _Pragma("unroll") for (int s = 0; s < 4; ++s) qg[s] = *(const LAS s16x8*)(uintptr_t)(qa ^ (unsigned)(32 * s));
            {
                KF ka, kb, kc; unsigned da = SEL_DESC(0), db = SEL_DESC(1), dc = 0u;
                kf_load(ka, Kg + (size_t)(da & 255u) * 4096, lane); kf_load(kb, Kg + (size_t)(db & 255u) * 4096, lane);
                auto step = [&](int k, KF& kcur, const unsigned dcur, KF& kpre, unsigned& dpre) __attribute__((always_inline)) {
                    dpre = SEL_DESC(k + 2);
                    kf_load(kpre, Kg + (size_t)(dpre & 255u) * 4096, lane);
                    const int j = (int)(dcur & 255u), ngrp = (int)((dcur >> 8) + 7u) >> 3; const bool near = j >= cur - 2;
                    const LAS unsigned char* tb = TOKB + (w + 8 * k) * 32;
#pragma unroll 1
                    for (int grp = 0; grp < ngrp; ++grp) {
                        SEL_COLS(tb, grp)
                        f32x16 p0 = qk_frag(kcur.k[0], qg, 0.f), p1 = qk_frag(kcur.k[1], qg, 0.f);
                        if (near) { bias_tile(p0, NBT, j * 64 + 4 * h, t0 + tokl, r32 & 3); bias_tile(p1, NBT, j * 64 + 32 + 4 * h, t0 + tokl, r32 & 3); }
                        float mx = max3f(p0[0], p1[0], NEGB);
#pragma unroll
                        for (int r = 1; r < 16; ++r) mx = max3f(mx, p0[r], p1[r]);
                        if (!near) mx += b31;
                        { auto rr2 = __builtin_amdgcn_permlane32_swap(__float_as_uint(mx), __float_as_uint(mx), false, false); mx = max3f(__uint_as_float(rr2[0]), __uint_as_float(rr2[1]), NEGB); }
                        if (valid && h == 0) lds_max_i32(SM + row, f2ord(mx));
                    }
                };
#pragma unroll 1
                for (int k = 0; k < nmine; k += 3) {
                    step(k, ka, da, kc, dc);
                    if (k + 1 >= nmine) break;
                    step(k + 1, kb, db, ka, da);
                    if (k + 2 >= nmine) break;
                    step(k + 2, kc, dc, kb, db);
                }
                asm volatile("s_waitcnt vmcnt(0) lgkmcnt(0)" ::: "memory");
            }
            __syncthreads();
            STAMP(6);
            {
                unsigned one2 = 0x3f803f80u; asm volatile("" : "+v"(one2));
                const s16x8 ones = __builtin_bit_cast(s16x8, (v4u){one2, one2, one2, one2});
                KF ka, kb; VF vf; unsigned dcur = SEL_DESC(0);
                kf_load(ka, Kg + (size_t)(dcur & 255u) * 4096, lane); vf_load(vf, Vg + (size_t)(dcur & 255u) * 4096, lane);
                auto step = [&](int k, KF& kcur, KF& knext) __attribute__((always_inline)) {
                    const unsigned dn = SEL_DESC(k + 1);
                    kf_load(knext, Kg + (size_t)(dn & 255u) * 4096, lane);
                    const int j = (int)(dcur & 255u), ngrp = (int)((dcur >> 8) + 7u) >> 3; const bool near = j >= cur - 2;
                    const LAS unsigned char* tb = TOKB + (w + 8 * k) * 32;
#pragma unroll 1
                    for (int grp = 0; grp < ngrp; ++grp) {
                        SEL_COLS(tb, grp)
                        const float mrow = ord2f(SM[row]) - kexp;
                        const float ci = valid ? (near ? -mrow : b31 - mrow) : NEGB;
                        f32x16 p0 = qk_frag(kcur.k[0], qg, ci), p1 = qk_frag(kcur.k[1], qg, ci);
                        if (near) { bias_tile(p0, NBT, j * 64 + 4 * h, t0 + tokl, r32 & 3); bias_tile(p1, NBT, j * 64 + 32 + 4 * h, t0 + tokl, r32 & 3); }
#pragma unroll
                        for (int r = 0; r < 16; ++r) { p0[r] = __builtin_amdgcn_exp2f(p0[r]); p1[r] = __builtin_amdgcn_exp2f(p1[r]); }
                        f32x16 o[3];
#pragma unroll
                        for (int r = 0; r < 16; ++r) { o[0][r] = 0.f; o[1][r] = 0.f; o[2][r] = 0.f; }
                        pvl_frag(o, vf.v[0], p0, ones); pvl_frag(o, vf.v[1], p1, ones);
                        if (valid) {
                            LAS int* op = SO + row * SO_P + 4 * h;
                            if (h == 0) lds_add_i32(SL + row, (int)o[2][0]);
#define SEL_ADD4(dt_, a_) lds_add_2i32_off<(32 * dt_ + 8 * a_) * 4>(op, (int)o[dt_][4 * a_], (int)o[dt_][4 * a_ + 1]); lds_add_2i32_off<(32 * dt_ + 8 * a_ + 2) * 4>(op, (int)o[dt_][4 * a_ + 2], (int)o[dt_][4 * a_ + 3]);
                            SEL_ADD4(0, 0) SEL_ADD4(0, 1) SEL_ADD4(0, 2) SEL_ADD4(0, 3) SEL_ADD4(1, 0) SEL_ADD4(1, 1) SEL_ADD4(1, 2) SEL_ADD4(1, 3)
#undef SEL_ADD4
                        }
                    }
                    vf_load(vf, Vg + (size_t)(dn & 255u) * 4096, lane);
                    dcur = dn;
                };
#pragma unroll 1
                for (int k = 0; k < nmine; k += 2) {
                    step(k, ka, kb);
                    if (k + 1 >= nmine) break;
                    step(k + 1, kb, ka);
                }
                asm volatile("s_waitcnt vmcnt(0) lgkmcnt(0)" ::: "memory");
            }
#undef SEL_DESC
#undef SEL_COLS
            __syncthreads();
            STAMP(7);
            {
                int r32 = r32_, h = h_; asm volatile("" : "+v"(r32), "+v"(h));
                const int row = (8 * w + (r32 >> 2)) * 4 + (r32 & 3);
                const float g1 = gt[1], lt = (float)SL[row], sc = lt > 0.f ? g1 / lt : 0.f;
                const LAS int* op = SO + row * SO_P + 4 * h;
#define SEL_RD4(off_) ({ const int l0 = op[off_], h0 = op[off_ + 1] - (l0 >> 31), l1 = op[off_ + 2], h1 = op[off_ + 3] - (l1 >> 31); (f32x4){(float)l0, (float)h0, (float)l1, (float)h1} * sc; })
#pragma unroll
                for (int q = 0; q < 4; ++q) { OACC[8 + q] = SEL_RD4(8 * q); OACC[12 + q] = SEL_RD4(32 + 8 * q); }
#undef SEL_RD4
            }
            NSA_BAR();
        }
        STAMP(3);
        {
            const int jb0 = cur >= 8 ? cur - 8 : 0, nwb = cur - jb0 + 1;
            const bf16* Kg = KW + (size_t)pl * SEQ * 64; const bf16* Vg = VWT + (size_t)pl * 64 * SEQ;
            float mref = 0.f; bool seen = false; f32x16 ow[3];
            LOAD_QF()
            unsigned one2 = 0x3f803f80u; asm volatile("" : "+v"(one2));
            const s16x8 ones = __builtin_bit_cast(s16x8, (v4u){one2, one2, one2, one2});
#pragma unroll
            for (int r = 0; r < 16; ++r) { ow[0][r] = 0.f; ow[1][r] = 0.f; ow[2][r] = 0.f; }
            auto body = [&](int i, const LAS bf16* Kl, const LAS bf16* Vl) __attribute__((always_inline)) {
                const int j = jb0 + i;
                const bool far = j <= cur - 3 && j >= cur - 7, nearb = j >= cur - 2;
                int r32 = r32_, h = h_; asm volatile("" : "+v"(r32), "+v"(h));
#pragma unroll
                for (int kt = 0; kt < 2; ++kt) {
                    KVFrag fr; frag_load(fr, Kl, Vl, kt, r32, h);
                    f32x16 pp = qk_tile(fr, qf, (nearb ? 0.f : b31) - mref);
                    if (nearb) bias_tile(pp, NBT, j * 64 + 32 * kt + 4 * h, tok, rr);
                    else if (!far) {
                        const int klo = tok - 512 - (j * 64 + 32 * kt + 4 * h);
#pragma unroll
                        for (int r = 0; r < 16; ++r) pp[r] = krow(r) > klo ? pp[r] : NEGB;
                    }
                    float tmax = max3f(pp[0], pp[1], pp[2]);
#pragma unroll
                    for (int r = 3; r < 15; r += 2) tmax = max3f(tmax, pp[r], pp[r + 1]);
                    tmax = fmaxf(tmax, pp[15]); tmax = xhalf_max(tmax);
                    const bool ok = tmax > -1.0e29f;
                    const float d = seen ? fmaxf(tmax, 0.f) : (ok ? tmax : 0.f);
                    if (__any(d != 0.f)) {
                        const float al = seen ? __builtin_amdgcn_exp2f(-d) : 1.0f; mref += d; ow[2][0] *= al;
#pragma unroll
                        for (int r = 0; r < 16; ++r) { ow[0][r] *= al; ow[1][r] *= al; pp[r] -= d; }
                    }
                    seen = seen || ok;
#pragma unroll
                    for (int r = 0; r < 16; ++r) pp[r] = __builtin_amdgcn_exp2f(pp[r]);
                    pvl_frag(ow, fr.v, pp, ones);
                }
            };
#define WK(ii) (Kg + (size_t)(jb0 + (ii)) * 64 * 64)
#define WV(ii) (Vg + (jb0 + (ii)) * 64)
            NSA_LOOP(GS, nwb, WK, WV, SEQ);
#undef WK
#undef WV
            const float g2 = gt[2], lt = ow[2][0], sc = lt > 0.f ? g2 / lt : 0.f;
#pragma unroll
            for (int r = 0; r < 16; ++r) { ow[0][r] *= sc; ow[1][r] *= sc; }
#pragma unroll
            for (int q = 0; q < 4; ++q) {
                const f32x4 a0 = OACC[q] + OACC[8 + q], a1 = OACC[4 + q] + OACC[12 + q];
#pragma unroll
                for (int j = 0; j < 4; ++j) { ow[0][4 * q + j] += a0[j]; ow[1][4 * q + j] += a1[j]; }
                __builtin_amdgcn_sched_barrier(0);
            }
            bf16* op = ONSA + (size_t)mrow * 1024 + H * 64 + 4 * h;
#pragma unroll
            for (int dt = 0; dt < 2; ++dt)
#pragma unroll
                for (int a = 0; a < 4; ++a) { v2u wv; wv.x = cvtpk(ow[dt][4 * a], ow[dt][4 * a + 1]); wv.y = cvtpk(ow[dt][4 * a + 2], ow[dt][4 * a + 3]); *(v2u*)(op + 32 * dt + 8 * a) = wv; }
            asm volatile("s_waitcnt lgkmcnt(0)" ::: "memory");
        }
        STAMP(4);
    }
#ifdef PROBE_SPIN_SEC
    { const unsigned long long t1_ = wall_clock64(); while (wall_clock64() - t1_ < tacc[PROBE_SPIN_SEC]) __builtin_amdgcn_s_sleep(8); }
#endif
#undef STAMP
#undef LOAD_QF
#undef NSA_ISSUE
#undef NSA_LOOP
}

template <class Epi, class Map>
__device__ __forceinline__ void run_gemm(const Frame& F, const bf16* A, const bf16* Bt, int lda, int ldb, int K, int nM, int nN, const Map& map, const Epi& E, int Gs = 0, int c0 = 0) {
    pg8::Gemm g{A, Bt, lda, ldb, K}; pg8::Order<Map> S; S.init(nM, nN, Gs ? Gs : F.G, (int)blockIdx.x - c0, map);
    int tid = F.tid; asm volatile("" : "+v"(tid));
    pg8::gemm_phase<Epi, pg8::Order<Map>, true, true>(F.lds + RING_OFF, g, S, E, tid);
}
enum { PH_PRO, PH_P1, PH_R1, PH_R2, PH_R3, PH_G, PH_OUT, PH_RES, PH_FI, PH_KVQN, PH_KVQS, PH_CMP, PH_CMP2, PH_NSA, PH_COUNT };

template <int PH> __device__ __forceinline__ void phase_body(const Frame& F, int b) {
    unsigned char* ws = F.ws; float* rinv = (float*)(ws + WS_RINV); bf16* XB = (bf16*)(ws + WS_XB);
    if constexpr (PH == PH_PRO) phase_prologue(F);
    if constexpr (PH == PH_P1) {
        { EpiP1N E{rinv + b * SEQ, (const f32x4*)(ws + WS_TABA), (bf16*)(ws + WS_AP), (bf16*)(ws + WS_KN)};
          run_gemm(F, XB + (size_t)b * SEQ * DM, (const bf16*)(ws + W_RI), DM, DM, DM, SEQ / 256, 8, pg8::MapPlain{DM, DM}, E); }
        __syncthreads();
        { EpiP1S E{rinv + b * SEQ, (const f32x4*)(ws + WS_TABB), (bf16*)(ws + WS_KT), (bf16*)(ws + WS_BP)};
          run_gemm(F, (const bf16*)(ws + W_RI) + (size_t)1024 * DM, XB + (size_t)b * SEQ * DM, DM, DM, DM, 12, SEQ / 256, pg8::MapPlain{DM, DM}, E); }
    }
    if constexpr (PH == PH_R1) {
        { EpiKV E{(bf16*)(ws + WS_KV)};
          run_gemm(F, (const bf16*)(ws + WS_BP), (const bf16*)(ws + WS_KT), APLD, SEQ, RCH, RH * NCH * 2, 1, MapKV{}, E); }
        __syncthreads();
        { EpiS E{(bf16*)(ws + WS_AP)};
          run_gemm(F, (const bf16*)(ws + WS_AP), (const bf16*)(ws + WS_KN), APLD, 1024, RDK, RH * NCH * 2, 2, MapS{}, E); }
    }
    if constexpr (PH == PH_R2) phase_ret_scan(F);
    if constexpr (PH == PH_R3) { EpiO E{(bf16*)F.out, (float*)(ws + WS_GSLOT), b};
        run_gemm(F, (const bf16*)(ws + WS_AP), (const bf16*)(ws + WS_BP), APLD, APLD, APLD, RH * NCH * 2, 2, MapO{}, E); }
    if constexpr (PH == PH_G) { EpiG E{rinv, (const float*)(ws + WS_GSLOT), (bf16*)F.out};
        run_gemm(F, XB, (const bf16*)(ws + W_RI) + (size_t)4096 * DM, DM, DM, DM, MTOK / 256, 8, pg8::MapPlain{DM, DM}, E); }
    if constexpr (PH == PH_OUT) {
        const bf16* A = b == 0 ? (const bf16*)F.out : b == 2 ? (const bf16*)(ws + WS_ONSA) : (const bf16*)(ws + WS_HID);
        const bf16* Bt = (const bf16*)(ws + (b == 0 ? W_RO : b == 1 ? W_FO0 : b == 2 ? W_NO : W_FO1));
        const int K = b == 0 ? 2048 : b == 2 ? DM : FFH;
        EpiOut E{(bf16*)(ws + WS_MIX), (float*)(ws + WS_OSLOT)};
        run_gemm(F, A, Bt, K, K, K, MTOK / 256, 4, pg8::MapPlain{K, K}, E); }
    if constexpr (PH == PH_RES) phase_resid(F, b == 0 ? gp(F.in[0]) : (const float*)nullptr, gp(b & 1 ? F.in[4] : F.in[2]) + (b >> 1) * DM, b == 3);
    if constexpr (PH == PH_FI) { EpiFfnIn E{rinv, (bf16*)(ws + WS_HID)};
        run_gemm(F, XB, (const bf16*)(ws + (b ? W_FI1 : W_FI0)), DM, DM, DM, MTOK / 256, 22, pg8::MapPlain{DM, DM}, E); }
    if constexpr (PH == PH_KVQN) { phase_peb_final(F);
        EpiKvqN E{rinv, (bf16*)(ws + WS_KC), (bf16*)(ws + WS_VC), (bf16*)(ws + WS_KS), (bf16*)(ws + WS_KW), (bf16*)(ws + WS_Q), (float*)(ws + WS_GATE)};
        run_gemm(F, XB, (const bf16*)(ws + W_KVQ), DM, DM, DM, MTOK / 256, 8, pg8::MapPlain{DM, DM}, E); }
    if constexpr (PH == PH_KVQS) {
        const int ncmp = F.G >= 128 ? F.G / 4 : 0;
        if (ncmp == 0 || (int)blockIdx.x < ncmp) { EpiCmp E{(const float*)(ws + WS_PEB), (bf16*)(ws + WS_HIDC)};
            run_gemm(F, (const bf16*)(ws + WS_KC), (const bf16*)(ws + W_C1), 1024, 2048, 2048, 64, 1, MapCmp{}, E, ncmp ? ncmp : F.G, 0); }
        if (ncmp == 0 || (int)blockIdx.x >= ncmp) {
            if (ncmp == 0) __syncthreads();
            { EpiKvqS E{rinv, (bf16*)(ws + WS_VST), (bf16*)(ws + WS_VWT), (unsigned*)(ws + WS_CTL) + CW_VMAX};
              run_gemm(F, (const bf16*)(ws + W_KVV), XB, DM, DM, DM, 2, MTOK / 256, pg8::MapPlain{DM, DM}, E, F.G - ncmp, ncmp); }
            __syncthreads();
            { EpiGate E{rinv, (float*)(ws + WS_GATE)};
              run_gemm(F, XB, (const bf16*)(ws + W_KVQ) + (size_t)2048 * DM, DM, DM, DM, MTOK / 256, 1, pg8::MapPlain{DM, DM}, E, F.G - ncmp, ncmp); }
        }
    }
    if constexpr (PH == PH_CMP2) phase_cmp2(F);
    if constexpr (PH == PH_NSA) phase_nsa(F);
}
__device__ __forceinline__ void make_frame(Frame& F, unsigned char* lds, const Args& args) {
    int tid = threadIdx.x; asm volatile("" : "+v"(tid));
    GAS unsigned char* wsg = (GAS unsigned char*)args.ws; GAS float* outg = (GAS float*)args.out; asm volatile("" : "+s"(wsg), "+s"(outg));
    F.lds = (LAS unsigned char*)lds; F.ws = (unsigned char*)wsg; F.out = (float*)outg; F.in = args.in;
    F.tid = tid; F.lane = tid & 63; F.wave = __builtin_amdgcn_readfirstlane(tid >> 6);
    F.G = gridDim.x; { const int bx = blockIdx.x; F.vcu = (F.G % 8 == 0) ? (bx % 8) * (F.G / 8) + bx / 8 : bx; }
    F.gw = F.vcu * NWAVES + F.wave; F.NGW = F.G * NWAVES;
}
__global__ void __launch_bounds__(NTHREADS, 2) fwd(Args args) {
    extern __shared__ __attribute__((aligned(16))) unsigned char lds[];
    {   LAS unsigned* ctl = (LAS unsigned*)((LAS unsigned char*)lds + LDSCTL_OFF);
        for (int u = threadIdx.x; u < (LDS_BYTES - LDSCTL_OFF) / 4; u += NTHREADS) ctl[u] = 0u; }
    __syncthreads();
    const int lo = args.ph, hi = args.b;
    XcdBarrier bar; bar.bar = (unsigned*)(args.ws + WS_CTL) + CW_BAR; bar.x = 0; bar.st = nullptr;
    if (hi - lo > 1) bar = xcd_barrier_post((unsigned*)(args.ws + WS_CTL) + CW_BAR, (volatile LAS unsigned*)((LAS unsigned char*)lds + MISC_OFF) + 8);
    int ph = 0;
#ifndef DBG_MASK
#define DBG_MASK 0xffffffffu
#endif
#ifdef PROBE_SPIN_PH
#define SPIN_T0() const unsigned long long t0_ = wall_clock64()
#define SPIN_T1(PH) do { if (PH == PROBE_SPIN_PH) { const unsigned long long t1_ = wall_clock64(); while (wall_clock64() - t1_ < t1_ - t0_) __builtin_amdgcn_s_sleep(8); } } while (0)
#else
#define SPIN_T0() do {} while (0)
#define SPIN_T1(PH) do {} while (0)
#endif
#define RUN(PH, bval) do { if (ph >= lo && ph < hi) { Frame F; make_frame(F, lds, args); SPIN_T0(); if constexpr ((DBG_MASK >> PH) & 1u) phase_body<PH>(F, (bval)); SPIN_T1(PH); if (ph + 1 < hi) xcd_barrier(bar); } ++ph; } while (0)
    RUN(PH_PRO, 0);
#pragma unroll 1
    for (int layer = 0; layer < 2; ++layer) {
#pragma unroll 1
        for (int sub = 0; sub < 2; ++sub) {
            if (sub == 0) {
                if (layer == 0) {
#pragma unroll 1
                    for (int b = 0; b < NBATCH; ++b) { RUN(PH_P1, b); RUN(PH_R1, b); RUN(PH_R2, b); RUN(PH_R3, b); }
                    RUN(PH_G, 0);
                } else { RUN(PH_KVQN, 0); RUN(PH_KVQS, 0); RUN(PH_CMP2, 0); RUN(PH_NSA, 0); }
            } else RUN(PH_FI, layer);
            RUN(PH_OUT, 2 * layer + sub);
            RUN(PH_RES, 2 * layer + sub);
        }
    }
#undef RUN
}
constexpr int NPHASES = 1 + (8 + 1 + 2) + 3 + (4 + 2) + 3;
#ifndef MK_N_LAUNCH
#define MK_N_LAUNCH 1
#endif
extern "C" void kernel_launch(void* const* d_in, const int* in_sizes, int n_in, void* d_out, int out_size, void* d_ws, size_t ws_size, hipStream_t stream) {
    static int grid = 0;
    if (grid == 0) {
        if (n_in != 20 || out_size != MTOK * DM || ws_size < WS_NEED) { fprintf(stderr, "kernel_launch: unexpected problem shape (n_in %d, out %d, ws %zu)\n", n_in, out_size, ws_size); grid = -1; return; }
        int dev = 0, cus = 0, per_cu = 0;
        if (hipGetDevice(&dev) != hipSuccess || hipDeviceGetAttribute(&cus, hipDeviceAttributeMultiprocessorCount, dev) != hipSuccess) { grid = -1; return; }
        if (hipFuncSetAttribute((const void*)fwd, hipFuncAttributeMaxDynamicSharedMemorySize, LDS_BYTES) != hipSuccess) { fprintf(stderr, "kernel_launch: hipFuncSetAttribute failed\n"); grid = -1; return; }
        if (hipOccupancyMaxActiveBlocksPerMultiprocessor(&per_cu, (const void*)fwd, NTHREADS, LDS_BYTES) != hipSuccess || per_cu < 1) { fprintf(stderr, "kernel_launch: occupancy query says %d blocks per CU\n", per_cu); }
        (void)hipGetLastError();
        grid = cus;
    }
    if (grid < 0) return;
    (void)hipMemsetAsync((char*)d_ws + WS_CTL, 0, CTL_ZERO_BYTES, stream);
    Args a{};
    for (int i = 0; i < 20; ++i) a.in[i] = (const float*)d_in[i];
    a.out = (float*)d_out; a.ws = (unsigned char*)d_ws;
    if (MK_N_LAUNCH == 1) { a.ph = 0; a.b = NPHASES; hipLaunchKernelGGL(fwd, dim3(grid), dim3(NTHREADS), LDS_BYTES, stream, a); }
    else for (int p = 0; p < NPHASES; ++p) { a.ph = p; a.b = p + 1; hipLaunchKernelGGL(fwd, dim3(grid), dim3(NTHREADS), LDS_BYTES, stream, a); }
}
```

```cpp
#include <hip/hip_runtime.h>
#include <cstdio>
#include <cstdint>
#include <utility>

namespace pg8 {
#define PG8_LAS __attribute__((address_space(3)))
typedef unsigned short bf16_t;
typedef short bf16x8 __attribute__((ext_vector_type(8)));
typedef float f32x4 __attribute__((ext_vector_type(4)));
typedef unsigned u32x4 __attribute__((ext_vector_type(4)));
constexpr int BM = 256, BK = 64, HALF = 128, HTB = HALF * BK * 2  , STAGE_BYTES = 8 * HTB, NXCD = 8, WGM = 8;

__host__ __device__ __forceinline__ int lds_byte(int r, int c) { const int st = (r >> 4) * 2 + (c >> 5), rr = r & 15, cc = c & 31, ob = rr * 64 + cc * 2; return st * 1024 + (ob ^ (((ob >> 9) & 1) << 5)); }
__host__ __device__ __forceinline__ void stage_rc(int b, int& R, int& C) { const int st = b / 1024, sb = b % 1024, swz = sb ^ (((sb >> 9) & 1) << 5); R = (st >> 1) * 16 + swz / 64; C = (st & 1) * 32 + (swz % 64) / 2; }
__host__ __device__ __forceinline__ int perm32(int rho) { const int n = rho >> 4, i = rho & 15; return 8 * (i >> 2) + 4 * n + (i & 3); }

struct Unit { int pm, pn; size_t offA, offB; };
struct Gemm { const bf16_t* A; const bf16_t* Bt; int lda, ldb, K; };

template <class Map> struct Order {
    int nM, nN, nwg, G, c; Map map;
    __device__ __forceinline__ void init(int nM_, int nN_, int G_, int c_, const Map& m) { nM = nM_; nN = nN_; nwg = nM * nN; G = G_; c = c_; map = m; }
    __device__ __forceinline__ bool next(int i, Unit& u) const {
        const long L = (long)i * G + c; if (L >= nwg) return false;
        int wgid = (int)L; { const int q = nwg / NXCD, r = nwg % NXCD, xcd = wgid % NXCD, off = wgid / NXCD; wgid = (xcd < r ? xcd * (q + 1) : r * (q + 1) + (xcd - r) * q) + off; }
        const int nig = WGM * nN, gid = wgid / nig, fm = gid * WGM, gsz = (nM - fm) < WGM ? (nM - fm) : WGM;
        u.pm = fm + ((wgid % nig) % gsz); u.pn = (wgid % nig) / gsz; map(u); return true;
    }
    __device__ __forceinline__ void a_ready(const Unit&) const {}
    __device__ __forceinline__ void done(const Unit&) const {}
};
struct MapPlain { int lda, ldb; __device__ __forceinline__ void operator()(Unit& u) const { u.offA = (size_t)u.pm * 256 * lda * 2; u.offB = (size_t)u.pn * 256 * ldb * 2; } };

template <class Epi, class Sched, bool ALIGN_EPI = false, bool SP2 = false>
__device__ __forceinline__ void gemm_phase(PG8_LAS unsigned char* lds, const Gemm g, const Sched& S, const Epi& E, const int tid) {
    const int wid = __builtin_amdgcn_readfirstlane(tid >> 6), lane = tid & 63, wr = wid >> 2, wc = wid & 3, fr = lane & 15, fq = lane >> 4;
    const int K = g.K, nt = K / BK;
    unsigned voffA[2], voffB[2];
#pragma unroll
    for (int i = 0; i < 2; ++i) { int R, C; stage_rc(tid * 16 + i * 8192, R, C); const int Rb = Epi::PERM ? ((R & ~31) + perm32(R & 31)) : R;
        voffA[i] = (unsigned)(R * g.lda + C) * 2u; voffB[i] = (unsigned)(Rb * g.ldb + C) * 2u; }
    const size_t kstep = (size_t)(BK * 2);
    const size_t hstepA = (size_t)HALF * g.lda * 2, hstepB = (size_t)HALF * g.ldb * 2;
    const unsigned ldsw = (unsigned)wid * 1024u;
    const int aoff = lds_byte(wr * 64 + fr, fq * 8), boff = lds_byte(wc * 32 + fr, fq * 8);
#define PG8_SA(b, h) (((b) * 2 + (h)) * HTB)
#define PG8_SB(b, h) ((4 + (b) * 2 + (h)) * HTB)
#define PG8_STAGE(bufoff, gbase, voff) do { _Pragma("unroll") for (int _i = 0; _i < 2; ++_i) \
        __builtin_amdgcn_global_load_lds((const unsigned*)((const char*)(gbase) + (voff)[_i]), (PG8_LAS unsigned*)(lds + (bufoff) + ldsw + _i * 8192), 16, 0, 0); } while (0)
#define PG8_LDA(dst, b, h) do { _Pragma("unroll") for (int m = 0; m < 4; ++m) _Pragma("unroll") for (int k = 0; k < 2; ++k) dst[m][k] = *(const PG8_LAS bf16x8*)(lds + PG8_SA(b, h) + aoff + m * 2048 + k * 1024); } while (0)
#define PG8_LDB(dst, b, h) do { _Pragma("unroll") for (int n = 0; n < 2; ++n) _Pragma("unroll") for (int k = 0; k < 2; ++k) dst[n][k] = *(const PG8_LAS bf16x8*)(lds + PG8_SB(b, h) + boff + n * 2048 + k * 1024); } while (0)
#define PG8_MMA(ai, bj, At, Bt) do { __builtin_amdgcn_s_setprio(1); _Pragma("unroll") for (int m = 0; m < 4; ++m) _Pragma("unroll") for (int n = 0; n < 2; ++n) _Pragma("unroll") for (int k = 0; k < 2; ++k) \
        acc[ai][bj][m][n] = __builtin_amdgcn_mfma_f32_16x16x32_bf16(Bt[n][k], At[m][k], acc[ai][bj][m][n], 0, 0, 0); __builtin_amdgcn_s_setprio(0); } while (0)
#define PG8_WAIT_V(n) asm volatile("s_waitcnt vmcnt(" #n ")" ::: "memory")
#define PG8_WAIT_L(n) asm volatile("s_waitcnt lgkmcnt(" #n ")" ::: "memory")
#define PG8_BAR __builtin_amdgcn_s_barrier()
#define PG8_SCHED __builtin_amdgcn_sched_barrier(0)
    Unit cur, nxt; int ui = 0;
    if (!S.next(0, cur)) return;
    f32x4 acc[2][2][4][2];
#pragma unroll
    for (int a = 0; a < 2; ++a)
#pragma unroll
        for (int b = 0; b < 2; ++b)
#pragma unroll
            for (int m = 0; m < 4; ++m)
#pragma unroll
                for (int n = 0; n < 2; ++n) acc[a][b][m][n] = (f32x4){0.f, 0.f, 0.f, 0.f};
    bf16x8 At[4][2], B0[2][2], B1[2][2];
    const char* cA = (const char*)g.A + cur.offA; const char* cB = (const char*)g.Bt + cur.offB;
    S.a_ready(cur);
    if constexpr (SP2) {
        PG8_STAGE(PG8_SB(0, 0), cB, voffB); PG8_STAGE(PG8_SB(0, 1), cB + hstepB, voffB); PG8_STAGE(PG8_SA(0, 0), cA, voffA); PG8_STAGE(PG8_SA(0, 1), cA + hstepA, voffA);
        if (wr == 1) PG8_BAR;
        PG8_WAIT_V(2); PG8_BAR;
        PG8_STAGE(PG8_SB(1, 0), cB + kstep, voffB); PG8_STAGE(PG8_SA(1, 0), cA + kstep, voffA); PG8_STAGE(PG8_SB(1, 1), cB + hstepB + kstep, voffB);
        PG8_WAIT_V(6); PG8_BAR;
    } else {
        PG8_STAGE(PG8_SB(0, 0), cB, voffB); PG8_STAGE(PG8_SA(0, 0), cA, voffA); PG8_STAGE(PG8_SB(0, 1), cB + hstepB, voffB); PG8_STAGE(PG8_SA(0, 1), cA + hstepA, voffA);
        if (wr == 1) PG8_BAR;
        PG8_WAIT_V(4); PG8_BAR;
        PG8_STAGE(PG8_SB(1, 0), cB + kstep, voffB); PG8_STAGE(PG8_SA(1, 0), cA + kstep, voffA); PG8_STAGE(PG8_SB(1, 1), cB + hstepB + kstep, voffB);
        PG8_WAIT_V(6); PG8_BAR;
    }
    for (;;) {
        const bool has_next = S.next(ui + 1, nxt);
        const char* nA = has_next ? (const char*)g.A + nxt.offA : cA; const char* nB = has_next ? (const char*)g.Bt + nxt.offB : cB;
#pragma unroll 1
        for (int t = 0; t < nt; t += 2) {
            const bool last = (t == nt - 2);
            const char* a1 = cA + (size_t)(t + 1) * kstep;
            const char* a2 = last ? nA : cA + (size_t)(t + 2) * kstep; const char* b2 = last ? nB : cB + (size_t)(t + 2) * kstep;
            const char* a3 = a2 + kstep; const char* b3 = b2 + kstep;
            if (last && has_next) S.a_ready(nxt);
            if constexpr (SP2) {
            PG8_LDB(B0, 0, 0); PG8_LDB(B1, 0, 1); PG8_SCHED; PG8_LDA(At, 0, 0); PG8_STAGE(PG8_SA(1, 1), a1 + hstepA, voffA);
            PG8_WAIT_V(8); PG8_WAIT_L(0); PG8_BAR; PG8_MMA(0, 0, At, B0); PG8_MMA(0, 1, At, B1); PG8_BAR; PG8_SCHED;
            PG8_LDA(At, 0, 1); PG8_STAGE(PG8_SB(0, 0), b2, voffB); PG8_STAGE(PG8_SB(0, 1), b2 + hstepB, voffB); PG8_STAGE(PG8_SA(0, 0), a2, voffA);
            PG8_WAIT_V(8); PG8_WAIT_L(0); PG8_BAR; PG8_MMA(1, 0, At, B0); PG8_MMA(1, 1, At, B1); PG8_BAR; PG8_SCHED;
            PG8_LDB(B0, 1, 0); PG8_LDB(B1, 1, 1); PG8_SCHED; PG8_LDA(At, 1, 0); PG8_STAGE(PG8_SA(0, 1), a2 + hstepA, voffA);
            PG8_WAIT_V(8); PG8_WAIT_L(0); PG8_BAR; PG8_MMA(0, 0, At, B0); PG8_MMA(0, 1, At, B1); PG8_BAR; PG8_SCHED;
            PG8_LDA(At, 1, 1); PG8_STAGE(PG8_SB(1, 0), b3, voffB); PG8_STAGE(PG8_SB(1, 1), b3 + hstepB, voffB); PG8_STAGE(PG8_SA(1, 0), a3, voffA);
            PG8_WAIT_V(8); PG8_WAIT_L(0); PG8_BAR; PG8_MMA(1, 0, At, B0); PG8_MMA(1, 1, At, B1); PG8_BAR; PG8_SCHED;
            } else {
            PG8_LDB(B0, 0, 0); PG8_SCHED; PG8_LDA(At, 0, 0); PG8_STAGE(PG8_SA(1, 1), a1 + hstepA, voffA);
            PG8_WAIT_L(8); PG8_BAR; PG8_WAIT_L(0); PG8_MMA(0, 0, At, B0); PG8_BAR; PG8_SCHED;
            PG8_LDB(B1, 0, 1); PG8_STAGE(PG8_SB(0, 0), b2, voffB);
            PG8_BAR; PG8_WAIT_L(0); PG8_MMA(0, 1, At, B1); PG8_BAR;
            PG8_LDA(At, 0, 1); PG8_STAGE(PG8_SA(0, 0), a2, voffA);
            PG8_BAR; PG8_WAIT_L(0); PG8_MMA(1, 0, At, B0); PG8_BAR; PG8_SCHED;
            PG8_STAGE(PG8_SB(0, 1), b2 + hstepB, voffB);
            PG8_WAIT_V(6); PG8_BAR; PG8_MMA(1, 1, At, B1); PG8_BAR;
            PG8_LDB(B0, 1, 0); PG8_SCHED; PG8_LDA(At, 1, 0); PG8_STAGE(PG8_SA(0, 1), a2 + hstepA, voffA);
            PG8_WAIT_L(8); PG8_BAR; PG8_WAIT_L(0); PG8_MMA(0, 0, At, B0); PG8_BAR; PG8_SCHED;
            PG8_LDB(B1, 1, 1); PG8_STAGE(PG8_SB(1, 0), b3, voffB);
            PG8_BAR; PG8_WAIT_L(0); PG8_MMA(0, 1, At, B1); PG8_BAR;
            PG8_LDA(At, 1, 1); PG8_STAGE(PG8_SA(1, 0), a3, voffA);
            PG8_BAR; PG8_WAIT_L(0); PG8_MMA(1, 0, At, B0); PG8_BAR; PG8_SCHED;
            PG8_STAGE(PG8_SB(1, 1), b3 + hstepB, voffB);
            PG8_WAIT_V(6); PG8_BAR; PG8_MMA(1, 1, At, B1); PG8_BAR;
            }
        }
        if constexpr (ALIGN_EPI) { if (wr == 0) PG8_BAR; }
        if constexpr (!Epi::AFTER_DRAIN) { E(acc, cur, wr, wc, fr, fq); S.done(cur); }
        if (!has_next) break;
#pragma unroll
        for (int a = 0; a < 2; ++a)
#pragma unroll
            for (int b = 0; b < 2; ++b)
#pragma unroll
                for (int m = 0; m < 4; ++m)
#pragma unroll
                    for (int n = 0; n < 2; ++n) acc[a][b][m][n] = (f32x4){0.f, 0.f, 0.f, 0.f};
        cur = nxt; cA = nA; cB = nB; ++ui;
        if constexpr (ALIGN_EPI) { if (wr == 1) PG8_BAR; }
    }
    PG8_WAIT_V(0);
    if constexpr (!ALIGN_EPI) { if (wr == 0) PG8_BAR; }
    PG8_BAR;
    if constexpr (Epi::AFTER_DRAIN) { E.fused(acc, cur, wr, wc, fr, fq, lds, wid, lane); S.done(cur); }
#undef PG8_SA
#undef PG8_SB
#undef PG8_STAGE
#undef PG8_LDA
#undef PG8_LDB
#undef PG8_MMA
#undef PG8_WAIT_V
#undef PG8_WAIT_L
#undef PG8_BAR
#undef PG8_SCHED
}
}

constexpr int DM = 1024, NBATCH = 2, SEQ = 16384, MTOK = NBATCH * SEQ;
constexpr int FFH = 2816;
constexpr int RH = 4, RDK = 256, RDV = 512, RCH = 512, NCH = SEQ / RCH;
constexpr int RIN = 2 * RH * RDK + 2 * RH * RDV;
constexpr int NG = 4, NR = 4, HD = 64, NCMP = 1023, NSEL = 256, NSAIN = 1072;
constexpr float RMS_EPS = 1e-6f;
constexpr int APLD = 768;

constexpr size_t MiB = 1u << 20;
constexpr size_t WS_CTL = 0, CTL_ZERO_BYTES = 1 * MiB;
constexpr int CW_VMAX = 16384;
constexpr size_t WS_RINV = 1 * MiB;
constexpr size_t WS_BIAST = WS_RINV + 256 * 1024;
constexpr size_t WS_PEB = WS_BIAST + 16 * 1024;
constexpr size_t WS_PEBP = WS_PEB + 4 * 1024;
constexpr size_t WS_GSLOT = 2 * MiB;
constexpr size_t WS_OSLOT = 6 * MiB;
constexpr size_t WS_W = 8 * MiB;
constexpr size_t W_RI = WS_W, W_RO = W_RI + 12 * MiB, W_FI0 = W_RO + 4 * MiB, W_FI1 = W_FI0 + 11 * MiB, W_FO0 = W_FI1 + 11 * MiB, W_FO1 = W_FO0 + 11 * MiB / 2,
                 W_KVQ = W_FO1 + 11 * MiB / 2, W_KVV = W_KVQ + 9 * MiB / 2, W_NO = W_KVV + 1 * MiB, W_C1 = W_NO + 2 * MiB, W_C2 = W_C1 + 2 * MiB, W_END = W_C2 + 1 * MiB;
static_assert(W_END <= 68 * MiB, "weights");
constexpr size_t WS_TABA = 68 * MiB, WS_TABB = 84 * MiB;
constexpr size_t WS_XB = 100 * MiB;
constexpr size_t WS_MIX = 164 * MiB;
constexpr size_t WS_KT = WS_MIX, WS_KV = WS_MIX + 32 * MiB;
constexpr size_t WS_SCR = 228 * MiB;
constexpr size_t WS_AP = WS_SCR, WS_BP = WS_AP + 96 * MiB, WS_KN = WS_BP + 96 * MiB;
static_assert(WS_KN + 32 * MiB <= 512 * MiB, "ret scratch");
constexpr size_t WS_HID = WS_SCR;
constexpr size_t WS_KC = WS_SCR, WS_VC = WS_KC + 16 * MiB, WS_KS = WS_VC + 17 * MiB, WS_KW = WS_KS + 16 * MiB, WS_VST = WS_KW + 16 * MiB, WS_VWT = WS_VST + 16 * MiB,
                 WS_Q = WS_VWT + 16 * MiB, WS_GATE = WS_Q + 64 * MiB, WS_HIDC = WS_GATE + 6 * MiB, WS_KCMP = WS_HIDC + 8 * MiB, WS_VCMPT = WS_KCMP + 1 * MiB, WS_ONSA = WS_VCMPT + 1 * MiB,
                 WS_NSA_END = WS_ONSA + 64 * MiB;
static_assert(WS_NSA_END <= 512 * MiB, "nsa scratch");
constexpr size_t WS_NEED = 512 * MiB;

#define GAS __attribute__((address_space(1)))
#define LAS __attribute__((address_space(3)))
typedef unsigned short bf16;
typedef unsigned v4u __attribute__((ext_vector_type(4)));
typedef unsigned v2u __attribute__((ext_vector_type(2)));
typedef float f32x4 __attribute__((ext_vector_type(4)));
typedef float f32x2_t __attribute__((ext_vector_type(2)));
typedef __bf16 bf16x2_t __attribute__((ext_vector_type(2)));
typedef GAS unsigned gu32;
#define RLX_AGENT __ATOMIC_RELAXED, __HIP_MEMORY_SCOPE_AGENT
__device__ __forceinline__ unsigned cvtpk(float lo, float hi) { f32x2_t v = {lo, hi}; bf16x2_t b = __builtin_convertvector(v, bf16x2_t); return __builtin_bit_cast(unsigned, b); }
__device__ __forceinline__ v4u pack8(f32x4 a, f32x4 b) { v4u w; w.x = cvtpk(a[0], a[1]); w.y = cvtpk(a[2], a[3]); w.z = cvtpk(b[0], b[1]); w.w = cvtpk(b[2], b[3]); return w; }
__device__ __forceinline__ float bflo(unsigned w) { return __uint_as_float(w << 16); }
__device__ __forceinline__ float bfhi(unsigned w) { return __uint_as_float(w & 0xffff0000u); }
__device__ __forceinline__ float bf2f(bf16 b) { return __uint_as_float(((unsigned)b) << 16); }
__device__ __forceinline__ void unpack8(v4u w, float* f) { f[0] = bflo(w.x); f[1] = bfhi(w.x); f[2] = bflo(w.y); f[3] = bfhi(w.y); f[4] = bflo(w.z); f[5] = bfhi(w.z); f[6] = bflo(w.w); f[7] = bfhi(w.w); }
__device__ __forceinline__ bf16 f2bf(float f) { return (bf16)(cvtpk(f, 0.f) & 0xffffu); }
__device__ __forceinline__ int vperm(int t) { return (t & ~12) | ((t & 4) << 1) | ((t & 8) >> 1); }
__device__ __forceinline__ float sigm(float x) { return 1.f / (1.f + __expf(-x)); }
__device__ __forceinline__ float silu(float x) { return x / (1.f + __expf(-x)); }
__device__ __forceinline__ float lg2gamma(int h) { return log2f(1.0f - exp2f(-5.0f - (float)h)); }
__device__ __forceinline__ float wave_sum(float v) {
#pragma unroll
    for (int o = 1; o < 64; o <<= 1) v += __shfl_xor(v, o);
    return v;
}
__device__ __forceinline__ float wave_max(float v) {
#pragma unroll
    for (int o = 1; o < 64; o <<= 1) v = fmaxf(v, __shfl_xor(v, o));
    return v;
}
__device__ __forceinline__ int t5_bucket(int n) {
    if (n < 16) return n;
    if (n >= 113) return 31;
    int b = 16 + (int)(logf((float)n * 0.0625f) / 2.0794415416798357f * 16.0f);
    return b < 31 ? b : 31;
}

#define XB_TMO      128
#define XB_XCNT(j)  (256  + 64 * (j))
#define XB_XSUB(j)  (1280 + 64 * (j))
#define XB_XGEN(j)  (2304 + 64 * (j))
#define XB_TOP      3328
#define XB_TOPGEN   3392
#define XCD_BAR_WORDS 3456
#define XB_SPIN_CAP (1u << 18)
__device__ __forceinline__ unsigned xb_ld(unsigned* p)              { return __hip_atomic_load(p, __ATOMIC_RELAXED, __HIP_MEMORY_SCOPE_AGENT); }
__device__ __forceinline__ unsigned xb_add(unsigned* p, unsigned v) { return __hip_atomic_fetch_add(p, v, __ATOMIC_RELAXED, __HIP_MEMORY_SCOPE_AGENT); }
__device__ __forceinline__ unsigned xb_xcc_id() { return (unsigned)__builtin_amdgcn_s_getreg((3 << 11) | 20) & 0xFu; }
#define XB_SPIN(cond, bar) do { unsigned _sp = 0; while (cond) { __builtin_amdgcn_s_sleep(1); \
    if ((++_sp & 255u) == 0u) { if (xb_ld(&(bar)[XB_TMO])) break; if (_sp > XB_SPIN_CAP) { atomicAdd(&(bar)[XB_TMO], 1u); break; } } } } while (0)
struct XcdBarrier { unsigned* bar; unsigned x; volatile LAS unsigned* st; };
__device__ __forceinline__ XcdBarrier xcd_barrier_post(unsigned* bar, volatile LAS unsigned* st) {
    XcdBarrier b; b.bar = bar; b.x = xb_xcc_id(); b.st = st;
    if (threadIdx.x == 0) { const unsigned rank = xb_add(&bar[XB_XCNT(b.x)], 1u); st[2] = rank; st[3] = b.x; }
    return b;
}
__device__ __forceinline__ void xcd_barrier_complete(unsigned* bar, unsigned x, unsigned& nloc, unsigned& nx) {
    const unsigned G = gridDim.x * gridDim.y * gridDim.z;
    unsigned sum, cnt, mine, sp = 0u;
    for (;;) {
        sum = 0u; cnt = 0u; mine = 0u;
#pragma unroll
        for (unsigned j = 0; j < 16; ++j) { const unsigned c = xb_ld(&bar[XB_XCNT(j)]); sum += c; cnt += (c > 0u) ? 1u : 0u; mine = (j == x) ? c : mine; }
        if (sum == G) break;
        __builtin_amdgcn_s_sleep(1);
        if ((++sp & 255u) == 0u) { if (xb_ld(&bar[XB_TMO])) break; if (sp > XB_SPIN_CAP) { atomicAdd(&bar[XB_TMO], 1u); break; } }
    }
    nloc = mine > 0u ? mine : 1u; nx = cnt > 0u ? cnt : 1u;
}
__device__ __forceinline__ void xcd_barrier(const XcdBarrier& b) {
    asm volatile("s_waitcnt vmcnt(0)" ::: "memory");
    __syncthreads();
    if (threadIdx.x == 0) {
        unsigned* bar = b.bar;
        __builtin_amdgcn_s_waitcnt(0);
        unsigned nloc = b.st[0], nx = b.st[1];
        if (nloc == 0u) { xcd_barrier_complete(bar, b.x, nloc, nx); b.st[0] = nloc; b.st[1] = nx; }
        const unsigned old = xb_add(&bar[XB_XSUB(b.x)], 1u);
        const unsigned gen = old / nloc;
        if (old + 1u == (gen + 1u) * nloc) {
            __builtin_amdgcn_fence(__ATOMIC_RELEASE, "agent");
            asm volatile("s_waitcnt vmcnt(0)" ::: "memory");
            const unsigned og = xb_add(&bar[XB_TOP], 1u);
            const unsigned tg = og / nx;
            if (og + 1u == (tg + 1u) * nx) xb_add(&bar[XB_TOPGEN], 1u);
            else XB_SPIN(xb_ld(&bar[XB_TOPGEN]) == tg, bar);
            __builtin_amdgcn_fence(__ATOMIC_ACQUIRE, "agent");
            xb_add(&bar[XB_XGEN(b.x)], 1u);
            asm volatile("s_waitcnt vmcnt(0)" ::: "memory");
        } else {
            XB_SPIN(xb_ld(&bar[XB_XGEN(b.x)]) == gen, bar);
            __builtin_amdgcn_fence(__ATOMIC_ACQUIRE, "agent");
            asm volatile("s_waitcnt vmcnt(0)" ::: "memory");
        }
    }
    __syncthreads();
}

using pg8::Unit;
typedef const f32x4 (&AccRef)[2][2][4][2];
#define EPI_ROW(u, ai, m) ((u).pm * 256 + (ai) * 128 + wr * 64 + (m) * 16 + fr)
#define EPI_COL(bj) ((bj) * 128 + wc * 32 + 8 * fq)

struct EpiP1N {
    static constexpr bool PERM = true, AFTER_DRAIN = false;
    const float* rinv; const f32x4* tabA; bf16* AP; bf16* KN;
    __device__ __forceinline__ void operator()(AccRef acc, const Unit& u, int wr, int wc, int fr, int fq) const {
        const int h = u.pn & 3; const bool isk = u.pn >= 4; const float lg = lg2gamma(h);
#pragma unroll
        for (int ai = 0; ai < 2; ++ai)
#pragma unroll
            for (int m = 0; m < 4; ++m) {
                const int t = EPI_ROW(u, ai, m); const int p = t & (RCH - 1), c = t / RCH;
                const float rs = rinv[t] * (isk ? 0.0625f * exp2f(-(float)p * lg) : exp2f((float)p * lg));
#pragma unroll
                for (int bj = 0; bj < 2; ++bj) {
                    const int d0 = EPI_COL(bj);
                    const f32x4 c0 = tabA[(size_t)t * 64 + (d0 >> 2)], c1 = tabA[(size_t)t * 64 + (d0 >> 2) + 1];
                    const f32x4 v0 = acc[ai][bj][m][0] * rs, v1 = acc[ai][bj][m][1] * rs;
                    const f32x4 o0 = {v0[0] * c0[0] - v0[1] * c0[1], v0[0] * c0[1] + v0[1] * c0[0], v0[2] * c0[2] - v0[3] * c0[3], v0[2] * c0[3] + v0[3] * c0[2]};
                    const f32x4 o1 = {v1[0] * c1[0] - v1[1] * c1[1], v1[0] * c1[1] + v1[1] * c1[0], v1[2] * c1[2] - v1[3] * c1[3], v1[2] * c1[3] + v1[3] * c1[2]};
                    const v4u w = pack8(o0, o1);
                    if (isk) *(v4u*)(KN + (size_t)t * 1024 + h * 256 + d0) = w;
                    else *(v4u*)(AP + ((size_t)(h * NCH + c) * RCH + p) * APLD + RCH + d0) = w;
                }
            }
    }
};
struct EpiP1S {
    static constexpr bool PERM = true, AFTER_DRAIN = false;
    const float* rinv; const f32x4* tabB; bf16* KT; bf16* BP;
    __device__ __forceinline__ void operator()(AccRef acc, const Unit& u, int wr, int wc, int fr, int fq) const {
        const bool isk = u.pm < 4; const float lg = lg2gamma(u.pm & 3);
#pragma unroll
        for (int bj = 0; bj < 2; ++bj) {
            const int t0 = u.pn * 256 + EPI_COL(bj); const int c = t0 / RCH, p0 = t0 & (RCH - 1);
            const f32x4 r0 = *(const f32x4*)(rinv + t0), r1 = *(const f32x4*)(rinv + t0 + 4);
            f32x4 s0, s1;
#pragma unroll
            for (int j = 0; j < 4; ++j) { s0[j] = r0[j] * 0.0625f * exp2f(-(float)(p0 + j) * lg); s1[j] = r1[j] * 0.0625f * exp2f(-(float)(p0 + 4 + j) * lg); }
#pragma unroll
            for (int ai = 0; ai < 2; ++ai)
#pragma unroll
                for (int m = 0; m < 4; ++m) {
                    const int row = EPI_ROW(u, ai, m);
                    if (isk) {
                        const int d = row & 255, i = d >> 1; const bool odd = d & 1;
                        const f32x4 v0 = acc[ai][bj][m][0] * s0, v1 = acc[ai][bj][m][1] * s1; f32x4 q0, q1;
#pragma unroll
                        for (int j = 0; j < 4; ++j) { q0[j] = __shfl_xor(v0[j], 1); q1[j] = __shfl_xor(v1[j], 1); }
                        const f32x4* tb = tabB + ((size_t)i * SEQ + t0) / 2;
                        const f32x4 ca = tb[0], cb = tb[1], cc = tb[2], cd = tb[3];
                        f32x4 o0, o1;
                        if (odd) { o0 = (f32x4){q0[0] * ca[1] + v0[0] * ca[0], q0[1] * ca[3] + v0[1] * ca[2], q0[2] * cb[1] + v0[2] * cb[0], q0[3] * cb[3] + v0[3] * cb[2]};
                                   o1 = (f32x4){q1[0] * cc[1] + v1[0] * cc[0], q1[1] * cc[3] + v1[1] * cc[2], q1[2] * cd[1] + v1[2] * cd[0], q1[3] * cd[3] + v1[3] * cd[2]}; }
                        else     { o0 = (f32x4){v0[0] * ca[0] - q0[0] * ca[1], v0[1] * ca[2] - q0[1] * ca[3], v0[2] * cb[0] - q0[2] * cb[1], v0[3] * cb[2] - q0[3] * cb[3]};
                                   o1 = (f32x4){v1[0] * cc[0] - q1[0] * cc[1], v1[1] * cc[2] - q1[1] * cc[3], v1[2] * cd[0] - q1[2] * cd[1], v1[3] * cd[2] - q1[3] * cd[3]}; }
                        *(v4u*)(KT + (size_t)row * SEQ + t0) = pack8(o0, o1);
                    } else {
                        const int eg = row - 1024, h = eg >> 9, e = eg & 511;
                        *(v4u*)(BP + ((size_t)(h * NCH + c) * RCH + e) * APLD + p0) = pack8(acc[ai][bj][m][0] * r0, acc[ai][bj][m][1] * r1);
                    }
                }
        }
    }
};
struct EpiG {
    static constexpr bool PERM = true, AFTER_DRAIN = false;
    const float* rinv; const float* gslots; bf16* O;
    __device__ __forceinline__ void operator()(AccRef acc, const Unit& u, int wr, int wc, int fr, int fq) const {
        const int h = u.pn >> 1;
#pragma unroll
        for (int ai = 0; ai < 2; ++ai)
#pragma unroll
            for (int m = 0; m < 4; ++m) {
                const int row = EPI_ROW(u, ai, m); const float rin = rinv[row];
                const f32x4 sa = *(const f32x4*)(gslots + (size_t)row * 32 + h * 8), sb = *(const f32x4*)(gslots + (size_t)row * 32 + h * 8 + 4);
                const float ss = ((sa[0] + sa[1]) + (sa[2] + sa[3])) + ((sb[0] + sb[1]) + (sb[2] + sb[3]));
                const float rs = rsqrtf(ss * (1.0f / RDV) + RMS_EPS);
#pragma unroll
                for (int bj = 0; bj < 2; ++bj) {
                    bf16* op = O + (size_t)row * 2048 + u.pn * 256 + EPI_COL(bj);
                    float o[8]; unpack8(*(const v4u*)op, o);
                    const f32x4 g0 = acc[ai][bj][m][0] * rin, g1 = acc[ai][bj][m][1] * rin; f32x4 a, b;
#pragma unroll
                    for (int j = 0; j < 4; ++j) { a[j] = o[j] * rs * silu(g0[j]); b[j] = o[4 + j] * rs * silu(g1[j]); }
                    *(v4u*)op = pack8(a, b);
                }
            }
    }
};
struct EpiOut {
    static constexpr bool PERM = true, AFTER_DRAIN = false;
    bf16* MIX; float* oslots;
    __device__ __forceinline__ void operator()(AccRef acc, const Unit& u, int wr, int wc, int fr, int fq) const {
#pragma unroll
        for (int ai = 0; ai < 2; ++ai)
#pragma unroll
            for (int m = 0; m < 4; ++m) {
                const int row = EPI_ROW(u, ai, m); float ss = 0.f;
#pragma unroll
                for (int bj = 0; bj < 2; ++bj) {
                    const f32x4 v0 = acc[ai][bj][m][0], v1 = acc[ai][bj][m][1];
                    ss += (v0[0] * v0[0] + v0[1] * v0[1]) + (v0[2] * v0[2] + v0[3] * v0[3]) + (v1[0] * v1[0] + v1[1] * v1[1]) + (v1[2] * v1[2] + v1[3] * v1[3]);
                    *(v4u*)(MIX + (size_t)row * 1024 + u.pn * 256 + EPI_COL(bj)) = pack8(v0, v1);
                }
                ss += __shfl_xor(ss, 16); ss += __shfl_xor(ss, 32);
                if (fq == 0) oslots[(size_t)row * 16 + u.pn * 4 + wc] = ss;
            }
    }
};
struct EpiFfnIn {
    static constexpr bool PERM = true, AFTER_DRAIN = false;
    const float* rinv; bf16* HID;
    __device__ __forceinline__ void operator()(AccRef acc, const Unit& u, int wr, int wc, int fr, int fq) const {
#pragma unroll
        for (int ai = 0; ai < 2; ++ai)
#pragma unroll
            for (int m = 0; m < 4; ++m) {
                const int row = EPI_ROW(u, ai, m); const float rin = rinv[row];
                const f32x4 a0 = acc[ai][0][m][0] * rin, a1 = acc[ai][0][m][1] * rin, b0 = acc[ai][1][m][0] * rin, b1 = acc[ai][1][m][1] * rin; f32x4 x, y;
#pragma unroll
                for (int j = 0; j < 4; ++j) { x[j] = silu(a0[j]) * b0[j]; y[j] = silu(a1[j]) * b1[j]; }
                *(v4u*)(HID + (size_t)row * FFH + u.pn * 128 + wc * 32 + 8 * fq) = pack8(x, y);
            }
    }
};
struct EpiKvqN {
    static constexpr bool PERM = true, AFTER_DRAIN = false;
    const float* rinv; bf16 *KC, *VC, *KS, *KW, *Q; float* GATE;
    __device__ __forceinline__ void operator()(AccRef acc, const Unit& u, int wr, int wc, int fr, int fq) const {
        bf16* plane = u.pn == 0 ? KC : u.pn == 1 ? VC : u.pn == 2 ? KS : KW;
#pragma unroll
        for (int ai = 0; ai < 2; ++ai)
#pragma unroll
            for (int m = 0; m < 4; ++m) {
                const int row = EPI_ROW(u, ai, m); const float rin = rinv[row]; const int b = row / SEQ, t = row % SEQ;
#pragma unroll
                for (int bj = 0; bj < 2; ++bj) {
                    const int cc = EPI_COL(bj);
                    f32x4 v0 = acc[ai][bj][m][0] * rin, v1 = acc[ai][bj][m][1] * rin;
                    if (u.pn < 4) { const int g = cc >> 6, d = cc & 63;
                        const int o = u.pn == 2 ? (t & ~63) * HD + ((((t >> 5) & 1) * 4 + (d >> 4)) * 64 + ((d >> 3) & 1) * 32 + (t & 31)) * 8 : t * HD + d;
                        *(v4u*)(plane + (size_t)(b * NG + g) * SEQ * HD + o) = pack8(v0, v1); }
                    else { *(v4u*)(Q + (size_t)row * 1024 + (u.pn - 4) * 256 + cc) = pack8(v0 * (0.125f * 1.4426950408889634f), v1 * (0.125f * 1.4426950408889634f)); }
                }
            }
    }
};
struct EpiGate {
    static constexpr bool PERM = true, AFTER_DRAIN = false;
    const float* rinv; float* GATE;
    __device__ __forceinline__ void operator()(AccRef acc, const Unit& u, int wr, int wc, int fr, int fq) const {
#pragma unroll
        for (int ai = 0; ai < 2; ++ai)
#pragma unroll
            for (int m = 0; m < 4; ++m) {
                const int row = EPI_ROW(u, ai, m); const float rin = rinv[row]; const int cc = EPI_COL(0);
                if (cc < 48) { f32x4 v0 = acc[ai][0][m][0] * rin, v1 = acc[ai][0][m][1] * rin;
#pragma unroll
                    for (int j = 0; j < 4; ++j) { v0[j] = sigm(v0[j]); v1[j] = sigm(v1[j]); }
                    *(f32x4*)(GATE + (size_t)row * 48 + cc) = v0; *(f32x4*)(GATE + (size_t)row * 48 + cc + 4) = v1; }
            }
    }
};
struct EpiKvqS {
    static constexpr bool PERM = true, AFTER_DRAIN = false;
    const float* rinv; bf16 *VST, *VWT; unsigned* vmx;
    __device__ __forceinline__ void operator()(AccRef acc, const Unit& u, int wr, int wc, int fr, int fq) const {
        bf16* plane = u.pm == 0 ? VST : VWT;
        float vm[2] = {0.f, 0.f};
#pragma unroll
        for (int bj = 0; bj < 2; ++bj) {
            const int mg = u.pn * 256 + EPI_COL(bj); const int b = mg / SEQ, t = mg % SEQ;
            const f32x4 r0 = *(const f32x4*)(rinv + mg), r1 = *(const f32x4*)(rinv + mg + 4);
#pragma unroll
            for (int ai = 0; ai < 2; ++ai)
#pragma unroll
                for (int m = 0; m < 4; ++m) {
                    const int r256 = ai * 128 + wr * 64 + m * 16 + fr; const int g = r256 >> 6, d = r256 & 63;
                    const f32x4 w0 = acc[ai][bj][m][0] * r0, w1 = acc[ai][bj][m][1] * r1;
                    const v4u pk = pack8(w0, w1);
                    v2u lo; lo.x = pk.x; lo.y = pk.y; v2u hi; hi.x = pk.z; hi.y = pk.w;
                    if (u.pm == 0) {
                        vm[ai] = fmaxf(vm[ai], fmaxf(fmaxf(fmaxf(fabsf(w0[0]), fabsf(w0[1])), fmaxf(fabsf(w0[2]), fabsf(w0[3]))), fmaxf(fmaxf(fabsf(w1[0]), fabsf(w1[1])), fmaxf(fabsf(w1[2]), fabsf(w1[3])))));
                        bf16* fp = plane + (size_t)(b * NG + g) * HD * SEQ + (size_t)(t >> 6) * 4096 + ((((t >> 4) & 3) * 2 + (d >> 5)) * 64 + (d & 31)) * 8 + 4 * ((t >> 3) & 1);
                        *(v2u*)fp = lo; *(v2u*)(fp + 256) = hi;
                    } else { bf16* rowp = plane + ((size_t)((b * NG + g) * HD + d)) * SEQ; *(v2u*)(rowp + vperm(t)) = lo; *(v2u*)(rowp + vperm(t + 4)) = hi; }
                }
        }
        if (u.pm == 0) {
#pragma unroll
            for (int ai = 0; ai < 2; ++ai) { const float mx = wave_max(vm[ai]);
                if ((fr | fq) == 0) __hip_atomic_fetch_max(vmx + ((u.pn * 256) / SEQ) * NG + 2 * ai + wr, __float_as_uint(mx), __ATOMIC_RELAXED, __HIP_MEMORY_SCOPE_AGENT); }
        }
    }
};
struct EpiCmp {
    static constexpr bool PERM = true, AFTER_DRAIN = false;
    const float* peb; bf16* HIDC;
    __device__ __forceinline__ void operator()(AccRef acc, const Unit& u, int wr, int wc, int fr, int fq) const {
        const int kv = u.pm >= 32 ? 1 : 0;
#pragma unroll
        for (int bj = 0; bj < 2; ++bj) {
            const int col = EPI_COL(bj);
            const f32x4 b0 = *(const f32x4*)(peb + kv * 256 + col), b1 = *(const f32x4*)(peb + kv * 256 + col + 4);
#pragma unroll
            for (int ai = 0; ai < 2; ++ai)
#pragma unroll
                for (int m = 0; m < 4; ++m) {
                    const int row = EPI_ROW(u, ai, m); f32x4 x = acc[ai][bj][m][0] + b0, y = acc[ai][bj][m][1] + b1;
#pragma unroll
                    for (int j = 0; j < 4; ++j) { x[j] = silu(x[j]); y[j] = silu(y[j]); }
                    *(v4u*)(HIDC + (size_t)row * 256 + col) = pack8(x, y);
                }
        }
    }
};
struct MapCmp { __device__ __forceinline__ void operator()(Unit& u) const { u.offA = (size_t)u.pm * 256 * 1024 * 2; u.offB = (size_t)(u.pm >= 32 ? 256 : 0) * 2048 * 2; } };

struct MapKV { __device__ __forceinline__ void operator()(Unit& u) const { const int hc = u.pm >> 1, eh = u.pm & 1, h = hc / NCH, c = hc % NCH;
    u.offA = ((size_t)(hc * RCH + eh * 256) * APLD) * 2; u.offB = ((size_t)(h * RDK) * SEQ + (size_t)c * RCH) * 2; } };
struct EpiKV {
    static constexpr bool PERM = true, AFTER_DRAIN = false;
    bf16* KV;
    __device__ __forceinline__ void operator()(AccRef acc, const Unit& u, int wr, int wc, int fr, int fq) const {
#pragma unroll
        for (int ai = 0; ai < 2; ++ai)
#pragma unroll
            for (int m = 0; m < 4; ++m) { const int row = EPI_ROW(u, ai, m);
#pragma unroll
                for (int bj = 0; bj < 2; ++bj) *(v4u*)(KV + (size_t)row * RDK + EPI_COL(bj)) = pack8(acc[ai][bj][m][0], acc[ai][bj][m][1]); }
    }
};
struct MapS { __device__ __forceinline__ void operator()(Unit& u) const { const int hc = u.pm >> 1, qh = u.pm & 1, h = hc / NCH, c = hc % NCH;
    u.offA = ((size_t)(hc * RCH + qh * 256) * APLD + RCH) * 2; u.offB = ((size_t)(c * RCH + u.pn * 256) * 1024 + h * RDK) * 2; } };
struct EpiS {
    static constexpr bool PERM = true, AFTER_DRAIN = false;
    bf16* AP;
    __device__ __forceinline__ void operator()(AccRef acc, const Unit& u, int wr, int wc, int fr, int fq) const {
        const int qh = u.pm & 1;
#pragma unroll
        for (int ai = 0; ai < 2; ++ai)
#pragma unroll
            for (int m = 0; m < 4; ++m) { const int row = EPI_ROW(u, ai, m); const int qi = qh * 256 + ai * 128 + wr * 64 + m * 16 + fr;
#pragma unroll
                for (int bj = 0; bj < 2; ++bj) { const int k0 = u.pn * 256 + EPI_COL(bj); f32x4 v0 = acc[ai][bj][m][0], v1 = acc[ai][bj][m][1];
#pragma unroll
                    for (int j = 0; j < 4; ++j) { if (k0 + j > qi) v0[j] = 0.f; if (k0 + 4 + j > qi) v1[j] = 0.f; }
                    *(v4u*)(AP + (size_t)row * APLD + k0) = pack8(v0, v1); } }
    }
};
struct MapO { __device__ __forceinline__ void operator()(Unit& u) const { const int hc = u.pm >> 1, qh = u.pm & 1;
    u.offA = ((size_t)(hc * RCH + qh * 256) * APLD) * 2; u.offB = ((size_t)(hc * RCH + u.pn * 256) * APLD) * 2; } };
struct EpiO {
    static constexpr bool PERM = true, AFTER_DRAIN = false;
    bf16* O; float* gslots; int b;
    __device__ __forceinline__ void operator()(AccRef acc, const Unit& u, int wr, int wc, int fr, int fq) const {
        const int hc = u.pm >> 1, qh = u.pm & 1, h = hc / NCH, c = hc % NCH;
#pragma unroll
        for (int ai = 0; ai < 2; ++ai)
#pragma unroll
            for (int m = 0; m < 4; ++m) { const size_t row = (size_t)b * SEQ + c * RCH + qh * 256 + ai * 128 + wr * 64 + m * 16 + fr; float ss = 0.f;
#pragma unroll
                for (int bj = 0; bj < 2; ++bj) { const f32x4 v0 = acc[ai][bj][m][0], v1 = acc[ai][bj][m][1];
                    ss += (v0[0] * v0[0] + v0[1] * v0[1]) + (v0[2] * v0[2] + v0[3] * v0[3]) + (v1[0] * v1[0] + v1[1] * v1[1]) + (v1[2] * v1[2] + v1[3] * v1[3]);
                    *(v4u*)(O + row * 2048 + h * RDV + u.pn * 256 + EPI_COL(bj)) = pack8(v0, v1); }
                ss += __shfl_xor(ss, 16); ss += __shfl_xor(ss, 32);
                if (fq == 0) gslots[row * 32 + h * 8 + u.pn * 4 + wc] = ss; }
    }
};

constexpr int NWAVES = 8, NTHREADS = NWAVES * 64;
constexpr int RING_OFF = 0, RING_BYTES = 131072;
constexpr int LDS_BYTES = 163840;
constexpr int LDSCTL_OFF = LDS_BYTES - 1024, MISC_OFF = LDSCTL_OFF + 320;
constexpr int CW_BAR = 4096;

struct Args { const float* in[20]; float* out; unsigned char* ws; int ph, b; };
struct Frame {
    LAS unsigned char* lds; unsigned char* ws; float* out; const float* const* in;
    int tid, lane, wave, G, vcu, gw, NGW;
};

template <class T> __device__ __forceinline__ T* gp(T* p) { return (T*)(GAS T*)p; }
struct TDesc { const float* W; const float* gain; bf16* WT; int K, ldw, ncols, nblk, mode, off, start, pad; };
__device__ __forceinline__ int dest_row(int mode, int off, int n) {
    if (mode == 1) { const int up = n >= FFH, j = up ? n - FFH : n; return (j >> 7) * 256 + up * 128 + (j & 127); }
    if (mode == 2) { const int s = n >> 8, d = n & 255; return s < 3 ? n : s == 3 ? 2304 + d : s == 4 ? 768 + d : 2304 + 256 + d; }
    return n + off;
}
__device__ __forceinline__ void transpose_item(const LAS TDesc& D, LAS float* scr, int it, int lane) {
    const float* W = D.W; const float* gain = D.gain; const int K = D.K, ldw = D.ldw, ncols = D.ncols, nblk = D.nblk;
    const int k0 = 64 * (it / nblk), n0 = 32 * (it % nblk);
    const int q = lane & 7, kr = lane >> 3;
#pragma unroll
    for (int i = 0; i < 8; ++i) { const int kk = 8 * i + kr, n = n0 + 4 * q;
        f32x4 v = {0.f, 0.f, 0.f, 0.f}; if (n < ncols) v = *(const f32x4*)(W + (size_t)(k0 + kk) * ldw + n);
        if (gain) v *= gain[k0 + kk];
        LAS float* s = scr + kk * 33 + 4 * q; s[0] = v[0]; s[1] = v[1]; s[2] = v[2]; s[3] = v[3]; }
    asm volatile("s_waitcnt lgkmcnt(0)" ::: "memory");
    const int c = lane & 7;
#pragma unroll
    for (int j = 0; j < 4; ++j) { const int n = (lane >> 3) + 8 * j; const LAS float* s = scr + (8 * c) * 33 + n;
        v4u o; o.x = cvtpk(s[0 * 33], s[1 * 33]); o.y = cvtpk(s[2 * 33], s[3 * 33]); o.z = cvtpk(s[4 * 33], s[5 * 33]); o.w = cvtpk(s[6 * 33], s[7 * 33]);
        *(v4u*)(D.WT + (size_t)dest_row(D.mode, D.off, n0 + n) * K + k0 + 8 * c) = o; }
    asm volatile("s_waitcnt lgkmcnt(0)" ::: "memory");
}

__device__ __forceinline__ void row_to_bf16(const float* xrow, bf16* orow, float* rinv, int lane) {
    const f32x4* xr = (const f32x4*)xrow + lane; f32x4 v[4]; float s = 0.f;
#pragma unroll
    for (int j = 0; j < 4; ++j) { v[j] = xr[64 * j]; s += (v[j][0] * v[j][0] + v[j][1] * v[j][1]) + (v[j][2] * v[j][2] + v[j][3] * v[j][3]); }
    s = wave_sum(s);
    v2u* o8 = (v2u*)orow + lane;
#pragma unroll
    for (int j = 0; j < 4; ++j) { v2u w; w.x = cvtpk(v[j][0], v[j][1]); w.y = cvtpk(v[j][2], v[j][3]); o8[64 * j] = w; }
    if (lane == 0) *rinv = rsqrtf(s * (1.0f / DM) + RMS_EPS);
}

constexpr int NTD = 13;
__device__ __forceinline__ void phase_prologue(const Frame& F) {
    unsigned char* ws = F.ws; const float* in[20];
#pragma unroll
    for (int i = 0; i < 20; ++i) in[i] = gp(F.in[i]);
    LAS TDesc* TD = (LAS TDesc*)(F.lds + RING_OFF + 8 * 16384);
    if (F.tid == 0) {
        int st = 0;
#define TDSET(k, W_, K_, ldw_, nc_, ncp_, gain_, WT_, mode_, off_) do { TD[k].W = (W_); TD[k].gain = (gain_); TD[k].WT = (bf16*)(WT_); TD[k].K = (K_); TD[k].ldw = (ldw_); TD[k].ncols = (nc_); \
            TD[k].nblk = (ncp_) / 32; TD[k].mode = (mode_); TD[k].off = (off_); TD[k].start = st; st += ((K_) / 64) * ((ncp_) / 32); } while (0)
        TDSET(0, in[7], DM, RIN, RIN, RIN, in[1], ws + W_RI, 0, 0);
        TDSET(1, in[8], 2048, DM, DM, DM, (const float*)nullptr, ws + W_RO, 0, 0);
        TDSET(2, in[5], DM, 2 * FFH, 2 * FFH, 2 * FFH, in[3], ws + W_FI0, 1, 0);
        TDSET(3, in[5] + (size_t)DM * 2 * FFH, DM, 2 * FFH, 2 * FFH, 2 * FFH, in[3] + DM, ws + W_FI1, 1, 0);
        TDSET(4, in[6], FFH, DM, DM, DM, (const float*)nullptr, ws + W_FO0, 0, 0);
        TDSET(5, in[6] + (size_t)FFH * DM, FFH, DM, DM, DM, (const float*)nullptr, ws + W_FO1, 0, 0);
        TDSET(6, in[10], DM, 1536, 1536, 1536, in[9], ws + W_KVQ, 2, 0);
        TDSET(7, in[17], DM, NSAIN, NSAIN, 1280, in[1] + DM, ws + W_KVQ, 0, 1024);
        TDSET(8, in[18], DM, DM, DM, DM, (const float*)nullptr, ws + W_NO, 0, 0);
        TDSET(9, in[12], 2048, 256, 256, 256, (const float*)nullptr, ws + W_C1, 0, 0);
        TDSET(10, in[15], 2048, 256, 256, 256, (const float*)nullptr, ws + W_C1, 0, 256);
        TDSET(11, in[13], 256, 64, 64, 64, (const float*)nullptr, ws + W_C2, 0, 0);
        TDSET(12, in[16], 256, 64, 64, 64, (const float*)nullptr, ws + W_C2, 0, 64);
#undef TDSET
        TD[NTD].start = st;
    }
    __syncthreads();
    const int NT = TD[NTD].start, NJ = NT + MTOK + SEQ * 128 / 64;
    LAS float* scr = (LAS float*)(F.lds + RING_OFF + F.wave * 16384);
    f32x2_t* tabA = (f32x2_t*)(ws + WS_TABA); f32x2_t* tabB = (f32x2_t*)(ws + WS_TABB);
    for (int jb = F.gw; jb < NJ; jb += F.NGW) {
        const int it = (int)(((long long)jb * 7919) % NJ);
        if (it < NT) {
            int k = 0;
#pragma unroll
            for (int q = 1; q < NTD; ++q) k = it >= TD[q].start ? q : k;
            transpose_item(TD[k], scr, it - TD[k].start, F.lane);
        } else if (it < NT + MTOK) {
            const int m = it - NT; row_to_bf16(in[0] + (size_t)m * DM, (bf16*)(ws + WS_XB) + (size_t)m * DM, (float*)(ws + WS_RINV) + m, F.lane);
        } else {
            const int idx = (it - NT - MTOK) * 64 + F.lane, t = idx >> 7, i = idx & 127;
            const float theta = 1.0f / powf(10000.0f, (float)i * (1.0f / 127.0f));
            const float ang = (float)t * theta; float s, c; sincosf(ang, &s, &c);
            const f32x2_t v = {c, s}; tabA[idx] = v; tabB[(size_t)i * SEQ + t] = v;
        }
    }
    if (blockIdx.x == 0) for (int i = F.tid; i < 128 * 16; i += NTHREADS) ((float*)(ws + WS_BIAST))[i] = in[19][t5_bucket(i >> 4) * 16 + (i & 15)];
    if (blockIdx.x < 32) {
        const int kv = F.tid >> 8, c = F.tid & 255; const float* pe = kv ? in[14] : in[11]; const float* w1 = kv ? in[15] : in[12]; float s = 0.f;
        for (int k = 64 * blockIdx.x; k < 64 * blockIdx.x + 64; ++k) s += pe[k] * w1[(size_t)k * 256 + c];
        ((float*)(ws + WS_PEBP))[blockIdx.x * 512 + F.tid] = s;
    }
}
__device__ __forceinline__ void phase_peb_final(const Frame& F) {
    if (blockIdx.x == 0) { float s = 0.f; for (int w = 0; w < 32; ++w) s += ((const float*)(F.ws + WS_PEBP))[w * 512 + F.tid]; ((float*)(F.ws + WS_PEB))[F.tid] = s; }
}

__device__ __forceinline__ void phase_resid(const Frame& F, const float* hold_f32, const float* gpost, bool last) {
    const bf16* MIX = (const bf16*)(F.ws + WS_MIX); const float* oslots = (const float*)(F.ws + WS_OSLOT);
    bf16* XB = (bf16*)(F.ws + WS_XB); float* rinv = (float*)(F.ws + WS_RINV);
    f32x4 gp[4];
#pragma unroll
    for (int j = 0; j < 4; ++j) gp[j] = ((const f32x4*)gpost)[F.lane + 64 * j];
    for (int m0 = F.gw; m0 < MTOK; m0 += 2 * F.NGW) {
        f32x4 hn[2][4]; float sq[2]; float rs[2];
#pragma unroll
        for (int r = 0; r < 2; ++r) { const int m = m0 + r * F.NGW < MTOK ? m0 + r * F.NGW : m0;
            const f32x4* sl = (const f32x4*)(oslots + (size_t)m * 16); const f32x4 s0 = sl[0], s1 = sl[1], s2 = sl[2], s3 = sl[3];
            const float ss = (((s0[0] + s0[1]) + (s0[2] + s0[3])) + ((s1[0] + s1[1]) + (s1[2] + s1[3]))) + (((s2[0] + s2[1]) + (s2[2] + s2[3])) + ((s3[0] + s3[1]) + (s3[2] + s3[3])));
            rs[r] = rsqrtf(ss * (1.0f / DM) + RMS_EPS);
            const v2u* mr = (const v2u*)(MIX + (size_t)m * DM) + F.lane; const v2u* xr = (const v2u*)(XB + (size_t)m * DM) + F.lane;
            sq[r] = 0.f;
#pragma unroll
            for (int j = 0; j < 4; ++j) { f32x4 hv;
                if (hold_f32) hv = ((const f32x4*)(hold_f32 + (size_t)m * DM) + F.lane)[64 * j];
                else { const v2u hw = xr[64 * j]; hv = (f32x4){bflo(hw.x), bfhi(hw.x), bflo(hw.y), bfhi(hw.y)}; }
                const v2u mw = mr[64 * j]; const f32x4 mx = {bflo(mw.x), bfhi(mw.x), bflo(mw.y), bfhi(mw.y)};
                hn[r][j] = hv + mx * rs[r] * gp[j]; sq[r] += (hn[r][j][0] * hn[r][j][0] + hn[r][j][1] * hn[r][j][1]) + (hn[r][j][2] * hn[r][j][2] + hn[r][j][3] * hn[r][j][3]); } }
#pragma unroll
        for (int r = 0; r < 2; ++r) { const int m = m0 + r * F.NGW; if (m >= MTOK) break;
            if (last) { f32x4* ho = (f32x4*)(F.out + (size_t)m * DM) + F.lane;
#pragma unroll
                for (int j = 0; j < 4; ++j) ho[64 * j] = hn[r][j];
            } else {
                const float s = wave_sum(sq[r]); v2u* xw = (v2u*)(XB + (size_t)m * DM) + F.lane;
#pragma unroll
                for (int j = 0; j < 4; ++j) { v2u w; w.x = cvtpk(hn[r][j][0], hn[r][j][1]); w.y = cvtpk(hn[r][j][2], hn[r][j][3]); xw[64 * j] = w; }
                if (F.lane == 0) rinv[m] = rsqrtf(s * (1.0f / DM) + RMS_EPS);
            } }
    }
}

__device__ __forceinline__ void phase_cmp2(const Frame& F) {
    typedef short s8_t __attribute__((ext_vector_type(8))); typedef float f16_t __attribute__((ext_vector_type(16)));
    const bf16* HIDC = (const bf16*)(F.ws + WS_HIDC); bf16* KCMP = (bf16*)(F.ws + WS_KCMP); bf16* VCT = (bf16*)(F.ws + WS_VCMPT); const bf16* W2T = (const bf16*)(F.ws + W_C2);
    const int r32 = F.lane & 31, h = F.lane >> 5;
    for (int task = F.gw; task < 1024; task += F.NGW) {
        const int R0 = (task >> 1) * 32, ch = task & 1, kv = R0 >> 13, pl = (R0 >> 10) & 7, n0 = R0 & 1023;
        const GAS s8_t* xp = (const GAS s8_t*)(GAS bf16*)(HIDC + (size_t)(R0 + r32) * 256 + 8 * h);
        const GAS s8_t* wp = (const GAS s8_t*)(GAS bf16*)(W2T + (size_t)(kv * 64 + ch * 32 + r32) * 256 + 8 * h);
        s8_t x[16], wv[16];
#pragma unroll
        for (int s = 0; s < 16; ++s) { x[s] = xp[2 * s]; wv[s] = wp[2 * s]; }
        f16_t acc;
#pragma unroll
        for (int r = 0; r < 16; ++r) acc[r] = 0.f;
        if (kv == 0) {
#pragma unroll
            for (int s = 0; s < 16; ++s) acc = __builtin_amdgcn_mfma_f32_32x32x16_bf16(wv[s], x[s], acc, 0, 0, 0);
            const int n = n0 + r32; const float z = n == NCMP ? 0.f : 1.f;
#pragma unroll
            for (int a = 0; a < 4; ++a) { v2u pk; pk.x = cvtpk(acc[4 * a] * z, acc[4 * a + 1] * z); pk.y = cvtpk(acc[4 * a + 2] * z, acc[4 * a + 3] * z);
                *(v2u*)(KCMP + ((size_t)pl * 1024 + n) * 64 + ch * 32 + 8 * a + 4 * h) = pk; }
        } else {
#pragma unroll
            for (int s = 0; s < 16; ++s) acc = __builtin_amdgcn_mfma_f32_32x32x16_bf16(x[s], wv[s], acc, 0, 0, 0);
            if (n0 == 992 && h == 1) acc[15] = 0.f;
            const int d = ch * 32 + r32;
#pragma unroll
            for (int a = 0; a < 4; ++a) { v2u pk; pk.x = cvtpk(acc[4 * a], acc[4 * a + 1]); pk.y = cvtpk(acc[4 * a + 2], acc[4 * a + 3]);
                *(v2u*)(VCT + ((size_t)pl * 64 + d) * 1024 + vperm(n0 + 8 * a + 4 * h)) = pk; }
        }
    }
}

__device__ __forceinline__ void phase_ret_scan(const Frame& F) {
    const bf16* KV = (const bf16*)(F.ws + WS_KV); bf16* BP = (bf16*)(F.ws + WS_BP);
    for (int it = F.vcu * NTHREADS + F.tid; it < RH * RDV * (RDK / 8); it += F.G * NTHREADS) {
        const int d8 = it & 31, e = (it >> 5) & 511, h = it >> 14;
        const float cdec = exp2f((float)RCH * lg2gamma(h));
        float carry[8];
#pragma unroll
        for (int i = 0; i < 8; ++i) carry[i] = 0.f;
#pragma unroll 4
        for (int c = 0; c < NCH; ++c) {
            const size_t r = (size_t)(h * NCH + c) * RCH + e;
            float kv[8]; unpack8(*(const v4u*)(KV + r * RDK + d8 * 8), kv);
            v4u w; w.x = cvtpk(carry[0], carry[1]); w.y = cvtpk(carry[2], carry[3]); w.z = cvtpk(carry[4], carry[5]); w.w = cvtpk(carry[6], carry[7]);
            *(v4u*)(BP + r * APLD + RCH + d8 * 8) = w;
#pragma unroll
            for (int i = 0; i < 8; ++i) carry[i] = cdec * (carry[i] + kv[i]);
        }
    }
}

namespace nsa {
typedef float f32x16 __attribute__((ext_vector_type(16)));
typedef short s16x8 __attribute__((ext_vector_type(8)));
constexpr int KP = 64, SLOTB = 8192, GC = 2, GS = 4;
constexpr float LOG2E = 1.4426950408889634f, NEGB = -1.0e30f;
constexpr int L_IMP = 4 * GC * SLOTB, IMP_P = 260, L_SELM = L_IMP + 64 * IMP_P * 4, L_BT = L_SELM + 2048, L_UNI = L_BT + 2048, L_LIST = L_UNI + 64, L_END = L_LIST + 1024 + 16;
static_assert(L_END <= LDSCTL_OFF, "nsa lds");
constexpr int NB_P = 264, L_NB = 137344;
static_assert(L_NB >= L_END && L_NB % 16 == 0 && L_NB + 16 * NB_P * 4 <= LDSCTL_OFF, "bias table");
constexpr float IMP_SC = 67108864.f;
constexpr int L_SQ = 0, L_SM = 32768, L_SL = L_SM + 1024, L_TL = L_SL + 1024, TL_CAP = 320, L_TC = L_TL + TL_CAP * 4, L_TOK = L_TC + 64, L_SMF = L_TOK + TL_CAP * 32, L_SEND = L_SMF + 1024, SO_P = 66, L_SO = 64000;
static_assert(L_SEND <= L_SO && L_TOK % 32 == 0 && L_SO + 256 * SO_P * 4 <= L_SELM && L_SO % 16 == 0 && (256 * SO_P * 4) % 16 == 0, "sel lds");
__device__ __forceinline__ constexpr int krow(int r) { return (r & 3) + 8 * (r >> 2); }

__device__ __forceinline__ void tile_issue(LAS unsigned char* L, int koff, int voff, const bf16* Kg, const bf16* Vg, int ldv, int w, int lane) {
    asm volatile("" : "+v"(lane));
    const int row = 8 * w + (lane >> 3), c = (lane & 7) ^ ((row ^ (row >> 3)) & 7);
    __builtin_amdgcn_global_load_lds((const unsigned*)(Kg + (size_t)row * 64 + c * 8), (LAS unsigned*)(L + koff + w * 1024), 16, 0, 0);
    __builtin_amdgcn_global_load_lds((const unsigned*)(Vg + (size_t)row * ldv + c * 8), (LAS unsigned*)(L + voff + w * 1024), 16, 0, 0);
}
__device__ __forceinline__ void ktile_issue(LAS unsigned char* L, int koff, const bf16* Kg, int w, int lane) {
    asm volatile("" : "+v"(lane));
    const int row = 8 * w + (lane >> 3), c = (lane & 7) ^ ((row ^ (row >> 3)) & 7);
    __builtin_amdgcn_global_load_lds((const unsigned*)(Kg + (size_t)row * 64 + c * 8), (LAS unsigned*)(L + koff + w * 1024), 16, 0, 0);
}
struct KVFrag { s16x8 k[4], v[2][2]; };
__device__ __forceinline__ void frag_load(KVFrag& f, const LAS bf16* Kl, const LAS bf16* Vl, int kt, int r32, int h) {
    const int kr = 32 * kt + r32;
#pragma unroll
    for (int s = 0; s < 4; ++s) f.k[s] = *(const LAS s16x8*)(Kl + kr * KP + 8 * ((2 * s + h) ^ ((kr ^ (kr >> 3)) & 7)));
#pragma unroll
    for (int s2 = 0; s2 < 2; ++s2)
#pragma unroll
        for (int dt = 0; dt < 2; ++dt) { const int d = 32 * dt + r32; f.v[s2][dt] = *(const LAS s16x8*)(Vl + d * KP + 8 * ((4 * kt + 2 * s2 + h) ^ ((d ^ (d >> 3)) & 7))); }
    __builtin_amdgcn_sched_barrier(0);
}
__device__ __forceinline__ f32x16 qk_tile(const KVFrag& f, const s16x8 (&qf)[4], float cinit) {
    f32x16 p;
#pragma unroll
    for (int r = 0; r < 16; ++r) p[r] = cinit;
#pragma unroll
    for (int s = 0; s < 4; ++s) p = __builtin_amdgcn_mfma_f32_32x32x16_bf16(f.k[s], qf[s], p, 0, 0, 0);
    return p;
}
__device__ __forceinline__ void pv_tile(f32x16 (&o)[2], const KVFrag& f, const f32x16& p) {
#pragma unroll
    for (int s2 = 0; s2 < 2; ++s2) {
        v4u pw; pw.x = cvtpk(p[8 * s2 + 0], p[8 * s2 + 1]); pw.y = cvtpk(p[8 * s2 + 2], p[8 * s2 + 3]); pw.z = cvtpk(p[8 * s2 + 4], p[8 * s2 + 5]); pw.w = cvtpk(p[8 * s2 + 6], p[8 * s2 + 7]);
        const s16x8 pb = __builtin_bit_cast(s16x8, pw);
#pragma unroll
        for (int dt = 0; dt < 2; ++dt) {
            o[dt] = __builtin_amdgcn_mfma_f32_32x32x16_bf16(f.v[s2][dt], pb, o[dt], 0, 0, 0);
        }
    }
}
__device__ __forceinline__ float xhalf_max(float v) { auto rr = __builtin_amdgcn_permlane32_swap(__float_as_uint(v), __float_as_uint(v), false, false); return fmaxf(__uint_as_float(rr[0]), __uint_as_float(rr[1])); }
template <int MODE> __device__ __forceinline__ unsigned post_tile(f32x16& p, int kbase, int t, int lim, bool colok, const LAS float* bT) {
    unsigned vm = 0u;
#pragma unroll
    for (int r = 0; r < 16; ++r) {
        const int key = kbase + krow(r);
        const int dist = MODE == 0 ? t - 31 - 16 * key : t - key;
        const bool ok = colok && dist >= 0 && (MODE == 0 ? key < NCMP : dist < lim);
        const int di = dist < 0 ? 0 : (dist > 127 ? 127 : dist);
        p[r] = p[r] + bT[di * 4];
        vm |= ok ? (1u << r) : 0u;
    }
    return vm;
}
__device__ __forceinline__ void bias_tile(f32x16& p, const LAS float* NB, int kb, int t, int hd) {
    const int idx = 191 - t + kb, c = idx & 3;
    const LAS f32x4* b = (const LAS f32x4*)(NB + (c * 4 + hd) * NB_P + (idx - c));
#pragma unroll
    for (int a = 0; a < 4; ++a) { const f32x4 v = b[2 * a]; p[4 * a] += v[0]; p[4 * a + 1] += v[1]; p[4 * a + 2] += v[2]; p[4 * a + 3] += v[3]; }
}
__device__ __forceinline__ void cmp_bias(f32x16& p, int d0, const LAS float* bT) {
#pragma unroll
    for (int r = 0; r < 16; ++r) {
        const int dist = d0 - 16 * krow(r), di = dist < 0 ? 0 : (dist > 127 ? 127 : dist);
        const float b = bT[di * 4];
        p[r] = dist < 0 ? NEGB : p[r] + b;
    }
}
__device__ __forceinline__ void softmax_update(f32x16& p, unsigned vm, float& m, float& l, f32x16 (&o)[2], bool has_o) {
    float mx = NEGB;
#pragma unroll
    for (int r = 0; r < 16; ++r) if ((vm >> r) & 1u) mx = fmaxf(mx, p[r]);
    mx = xhalf_max(mx);
    const float mn = fmaxf(m, mx), alpha = __builtin_amdgcn_exp2f(m - mn);
    m = mn; float ls = 0.f;
#pragma unroll
    for (int r = 0; r < 16; ++r) { p[r] = ((vm >> r) & 1u) ? __builtin_amdgcn_exp2f(p[r] - mn) : 0.f; ls += p[r]; }
    l = l * alpha + ls;
    if (has_o && !__all(alpha == 1.0f)) {
#pragma unroll
        for (int r = 0; r < 16; ++r) { o[0][r] *= alpha; o[1][r] *= alpha; } }
}
__device__ __forceinline__ void softmax_update_fast(f32x16& p, float& m, float& l, f32x16 (&o)[2]) {
    float mx = p[0];
#pragma unroll
    for (int r = 1; r < 16; ++r) mx = fmaxf(mx, p[r]);
    mx = xhalf_max(mx);
    const float mn = fmaxf(m, mx), alpha = __builtin_amdgcn_exp2f(m - mn);
    m = mn; float ls = 0.f;
#pragma unroll
    for (int r = 0; r < 16; ++r) { p[r] = __builtin_amdgcn_exp2f(p[r] - mn); ls += p[r]; }
    l = l * alpha + ls;
    if (!__all(alpha == 1.0f)) {
#pragma unroll
        for (int r = 0; r < 16; ++r) { o[0][r] *= alpha; o[1][r] *= alpha; } }
}
#define DPP_XOR1 0xB1
#define DPP_XOR2 0x4E
#define DPP_HMIR 0x141
__device__ __forceinline__ float quad_sum(float v) { v += __int_as_float(__builtin_amdgcn_update_dpp(0, __float_as_int(v), DPP_XOR1, 0xf, 0xf, true)); v += __int_as_float(__builtin_amdgcn_update_dpp(0, __float_as_int(v), DPP_XOR2, 0xf, 0xf, true)); return v; }
__device__ __forceinline__ unsigned oct_umax(unsigned v) {
    unsigned o = (unsigned)__builtin_amdgcn_update_dpp(0, (int)v, DPP_XOR1, 0xf, 0xf, true); v = v > o ? v : o;
    o = (unsigned)__builtin_amdgcn_update_dpp(0, (int)v, DPP_XOR2, 0xf, 0xf, true); v = v > o ? v : o;
    o = (unsigned)__builtin_amdgcn_update_dpp(0, (int)v, DPP_HMIR, 0xf, 0xf, true); return v > o ? v : o;
}
__device__ __forceinline__ void lds_add_f32(LAS float* p, float v) { asm volatile("ds_add_f32 %0, %1" :: "v"((unsigned)(uintptr_t)p), "v"(v) : "memory"); }
__device__ __forceinline__ float max3f(float a, float b, float c) { float d; asm("v_max3_f32 %0, %1, %2, %3" : "=v"(d) : "v"(a), "v"(b), "v"(c)); return d; }
template <int OFF> __device__ __forceinline__ void lds_add_2i32_off(LAS int* p, int lo, int hi) {
    const unsigned long long v = ((unsigned long long)(unsigned)(hi + (lo >> 31)) << 32) | (unsigned)lo;
    asm volatile("ds_add_u64 %0, %1 offset:%2" :: "v"((unsigned)(uintptr_t)p), "v"(v), "n"(OFF) : "memory"); }
__device__ __forceinline__ void lds_max_i32(LAS int* p, int v) { asm volatile("ds_max_i32 %0, %1" :: "v"((unsigned)(uintptr_t)p), "v"(v) : "memory"); }
__device__ __forceinline__ void lds_add_i32(LAS int* p, int v) { asm volatile("ds_add_u32 %0, %1" :: "v"((unsigned)(uintptr_t)p), "v"(v) : "memory"); }
__device__ __forceinline__ int f2ord(float f) { const int b = __float_as_int(f); return b ^ ((b >> 31) & 0x7fffffff); }
__device__ __forceinline__ float ord2f(int o) { return __int_as_float(o ^ ((o >> 31) & 0x7fffffff)); }
struct KF { s16x8 k[2][4]; };
struct VF { s16x8 v[2][2][2]; };
__device__ __forceinline__ void kf_load(KF& f, const bf16* blk, int lane) {
    const GAS s16x8* p = (const GAS s16x8*)(GAS bf16*)blk + lane;
#pragma unroll
    for (int kt = 0; kt < 2; ++kt)
#pragma unroll
        for (int s = 0; s < 4; ++s) f.k[kt][s] = p[(kt * 4 + s) * 64];
}
__device__ __forceinline__ void vf_load(VF& f, const bf16* blk, int lane) {
    const GAS s16x8* p = (const GAS s16x8*)(GAS bf16*)blk + lane;
#pragma unroll
    for (int kt = 0; kt < 2; ++kt)
#pragma unroll
        for (int s2 = 0; s2 < 2; ++s2)
#pragma unroll
            for (int dt = 0; dt < 2; ++dt) f.v[kt][s2][dt] = p[((kt * 2 + s2) * 2 + dt) * 64];
}
__device__ __forceinline__ f32x16 qk_frag(const s16x8 (&kf)[4], const s16x8 (&qf)[4], float cinit) {
    f32x16 p;
#pragma unroll
    for (int r = 0; r < 16; ++r) p[r] = cinit;
#pragma unroll
    for (int s = 0; s < 4; ++s) p = __builtin_amdgcn_mfma_f32_32x32x16_bf16(kf[s], qf[s], p, 0, 0, 0);
    return p;
}
__device__ __forceinline__ void pv_frag(f32x16 (&o)[2], const s16x8 (&vf)[2][2], const f32x16& p) {
#pragma unroll
    for (int s2 = 0; s2 < 2; ++s2) {
        v4u pw; pw.x = cvtpk(p[8 * s2 + 0], p[8 * s2 + 1]); pw.y = cvtpk(p[8 * s2 + 2], p[8 * s2 + 3]); pw.z = cvtpk(p[8 * s2 + 4], p[8 * s2 + 5]); pw.w = cvtpk(p[8 * s2 + 6], p[8 * s2 + 7]);
        const s16x8 pb = __builtin_bit_cast(s16x8, pw);
#pragma unroll
        for (int dt = 0; dt < 2; ++dt) o[dt] = __builtin_amdgcn_mfma_f32_32x32x16_bf16(vf[s2][dt], pb, o[dt], 0, 0, 0);
    }
}
__device__ __forceinline__ void pvl_frag(f32x16 (&o)[3], const s16x8 (&vf)[2][2], const f32x16& p, const s16x8& ones) {
#pragma unroll
    for (int s2 = 0; s2 < 2; ++s2) {
        v4u pw; pw.x = cvtpk(p[8 * s2 + 0], p[8 * s2 + 1]); pw.y = cvtpk(p[8 * s2 + 2], p[8 * s2 + 3]); pw.z = cvtpk(p[8 * s2 + 4], p[8 * s2 + 5]); pw.w = cvtpk(p[8 * s2 + 6], p[8 * s2 + 7]);
        const s16x8 pb = __builtin_bit_cast(s16x8, pw);
#pragma unroll
        for (int dt = 0; dt < 2; ++dt) o[dt] = __builtin_amdgcn_mfma_f32_32x32x16_bf16(vf[s2][dt], pb, o[dt], 0, 0, 0);
        o[2] = __builtin_amdgcn_mfma_f32_32x32x16_bf16(ones, pb, o[2], 0, 0, 0);
    }
}
__device__ __forceinline__ void stats_update_fast(const f32x16& p, float& m, float& l) {
    float mx = p[0];
#pragma unroll
    for (int r = 1; r < 16; ++r) mx = fmaxf(mx, p[r]);
    mx = xhalf_max(mx);
    const float mn = fmaxf(m, mx), alpha = __builtin_amdgcn_exp2f(m - mn);
    m = mn; float ls = 0.f;
#pragma unroll
    for (int r = 0; r < 16; ++r) ls += __builtin_amdgcn_exp2f(p[r] - mn);
    l = l * alpha + ls;
}
#define NSA_BAR() do { asm volatile("s_waitcnt lgkmcnt(0)" ::: "memory"); __builtin_amdgcn_s_barrier(); asm volatile("" ::: "memory"); } while (0)
}

__device__ __forceinline__ void phase_nsa(const Frame& F) {
    using namespace nsa;
    const int tid = F.tid, lane = F.lane, w = F.wave, r32_ = lane & 31, h_ = lane >> 5;
    LAS unsigned char* L = F.lds + RING_OFF;
    LAS float* IMP = (LAS float*)(L + L_IMP); LAS unsigned* SELM = (LAS unsigned*)(L + L_SELM); LAS float* BT = (LAS float*)(L + L_BT);
    LAS float* NBT = (LAS float*)(L + L_NB);
    const bf16* Q = (const bf16*)(F.ws + WS_Q); const bf16* KCMP = (const bf16*)(F.ws + WS_KCMP); const bf16* VCT = (const bf16*)(F.ws + WS_VCMPT);
    const bf16* KS = (const bf16*)(F.ws + WS_KS); const bf16* KW = (const bf16*)(F.ws + WS_KW); const bf16* VST = (const bf16*)(F.ws + WS_VST); const bf16* VWT = (const bf16*)(F.ws + WS_VWT);
    const float* GATE = (const float*)(F.ws + WS_GATE); const float* biasT = (const float*)(F.ws + WS_BIAST); bf16* ONSA = (bf16*)(F.ws + WS_ONSA);
#if defined(PROBE_SPIN_SEC)
    unsigned long long tacc[8] = {0, 0, 0, 0, 0, 0, 0, 0}, tlast = wall_clock64(); const unsigned long long tstart = tlast;
#define STAMP(k) do { const unsigned long long tn_ = wall_clock64(); tacc[k] += tn_ - tlast; tlast = tn_; } while (0)
#else
#define STAMP(k) do {} while (0)
#endif
    int g_bt = -1;
#pragma unroll 1
    for (int e = F.vcu; e < 2048; e += F.G) {
        const int ui = e >> 8, pl = (e >> 5) & 7, wi = e & 31, b = pl >> 2, g = pl & 3;
        if (g != g_bt) {
            __syncthreads();
            for (int i = tid; i < 512; i += NTHREADS) BT[i] = biasT[(i >> 2) * 16 + g * 4 + (i & 3)] * LOG2E;
            for (int i = tid; i < 16 * NB_P; i += NTHREADS) { const int c = i / (4 * NB_P), hd = (i / NB_P) & 3, dist = 127 - ((i % NB_P) + c - 64);
                NBT[i] = dist < 0 ? NEGB : biasT[(dist > 127 ? 127 : dist) * 16 + g * 4 + hd] * LOG2E; }
            g_bt = g;
            __syncthreads();
        }
        const int qt = 32 * ui + ((wi + 4 * ui) & 31);
        const int t0 = qt * 64, cur = qt, m0 = b * SEQ + t0;
#define TOK(r_) (t0 + 8 * w + ((r_) >> 2))
#define MROW(r_) (m0 + 8 * w + ((r_) >> 2))
#define HEADG(r_) (g * NR + ((r_) & 3))
#define B31(r_) (BT[127 * 4 + ((r_) & 3)])
#define LOAD_QF() s16x8 qf[4]; { int r_o = r32_, h_o = h_; asm volatile("" : "+v"(r_o), "+v"(h_o)); _Pragma("unroll") for (int s = 0; s < 4; ++s) qf[s] = *(const GAS s16x8*)(GAS bf16*)(Q + (size_t)MROW(r_o) * 1024 + HEADG(r_o) * 64 + 16 * s + 8 * h_o); }
#define OACC_DECL() int t_o = tid; asm volatile("" : "+v"(t_o)); f32x4* OACC = (f32x4*)((float*)(F.ws + WS_MIX) + ((size_t)blockIdx.x * NTHREADS + t_o) * 64);
#define GATE_LOAD(k_) ({ int l_o = r32_; asm volatile("" : "+v"(l_o)); GATE[(size_t)(m0 + 8 * w + (l_o >> 2)) * 48 + (g * NR + (l_o & 3)) * 3 + (k_)]; })
        const float gate0 = GATE_LOAD(0);
        LOAD_QF()
        for (int i = lane; i < 8 * IMP_P; i += 64) IMP[8 * w * IMP_P + i] = 0.f;
        for (int i = tid; i < 512; i += NTHREADS) SELM[i] = 0u;
        __syncthreads();
        STAMP(0);
        const int ncb = t0 >= 0 ? ((t0 + 63 - 31) / 16) / 64 + 1 : 0;
        const int icut = t0 >= 1152 ? (((t0 - 144) >> 4) - 63) / 64 + 1 : 0;
        const bf16* Kc = KCMP + (size_t)pl * 1024 * 64; const bf16* Vc = VCT + (size_t)pl * 64 * 1024;
        f32x16 oc[2];
#pragma unroll
        for (int r = 0; r < 16; ++r) { oc[0][r] = 0.f; oc[1][r] = 0.f; }
#define CK(ii) (Kc + (size_t)(ii) * 64 * 64)
#define CV(ii) (Vc + (ii) * 64)
        float mref = 0.f, lc = 0.f; bool first = true;
        {
            auto body0 = [&](int i, const LAS bf16* Kl) __attribute__((always_inline)) {
                int r32 = r32_, h = h_; asm volatile("" : "+v"(r32), "+v"(h));
                const bool far = i < icut;
#pragma unroll
                for (int kt = 0; kt < 2; ++kt) {
                    const int kr = 32 * kt + r32; s16x8 kf[4];
#pragma unroll
                    for (int s = 0; s < 4; ++s) kf[s] = *(const LAS s16x8*)(Kl + kr * KP + 8 * ((2 * s + h) ^ ((kr ^ (kr >> 3)) & 7)));
                    f32x16 pp = qk_frag(kf, qf, far ? B31(r32) - mref : -mref);
                    if (!far) cmp_bias(pp, TOK(r32) - 31 - 16 * (i * 64 + 32 * kt + 4 * h), BT + (r32 & 3));
                    float tmax = max3f(pp[0], pp[1], pp[2]);
#pragma unroll
                    for (int r = 3; r < 15; r += 2) tmax = max3f(tmax, pp[r], pp[r + 1]);
                    tmax = fmaxf(tmax, pp[15]); tmax = xhalf_max(tmax);
                    const float d = first ? tmax : fmaxf(tmax, 0.f);
                    if (__any(d != 0.f)) {
                        mref += d; lc = first ? 0.f : lc * __builtin_amdgcn_exp2f(-d);
#pragma unroll
                        for (int r = 0; r < 16; ++r) pp[r] -= d;
                    }
                    first = false;
#pragma unroll
                    for (int r = 0; r < 16; ++r) lc += __builtin_amdgcn_exp2f(pp[r]);
                }
            };
            const int ng0 = (ncb + 3) >> 2;
#define K0_ISSUE(g) do { _Pragma("unroll") for (int q_ = 0; q_ < 4; ++q_) { const int b_ = (g) * 4 + q_; if (b_ < ncb) ktile_issue(L, (((g) & 1) * 4 + q_) * SLOTB, CK(b_), w, lane); } } while (0)
            K0_ISSUE(0);
#pragma unroll 1
            for (int g_ = 0; g_ < ng0; ++g_) {
                asm volatile("s_waitcnt vmcnt(0)" ::: "memory"); NSA_BAR(); if (g_ + 1 < ng0) K0_ISSUE(g_ + 1);
#pragma unroll 1
                for (int q_ = 0; q_ < 4; ++q_) { const int b_ = g_ * 4 + q_; if (b_ < ncb) body0(b_, (const LAS bf16*)(L + ((g_ & 1) * 4 + q_) * SLOTB)); }
            }
            NSA_BAR();
#undef K0_ISSUE
        }
        {
            const float lt = lc + __shfl_xor(lc, 32);
            const float mcl = (mref > -1.0e29f && lt > 0.f) ? mref + __builtin_amdgcn_logf(lt) - 26.0f : 1.0e30f;
            auto body = [&](int i, const LAS bf16* Kl, const LAS bf16* Vl) __attribute__((always_inline)) {
                int r32 = r32_, h = h_; asm volatile("" : "+v"(r32), "+v"(h));
                const bool far = i < icut;
#pragma unroll
                for (int kt = 0; kt < 2; ++kt) {
                    KVFrag fr; frag_load(fr, Kl, Vl, kt, r32, h);
                    f32x16 pp = qk_tile(fr, qf, far ? B31(r32) - mcl : -mcl);
                    if (!far) cmp_bias(pp, TOK(r32) - 31 - 16 * (i * 64 + 32 * kt + 4 * h), BT + (r32 & 3));
#pragma unroll
                    for (int r = 0; r < 16; ++r) pp[r] = __builtin_amdgcn_exp2f(pp[r]);
#pragma unroll
                    for (int a = 0; a < 4; ++a) {
                        const float s4 = quad_sum((pp[4 * a] + pp[4 * a + 1]) + (pp[4 * a + 2] + pp[4 * a + 3])), s1 = quad_sum(pp[4 * a + 3]);
                        const int j = i * 16 + kt * 8 + 2 * a + h;
                        if ((r32 & 3) == 0) { LAS int* ip = (LAS int*)IMP + (8 * w + (r32 >> 2)) * IMP_P + j; lds_add_i32(ip, (int)s4); lds_add_i32(ip + 1, (int)s1); }
                    }
                    pv_tile(oc, fr, pp);
                }
            };
#define NSA_ISSUE(G, g, n, KPTR, VPTR, LDV) do { _Pragma("unroll") for (int q_ = 0; q_ < G; ++q_) { const int b_ = (g) * G + q_, s_ = ((g) & 1) * G + q_; \
                if (b_ < (n)) tile_issue(L, s_ * SLOTB, (2 * G + s_) * SLOTB, KPTR(b_), VPTR(b_), LDV, w, lane); } } while (0)
#define NSA_LOOP(G, n, KPTR, VPTR, LDV) do { const int ng_ = ((n) + G - 1) / G; NSA_ISSUE(G, 0, (n), KPTR, VPTR, LDV); \
                _Pragma("unroll 1") for (int g_ = 0; g_ < ng_; ++g_) { asm volatile("s_waitcnt vmcnt(0)" ::: "memory"); NSA_BAR(); if (g_ + 1 < ng_) NSA_ISSUE(G, g_ + 1, (n), KPTR, VPTR, LDV); \
                    _Pragma("unroll 1") for (int q_ = 0; q_ < G; ++q_) { const int b_ = g_ * G + q_; const int s_ = (g_ & 1) * G + q_; \
                        if (b_ < (n)) body(b_, (const LAS bf16*)(L + s_ * SLOTB), (const LAS bf16*)(L + (2 * G + s_) * SLOTB)); } } \
                NSA_BAR(); } while (0)
            NSA_LOOP(GC, ncb, CK, CV, 1024);
        }
#undef CK
#undef CV
        const float g0 = gate0 * 1.4901161193847656e-08f;
        OACC_DECL()
#pragma unroll
        for (int q = 0; q < 4; ++q) { OACC[q] = (f32x4){oc[0][4 * q], oc[0][4 * q + 1], oc[0][4 * q + 2], oc[0][4 * q + 3]} * g0; OACC[4 + q] = (f32x4){oc[1][4 * q], oc[1][4 * q + 1], oc[1][4 * q + 2], oc[1][4 * q + 3]} * g0; }
        STAMP(1);
        {
            int lane_q = lane; asm volatile("" : "+v"(lane_q));
#pragma unroll
            for (int q = 0; q < 4; ++q) { const int row = 32 * w + 8 * q + (lane_q >> 3), c = (lane_q & 7) ^ (row & 7);
                __builtin_amdgcn_global_load_lds((const unsigned*)(Q + (size_t)(m0 + (row >> 2)) * 1024 + (g * NR + (row & 3)) * 64 + c * 8), (LAS unsigned*)(L + L_SQ + (32 * w + 8 * q) * 128), 16, 0, 0); }
        }
        {
            int lane_o = lane; asm volatile("" : "+v"(lane_o));
            const int tk = lane_o >> 3, sub = lane_o & 7; LAS unsigned* sm = SELM + (8 * w + tk) * 8;
            const int ncand = cur - 2, nf = cur + 1 < 3 ? cur + 1 : 3, need = 16 - nf;
            asm volatile("s_waitcnt lgkmcnt(0)" ::: "memory");
            if (sub == 0) { (void)__hip_atomic_fetch_or(sm, 1u, __ATOMIC_RELAXED, __HIP_MEMORY_SCOPE_WORKGROUP); (void)__hip_atomic_fetch_or(sm + (cur >> 5), 1u << (cur & 31), __ATOMIC_RELAXED, __HIP_MEMORY_SCOPE_WORKGROUP); if (cur >= 1) (void)__hip_atomic_fetch_or(sm + ((cur - 1) >> 5), 1u << ((cur - 1) & 31), __ATOMIC_RELAXED, __HIP_MEMORY_SCOPE_WORKGROUP); }
            if (ncand <= need) {
                if (sub == 0) for (int j = 1; j <= cur - 2; ++j) (void)__hip_atomic_fetch_or(sm + (j >> 5), 1u << (j & 31), __ATOMIC_RELAXED, __HIP_MEMORY_SCOPE_WORKGROUP);
            } else {
                const LAS int* ip = (const LAS int*)IMP + (8 * w + tk) * IMP_P;
                unsigned key[32];
#pragma unroll
                for (int i = 0; i < 32; ++i) { const int j = sub + 8 * i; key[i] = (j >= 1 && j <= cur - 2) ? ((((unsigned)ip[j] >> 5) << 8) | (unsigned)(255 - j)) : 0u; }
#pragma unroll 1
                for (int round = 0; round < need; ++round) {
                    unsigned bk = key[0];
#pragma unroll
                    for (int i = 1; i < 32; ++i) bk = bk > key[i] ? bk : key[i];
                    bk = oct_umax(bk);
#pragma unroll
                    for (int i = 0; i < 32; ++i) key[i] = key[i] == bk ? 0u : key[i];
                    const int bj = 255 - (int)(bk & 0xffu);
                    if (sub == 0 && bk != 0u) (void)__hip_atomic_fetch_or(sm + (bj >> 5), 1u << (bj & 31), __ATOMIC_RELAXED, __HIP_MEMORY_SCOPE_WORKGROUP);
                }
            }
        }
        asm volatile("s_waitcnt vmcnt(0)" ::: "memory");
        __syncthreads();
        STAMP(2);
        {
            LAS int* SO = (LAS int*)(L + L_SO); LAS int* SM = (LAS int*)(L + L_SM); LAS int* SL = (LAS int*)(L + L_SL);
            LAS unsigned char* SQ = L + L_SQ; LAS unsigned* TL = (LAS unsigned*)(L + L_TL); LAS unsigned* TC = (LAS unsigned*)(L + L_TC); LAS unsigned char* TOKB = L + L_TOK;
            {
                int tid_o = tid; asm volatile("" : "+v"(tid_o));
                const int ln = tid_o & 63;
                const unsigned word = SELM[ln * 8 + w];
                unsigned long long tm = 0ull;
#pragma unroll
                for (int bt = 0; bt < 32; ++bt) { const unsigned long long mk = __ballot((word >> bt) & 1u); tm = ln == bt ? mk : tm; }
                const int jb = 32 * w + ln;
                const int cnt = (ln < 32 && jb != 0 && jb != cur && jb != cur - 1) ? __popcll(tm) : 0, nt = (cnt + 31) >> 5;
                int sc = nt;
#pragma unroll
                for (int o = 1; o < 32; o <<= 1) { const int v = __shfl_up(sc, o); if (ln >= o) sc += v; }
                if (ln == 31) TC[4 + w] = (unsigned)sc;
                if (tid_o < 256) SM[tid_o] = f2ord(NEGB);
                __syncthreads();
                if (nt > 0) {
                    const int j = 32 * w + ln;
                    int pos = sc - nt; for (int ww = 0; ww < w; ++ww) pos += (int)TC[4 + ww];
                    LAS unsigned char* tb = TOKB + pos * 32;
                    if (tm == ~0ull) {
                        unsigned pat = 0x03020100u; asm volatile("" : "+v"(pat));
#pragma unroll 1
                        for (int q = 0; q < 16; ++q) { ((LAS unsigned*)tb)[q] = pat; pat += 0x04040404u; }
                        TL[pos] = (unsigned)j | (32u << 8); TL[pos + 1] = (unsigned)j | (32u << 8);
                    } else {
                        unsigned long long rem = tm; int c = 0;
                        for (; rem != 0ull; ++c) { const int t = __ffsll((long long)rem) - 1; rem &= rem - 1ull; tb[c] = (unsigned char)t; }
                        for (; (c & 7) != 0; ++c) tb[c] = (unsigned char)0xff;
                        for (int k = 0; k < nt; ++k) TL[pos + k] = (unsigned)j | ((unsigned)(cnt - 32 * k < 32 ? cnt - 32 * k : 32) << 8);
                    }
                }
                __syncthreads();
            }
            STAMP(5);
            const int ntl = (int)(TC[4] + TC[5] + TC[6] + TC[7] + TC[8] + TC[9] + TC[10] + TC[11]);
            const int nmine = (ntl - w + 7) >> 3;
            const float vmax = __uint_as_float(((const unsigned*)(F.ws + WS_CTL))[CW_VMAX + pl]);
            const float kexp = fminf(20.f, floorf(19.f - log2f(fmaxf(vmax, 1.0e-30f))));
            const bf16* Kg = KS + (size_t)pl * SEQ * 64; const bf16* Vg = VST + (size_t)pl * 64 * SEQ;
#define SEL_DESC(k_) ({ int kk_ = (k_) < nmine ? (k_) : nmine - 1; kk_ = kk_ < 0 ? 0 : kk_; (unsigned)__builtin_amdgcn_readfirstlane(TL[w + 8 * kk_]); })
#define SEL_COLS(tb_, grp_) int r32 = r32_, h = h_; asm volatile("" : "+v"(r32), "+v"(h)); \
                    const unsigned tokb = (tb_)[8 * (grp_) + (r32 >> 2)]; \
                    const bool valid = tokb != 0xffu; const int tokl = valid ? (int)tokb : 0, row = tokl * 4 + (r32 & 3); \
                    s16x8 qg[4]; const unsigned qa = (unsigned)(uintptr_t)(SQ + row * 128) + (unsigned)((h ^ (row & 7)) << 4);     \
                    _Pragma("unroll") for (int s = 0; s < 4; ++s) qg[s] = *(const LAS s16x8*)(uintptr_t)(qa ^ (unsigned)(32 * s));
            const float kexpT = kexp - 2.0f;
            f32x4 pc[8];
            LAS float* SMF = (LAS float*)(L + L_SMF);
#pragma unroll 1
            for (int attempt = 0; attempt < 2; ++attempt) {
                int lane_ = lane; asm volatile("" : "+v"(lane_));
#define lane lane_
                if (attempt == 1) {
                {
                    KF ka, kb, kc; unsigned da = SEL_DESC(0), db = SEL_DESC(1), dc = 0u;
                    kf_load(ka, Kg + (size_t)(da & 255u) * 4096, lane); kf_load(kb, Kg + (size_t)(db & 255u) * 4096, lane);
                    auto step = [&](int k, KF& kcur, const unsigned dcur, KF& kpre, unsigned& dpre) __attribute__((always_inline)) {
                        dpre = SEL_DESC(k + 2);
                        kf_load(kpre, Kg + (size_t)(dpre & 255u) * 4096, lane);
                        const int j = (int)(dcur & 255u), ngrp = (int)((dcur >> 8) + 7u) >> 3; const bool near = j >= cur - 2;
                        const LAS unsigned char* tb = TOKB + (w + 8 * k) * 32;
#pragma unroll 1
                        for (int grp = 0; grp < ngrp; ++grp) {
                            SEL_COLS(tb, grp)
                            f32x16 p0 = qk_frag(kcur.k[0], qg, 0.f), p1 = qk_frag(kcur.k[1], qg, 0.f);
                            if (near) { bias_tile(p0, NBT, j * 64 + 4 * h, t0 + tokl, r32 & 3); bias_tile(p1, NBT, j * 64 + 32 + 4 * h, t0 + tokl, r32 & 3); }
                            float mx = max3f(p0[0], p1[0], NEGB);
#pragma unroll
                            for (int r = 1; r < 16; ++r) mx = max3f(mx, p0[r], p1[r]);
                            if (!near) mx += B31(r32);
                            { auto rr2 = __builtin_amdgcn_permlane32_swap(__float_as_uint(mx), __float_as_uint(mx), false, false); mx = max3f(__uint_as_float(rr2[0]), __uint_as_float(rr2[1]), NEGB); }
                            if (valid && h == 0) lds_max_i32(SM + row, f2ord(mx));
                        }
                    };
#pragma unroll 1
                    for (int k = 0; k < nmine; k += 3) {
                        step(k, ka, da, kc, dc);
                        if (k + 1 >= nmine) break;
                        step(k + 1, kb, db, ka, da);
                        if (k + 2 >= nmine) break;
                        step(k + 2, kc, dc, kb, db);
                    }
                    asm volatile("s_waitcnt vmcnt(0) lgkmcnt(0)" ::: "memory");
                }

                    __syncthreads();
                }
                {
                    LOAD_QF()
                    unsigned one2 = 0x3f803f80u; asm volatile("" : "+v"(one2));
                    const s16x8 ones = __builtin_bit_cast(s16x8, (v4u){one2, one2, one2, one2});
                    int r32 = r32_, h = h_; asm volatile("" : "+v"(r32), "+v"(h));
                    const int nfb = cur >= 2 ? 3 : cur + 1;
                    float mref = 0.f; bool seen = false; f32x16 ow[3];
#pragma unroll
                    for (int r = 0; r < 16; ++r) { ow[0][r] = 0.f; ow[1][r] = 0.f; ow[2][r] = 0.f; }
                    KF ka, kb; VF vf;
                    kf_load(ka, Kg, lane);
                    auto fstep = [&](int i, KF& kcur, KF& knext) __attribute__((always_inline)) {
                        const int j = i == 0 ? 0 : cur - (nfb - 1 - i), jn = (i + 1 < nfb) ? cur - (nfb - 2 - i) : j;
                        vf_load(vf, Vg + (size_t)j * 4096, lane); kf_load(knext, Kg + (size_t)jn * 4096, lane);
                        const bool nearb = j >= cur - 2;
#pragma unroll
                        for (int kt = 0; kt < 2; ++kt) {
                            f32x16 pp = qk_frag(kcur.k[kt], qf, (nearb ? 0.f : B31(r32)) - mref);
                            if (nearb) bias_tile(pp, NBT, j * 64 + 32 * kt + 4 * h, TOK(r32), r32 & 3);
                            float tmax = max3f(pp[0], pp[1], pp[2]);
#pragma unroll
                            for (int r = 3; r < 15; r += 2) tmax = max3f(tmax, pp[r], pp[r + 1]);
                            tmax = fmaxf(tmax, pp[15]); tmax = xhalf_max(tmax);
                            const bool ok = tmax > -1.0e29f;
                            const float d = seen ? fmaxf(tmax, 0.f) : (ok ? tmax : 0.f);
                            if (__any(d != 0.f)) {
                                const float al = seen ? __builtin_amdgcn_exp2f(-d) : 1.0f; mref += d; ow[2][0] *= al;
#pragma unroll
                                for (int r = 0; r < 16; ++r) { ow[0][r] *= al; ow[1][r] *= al; pp[r] -= d; }
                            }
                            seen = seen || ok;
#pragma unroll
                            for (int r = 0; r < 16; ++r) pp[r] = __builtin_amdgcn_exp2f(pp[r]);
                            pvl_frag(ow, vf.v[kt], pp, ones);
                        }
                    };
                    fstep(0, ka, kb);
                    if (nfb > 1) fstep(1, kb, ka);
                    if (nfb > 2) fstep(2, ka, kb);
                    const int row = (8 * w + (r32 >> 2)) * 4 + (r32 & 3);
                    const float refr = attempt == 0 ? mref + 4.0f : fmaxf(ord2f(SM[row]), mref);
                    const float fac = __builtin_amdgcn_exp2f(mref - refr + kexpT);
                    LAS int* op = SO + row * SO_P + 4 * h;
#pragma unroll
                    for (int dt = 0; dt < 2; ++dt)
#pragma unroll
                        for (int a = 0; a < 4; ++a) {
                            const int l0 = (int)(ow[dt][4 * a] * fac), h0 = (int)(ow[dt][4 * a + 1] * fac), l1 = (int)(ow[dt][4 * a + 2] * fac), h1 = (int)(ow[dt][4 * a + 3] * fac);
                            *(LAS v4u*)(op + 32 * dt + 8 * a) = (v4u){(unsigned)l0, (unsigned)(h0 + (l0 >> 31)), (unsigned)l1, (unsigned)(h1 + (l1 >> 31))};
                        }
                    if (h == 0) { SL[row] = (int)(ow[2][0] * fac); SMF[row] = refr; }
                    if (tid == 0) TC[3] = 0u;
                }
                __syncthreads();
                {
                    unsigned one2 = 0x3f803f80u; asm volatile("" : "+v"(one2));
                    const s16x8 ones = __builtin_bit_cast(s16x8, (v4u){one2, one2, one2, one2});
                    KF ka, kb; VF vf; unsigned dcur = SEL_DESC(0);
                    kf_load(ka, Kg + (size_t)(dcur & 255u) * 4096, lane); vf_load(vf, Vg + (size_t)(dcur & 255u) * 4096, lane);
                    auto step = [&](int k, KF& kcur, KF& knext) __attribute__((always_inline)) {
                        const unsigned dn = SEL_DESC(k + 1);
                        kf_load(knext, Kg + (size_t)(dn & 255u) * 4096, lane);
                        const int j = (int)(dcur & 255u), ngrp = (int)((dcur >> 8) + 7u) >> 3; const bool near = j >= cur - 2;
                        const LAS unsigned char* tb = TOKB + (w + 8 * k) * 32;
#pragma unroll 1
                        for (int grp = 0; grp < ngrp; ++grp) {
                            SEL_COLS(tb, grp)
                            const float mrow = SMF[row] - kexpT;
                            const float ci = valid ? (near ? -mrow : B31(r32) - mrow) : NEGB;
                            f32x16 p0 = qk_frag(kcur.k[0], qg, ci), p1 = qk_frag(kcur.k[1], qg, ci);
                            if (near) { bias_tile(p0, NBT, j * 64 + 4 * h, t0 + tokl, r32 & 3); bias_tile(p1, NBT, j * 64 + 32 + 4 * h, t0 + tokl, r32 & 3); }
                            if (attempt == 0) {
                                float tmax = max3f(p0[0], p1[0], p0[1]);
#pragma unroll
                                for (int r = 1; r < 15; ++r) tmax = max3f(tmax, p1[r], p0[r + 1]);
                                tmax = fmaxf(tmax, p1[15]);
                                if (__any(tmax > kexpT + 2.0f)) { if (lane == 0) TC[3] = 1u; }
                            }
#pragma unroll
                            for (int r = 0; r < 16; ++r) { p0[r] = __builtin_amdgcn_exp2f(p0[r]); p1[r] = __builtin_amdgcn_exp2f(p1[r]); }
                            f32x16 o[3];
#pragma unroll
                            for (int r = 0; r < 16; ++r) { o[0][r] = 0.f; o[1][r] = 0.f; o[2][r] = 0.f; }
                            pvl_frag(o, vf.v[0], p0, ones); pvl_frag(o, vf.v[1], p1, ones);
                            if (valid) {
                                LAS int* op = SO + row * SO_P + 4 * h;
                                if (h == 0) lds_add_i32(SL + row, (int)o[2][0]);
#define SEL_ADD4(dt_, a_) lds_add_2i32_off<(32 * dt_ + 8 * a_) * 4>(op, (int)o[dt_][4 * a_], (int)o[dt_][4 * a_ + 1]); lds_add_2i32_off<(32 * dt_ + 8 * a_ + 2) * 4>(op, (int)o[dt_][4 * a_ + 2], (int)o[dt_][4 * a_ + 3]);
                                SEL_ADD4(0, 0) SEL_ADD4(0, 1) SEL_ADD4(0, 2) SEL_ADD4(0, 3) SEL_ADD4(1, 0) SEL_ADD4(1, 1) SEL_ADD4(1, 2) SEL_ADD4(1, 3)
#undef SEL_ADD4
                            }
                        }
                        vf_load(vf, Vg + (size_t)(dn & 255u) * 4096, lane);
                        dcur = dn;
                    };
#pragma unroll 1
                    for (int k = 0; k < nmine; k += 2) {
                        step(k, ka, kb);
                        if (k + 1 >= nmine) break;
                        step(k + 1, kb, ka);
                    }
                    asm volatile("s_waitcnt vmcnt(0) lgkmcnt(0)" ::: "memory");
                }

{ OACC_DECL()
#pragma unroll
                for (int q = 0; q < 8; ++q) pc[q] = OACC[q];
                }
                __syncthreads();
                if (attempt == 1 || TC[3] == 0u) break;
#undef lane
            }
#undef SEL_DESC
#undef SEL_COLS
            STAMP(7);
            {
                int r32 = r32_, h = h_; asm volatile("" : "+v"(r32), "+v"(h));
                const int row = (8 * w + (r32 >> 2)) * 4 + (r32 & 3);
                OACC_DECL()
                const float g1 = GATE_LOAD(1), lt = (float)SL[row], sc = lt > 0.f ? g1 / lt : 0.f;
                const LAS int* op = SO + row * SO_P + 4 * h;
#define SEL_RD4(off_) ({ const int l0 = op[off_], h0 = op[off_ + 1] - (l0 >> 31), l1 = op[off_ + 2], h1 = op[off_ + 3] - (l1 >> 31); (f32x4){(float)l0, (float)h0, (float)l1, (float)h1} * sc; })
#pragma unroll
                for (int q = 0; q < 4; ++q) { OACC[q] = SEL_RD4(8 * q) + pc[q]; OACC[4 + q] = SEL_RD4(32 + 8 * q) + pc[4 + q]; }
#undef SEL_RD4
            }
            NSA_BAR();
        }
        STAMP(3);
        {
            const int jb0 = cur >= 8 ? cur - 8 : 0, nwb = cur - jb0 + 1;
            const bf16* Kg = KW + (size_t)pl * SEQ * 64; const bf16* Vg = VWT + (size_t)pl * 64 * SEQ;
            float mref = 0.f; bool seen = false; f32x16 ow[3];
            LOAD_QF()
            unsigned one2 = 0x3f803f80u; asm volatile("" : "+v"(one2));
            const s16x8 ones = __builtin_bit_cast(s16x8, (v4u){one2, one2, one2, one2});
#pragma unroll
            for (int r = 0; r < 16; ++r) { ow[0][r] = 0.f; ow[1][r] = 0.f; ow[2][r] = 0.f; }
            auto body = [&](int i, const LAS bf16* Kl, const LAS bf16* Vl) __attribute__((always_inline)) {
                const int j = jb0 + i;
                const bool far = j <= cur - 3 && j >= cur - 7, nearb = j >= cur - 2;
                int r32 = r32_, h = h_; asm volatile("" : "+v"(r32), "+v"(h));
#pragma unroll
                for (int kt = 0; kt < 2; ++kt) {
                    KVFrag fr; frag_load(fr, Kl, Vl, kt, r32, h);
                    f32x16 pp = qk_tile(fr, qf, (nearb ? 0.f : B31(r32)) - mref);
                    if (nearb) bias_tile(pp, NBT, j * 64 + 32 * kt + 4 * h, TOK(r32), r32 & 3);
                    else if (!far) {
                        const int klo = TOK(r32) - 512 - (j * 64 + 32 * kt + 4 * h);
#pragma unroll
                        for (int r = 0; r < 16; ++r) pp[r] = krow(r) > klo ? pp[r] : NEGB;
                    }
                    float tmax = max3f(pp[0], pp[1], pp[2]);
#pragma unroll
                    for (int r = 3; r < 15; r += 2) tmax = max3f(tmax, pp[r], pp[r + 1]);
                    tmax = fmaxf(tmax, pp[15]); tmax = xhalf_max(tmax);
                    const bool ok = tmax > -1.0e29f;
                    const float d = seen ? fmaxf(tmax, 0.f) : (ok ? tmax : 0.f);
                    if (__any(d != 0.f)) {
                        const float al = seen ? __builtin_amdgcn_exp2f(-d) : 1.0f; mref += d; ow[2][0] *= al;
#pragma unroll
                        for (int r = 0; r < 16; ++r) { ow[0][r] *= al; ow[1][r] *= al; pp[r] -= d; }
                    }
                    seen = seen || ok;
#pragma unroll
                    for (int r = 0; r < 16; ++r) pp[r] = __builtin_amdgcn_exp2f(pp[r]);
                    pvl_frag(ow, fr.v, pp, ones);
                }
            };
#define WK(ii) (Kg + (size_t)(jb0 + (ii)) * 64 * 64)
#define WV(ii) (Vg + (jb0 + (ii)) * 64)
            const float gate2 = GATE_LOAD(2);
            OACC_DECL()
            f32x4 pk[8];
#pragma unroll
            for (int q = 0; q < 8; ++q) pk[q] = OACC[q];
            NSA_LOOP(GS, nwb, WK, WV, SEQ);
#undef WK
#undef WV
            const float g2 = gate2, lt = ow[2][0], sc = lt > 0.f ? g2 / lt : 0.f;
#pragma unroll
            for (int r = 0; r < 16; ++r) { ow[0][r] *= sc; ow[1][r] *= sc; }
#pragma unroll
            for (int q = 0; q < 4; ++q) {
                const f32x4 a0 = pk[q], a1 = pk[4 + q];
#pragma unroll
                for (int j = 0; j < 4; ++j) { ow[0][4 * q + j] += a0[j]; ow[1][4 * q + j] += a1[j]; }
                __builtin_amdgcn_sched_barrier(0);
            }
            int r32 = r32_, h = h_; asm volatile("" : "+v"(r32), "+v"(h));
            bf16* op = ONSA + (size_t)MROW(r32) * 1024 + HEADG(r32) * 64 + 4 * h;
#pragma unroll
            for (int dt = 0; dt < 2; ++dt)
#pragma unroll
                for (int a = 0; a < 4; ++a) { v2u wv; wv.x = cvtpk(ow[dt][4 * a], ow[dt][4 * a + 1]); wv.y = cvtpk(ow[dt][4 * a + 2], ow[dt][4 * a + 3]); *(v2u*)(op + 32 * dt + 8 * a) = wv; }
            asm volatile("s_waitcnt lgkmcnt(0)" ::: "memory");
        }
        STAMP(4);
    }
#ifdef PROBE_SPIN_SEC
    { const unsigned long long t1_ = wall_clock64(); while (wall_clock64() - t1_ < tacc[PROBE_SPIN_SEC]) __builtin_amdgcn_s_sleep(8); }
#endif
#undef STAMP
#undef TOK
#undef MROW
#undef HEADG
#undef B31
#undef OACC_DECL
#undef GATE_LOAD
#undef LOAD_QF
#undef NSA_ISSUE
#undef NSA_LOOP
}

template <class Epi, class Map>
__device__ __forceinline__ void run_gemm(const Frame& F, const bf16* A, const bf16* Bt, int lda, int ldb, int K, int nM, int nN, const Map& map, const Epi& E, int Gs = 0, int c0 = 0) {
    pg8::Gemm g{A, Bt, lda, ldb, K}; pg8::Order<Map> S; S.init(nM, nN, Gs ? Gs : F.G, (int)blockIdx.x - c0, map);
    int tid = F.tid; asm volatile("" : "+v"(tid));
    pg8::gemm_phase<Epi, pg8::Order<Map>, true, true>(F.lds + RING_OFF, g, S, E, tid);
}
enum { PH_PRO, PH_P1, PH_R1, PH_R2, PH_R3, PH_G, PH_OUT, PH_RES, PH_FI, PH_KVQN, PH_KVQS, PH_CMP, PH_CMP2, PH_NSA, PH_COUNT };

template <int PH> __device__ __forceinline__ void phase_body(const Frame& F, int b) {
    unsigned char* ws = F.ws; float* rinv = (float*)(ws + WS_RINV); bf16* XB = (bf16*)(ws + WS_XB);
    if constexpr (PH == PH_PRO) phase_prologue(F);
    if constexpr (PH == PH_P1) {
        { EpiP1N E{rinv + b * SEQ, (const f32x4*)(ws + WS_TABA), (bf16*)(ws + WS_AP), (bf16*)(ws + WS_KN)};
          run_gemm(F, XB + (size_t)b * SEQ * DM, (const bf16*)(ws + W_RI), DM, DM, DM, SEQ / 256, 8, pg8::MapPlain{DM, DM}, E); }
        __syncthreads();
        { EpiP1S E{rinv + b * SEQ, (const f32x4*)(ws + WS_TABB), (bf16*)(ws + WS_KT), (bf16*)(ws + WS_BP)};
          run_gemm(F, (const bf16*)(ws + W_RI) + (size_t)1024 * DM, XB + (size_t)b * SEQ * DM, DM, DM, DM, 12, SEQ / 256, pg8::MapPlain{DM, DM}, E); }
    }
    if constexpr (PH == PH_R1) {
        { EpiKV E{(bf16*)(ws + WS_KV)};
          run_gemm(F, (const bf16*)(ws + WS_BP), (const bf16*)(ws + WS_KT), APLD, SEQ, RCH, RH * NCH * 2, 1, MapKV{}, E); }
        __syncthreads();
        { EpiS E{(bf16*)(ws + WS_AP)};
          run_gemm(F, (const bf16*)(ws + WS_AP), (const bf16*)(ws + WS_KN), APLD, 1024, RDK, RH * NCH * 2, 2, MapS{}, E); }
    }
    if constexpr (PH == PH_R2) phase_ret_scan(F);
    if constexpr (PH == PH_R3) { EpiO E{(bf16*)F.out, (float*)(ws + WS_GSLOT), b};
        run_gemm(F, (const bf16*)(ws + WS_AP), (const bf16*)(ws + WS_BP), APLD, APLD, APLD, RH * NCH * 2, 2, MapO{}, E); }
    if constexpr (PH == PH_G) { EpiG E{rinv, (const float*)(ws + WS_GSLOT), (bf16*)F.out};
        run_gemm(F, XB, (const bf16*)(ws + W_RI) + (size_t)4096 * DM, DM, DM, DM, MTOK / 256, 8, pg8::MapPlain{DM, DM}, E); }
    if constexpr (PH == PH_OUT) {
        const bf16* A = b == 0 ? (const bf16*)F.out : b == 2 ? (const bf16*)(ws + WS_ONSA) : (const bf16*)(ws + WS_HID);
        const bf16* Bt = (const bf16*)(ws + (b == 0 ? W_RO : b == 1 ? W_FO0 : b == 2 ? W_NO : W_FO1));
        const int K = b == 0 ? 2048 : b == 2 ? DM : FFH;
        EpiOut E{(bf16*)(ws + WS_MIX), (float*)(ws + WS_OSLOT)};
        run_gemm(F, A, Bt, K, K, K, MTOK / 256, 4, pg8::MapPlain{K, K}, E); }
    if constexpr (PH == PH_RES) phase_resid(F, b == 0 ? gp(F.in[0]) : (const float*)nullptr, gp(b & 1 ? F.in[4] : F.in[2]) + (b >> 1) * DM, b == 3);
    if constexpr (PH == PH_FI) { EpiFfnIn E{rinv, (bf16*)(ws + WS_HID)};
        run_gemm(F, XB, (const bf16*)(ws + (b ? W_FI1 : W_FI0)), DM, DM, DM, MTOK / 256, 22, pg8::MapPlain{DM, DM}, E); }
    if constexpr (PH == PH_KVQN) { phase_peb_final(F);
        EpiKvqN E{rinv, (bf16*)(ws + WS_KC), (bf16*)(ws + WS_VC), (bf16*)(ws + WS_KS), (bf16*)(ws + WS_KW), (bf16*)(ws + WS_Q), (float*)(ws + WS_GATE)};
        run_gemm(F, XB, (const bf16*)(ws + W_KVQ), DM, DM, DM, MTOK / 256, 8, pg8::MapPlain{DM, DM}, E); }
    if constexpr (PH == PH_KVQS) {
        const int ncmp = F.G >= 128 ? F.G / 4 : 0;
        if (ncmp == 0 || (int)blockIdx.x < ncmp) { EpiCmp E{(const float*)(ws + WS_PEB), (bf16*)(ws + WS_HIDC)};
            run_gemm(F, (const bf16*)(ws + WS_KC), (const bf16*)(ws + W_C1), 1024, 2048, 2048, 64, 1, MapCmp{}, E, ncmp ? ncmp : F.G, 0); }
        if (ncmp == 0 || (int)blockIdx.x >= ncmp) {
            if (ncmp == 0) __syncthreads();
            { EpiKvqS E{rinv, (bf16*)(ws + WS_VST), (bf16*)(ws + WS_VWT), (unsigned*)(ws + WS_CTL) + CW_VMAX};
              run_gemm(F, (const bf16*)(ws + W_KVV), XB, DM, DM, DM, 2, MTOK / 256, pg8::MapPlain{DM, DM}, E, F.G - ncmp, ncmp); }
            __syncthreads();
            { EpiGate E{rinv, (float*)(ws + WS_GATE)};
              run_gemm(F, XB, (const bf16*)(ws + W_KVQ) + (size_t)2048 * DM, DM, DM, DM, MTOK / 256, 1, pg8::MapPlain{DM, DM}, E, F.G - ncmp, ncmp); }
        }
    }
    if constexpr (PH == PH_CMP2) phase_cmp2(F);
    if constexpr (PH == PH_NSA) phase_nsa(F);
}
__device__ __forceinline__ void make_frame(Frame& F, unsigned char* lds, const Args& args) {
    int tid = threadIdx.x; asm volatile("" : "+v"(tid));
    GAS unsigned char* wsg = (GAS unsigned char*)args.ws; GAS float* outg = (GAS float*)args.out; asm volatile("" : "+s"(wsg), "+s"(outg));
    F.lds = (LAS unsigned char*)lds; F.ws = (unsigned char*)wsg; F.out = (float*)outg; F.in = args.in;
    F.tid = tid; F.lane = tid & 63; F.wave = __builtin_amdgcn_readfirstlane(tid >> 6);
    F.G = gridDim.x; { const int bx = blockIdx.x; F.vcu = (F.G % 8 == 0) ? (bx % 8) * (F.G / 8) + bx / 8 : bx; }
    F.gw = F.vcu * NWAVES + F.wave; F.NGW = F.G * NWAVES;
}
__global__ void __launch_bounds__(NTHREADS, 2) fwd(Args args) {
    extern __shared__ __attribute__((aligned(16))) unsigned char lds[];
    {   LAS unsigned* ctl = (LAS unsigned*)((LAS unsigned char*)lds + LDSCTL_OFF);
        for (int u = threadIdx.x; u < (LDS_BYTES - LDSCTL_OFF) / 4; u += NTHREADS) ctl[u] = 0u; }
    __syncthreads();
    const int lo = args.ph, hi = args.b;
    XcdBarrier bar; bar.bar = (unsigned*)(args.ws + WS_CTL) + CW_BAR; bar.x = 0; bar.st = nullptr;
    if (hi - lo > 1) bar = xcd_barrier_post((unsigned*)(args.ws + WS_CTL) + CW_BAR, (volatile LAS unsigned*)((LAS unsigned char*)lds + MISC_OFF) + 8);
    int ph = 0;
#ifndef DBG_MASK
#define DBG_MASK 0xffffffffu
#endif
#ifdef PROBE_SPIN_PH
#define SPIN_T0() const unsigned long long t0_ = wall_clock64()
#define SPIN_T1(PH) do { if (PH == PROBE_SPIN_PH) { const unsigned long long t1_ = wall_clock64(); while (wall_clock64() - t1_ < t1_ - t0_) __builtin_amdgcn_s_sleep(8); } } while (0)
#else
#define SPIN_T0() do {} while (0)
#define SPIN_T1(PH) do {} while (0)
#endif
#define RUN(PH, bval) do { if (ph >= lo && ph < hi) { Frame F; make_frame(F, lds, args); SPIN_T0(); if constexpr ((DBG_MASK >> PH) & 1u) phase_body<PH>(F, (bval)); SPIN_T1(PH); if (ph + 1 < hi) xcd_barrier(bar); } ++ph; } while (0)
    RUN(PH_PRO, 0);
#pragma unroll 1
    for (int layer = 0; layer < 2; ++layer) {
#pragma unroll 1
        for (int sub = 0; sub < 2; ++sub) {
            if (sub == 0) {
                if (layer == 0) {
#pragma unroll 1
                    for (int b = 0; b < NBATCH; ++b) { RUN(PH_P1, b); RUN(PH_R1, b); RUN(PH_R2, b); RUN(PH_R3, b); }
                    RUN(PH_G, 0);
                } else { RUN(PH_KVQN, 0); RUN(PH_KVQS, 0); RUN(PH_CMP2, 0); RUN(PH_NSA, 0); }
            } else RUN(PH_FI, layer);
            RUN(PH_OUT, 2 * layer + sub);
            RUN(PH_RES, 2 * layer + sub);
        }
    }
#undef RUN
}
constexpr int NPHASES = 1 + (8 + 1 + 2) + 3 + (4 + 2) + 3;
#ifndef MK_N_LAUNCH
#define MK_N_LAUNCH 1
#endif
extern "C" void kernel_launch(void* const* d_in, const int* in_sizes, int n_in, void* d_out, int out_size, void* d_ws, size_t ws_size, hipStream_t stream) {
    static int grid = 0;
    if (grid == 0) {
        if (n_in != 20 || out_size != MTOK * DM || ws_size < WS_NEED) { fprintf(stderr, "kernel_launch: unexpected problem shape (n_in %d, out %d, ws %zu)\n", n_in, out_size, ws_size); grid = -1; return; }
        int dev = 0, cus = 0, per_cu = 0;
        if (hipGetDevice(&dev) != hipSuccess || hipDeviceGetAttribute(&cus, hipDeviceAttributeMultiprocessorCount, dev) != hipSuccess) { grid = -1; return; }
        if (hipFuncSetAttribute((const void*)fwd, hipFuncAttributeMaxDynamicSharedMemorySize, LDS_BYTES) != hipSuccess) { fprintf(stderr, "kernel_launch: hipFuncSetAttribute failed\n"); grid = -1; return; }
        if (hipOccupancyMaxActiveBlocksPerMultiprocessor(&per_cu, (const void*)fwd, NTHREADS, LDS_BYTES) != hipSuccess || per_cu < 1) { fprintf(stderr, "kernel_launch: occupancy query says %d blocks per CU\n", per_cu); }
        (void)hipGetLastError();
        grid = cus;
    }
    if (grid < 0) return;
    (void)hipMemsetAsync((char*)d_ws + WS_CTL, 0, CTL_ZERO_BYTES, stream);
    Args a{};
    for (int i = 0; i < 20; ++i) a.in[i] = (const float*)d_in[i];
    a.out = (float*)d_out; a.ws = (unsigned char*)d_ws;
    if (MK_N_LAUNCH == 1) { a.ph = 0; a.b = NPHASES; hipLaunchKernelGGL(fwd, dim3(grid), dim3(NTHREADS), LDS_BYTES, stream, a); }
    else for (int p = 0; p < NPHASES; ++p) { a.ph = p; a.b = p + 1; hipLaunchKernelGGL(fwd, dim3(grid), dim3(NTHREADS), LDS_BYTES, stream, a); }
}
```

```cpp
#include <hip/hip_runtime.h>
#include <cstdio>
#include <cstdint>
#include <utility>

namespace pg8 {
#define PG8_LAS __attribute__((address_space(3)))
typedef unsigned short bf16_t;
typedef short bf16x8 __attribute__((ext_vector_type(8)));
typedef float f32x4 __attribute__((ext_vector_type(4)));
typedef unsigned u32x4 __attribute__((ext_vector_type(4)));
constexpr int BM = 256, BK = 64, HALF = 128, HTB = HALF * BK * 2  , STAGE_BYTES = 8 * HTB, NXCD = 8, WGM = 8;

__host__ __device__ __forceinline__ int lds_byte(int r, int c) { const int st = (r >> 4) * 2 + (c >> 5), rr = r & 15, cc = c & 31, ob = rr * 64 + cc * 2; return st * 1024 + (ob ^ (((ob >> 9) & 1) << 5)); }
__host__ __device__ __forceinline__ void stage_rc(int b, int& R, int& C) { const int st = b / 1024, sb = b % 1024, swz = sb ^ (((sb >> 9) & 1) << 5); R = (st >> 1) * 16 + swz / 64; C = (st & 1) * 32 + (swz % 64) / 2; }
__host__ __device__ __forceinline__ int perm32(int rho) { const int n = rho >> 4, i = rho & 15; return 8 * (i >> 2) + 4 * n + (i & 3); }

struct Unit { int pm, pn; size_t offA, offB; };
struct Gemm { const bf16_t* A; const bf16_t* Bt; int lda, ldb, K; };

template <class Map> struct Order {
    int nM, nN, nwg, G, c; Map map;
    __device__ __forceinline__ void init(int nM_, int nN_, int G_, int c_, const Map& m) { nM = nM_; nN = nN_; nwg = nM * nN; G = G_; c = c_; map = m; }
    __device__ __forceinline__ bool next(int i, Unit& u) const {
        const long L = (long)i * G + c; if (L >= nwg) return false;
        int wgid = (int)L; { const int q = nwg / NXCD, r = nwg % NXCD, xcd = wgid % NXCD, off = wgid / NXCD; wgid = (xcd < r ? xcd * (q + 1) : r * (q + 1) + (xcd - r) * q) + off; }
        const int nig = WGM * nN, gid = wgid / nig, fm = gid * WGM, gsz = (nM - fm) < WGM ? (nM - fm) : WGM;
        u.pm = fm + ((wgid % nig) % gsz); u.pn = (wgid % nig) / gsz; map(u); return true;
    }
    __device__ __forceinline__ void a_ready(const Unit&) const {}
    __device__ __forceinline__ void done(const Unit&) const {}
};
struct MapPlain { int lda, ldb; __device__ __forceinline__ void operator()(Unit& u) const { u.offA = (size_t)u.pm * 256 * lda * 2; u.offB = (size_t)u.pn * 256 * ldb * 2; } };

template <class Epi, class Sched, bool ALIGN_EPI = false, bool SP2 = false>
__device__ __forceinline__ void gemm_phase(PG8_LAS unsigned char* lds, const Gemm g, const Sched& S, const Epi& E, const int tid) {
    const int wid = __builtin_amdgcn_readfirstlane(tid >> 6), lane = tid & 63, wr = wid >> 2, wc = wid & 3, fr = lane & 15, fq = lane >> 4;
    const int K = g.K, nt = K / BK;
    unsigned voffA[2], voffB[2];
#pragma unroll
    for (int i = 0; i < 2; ++i) { int R, C; stage_rc(tid * 16 + i * 8192, R, C); const int Rb = Epi::PERM ? ((R & ~31) + perm32(R & 31)) : R;
        voffA[i] = (unsigned)(R * g.lda + C) * 2u; voffB[i] = (unsigned)(Rb * g.ldb + C) * 2u; }
    const size_t kstep = (size_t)(BK * 2);
    const size_t hstepA = (size_t)HALF * g.lda * 2, hstepB = (size_t)HALF * g.ldb * 2;
    const unsigned ldsw = (unsigned)wid * 1024u;
    const int aoff = lds_byte(wr * 64 + fr, fq * 8), boff = lds_byte(wc * 32 + fr, fq * 8);
#define PG8_SA(b, h) (((b) * 2 + (h)) * HTB)
#define PG8_SB(b, h) ((4 + (b) * 2 + (h)) * HTB)
#define PG8_STAGE(bufoff, gbase, voff) do { _Pragma("unroll") for (int _i = 0; _i < 2; ++_i) \
        __builtin_amdgcn_global_load_lds((const unsigned*)((const char*)(gbase) + (voff)[_i]), (PG8_LAS unsigned*)(lds + (bufoff) + ldsw + _i * 8192), 16, 0, 0); } while (0)
#define PG8_LDA(dst, b, h) do { _Pragma("unroll") for (int m = 0; m < 4; ++m) _Pragma("unroll") for (int k = 0; k < 2; ++k) dst[m][k] = *(const PG8_LAS bf16x8*)(lds + PG8_SA(b, h) + aoff + m * 2048 + k * 1024); } while (0)
#define PG8_LDB(dst, b, h) do { _Pragma("unroll") for (int n = 0; n < 2; ++n) _Pragma("unroll") for (int k = 0; k < 2; ++k) dst[n][k] = *(const PG8_LAS bf16x8*)(lds + PG8_SB(b, h) + boff + n * 2048 + k * 1024); } while (0)
#define PG8_MMA(ai, bj, At, Bt) do { __builtin_amdgcn_s_setprio(1); _Pragma("unroll") for (int m = 0; m < 4; ++m) _Pragma("unroll") for (int n = 0; n < 2; ++n) _Pragma("unroll") for (int k = 0; k < 2; ++k) \
        acc[ai][bj][m][n] = __builtin_amdgcn_mfma_f32_16x16x32_bf16(Bt[n][k], At[m][k], acc[ai][bj][m][n], 0, 0, 0); __builtin_amdgcn_s_setprio(0); } while (0)
#define PG8_WAIT_V(n) asm volatile("s_waitcnt vmcnt(" #n ")" ::: "memory")
#define PG8_WAIT_L(n) asm volatile("s_waitcnt lgkmcnt(" #n ")" ::: "memory")
#define PG8_BAR __builtin_amdgcn_s_barrier()
#define PG8_SCHED __builtin_amdgcn_sched_barrier(0)
    Unit cur, nxt; int ui = 0;
    if (!S.next(0, cur)) return;
    f32x4 acc[2][2][4][2];
#pragma unroll
    for (int a = 0; a < 2; ++a)
#pragma unroll
        for (int b = 0; b < 2; ++b)
#pragma unroll
            for (int m = 0; m < 4; ++m)
#pragma unroll
                for (int n = 0; n < 2; ++n) acc[a][b][m][n] = (f32x4){0.f, 0.f, 0.f, 0.f};
    bf16x8 At[4][2], B0[2][2], B1[2][2];
    const char* cA = (const char*)g.A + cur.offA; const char* cB = (const char*)g.Bt + cur.offB;
    S.a_ready(cur);
    if constexpr (SP2) {
        PG8_STAGE(PG8_SB(0, 0), cB, voffB); PG8_STAGE(PG8_SB(0, 1), cB + hstepB, voffB); PG8_STAGE(PG8_SA(0, 0), cA, voffA); PG8_STAGE(PG8_SA(0, 1), cA + hstepA, voffA);
        if (wr == 1) PG8_BAR;
        PG8_WAIT_V(2); PG8_BAR;
        PG8_STAGE(PG8_SB(1, 0), cB + kstep, voffB); PG8_STAGE(PG8_SA(1, 0), cA + kstep, voffA); PG8_STAGE(PG8_SB(1, 1), cB + hstepB + kstep, voffB);
        PG8_WAIT_V(6); PG8_BAR;
    } else {
        PG8_STAGE(PG8_SB(0, 0), cB, voffB); PG8_STAGE(PG8_SA(0, 0), cA, voffA); PG8_STAGE(PG8_SB(0, 1), cB + hstepB, voffB); PG8_STAGE(PG8_SA(0, 1), cA + hstepA, voffA);
        if (wr == 1) PG8_BAR;
        PG8_WAIT_V(4); PG8_BAR;
        PG8_STAGE(PG8_SB(1, 0), cB + kstep, voffB); PG8_STAGE(PG8_SA(1, 0), cA + kstep, voffA); PG8_STAGE(PG8_SB(1, 1), cB + hstepB + kstep, voffB);
        PG8_WAIT_V(6); PG8_BAR;
    }
    for (;;) {
        const bool has_next = S.next(ui + 1, nxt);
        const char* nA = has_next ? (const char*)g.A + nxt.offA : cA; const char* nB = has_next ? (const char*)g.Bt + nxt.offB : cB;
#pragma unroll 1
        for (int t = 0; t < nt; t += 2) {
            const bool last = (t == nt - 2);
            const char* a1 = cA + (size_t)(t + 1) * kstep;
            const char* a2 = last ? nA : cA + (size_t)(t + 2) * kstep; const char* b2 = last ? nB : cB + (size_t)(t + 2) * kstep;
            const char* a3 = a2 + kstep; const char* b3 = b2 + kstep;
            if (last && has_next) S.a_ready(nxt);
            if constexpr (SP2) {
            PG8_LDB(B0, 0, 0); PG8_LDB(B1, 0, 1); PG8_SCHED; PG8_LDA(At, 0, 0); PG8_STAGE(PG8_SA(1, 1), a1 + hstepA, voffA);
            PG8_WAIT_V(8); PG8_WAIT_L(0); PG8_BAR; PG8_MMA(0, 0, At, B0); PG8_MMA(0, 1, At, B1); PG8_BAR; PG8_SCHED;
            PG8_LDA(At, 0, 1); PG8_STAGE(PG8_SB(0, 0), b2, voffB); PG8_STAGE(PG8_SB(0, 1), b2 + hstepB, voffB); PG8_STAGE(PG8_SA(0, 0), a2, voffA);
            PG8_WAIT_V(8); PG8_WAIT_L(0); PG8_BAR; PG8_MMA(1, 0, At, B0); PG8_MMA(1, 1, At, B1); PG8_BAR; PG8_SCHED;
            PG8_LDB(B0, 1, 0); PG8_LDB(B1, 1, 1); PG8_SCHED; PG8_LDA(At, 1, 0); PG8_STAGE(PG8_SA(0, 1), a2 + hstepA, voffA);
            PG8_WAIT_V(8); PG8_WAIT_L(0); PG8_BAR; PG8_MMA(0, 0, At, B0); PG8_MMA(0, 1, At, B1); PG8_BAR; PG8_SCHED;
            PG8_LDA(At, 1, 1); PG8_STAGE(PG8_SB(1, 0), b3, voffB); PG8_STAGE(PG8_SB(1, 1), b3 + hstepB, voffB); PG8_STAGE(PG8_SA(1, 0), a3, voffA);
            PG8_WAIT_V(8); PG8_WAIT_L(0); PG8_BAR; PG8_MMA(1, 0, At, B0); PG8_MMA(1, 1, At, B1); PG8_BAR; PG8_SCHED;
            } else {
            PG8_LDB(B0, 0, 0); PG8_SCHED; PG8_LDA(At, 0, 0); PG8_STAGE(PG8_SA(1, 1), a1 + hstepA, voffA);
            PG8_WAIT_L(8); PG8_BAR; PG8_WAIT_L(0); PG8_MMA(0, 0, At, B0); PG8_BAR; PG8_SCHED;
            PG8_LDB(B1, 0, 1); PG8_STAGE(PG8_SB(0, 0), b2, voffB);
            PG8_BAR; PG8_WAIT_L(0); PG8_MMA(0, 1, At, B1); PG8_BAR;
            PG8_LDA(At, 0, 1); PG8_STAGE(PG8_SA(0, 0), a2, voffA);
            PG8_BAR; PG8_WAIT_L(0); PG8_MMA(1, 0, At, B0); PG8_BAR; PG8_SCHED;
            PG8_STAGE(PG8_SB(0, 1), b2 + hstepB, voffB);
            PG8_WAIT_V(6); PG8_BAR; PG8_MMA(1, 1, At, B1); PG8_BAR;
            PG8_LDB(B0, 1, 0); PG8_SCHED; PG8_LDA(At, 1, 0); PG8_STAGE(PG8_SA(0, 1), a2 + hstepA, voffA);
            PG8_WAIT_L(8); PG8_BAR; PG8_WAIT_L(0); PG8_MMA(0, 0, At, B0); PG8_BAR; PG8_SCHED;
            PG8_LDB(B1, 1, 1); PG8_STAGE(PG8_SB(1, 0), b3, voffB);
            PG8_BAR; PG8_WAIT_L(0); PG8_MMA(0, 1, At, B1); PG8_BAR;
            PG8_LDA(At, 1, 1); PG8_STAGE(PG8_SA(1, 0), a3, voffA);
            PG8_BAR; PG8_WAIT_L(0); PG8_MMA(1, 0, At, B0); PG8_BAR; PG8_SCHED;
            PG8_STAGE(PG8_SB(1, 1), b3 + hstepB, voffB);
            PG8_WAIT_V(6); PG8_BAR; PG8_MMA(1, 1, At, B1); PG8_BAR;
            }
        }
        if constexpr (ALIGN_EPI) { if (wr == 0) PG8_BAR; }
        if constexpr (!Epi::AFTER_DRAIN) { E(acc, cur, wr, wc, fr, fq); S.done(cur); }
        if (!has_next) break;
#pragma unroll
        for (int a = 0; a < 2; ++a)
#pragma unroll
            for (int b = 0; b < 2; ++b)
#pragma unroll
                for (int m = 0; m < 4; ++m)
#pragma unroll
                    for (int n = 0; n < 2; ++n) acc[a][b][m][n] = (f32x4){0.f, 0.f, 0.f, 0.f};
        cur = nxt; cA = nA; cB = nB; ++ui;
        if constexpr (ALIGN_EPI) { if (wr == 1) PG8_BAR; }
    }
    PG8_WAIT_V(0);
    if constexpr (!ALIGN_EPI) { if (wr == 0) PG8_BAR; }
    PG8_BAR;
    if constexpr (Epi::AFTER_DRAIN) { E.fused(acc, cur, wr, wc, fr, fq, lds, wid, lane); S.done(cur); }
#undef PG8_SA
#undef PG8_SB
#undef PG8_STAGE
#undef PG8_LDA
#undef PG8_LDB
#undef PG8_MMA
#undef PG8_WAIT_V
#undef PG8_WAIT_L
#undef PG8_BAR
#undef PG8_SCHED
}
}

constexpr int DM = 1024, NBATCH = 2, SEQ = 16384, MTOK = NBATCH * SEQ;
constexpr int FFH = 2816;
constexpr int RH = 4, RDK = 256, RDV = 512, RCH = 512, NCH = SEQ / RCH;
constexpr int RIN = 2 * RH * RDK + 2 * RH * RDV;
constexpr int NG = 4, NR = 4, HD = 64, NCMP = 1023, NSEL = 256, NSAIN = 1072;
constexpr float RMS_EPS = 1e-6f;
constexpr int APLD = 768;

constexpr size_t MiB = 1u << 20;
constexpr size_t WS_CTL = 0, CTL_ZERO_BYTES = 1 * MiB;
constexpr int CW_VMAX = 16384;
constexpr size_t WS_RINV = 1 * MiB;
constexpr size_t WS_BIAST = WS_RINV + 256 * 1024;
constexpr size_t WS_PEB = WS_BIAST + 16 * 1024;
constexpr size_t WS_PEBP = WS_PEB + 4 * 1024;
constexpr size_t WS_GSLOT = 2 * MiB;
constexpr size_t WS_OSLOT = 6 * MiB;
constexpr size_t WS_W = 8 * MiB;
constexpr size_t W_RI = WS_W, W_RO = W_RI + 12 * MiB, W_FI0 = W_RO + 4 * MiB, W_FI1 = W_FI0 + 11 * MiB, W_FO0 = W_FI1 + 11 * MiB, W_FO1 = W_FO0 + 11 * MiB / 2,
                 W_KVQ = W_FO1 + 11 * MiB / 2, W_KVV = W_KVQ + 9 * MiB / 2, W_NO = W_KVV + 1 * MiB, W_C1 = W_NO + 2 * MiB, W_C2 = W_C1 + 2 * MiB, W_END = W_C2 + 1 * MiB;
static_assert(W_END <= 68 * MiB, "weights");
constexpr size_t WS_TABA = 68 * MiB, WS_TABB = 84 * MiB;
constexpr size_t WS_XB = 100 * MiB;
constexpr size_t WS_MIX = 164 * MiB;
constexpr size_t WS_KT = WS_MIX, WS_KV = WS_MIX + 32 * MiB;
constexpr size_t WS_SCR = 228 * MiB;
constexpr size_t WS_AP = WS_SCR, WS_BP = WS_AP + 96 * MiB, WS_KN = WS_BP + 96 * MiB;
static_assert(WS_KN + 32 * MiB <= 512 * MiB, "ret scratch");
constexpr size_t WS_HID = WS_SCR;
constexpr size_t WS_KC = WS_SCR, WS_VC = WS_KC + 16 * MiB, WS_KS = WS_VC + 17 * MiB, WS_KW = WS_KS + 16 * MiB, WS_VST = WS_KW + 16 * MiB, WS_VWT = WS_VST + 16 * MiB,
                 WS_Q = WS_VWT + 16 * MiB, WS_GATE = WS_Q + 64 * MiB, WS_HIDC = WS_GATE + 6 * MiB, WS_KCMP = WS_HIDC + 8 * MiB, WS_VCMPT = WS_KCMP + 1 * MiB, WS_ONSA = WS_VCMPT + 1 * MiB,
                 WS_NSA_END = WS_ONSA + 64 * MiB;
static_assert(WS_NSA_END <= 512 * MiB, "nsa scratch");
constexpr size_t WS_NEED = 512 * MiB;

#define GAS __attribute__((address_space(1)))
#define LAS __attribute__((address_space(3)))
typedef unsigned short bf16;
typedef unsigned v4u __attribute__((ext_vector_type(4)));
typedef unsigned v2u __attribute__((ext_vector_type(2)));
typedef float f32x4 __attribute__((ext_vector_type(4)));
typedef float f32x2_t __attribute__((ext_vector_type(2)));
typedef __bf16 bf16x2_t __attribute__((ext_vector_type(2)));
typedef GAS unsigned gu32;
#define RLX_AGENT __ATOMIC_RELAXED, __HIP_MEMORY_SCOPE_AGENT
__device__ __forceinline__ unsigned cvtpk(float lo, float hi) { f32x2_t v = {lo, hi}; bf16x2_t b = __builtin_convertvector(v, bf16x2_t); return __builtin_bit_cast(unsigned, b); }
__device__ __forceinline__ v4u pack8(f32x4 a, f32x4 b) { v4u w; w.x = cvtpk(a[0], a[1]); w.y = cvtpk(a[2], a[3]); w.z = cvtpk(b[0], b[1]); w.w = cvtpk(b[2], b[3]); return w; }
__device__ __forceinline__ float bflo(unsigned w) { return __uint_as_float(w << 16); }
__device__ __forceinline__ float bfhi(unsigned w) { return __uint_as_float(w & 0xffff0000u); }
__device__ __forceinline__ float bf2f(bf16 b) { return __uint_as_float(((unsigned)b) << 16); }
__device__ __forceinline__ void unpack8(v4u w, float* f) { f[0] = bflo(w.x); f[1] = bfhi(w.x); f[2] = bflo(w.y); f[3] = bfhi(w.y); f[4] = bflo(w.z); f[5] = bfhi(w.z); f[6] = bflo(w.w); f[7] = bfhi(w.w); }
__device__ __forceinline__ bf16 f2bf(float f) { return (bf16)(cvtpk(f, 0.f) & 0xffffu); }
__device__ __forceinline__ int vperm(int t) { return (t & ~12) | ((t & 4) << 1) | ((t & 8) >> 1); }
__device__ __forceinline__ float sigm(float x) { return 1.f / (1.f + __expf(-x)); }
__device__ __forceinline__ float silu(float x) { return x / (1.f + __expf(-x)); }
__device__ __forceinline__ float lg2gamma(int h) { return log2f(1.0f - exp2f(-5.0f - (float)h)); }
__device__ __forceinline__ float wave_sum(float v) {
#pragma unroll
    for (int o = 1; o < 64; o <<= 1) v += __shfl_xor(v, o);
    return v;
}
__device__ __forceinline__ float wave_max(float v) {
#pragma unroll
    for (int o = 1; o < 64; o <<= 1) v = fmaxf(v, __shfl_xor(v, o));
    return v;
}
__device__ __forceinline__ int t5_bucket(int n) {
    if (n < 16) return n;
    if (n >= 113) return 31;
    int b = 16 + (int)(logf((float)n * 0.0625f) / 2.0794415416798357f * 16.0f);
    return b < 31 ? b : 31;
}

#define XB_TMO      128
#define XB_XCNT(j)  (256  + 64 * (j))
#define XB_XSUB(j)  (1280 + 64 * (j))
#define XB_XGEN(j)  (2304 + 64 * (j))
#define XB_TOP      3328
#define XB_TOPGEN   3392
#define XCD_BAR_WORDS 3456
#define XB_SPIN_CAP (1u << 18)
__device__ __forceinline__ unsigned xb_ld(unsigned* p)              { return __hip_atomic_load(p, __ATOMIC_RELAXED, __HIP_MEMORY_SCOPE_AGENT); }
__device__ __forceinline__ unsigned xb_add(unsigned* p, unsigned v) { return __hip_atomic_fetch_add(p, v, __ATOMIC_RELAXED, __HIP_MEMORY_SCOPE_AGENT); }
__device__ __forceinline__ unsigned xb_xcc_id() { return (unsigned)__builtin_amdgcn_s_getreg((3 << 11) | 20) & 0xFu; }
#define XB_SPIN(cond, bar) do { unsigned _sp = 0; while (cond) { __builtin_amdgcn_s_sleep(1); \
    if ((++_sp & 255u) == 0u) { if (xb_ld(&(bar)[XB_TMO])) break; if (_sp > XB_SPIN_CAP) { atomicAdd(&(bar)[XB_TMO], 1u); break; } } } } while (0)
struct XcdBarrier { unsigned* bar; unsigned x; volatile LAS unsigned* st; };
__device__ __forceinline__ XcdBarrier xcd_barrier_post(unsigned* bar, volatile LAS unsigned* st) {
    XcdBarrier b; b.bar = bar; b.x = xb_xcc_id(); b.st = st;
    if (threadIdx.x == 0) { const unsigned rank = xb_add(&bar[XB_XCNT(b.x)], 1u); st[2] = rank; st[3] = b.x; }
    return b;
}
__device__ __forceinline__ void xcd_barrier_complete(unsigned* bar, unsigned x, unsigned& nloc, unsigned& nx) {
    const unsigned G = gridDim.x * gridDim.y * gridDim.z;
    unsigned sum, cnt, mine, sp = 0u;
    for (;;) {
        sum = 0u; cnt = 0u; mine = 0u;
#pragma unroll
        for (unsigned j = 0; j < 16; ++j) { const unsigned c = xb_ld(&bar[XB_XCNT(j)]); sum += c; cnt += (c > 0u) ? 1u : 0u; mine = (j == x) ? c : mine; }
        if (sum == G) break;
        __builtin_amdgcn_s_sleep(1);
        if ((++sp & 255u) == 0u) { if (xb_ld(&bar[XB_TMO])) break; if (sp > XB_SPIN_CAP) { atomicAdd(&bar[XB_TMO], 1u); break; } }
    }
    nloc = mine > 0u ? mine : 1u; nx = cnt > 0u ? cnt : 1u;
}
__device__ __forceinline__ void xcd_barrier(const XcdBarrier& b) {
    asm volatile("s_waitcnt vmcnt(0)" ::: "memory");
    __syncthreads();
    if (threadIdx.x == 0) {
        unsigned* bar = b.bar;
        __builtin_amdgcn_s_waitcnt(0);
        unsigned nloc = b.st[0], nx = b.st[1];
        if (nloc == 0u) { xcd_barrier_complete(bar, b.x, nloc, nx); b.st[0] = nloc; b.st[1] = nx; }
        const unsigned old = xb_add(&bar[XB_XSUB(b.x)], 1u);
        const unsigned gen = old / nloc;
        if (old + 1u == (gen + 1u) * nloc) {
            __builtin_amdgcn_fence(__ATOMIC_RELEASE, "agent");
            asm volatile("s_waitcnt vmcnt(0)" ::: "memory");
            const unsigned og = xb_add(&bar[XB_TOP], 1u);
            const unsigned tg = og / nx;
            if (og + 1u == (tg + 1u) * nx) xb_add(&bar[XB_TOPGEN], 1u);
            else XB_SPIN(xb_ld(&bar[XB_TOPGEN]) == tg, bar);
            __builtin_amdgcn_fence(__ATOMIC_ACQUIRE, "agent");
            xb_add(&bar[XB_XGEN(b.x)], 1u);
            asm volatile("s_waitcnt vmcnt(0)" ::: "memory");
        } else {
            XB_SPIN(xb_ld(&bar[XB_XGEN(b.x)]) == gen, bar);
            __builtin_amdgcn_fence(__ATOMIC_ACQUIRE, "agent");
            asm volatile("s_waitcnt vmcnt(0)" ::: "memory");
        }
    }
    __syncthreads();
}

using pg8::Unit;
typedef const f32x4 (&AccRef)[2][2][4][2];
#define EPI_ROW(u, ai, m) ((u).pm * 256 + (ai) * 128 + wr * 64 + (m) * 16 + fr)
#define EPI_COL(bj) ((bj) * 128 + wc * 32 + 8 * fq)

struct EpiP1N {
    static constexpr bool PERM = true, AFTER_DRAIN = false;
    const float* rinv; const f32x4* tabA; bf16* AP; bf16* KN;
    __device__ __forceinline__ void operator()(AccRef acc, const Unit& u, int wr, int wc, int fr, int fq) const {
        const int h = u.pn & 3; const bool isk = u.pn >= 4; const float lg = lg2gamma(h);
#pragma unroll
        for (int ai = 0; ai < 2; ++ai)
#pragma unroll
            for (int m = 0; m < 4; ++m) {
                const int t = EPI_ROW(u, ai, m); const int p = t & (RCH - 1), c = t / RCH;
                const float rs = rinv[t] * (isk ? 0.0625f * exp2f(-(float)p * lg) : exp2f((float)p * lg));
#pragma unroll
                for (int bj = 0; bj < 2; ++bj) {
                    const int d0 = EPI_COL(bj);
                    const f32x4 c0 = tabA[(size_t)t * 64 + (d0 >> 2)], c1 = tabA[(size_t)t * 64 + (d0 >> 2) + 1];
                    const f32x4 v0 = acc[ai][bj][m][0] * rs, v1 = acc[ai][bj][m][1] * rs;
                    const f32x4 o0 = {v0[0] * c0[0] - v0[1] * c0[1], v0[0] * c0[1] + v0[1] * c0[0], v0[2] * c0[2] - v0[3] * c0[3], v0[2] * c0[3] + v0[3] * c0[2]};
                    const f32x4 o1 = {v1[0] * c1[0] - v1[1] * c1[1], v1[0] * c1[1] + v1[1] * c1[0], v1[2] * c1[2] - v1[3] * c1[3], v1[2] * c1[3] + v1[3] * c1[2]};
                    const v4u w = pack8(o0, o1);
                    if (isk) *(v4u*)(KN + (size_t)t * 1024 + h * 256 + d0) = w;
                    else *(v4u*)(AP + ((size_t)(h * NCH + c) * RCH + p) * APLD + RCH + d0) = w;
                }
            }
    }
};
struct EpiP1S {
    static constexpr bool PERM = true, AFTER_DRAIN = false;
    const float* rinv; const f32x4* tabB; bf16* KT; bf16* BP;
    __device__ __forceinline__ void operator()(AccRef acc, const Unit& u, int wr, int wc, int fr, int fq) const {
        const bool isk = u.pm < 4; const float lg = lg2gamma(u.pm & 3);
#pragma unroll
        for (int bj = 0; bj < 2; ++bj) {
            const int t0 = u.pn * 256 + EPI_COL(bj); const int c = t0 / RCH, p0 = t0 & (RCH - 1);
            const f32x4 r0 = *(const f32x4*)(rinv + t0), r1 = *(const f32x4*)(rinv + t0 + 4);
            f32x4 s0, s1;
#pragma unroll
            for (int j = 0; j < 4; ++j) { s0[j] = r0[j] * 0.0625f * exp2f(-(float)(p0 + j) * lg); s1[j] = r1[j] * 0.0625f * exp2f(-(float)(p0 + 4 + j) * lg); }
#pragma unroll
            for (int ai = 0; ai < 2; ++ai)
#pragma unroll
                for (int m = 0; m < 4; ++m) {
                    const int row = EPI_ROW(u, ai, m);
                    if (isk) {
                        const int d = row & 255, i = d >> 1; const bool odd = d & 1;
                        const f32x4 v0 = acc[ai][bj][m][0] * s0, v1 = acc[ai][bj][m][1] * s1; f32x4 q0, q1;
#pragma unroll
                        for (int j = 0; j < 4; ++j) { q0[j] = __shfl_xor(v0[j], 1); q1[j] = __shfl_xor(v1[j], 1); }
                        const f32x4* tb = tabB + ((size_t)i * SEQ + t0) / 2;
                        const f32x4 ca = tb[0], cb = tb[1], cc = tb[2], cd = tb[3];
                        f32x4 o0, o1;
                        if (odd) { o0 = (f32x4){q0[0] * ca[1] + v0[0] * ca[0], q0[1] * ca[3] + v0[1] * ca[2], q0[2] * cb[1] + v0[2] * cb[0], q0[3] * cb[3] + v0[3] * cb[2]};
                                   o1 = (f32x4){q1[0] * cc[1] + v1[0] * cc[0], q1[1] * cc[3] + v1[1] * cc[2], q1[2] * cd[1] + v1[2] * cd[0], q1[3] * cd[3] + v1[3] * cd[2]}; }
                        else     { o0 = (f32x4){v0[0] * ca[0] - q0[0] * ca[1], v0[1] * ca[2] - q0[1] * ca[3], v0[2] * cb[0] - q0[2] * cb[1], v0[3] * cb[2] - q0[3] * cb[3]};
                                   o1 = (f32x4){v1[0] * cc[0] - q1[0] * cc[1], v1[1] * cc[2] - q1[1] * cc[3], v1[2] * cd[0] - q1[2] * cd[1], v1[3] * cd[2] - q1[3] * cd[3]}; }
                        *(v4u*)(KT + (size_t)row * SEQ + t0) = pack8(o0, o1);
                    } else {
                        const int eg = row - 1024, h = eg >> 9, e = eg & 511;
                        *(v4u*)(BP + ((size_t)(h * NCH + c) * RCH + e) * APLD + p0) = pack8(acc[ai][bj][m][0] * r0, acc[ai][bj][m][1] * r1);
                    }
                }
        }
    }
};
struct EpiG {
    static constexpr bool PERM = true, AFTER_DRAIN = false;
    const float* rinv; const float* gslots; bf16* O;
    __device__ __forceinline__ void operator()(AccRef acc, const Unit& u, int wr, int wc, int fr, int fq) const {
        const int h = u.pn >> 1;
#pragma unroll
        for (int ai = 0; ai < 2; ++ai)
#pragma unroll
            for (int m = 0; m < 4; ++m) {
                const int row = EPI_ROW(u, ai, m); const float rin = rinv[row];
                const f32x4 sa = *(const f32x4*)(gslots + (size_t)row * 32 + h * 8), sb = *(const f32x4*)(gslots + (size_t)row * 32 + h * 8 + 4);
                const float ss = ((sa[0] + sa[1]) + (sa[2] + sa[3])) + ((sb[0] + sb[1]) + (sb[2] + sb[3]));
                const float rs = rsqrtf(ss * (1.0f / RDV) + RMS_EPS);
#pragma unroll
                for (int bj = 0; bj < 2; ++bj) {
                    bf16* op = O + (size_t)row * 2048 + u.pn * 256 + EPI_COL(bj);
                    float o[8]; unpack8(*(const v4u*)op, o);
                    const f32x4 g0 = acc[ai][bj][m][0] * rin, g1 = acc[ai][bj][m][1] * rin; f32x4 a, b;
#pragma unroll
                    for (int j = 0; j < 4; ++j) { a[j] = o[j] * rs * silu(g0[j]); b[j] = o[4 + j] * rs * silu(g1[j]); }
                    *(v4u*)op = pack8(a, b);
                }
            }
    }
};
struct EpiOut {
    static constexpr bool PERM = true, AFTER_DRAIN = false;
    bf16* MIX; float* oslots;
    __device__ __forceinline__ void operator()(AccRef acc, const Unit& u, int wr, int wc, int fr, int fq) const {
#pragma unroll
        for (int ai = 0; ai < 2; ++ai)
#pragma unroll
            for (int m = 0; m < 4; ++m) {
                const int row = EPI_ROW(u, ai, m); float ss = 0.f;
#pragma unroll
                for (int bj = 0; bj < 2; ++bj) {
                    const f32x4 v0 = acc[ai][bj][m][0], v1 = acc[ai][bj][m][1];
                    ss += (v0[0] * v0[0] + v0[1] * v0[1]) + (v0[2] * v0[2] + v0[3] * v0[3]) + (v1[0] * v1[0] + v1[1] * v1[1]) + (v1[2] * v1[2] + v1[3] * v1[3]);
                    *(v4u*)(MIX + (size_t)row * 1024 + u.pn * 256 + EPI_COL(bj)) = pack8(v0, v1);
                }
                ss += __shfl_xor(ss, 16); ss += __shfl_xor(ss, 32);
                if (fq == 0) oslots[(size_t)row * 16 + u.pn * 4 + wc] = ss;
            }
    }
};
struct EpiFfnIn {
    static constexpr bool PERM = true, AFTER_DRAIN = false;
    const float* rinv; bf16* HID;
    __device__ __forceinline__ void operator()(AccRef acc, const Unit& u, int wr, int wc, int fr, int fq) const {
#pragma unroll
        for (int ai = 0; ai < 2; ++ai)
#pragma unroll
            for (int m = 0; m < 4; ++m) {
                const int row = EPI_ROW(u, ai, m); const float rin = rinv[row];
                const f32x4 a0 = acc[ai][0][m][0] * rin, a1 = acc[ai][0][m][1] * rin, b0 = acc[ai][1][m][0] * rin, b1 = acc[ai][1][m][1] * rin; f32x4 x, y;
#pragma unroll
                for (int j = 0; j < 4; ++j) { x[j] = silu(a0[j]) * b0[j]; y[j] = silu(a1[j]) * b1[j]; }
                *(v4u*)(HID + (size_t)row * FFH + u.pn * 128 + wc * 32 + 8 * fq) = pack8(x, y);
            }
    }
};
struct EpiKvqN {
    static constexpr bool PERM = true, AFTER_DRAIN = false;
    const float* rinv; bf16 *KC, *VC, *KS, *KW, *Q; float* GATE;
    __device__ __forceinline__ void operator()(AccRef acc, const Unit& u, int wr, int wc, int fr, int fq) const {
        bf16* plane = u.pn == 0 ? KC : u.pn == 1 ? VC : u.pn == 2 ? KS : KW;
#pragma unroll
        for (int ai = 0; ai < 2; ++ai)
#pragma unroll
            for (int m = 0; m < 4; ++m) {
                const int row = EPI_ROW(u, ai, m); const float rin = rinv[row]; const int b = row / SEQ, t = row % SEQ;
#pragma unroll
                for (int bj = 0; bj < 2; ++bj) {
                    const int cc = EPI_COL(bj);
                    f32x4 v0 = acc[ai][bj][m][0] * rin, v1 = acc[ai][bj][m][1] * rin;
                    if (u.pn < 4) { const int g = cc >> 6, d = cc & 63;
                        const int o = u.pn == 2 ? (t & ~63) * HD + ((((t >> 5) & 1) * 4 + (d >> 4)) * 64 + ((d >> 3) & 1) * 32 + (t & 31)) * 8 : t * HD + d;
                        *(v4u*)(plane + (size_t)(b * NG + g) * SEQ * HD + o) = pack8(v0, v1); }
                    else { *(v4u*)(Q + (size_t)row * 1024 + (u.pn - 4) * 256 + cc) = pack8(v0 * (0.125f * 1.4426950408889634f), v1 * (0.125f * 1.4426950408889634f)); }
                }
            }
    }
};
struct EpiGate {
    static constexpr bool PERM = true, AFTER_DRAIN = false;
    const float* rinv; float* GATE;
    __device__ __forceinline__ void operator()(AccRef acc, const Unit& u, int wr, int wc, int fr, int fq) const {
#pragma unroll
        for (int ai = 0; ai < 2; ++ai)
#pragma unroll
            for (int m = 0; m < 4; ++m) {
                const int row = EPI_ROW(u, ai, m); const float rin = rinv[row]; const int cc = EPI_COL(0);
                if (cc < 48) { f32x4 v0 = acc[ai][0][m][0] * rin, v1 = acc[ai][0][m][1] * rin;
#pragma unroll
                    for (int j = 0; j < 4; ++j) { v0[j] = sigm(v0[j]); v1[j] = sigm(v1[j]); }
                    *(f32x4*)(GATE + (size_t)row * 48 + cc) = v0; *(f32x4*)(GATE + (size_t)row * 48 + cc + 4) = v1; }
            }
    }
};
struct EpiKvqS {
    static constexpr bool PERM = true, AFTER_DRAIN = false;
    const float* rinv; bf16 *VST, *VWT; unsigned* vmx;
    __device__ __forceinline__ void operator()(AccRef acc, const Unit& u, int wr, int wc, int fr, int fq) const {
        bf16* plane = u.pm == 0 ? VST : VWT;
        float vm[2] = {0.f, 0.f};
#pragma unroll
        for (int bj = 0; bj < 2; ++bj) {
            const int mg = u.pn * 256 + EPI_COL(bj); const int b = mg / SEQ, t = mg % SEQ;
            const f32x4 r0 = *(const f32x4*)(rinv + mg), r1 = *(const f32x4*)(rinv + mg + 4);
#pragma unroll
            for (int ai = 0; ai < 2; ++ai)
#pragma unroll
                for (int m = 0; m < 4; ++m) {
                    const int r256 = ai * 128 + wr * 64 + m * 16 + fr; const int g = r256 >> 6, d = r256 & 63;
                    const f32x4 w0 = acc[ai][bj][m][0] * r0, w1 = acc[ai][bj][m][1] * r1;
                    const v4u pk = pack8(w0, w1);
                    v2u lo; lo.x = pk.x; lo.y = pk.y; v2u hi; hi.x = pk.z; hi.y = pk.w;
                    if (u.pm == 0) {
                        vm[ai] = fmaxf(vm[ai], fmaxf(fmaxf(fmaxf(fabsf(w0[0]), fabsf(w0[1])), fmaxf(fabsf(w0[2]), fabsf(w0[3]))), fmaxf(fmaxf(fabsf(w1[0]), fabsf(w1[1])), fmaxf(fabsf(w1[2]), fabsf(w1[3])))));
                        bf16* fp = plane + (size_t)(b * NG + g) * HD * SEQ + (size_t)(t >> 6) * 4096 + ((((t >> 4) & 3) * 2 + (d >> 5)) * 64 + (d & 31)) * 8 + 4 * ((t >> 3) & 1);
                        *(v2u*)fp = lo; *(v2u*)(fp + 256) = hi;
                    } else { bf16* rowp = plane + ((size_t)((b * NG + g) * HD + d)) * SEQ; *(v2u*)(rowp + vperm(t)) = lo; *(v2u*)(rowp + vperm(t + 4)) = hi; }
                }
        }
        if (u.pm == 0) {
#pragma unroll
            for (int ai = 0; ai < 2; ++ai) { const float mx = wave_max(vm[ai]);
                if ((fr | fq) == 0) __hip_atomic_fetch_max(vmx + ((u.pn * 256) / SEQ) * NG + 2 * ai + wr, __float_as_uint(mx), __ATOMIC_RELAXED, __HIP_MEMORY_SCOPE_AGENT); }
        }
    }
};
struct EpiCmp {
    static constexpr bool PERM = true, AFTER_DRAIN = false;
    const float* peb; bf16* HIDC;
    __device__ __forceinline__ void operator()(AccRef acc, const Unit& u, int wr, int wc, int fr, int fq) const {
        const int kv = u.pm >= 32 ? 1 : 0;
#pragma unroll
        for (int bj = 0; bj < 2; ++bj) {
            const int col = EPI_COL(bj);
            const f32x4 b0 = *(const f32x4*)(peb + kv * 256 + col), b1 = *(const f32x4*)(peb + kv * 256 + col + 4);
#pragma unroll
            for (int ai = 0; ai < 2; ++ai)
#pragma unroll
                for (int m = 0; m < 4; ++m) {
                    const int row = EPI_ROW(u, ai, m); f32x4 x = acc[ai][bj][m][0] + b0, y = acc[ai][bj][m][1] + b1;
#pragma unroll
                    for (int j = 0; j < 4; ++j) { x[j] = silu(x[j]); y[j] = silu(y[j]); }
                    *(v4u*)(HIDC + (size_t)row * 256 + col) = pack8(x, y);
                }
        }
    }
};
struct MapCmp { __device__ __forceinline__ void operator()(Unit& u) const { u.offA = (size_t)u.pm * 256 * 1024 * 2; u.offB = (size_t)(u.pm >= 32 ? 256 : 0) * 2048 * 2; } };

struct MapKV { __device__ __forceinline__ void operator()(Unit& u) const { const int hc = u.pm >> 1, eh = u.pm & 1, h = hc / NCH, c = hc % NCH;
    u.offA = ((size_t)(hc * RCH + eh * 256) * APLD) * 2; u.offB = ((size_t)(h * RDK) * SEQ + (size_t)c * RCH) * 2; } };
struct EpiKV {
    static constexpr bool PERM = true, AFTER_DRAIN = false;
    bf16* KV;
    __device__ __forceinline__ void operator()(AccRef acc, const Unit& u, int wr, int wc, int fr, int fq) const {
#pragma unroll
        for (int ai = 0; ai < 2; ++ai)
#pragma unroll
            for (int m = 0; m < 4; ++m) { const int row = EPI_ROW(u, ai, m);
#pragma unroll
                for (int bj = 0; bj < 2; ++bj) *(v4u*)(KV + (size_t)row * RDK + EPI_COL(bj)) = pack8(acc[ai][bj][m][0], acc[ai][bj][m][1]); }
    }
};
struct MapS { __device__ __forceinline__ void operator()(Unit& u) const { const int hc = u.pm >> 1, qh = u.pm & 1, h = hc / NCH, c = hc % NCH;
    u.offA = ((size_t)(hc * RCH + qh * 256) * APLD + RCH) * 2; u.offB = ((size_t)(c * RCH + u.pn * 256) * 1024 + h * RDK) * 2; } };
struct EpiS {
    static constexpr bool PERM = true, AFTER_DRAIN = false;
    bf16* AP;
    __device__ __forceinline__ void operator()(AccRef acc, const Unit& u, int wr, int wc, int fr, int fq) const {
        const int qh = u.pm & 1;
#pragma unroll
        for (int ai = 0; ai < 2; ++ai)
#pragma unroll
            for (int m = 0; m < 4; ++m) { const int row = EPI_ROW(u, ai, m); const int qi = qh * 256 + ai * 128 + wr * 64 + m * 16 + fr;
#pragma unroll
                for (int bj = 0; bj < 2; ++bj) { const int k0 = u.pn * 256 + EPI_COL(bj); f32x4 v0 = acc[ai][bj][m][0], v1 = acc[ai][bj][m][1];
#pragma unroll
                    for (int j = 0; j < 4; ++j) { if (k0 + j > qi) v0[j] = 0.f; if (k0 + 4 + j > qi) v1[j] = 0.f; }
                    *(v4u*)(AP + (size_t)row * APLD + k0) = pack8(v0, v1); } }
    }
};
struct MapO { __device__ __forceinline__ void operator()(Unit& u) const { const int hc = u.pm >> 1, qh = u.pm & 1;
    u.offA = ((size_t)(hc * RCH + qh * 256) * APLD) * 2; u.offB = ((size_t)(hc * RCH + u.pn * 256) * APLD) * 2; } };
struct EpiO {
    static constexpr bool PERM = true, AFTER_DRAIN = false;
    bf16* O; float* gslots; int b;
    __device__ __forceinline__ void operator()(AccRef acc, const Unit& u, int wr, int wc, int fr, int fq) const {
        const int hc = u.pm >> 1, qh = u.pm & 1, h = hc / NCH, c = hc % NCH;
#pragma unroll
        for (int ai = 0; ai < 2; ++ai)
#pragma unroll
            for (int m = 0; m < 4; ++m) { const size_t row = (size_t)b * SEQ + c * RCH + qh * 256 + ai * 128 + wr * 64 + m * 16 + fr; float ss = 0.f;
#pragma unroll
                for (int bj = 0; bj < 2; ++bj) { const f32x4 v0 = acc[ai][bj][m][0], v1 = acc[ai][bj][m][1];
                    ss += (v0[0] * v0[0] + v0[1] * v0[1]) + (v0[2] * v0[2] + v0[3] * v0[3]) + (v1[0] * v1[0] + v1[1] * v1[1]) + (v1[2] * v1[2] + v1[3] * v1[3]);
                    *(v4u*)(O + row * 2048 + h * RDV + u.pn * 256 + EPI_COL(bj)) = pack8(v0, v1); }
                ss += __shfl_xor(ss, 16); ss += __shfl_xor(ss, 32);
                if (fq == 0) gslots[row * 32 + h * 8 + u.pn * 4 + wc] = ss; }
    }
};

constexpr int NWAVES = 8, NTHREADS = NWAVES * 64;
constexpr int RING_OFF = 0, RING_BYTES = 131072;
constexpr int LDS_BYTES = 163840;
constexpr int LDSCTL_OFF = LDS_BYTES - 1024, MISC_OFF = LDSCTL_OFF + 320;
constexpr int CW_BAR = 4096;

struct Args { const float* in[20]; float* out; unsigned char* ws; int ph, b; };
struct Frame {
    LAS unsigned char* lds; unsigned char* ws; float* out; const float* const* in;
    int tid, lane, wave, G, vcu, gw, NGW;
};

template <class T> __device__ __forceinline__ T* gp(T* p) { return (T*)(GAS T*)p; }
struct TDesc { const float* W; const float* gain; bf16* WT; int K, ldw, ncols, nblk, mode, off, start, pad; };
__device__ __forceinline__ int dest_row(int mode, int off, int n) {
    if (mode == 1) { const int up = n >= FFH, j = up ? n - FFH : n; return (j >> 7) * 256 + up * 128 + (j & 127); }
    if (mode == 2) { const int s = n >> 8, d = n & 255; return s < 3 ? n : s == 3 ? 2304 + d : s == 4 ? 768 + d : 2304 + 256 + d; }
    return n + off;
}
__device__ __forceinline__ void transpose_item(const LAS TDesc& D, LAS float* scr, int it, int lane) {
    const float* W = D.W; const float* gain = D.gain; const int K = D.K, ldw = D.ldw, ncols = D.ncols, nblk = D.nblk;
    const int k0 = 64 * (it / nblk), n0 = 32 * (it % nblk);
    const int q = lane & 7, kr = lane >> 3;
#pragma unroll
    for (int i = 0; i < 8; ++i) { const int kk = 8 * i + kr, n = n0 + 4 * q;
        f32x4 v = {0.f, 0.f, 0.f, 0.f}; if (n < ncols) v = *(const f32x4*)(W + (size_t)(k0 + kk) * ldw + n);
        if (gain) v *= gain[k0 + kk];
        LAS float* s = scr + kk * 33 + 4 * q; s[0] = v[0]; s[1] = v[1]; s[2] = v[2]; s[3] = v[3]; }
    asm volatile("s_waitcnt lgkmcnt(0)" ::: "memory");
    const int c = lane & 7;
#pragma unroll
    for (int j = 0; j < 4; ++j) { const int n = (lane >> 3) + 8 * j; const LAS float* s = scr + (8 * c) * 33 + n;
        v4u o; o.x = cvtpk(s[0 * 33], s[1 * 33]); o.y = cvtpk(s[2 * 33], s[3 * 33]); o.z = cvtpk(s[4 * 33], s[5 * 33]); o.w = cvtpk(s[6 * 33], s[7 * 33]);
        *(v4u*)(D.WT + (size_t)dest_row(D.mode, D.off, n0 + n) * K + k0 + 8 * c) = o; }
    asm volatile("s_waitcnt lgkmcnt(0)" ::: "memory");
}

__device__ __forceinline__ void row_to_bf16(const float* xrow, bf16* orow, float* rinv, int lane) {
    const f32x4* xr = (const f32x4*)xrow + lane; f32x4 v[4]; float s = 0.f;
#pragma unroll
    for (int j = 0; j < 4; ++j) { v[j] = xr[64 * j]; s += (v[j][0] * v[j][0] + v[j][1] * v[j][1]) + (v[j][2] * v[j][2] + v[j][3] * v[j][3]); }
    s = wave_sum(s);
    v2u* o8 = (v2u*)orow + lane;
#pragma unroll
    for (int j = 0; j < 4; ++j) { v2u w; w.x = cvtpk(v[j][0], v[j][1]); w.y = cvtpk(v[j][2], v[j][3]); o8[64 * j] = w; }
    if (lane == 0) *rinv = rsqrtf(s * (1.0f / DM) + RMS_EPS);
}

constexpr int NTD = 13;
__device__ __forceinline__ void phase_prologue(const Frame& F) {
    unsigned char* ws = F.ws; const float* in[20];
#pragma unroll
    for (int i = 0; i < 20; ++i) in[i] = gp(F.in[i]);
    LAS TDesc* TD = (LAS TDesc*)(F.lds + RING_OFF + 8 * 16384);
    if (F.tid == 0) {
        int st = 0;
#define TDSET(k, W_, K_, ldw_, nc_, ncp_, gain_, WT_, mode_, off_) do { TD[k].W = (W_); TD[k].gain = (gain_); TD[k].WT = (bf16*)(WT_); TD[k].K = (K_); TD[k].ldw = (ldw_); TD[k].ncols = (nc_); \
            TD[k].nblk = (ncp_) / 32; TD[k].mode = (mode_); TD[k].off = (off_); TD[k].start = st; st += ((K_) / 64) * ((ncp_) / 32); } while (0)
        TDSET(0, in[7], DM, RIN, RIN, RIN, in[1], ws + W_RI, 0, 0);
        TDSET(1, in[8], 2048, DM, DM, DM, (const float*)nullptr, ws + W_RO, 0, 0);
        TDSET(2, in[5], DM, 2 * FFH, 2 * FFH, 2 * FFH, in[3], ws + W_FI0, 1, 0);
        TDSET(3, in[5] + (size_t)DM * 2 * FFH, DM, 2 * FFH, 2 * FFH, 2 * FFH, in[3] + DM, ws + W_FI1, 1, 0);
        TDSET(4, in[6], FFH, DM, DM, DM, (const float*)nullptr, ws + W_FO0, 0, 0);
        TDSET(5, in[6] + (size_t)FFH * DM, FFH, DM, DM, DM, (const float*)nullptr, ws + W_FO1, 0, 0);
        TDSET(6, in[10], DM, 1536, 1536, 1536, in[9], ws + W_KVQ, 2, 0);
        TDSET(7, in[17], DM, NSAIN, NSAIN, 1280, in[1] + DM, ws + W_KVQ, 0, 1024);
        TDSET(8, in[18], DM, DM, DM, DM, (const float*)nullptr, ws + W_NO, 0, 0);
        TDSET(9, in[12], 2048, 256, 256, 256, (const float*)nullptr, ws + W_C1, 0, 0);
        TDSET(10, in[15], 2048, 256, 256, 256, (const float*)nullptr, ws + W_C1, 0, 256);
        TDSET(11, in[13], 256, 64, 64, 64, (const float*)nullptr, ws + W_C2, 0, 0);
        TDSET(12, in[16], 256, 64, 64, 64, (const float*)nullptr, ws + W_C2, 0, 64);
#undef TDSET
        TD[NTD].start = st;
    }
    __syncthreads();
    const int NT = TD[NTD].start, NJ = NT + MTOK + SEQ * 128 / 64;
    LAS float* scr = (LAS float*)(F.lds + RING_OFF + F.wave * 16384);
    f32x2_t* tabA = (f32x2_t*)(ws + WS_TABA); f32x2_t* tabB = (f32x2_t*)(ws + WS_TABB);
    for (int jb = F.gw; jb < NJ; jb += F.NGW) {
        const int it = (int)(((long long)jb * 7919) % NJ);
        if (it < NT) {
            int k = 0;
#pragma unroll
            for (int q = 1; q < NTD; ++q) k = it >= TD[q].start ? q : k;
            transpose_item(TD[k], scr, it - TD[k].start, F.lane);
        } else if (it < NT + MTOK) {
            const int m = it - NT; row_to_bf16(in[0] + (size_t)m * DM, (bf16*)(ws + WS_XB) + (size_t)m * DM, (float*)(ws + WS_RINV) + m, F.lane);
        } else {
            const int idx = (it - NT - MTOK) * 64 + F.lane, t = idx >> 7, i = idx & 127;
            const float theta = 1.0f / powf(10000.0f, (float)i * (1.0f / 127.0f));
            const float ang = (float)t * theta; float s, c; sincosf(ang, &s, &c);
            const f32x2_t v = {c, s}; tabA[idx] = v; tabB[(size_t)i * SEQ + t] = v;
        }
    }
    if (blockIdx.x == 0) for (int i = F.tid; i < 128 * 16; i += NTHREADS) ((float*)(ws + WS_BIAST))[i] = in[19][t5_bucket(i >> 4) * 16 + (i & 15)];
    if (blockIdx.x < 32) {
        const int kv = F.tid >> 8, c = F.tid & 255; const float* pe = kv ? in[14] : in[11]; const float* w1 = kv ? in[15] : in[12]; float s = 0.f;
        for (int k = 64 * blockIdx.x; k < 64 * blockIdx.x + 64; ++k) s += pe[k] * w1[(size_t)k * 256 + c];
        ((float*)(ws + WS_PEBP))[blockIdx.x * 512 + F.tid] = s;
    }
}
__device__ __forceinline__ void phase_peb_final(const Frame& F) {
    if (blockIdx.x == 0) { float s = 0.f; for (int w = 0; w < 32; ++w) s += ((const float*)(F.ws + WS_PEBP))[w * 512 + F.tid]; ((float*)(F.ws + WS_PEB))[F.tid] = s; }
}

__device__ __forceinline__ void phase_resid(const Frame& F, const float* hold_f32, const float* gpost, bool last) {
    const bf16* MIX = (const bf16*)(F.ws + WS_MIX); const float* oslots = (const float*)(F.ws + WS_OSLOT);
    bf16* XB = (bf16*)(F.ws + WS_XB); float* rinv = (float*)(F.ws + WS_RINV);
    constexpr int RPP = 4;
    f32x4 gp[4];
#pragma unroll
    for (int j = 0; j < 4; ++j) gp[j] = ((const f32x4*)gpost)[F.lane + 64 * j];
    for (int m0 = F.gw; m0 < MTOK; m0 += RPP * F.NGW) {
        f32x4 hn[RPP][4]; float sq[RPP]; float rs[RPP];
#pragma unroll
        for (int r = 0; r < RPP; ++r) { const int m = m0 + r * F.NGW < MTOK ? m0 + r * F.NGW : m0;
            const f32x4* sl = (const f32x4*)(oslots + (size_t)m * 16); const f32x4 s0 = sl[0], s1 = sl[1], s2 = sl[2], s3 = sl[3];
            const float ss = (((s0[0] + s0[1]) + (s0[2] + s0[3])) + ((s1[0] + s1[1]) + (s1[2] + s1[3]))) + (((s2[0] + s2[1]) + (s2[2] + s2[3])) + ((s3[0] + s3[1]) + (s3[2] + s3[3])));
            rs[r] = rsqrtf(ss * (1.0f / DM) + RMS_EPS);
            const v2u* mr = (const v2u*)(MIX + (size_t)m * DM) + F.lane; const v2u* xr = (const v2u*)(XB + (size_t)m * DM) + F.lane;
            sq[r] = 0.f;
#pragma unroll
            for (int j = 0; j < 4; ++j) { f32x4 hv;
                if (hold_f32) hv = ((const f32x4*)(hold_f32 + (size_t)m * DM) + F.lane)[64 * j];
                else { const v2u hw = xr[64 * j]; hv = (f32x4){bflo(hw.x), bfhi(hw.x), bflo(hw.y), bfhi(hw.y)}; }
                const v2u mw = mr[64 * j]; const f32x4 mx = {bflo(mw.x), bfhi(mw.x), bflo(mw.y), bfhi(mw.y)};
                hn[r][j] = hv + mx * rs[r] * gp[j]; sq[r] += (hn[r][j][0] * hn[r][j][0] + hn[r][j][1] * hn[r][j][1]) + (hn[r][j][2] * hn[r][j][2] + hn[r][j][3] * hn[r][j][3]); } }
#pragma unroll
        for (int r = 0; r < RPP; ++r) { const int m = m0 + r * F.NGW; if (m >= MTOK) break;
            if (last) { f32x4* ho = (f32x4*)(F.out + (size_t)m * DM) + F.lane;
#pragma unroll
                for (int j = 0; j < 4; ++j) ho[64 * j] = hn[r][j];
            } else {
                const float s = wave_sum(sq[r]); v2u* xw = (v2u*)(XB + (size_t)m * DM) + F.lane;
#pragma unroll
                for (int j = 0; j < 4; ++j) { v2u w; w.x = cvtpk(hn[r][j][0], hn[r][j][1]); w.y = cvtpk(hn[r][j][2], hn[r][j][3]); xw[64 * j] = w; }
                if (F.lane == 0) rinv[m] = rsqrtf(s * (1.0f / DM) + RMS_EPS);
            } }
    }
}

__device__ __forceinline__ void phase_cmp2(const Frame& F) {
    typedef short s8_t __attribute__((ext_vector_type(8))); typedef float f16_t __attribute__((ext_vector_type(16)));
    const bf16* HIDC = (const bf16*)(F.ws + WS_HIDC); bf16* KCMP = (bf16*)(F.ws + WS_KCMP); bf16* VCT = (bf16*)(F.ws + WS_VCMPT); const bf16* W2T = (const bf16*)(F.ws + W_C2);
    const int r32 = F.lane & 31, h = F.lane >> 5;
    for (int task = F.gw; task < 1024; task += F.NGW) {
        const int R0 = (task >> 1) * 32, ch = task & 1, kv = R0 >> 13, pl = (R0 >> 10) & 7, n0 = R0 & 1023;
        const GAS s8_t* xp = (const GAS s8_t*)(GAS bf16*)(HIDC + (size_t)(R0 + r32) * 256 + 8 * h);
        const GAS s8_t* wp = (const GAS s8_t*)(GAS bf16*)(W2T + (size_t)(kv * 64 + ch * 32 + r32) * 256 + 8 * h);
        s8_t x[16], wv[16];
#pragma unroll
        for (int s = 0; s < 16; ++s) { x[s] = xp[2 * s]; wv[s] = wp[2 * s]; }
        f16_t acc;
#pragma unroll
        for (int r = 0; r < 16; ++r) acc[r] = 0.f;
        if (kv == 0) {
#pragma unroll
            for (int s = 0; s < 16; ++s) acc = __builtin_amdgcn_mfma_f32_32x32x16_bf16(wv[s], x[s], acc, 0, 0, 0);
            const int n = n0 + r32; const float z = n == NCMP ? 0.f : 1.f;
#pragma unroll
            for (int a = 0; a < 4; ++a) { v2u pk; pk.x = cvtpk(acc[4 * a] * z, acc[4 * a + 1] * z); pk.y = cvtpk(acc[4 * a + 2] * z, acc[4 * a + 3] * z);
                *(v2u*)(KCMP + ((size_t)pl * 1024 + n) * 64 + ch * 32 + 8 * a + 4 * h) = pk; }
        } else {
#pragma unroll
            for (int s = 0; s < 16; ++s) acc = __builtin_amdgcn_mfma_f32_32x32x16_bf16(x[s], wv[s], acc, 0, 0, 0);
            if (n0 == 992 && h == 1) acc[15] = 0.f;
            const int d = ch * 32 + r32;
#pragma unroll
            for (int a = 0; a < 4; ++a) { v2u pk; pk.x = cvtpk(acc[4 * a], acc[4 * a + 1]); pk.y = cvtpk(acc[4 * a + 2], acc[4 * a + 3]);
                *(v2u*)(VCT + ((size_t)pl * 64 + d) * 1024 + vperm(n0 + 8 * a + 4 * h)) = pk; }
        }
    }
}

__device__ __forceinline__ void phase_ret_scan(const Frame& F) {
    const bf16* KV = (const bf16*)(F.ws + WS_KV); bf16* BP = (bf16*)(F.ws + WS_BP);
    for (int it = F.vcu * NTHREADS + F.tid; it < RH * RDV * (RDK / 8); it += F.G * NTHREADS) {
        const int d8 = it & 31, e = (it >> 5) & 511, h = it >> 14;
        const float cdec = exp2f((float)RCH * lg2gamma(h));
        float carry[8];
#pragma unroll
        for (int i = 0; i < 8; ++i) carry[i] = 0.f;
#pragma unroll 4
        for (int c = 0; c < NCH; ++c) {
            const size_t r = (size_t)(h * NCH + c) * RCH + e;
            float kv[8]; unpack8(*(const v4u*)(KV + r * RDK + d8 * 8), kv);
            v4u w; w.x = cvtpk(carry[0], carry[1]); w.y = cvtpk(carry[2], carry[3]); w.z = cvtpk(carry[4], carry[5]); w.w = cvtpk(carry[6], carry[7]);
            *(v4u*)(BP + r * APLD + RCH + d8 * 8) = w;
#pragma unroll
            for (int i = 0; i < 8; ++i) carry[i] = cdec * (carry[i] + kv[i]);
        }
    }
}

namespace nsa {
typedef float f32x16 __attribute__((ext_vector_type(16)));
typedef short s16x8 __attribute__((ext_vector_type(8)));
constexpr int KP = 64, SLOTB = 8192, GC = 2, GS = 4;
constexpr float LOG2E = 1.4426950408889634f, NEGB = -1.0e30f;
constexpr int L_IMP = 4 * GC * SLOTB, IMP_P = 260, L_SELM = L_IMP + 64 * IMP_P * 4, L_BT = L_SELM + 2048, L_UNI = L_BT + 2048, L_LIST = L_UNI + 64, L_END = L_LIST + 1024 + 16;
static_assert(L_END <= LDSCTL_OFF, "nsa lds");
constexpr int NB_P = 264, L_NB = 137344;
static_assert(L_NB >= L_END && L_NB % 16 == 0 && L_NB + 16 * NB_P * 4 <= LDSCTL_OFF, "bias table");
constexpr float IMP_SC = 67108864.f;
constexpr int L_SQ = 0, L_SM = 32768, L_SL = L_SM + 1024, L_TL = L_SL + 1024, TL_CAP = 320, L_TC = L_TL + TL_CAP * 4, L_TOK = L_TC + 64, L_SMF = L_TOK + TL_CAP * 32, L_SEND = L_SMF + 1024, SO_P = 66, L_SO = 64000;
static_assert(L_SEND <= L_SO && L_TOK % 32 == 0 && L_SO + 256 * SO_P * 4 <= L_SELM && L_SO % 16 == 0 && (256 * SO_P * 4) % 16 == 0, "sel lds");
__device__ __forceinline__ constexpr int krow(int r) { return (r & 3) + 8 * (r >> 2); }

__device__ __forceinline__ void tile_issue(LAS unsigned char* L, int koff, int voff, const bf16* Kg, const bf16* Vg, int ldv, int w, int lane) {
    asm volatile("" : "+v"(lane));
    const int row = 8 * w + (lane >> 3), c = (lane & 7) ^ ((row ^ (row >> 3)) & 7);
    __builtin_amdgcn_global_load_lds((const unsigned*)(Kg + (size_t)row * 64 + c * 8), (LAS unsigned*)(L + koff + w * 1024), 16, 0, 0);
    __builtin_amdgcn_global_load_lds((const unsigned*)(Vg + (size_t)row * ldv + c * 8), (LAS unsigned*)(L + voff + w * 1024), 16, 0, 0);
}
__device__ __forceinline__ void ktile_issue(LAS unsigned char* L, int koff, const bf16* Kg, int w, int lane) {
    asm volatile("" : "+v"(lane));
    const int row = 8 * w + (lane >> 3), c = (lane & 7) ^ ((row ^ (row >> 3)) & 7);
    __builtin_amdgcn_global_load_lds((const unsigned*)(Kg + (size_t)row * 64 + c * 8), (LAS unsigned*)(L + koff + w * 1024), 16, 0, 0);
}
struct KVFrag { s16x8 k[4], v[2][2]; };
__device__ __forceinline__ void frag_load(KVFrag& f, const LAS bf16* Kl, const LAS bf16* Vl, int kt, int r32, int h) {
    const int kr = 32 * kt + r32;
#pragma unroll
    for (int s = 0; s < 4; ++s) f.k[s] = *(const LAS s16x8*)(Kl + kr * KP + 8 * ((2 * s + h) ^ ((kr ^ (kr >> 3)) & 7)));
#pragma unroll
    for (int s2 = 0; s2 < 2; ++s2)
#pragma unroll
        for (int dt = 0; dt < 2; ++dt) { const int d = 32 * dt + r32; f.v[s2][dt] = *(const LAS s16x8*)(Vl + d * KP + 8 * ((4 * kt + 2 * s2 + h) ^ ((d ^ (d >> 3)) & 7))); }
    __builtin_amdgcn_sched_barrier(0);
}
__device__ __forceinline__ f32x16 qk_tile(const KVFrag& f, const s16x8 (&qf)[4], float cinit) {
    f32x16 p;
#pragma unroll
    for (int r = 0; r < 16; ++r) p[r] = cinit;
#pragma unroll
    for (int s = 0; s < 4; ++s) p = __builtin_amdgcn_mfma_f32_32x32x16_bf16(f.k[s], qf[s], p, 0, 0, 0);
    return p;
}
__device__ __forceinline__ void pv_tile(f32x16 (&o)[2], const KVFrag& f, const f32x16& p) {
#pragma unroll
    for (int s2 = 0; s2 < 2; ++s2) {
        v4u pw; pw.x = cvtpk(p[8 * s2 + 0], p[8 * s2 + 1]); pw.y = cvtpk(p[8 * s2 + 2], p[8 * s2 + 3]); pw.z = cvtpk(p[8 * s2 + 4], p[8 * s2 + 5]); pw.w = cvtpk(p[8 * s2 + 6], p[8 * s2 + 7]);
        const s16x8 pb = __builtin_bit_cast(s16x8, pw);
#pragma unroll
        for (int dt = 0; dt < 2; ++dt) {
            o[dt] = __builtin_amdgcn_mfma_f32_32x32x16_bf16(f.v[s2][dt], pb, o[dt], 0, 0, 0);
        }
    }
}
__device__ __forceinline__ float xhalf_max(float v) { auto rr = __builtin_amdgcn_permlane32_swap(__float_as_uint(v), __float_as_uint(v), false, false); return fmaxf(__uint_as_float(rr[0]), __uint_as_float(rr[1])); }
template <int MODE> __device__ __forceinline__ unsigned post_tile(f32x16& p, int kbase, int t, int lim, bool colok, const LAS float* bT) {
    unsigned vm = 0u;
#pragma unroll
    for (int r = 0; r < 16; ++r) {
        const int key = kbase + krow(r);
        const int dist = MODE == 0 ? t - 31 - 16 * key : t - key;
        const bool ok = colok && dist >= 0 && (MODE == 0 ? key < NCMP : dist < lim);
        const int di = dist < 0 ? 0 : (dist > 127 ? 127 : dist);
        p[r] = p[r] + bT[di * 4];
        vm |= ok ? (1u << r) : 0u;
    }
    return vm;
}
__device__ __forceinline__ void bias_tile(f32x16& p, const LAS float* NB, int kb, int t, int hd) {
    const int idx = 191 - t + kb, c = idx & 3;
    const LAS f32x4* b = (const LAS f32x4*)(NB + (c * 4 + hd) * NB_P + (idx - c));
#pragma unroll
    for (int a = 0; a < 4; ++a) { const f32x4 v = b[2 * a]; p[4 * a] += v[0]; p[4 * a + 1] += v[1]; p[4 * a + 2] += v[2]; p[4 * a + 3] += v[3]; }
}
__device__ __forceinline__ void cmp_bias(f32x16& p, int d0, const LAS float* bT) {
#pragma unroll
    for (int r = 0; r < 16; ++r) {
        const int dist = d0 - 16 * krow(r), di = dist < 0 ? 0 : (dist > 127 ? 127 : dist);
        const float b = bT[di * 4];
        p[r] = dist < 0 ? NEGB : p[r] + b;
    }
}
__device__ __forceinline__ void softmax_update(f32x16& p, unsigned vm, float& m, float& l, f32x16 (&o)[2], bool has_o) {
    float mx = NEGB;
#pragma unroll
    for (int r = 0; r < 16; ++r) if ((vm >> r) & 1u) mx = fmaxf(mx, p[r]);
    mx = xhalf_max(mx);
    const float mn = fmaxf(m, mx), alpha = __builtin_amdgcn_exp2f(m - mn);
    m = mn; float ls = 0.f;
#pragma unroll
    for (int r = 0; r < 16; ++r) { p[r] = ((vm >> r) & 1u) ? __builtin_amdgcn_exp2f(p[r] - mn) : 0.f; ls += p[r]; }
    l = l * alpha + ls;
    if (has_o && !__all(alpha == 1.0f)) {
#pragma unroll
        for (int r = 0; r < 16; ++r) { o[0][r] *= alpha; o[1][r] *= alpha; } }
}
__device__ __forceinline__ void softmax_update_fast(f32x16& p, float& m, float& l, f32x16 (&o)[2]) {
    float mx = p[0];
#pragma unroll
    for (int r = 1; r < 16; ++r) mx = fmaxf(mx, p[r]);
    mx = xhalf_max(mx);
    const float mn = fmaxf(m, mx), alpha = __builtin_amdgcn_exp2f(m - mn);
    m = mn; float ls = 0.f;
#pragma unroll
    for (int r = 0; r < 16; ++r) { p[r] = __builtin_amdgcn_exp2f(p[r] - mn); ls += p[r]; }
    l = l * alpha + ls;
    if (!__all(alpha == 1.0f)) {
#pragma unroll
        for (int r = 0; r < 16; ++r) { o[0][r] *= alpha; o[1][r] *= alpha; } }
}
#define DPP_XOR1 0xB1
#define DPP_XOR2 0x4E
#define DPP_HMIR 0x141
__device__ __forceinline__ float quad_sum(float v) { v += __int_as_float(__builtin_amdgcn_update_dpp(0, __float_as_int(v), DPP_XOR1, 0xf, 0xf, true)); v += __int_as_float(__builtin_amdgcn_update_dpp(0, __float_as_int(v), DPP_XOR2, 0xf, 0xf, true)); return v; }
__device__ __forceinline__ unsigned oct_umax(unsigned v) {
    unsigned o = (unsigned)__builtin_amdgcn_update_dpp(0, (int)v, DPP_XOR1, 0xf, 0xf, true); v = v > o ? v : o;
    o = (unsigned)__builtin_amdgcn_update_dpp(0, (int)v, DPP_XOR2, 0xf, 0xf, true); v = v > o ? v : o;
    o = (unsigned)__builtin_amdgcn_update_dpp(0, (int)v, DPP_HMIR, 0xf, 0xf, true); return v > o ? v : o;
}
__device__ __forceinline__ unsigned umax3(unsigned a, unsigned b, unsigned c) { unsigned d; asm("v_max3_u32 %0, %1, %2, %3" : "=v"(d) : "v"(a), "v"(b), "v"(c)); return d; }
template <int N> __device__ __forceinline__ unsigned umax_tree(const unsigned (&t)[N]) {
    if constexpr (N == 1) return t[0];
    else { constexpr int M = (N + 2) / 3; unsigned u[M];
#pragma unroll
        for (int i = 0; i < M; ++i) u[i] = umax3(t[3 * i], 3 * i + 1 < N ? t[3 * i + 1] : t[3 * i], 3 * i + 2 < N ? t[3 * i + 2] : t[3 * i]);
        return umax_tree<M>(u); }
}
template <int NE> __device__ __forceinline__ void topk_rounds(const LAS int* ip, LAS unsigned* sm, int sub, int cur, int need) {
    unsigned key[NE];
#pragma unroll
    for (int i = 0; i < NE; ++i) { const int j = sub + 8 * i; key[i] = (j >= 1 && j <= cur - 2) ? ((((unsigned)ip[j] >> 5) << 8) | (unsigned)(255 - j)) : 0u; }
#pragma unroll 1
    for (int round = 0; round < need; ++round) {
        unsigned bk = oct_umax(umax_tree<NE>(key));
#pragma unroll
        for (int i = 0; i < NE; ++i) key[i] = key[i] == bk ? 0u : key[i];
        const int bj = 255 - (int)(bk & 0xffu);
        if (sub == 0 && bk != 0u) (void)__hip_atomic_fetch_or(sm + (bj >> 5), 1u << (bj & 31), __ATOMIC_RELAXED, __HIP_MEMORY_SCOPE_WORKGROUP);
    }
}
__device__ __forceinline__ void lds_add_f32(LAS float* p, float v) { asm volatile("ds_add_f32 %0, %1" :: "v"((unsigned)(uintptr_t)p), "v"(v) : "memory"); }
__device__ __forceinline__ float max3f(float a, float b, float c) { float d; asm("v_max3_f32 %0, %1, %2, %3" : "=v"(d) : "v"(a), "v"(b), "v"(c)); return d; }
template <int OFF> __device__ __forceinline__ void lds_add_2i32_off(LAS int* p, int lo, int hi) {
    const unsigned long long v = ((unsigned long long)(unsigned)(hi + (lo >> 31)) << 32) | (unsigned)lo;
    asm volatile("ds_add_u64 %0, %1 offset:%2" :: "v"((unsigned)(uintptr_t)p), "v"(v), "n"(OFF) : "memory"); }
__device__ __forceinline__ void lds_max_i32(LAS int* p, int v) { asm volatile("ds_max_i32 %0, %1" :: "v"((unsigned)(uintptr_t)p), "v"(v) : "memory"); }
__device__ __forceinline__ void lds_add_i32(LAS int* p, int v) { asm volatile("ds_add_u32 %0, %1" :: "v"((unsigned)(uintptr_t)p), "v"(v) : "memory"); }
__device__ __forceinline__ int f2ord(float f) { const int b = __float_as_int(f); return b ^ ((b >> 31) & 0x7fffffff); }
__device__ __forceinline__ float ord2f(int o) { return __int_as_float(o ^ ((o >> 31) & 0x7fffffff)); }
struct KF { s16x8 k[2][4]; };
struct VF { s16x8 v[2][2][2]; };
__device__ __forceinline__ void kf_load(KF& f, const bf16* blk, int lane) {
    const GAS s16x8* p = (const GAS s16x8*)(GAS bf16*)blk + lane;
#pragma unroll
    for (int kt = 0; kt < 2; ++kt)
#pragma unroll
        for (int s = 0; s < 4; ++s) f.k[kt][s] = p[(kt * 4 + s) * 64];
}
__device__ __forceinline__ void vf_load(VF& f, const bf16* blk, int lane) {
    const GAS s16x8* p = (const GAS s16x8*)(GAS bf16*)blk + lane;
#pragma unroll
    for (int kt = 0; kt < 2; ++kt)
#pragma unroll
        for (int s2 = 0; s2 < 2; ++s2)
#pragma unroll
            for (int dt = 0; dt < 2; ++dt) f.v[kt][s2][dt] = p[((kt * 2 + s2) * 2 + dt) * 64];
}
__device__ __forceinline__ f32x16 qk_frag(const s16x8 (&kf)[4], const s16x8 (&qf)[4], float cinit) {
    f32x16 p;
#pragma unroll
    for (int r = 0; r < 16; ++r) p[r] = cinit;
#pragma unroll
    for (int s = 0; s < 4; ++s) p = __builtin_amdgcn_mfma_f32_32x32x16_bf16(kf[s], qf[s], p, 0, 0, 0);
    return p;
}
__device__ __forceinline__ void pv_frag(f32x16 (&o)[2], const s16x8 (&vf)[2][2], const f32x16& p) {
#pragma unroll
    for (int s2 = 0; s2 < 2; ++s2) {
        v4u pw; pw.x = cvtpk(p[8 * s2 + 0], p[8 * s2 + 1]); pw.y = cvtpk(p[8 * s2 + 2], p[8 * s2 + 3]); pw.z = cvtpk(p[8 * s2 + 4], p[8 * s2 + 5]); pw.w = cvtpk(p[8 * s2 + 6], p[8 * s2 + 7]);
        const s16x8 pb = __builtin_bit_cast(s16x8, pw);
#pragma unroll
        for (int dt = 0; dt < 2; ++dt) o[dt] = __builtin_amdgcn_mfma_f32_32x32x16_bf16(vf[s2][dt], pb, o[dt], 0, 0, 0);
    }
}
__device__ __forceinline__ void pvl_frag(f32x16 (&o)[3], const s16x8 (&vf)[2][2], const f32x16& p, const s16x8& ones) {
#pragma unroll
    for (int s2 = 0; s2 < 2; ++s2) {
        v4u pw; pw.x = cvtpk(p[8 * s2 + 0], p[8 * s2 + 1]); pw.y = cvtpk(p[8 * s2 + 2], p[8 * s2 + 3]); pw.z = cvtpk(p[8 * s2 + 4], p[8 * s2 + 5]); pw.w = cvtpk(p[8 * s2 + 6], p[8 * s2 + 7]);
        const s16x8 pb = __builtin_bit_cast(s16x8, pw);
#pragma unroll
        for (int dt = 0; dt < 2; ++dt) o[dt] = __builtin_amdgcn_mfma_f32_32x32x16_bf16(vf[s2][dt], pb, o[dt], 0, 0, 0);
        o[2] = __builtin_amdgcn_mfma_f32_32x32x16_bf16(ones, pb, o[2], 0, 0, 0);
    }
}
__device__ __forceinline__ void stats_update_fast(const f32x16& p, float& m, float& l) {
    float mx = p[0];
#pragma unroll
    for (int r = 1; r < 16; ++r) mx = fmaxf(mx, p[r]);
    mx = xhalf_max(mx);
    const float mn = fmaxf(m, mx), alpha = __builtin_amdgcn_exp2f(m - mn);
    m = mn; float ls = 0.f;
#pragma unroll
    for (int r = 0; r < 16; ++r) ls += __builtin_amdgcn_exp2f(p[r] - mn);
    l = l * alpha + ls;
}
#define NSA_BAR() do { asm volatile("s_waitcnt lgkmcnt(0)" ::: "memory"); __builtin_amdgcn_s_barrier(); asm volatile("" ::: "memory"); } while (0)
}

__device__ __forceinline__ void phase_nsa(const Frame& F) {
    using namespace nsa;
    const int tid = F.tid, lane = F.lane, w = F.wave, r32_ = lane & 31, h_ = lane >> 5;
    LAS unsigned char* L = F.lds + RING_OFF;
    LAS float* IMP = (LAS float*)(L + L_IMP); LAS unsigned* SELM = (LAS unsigned*)(L + L_SELM); LAS float* BT = (LAS float*)(L + L_BT);
    LAS float* NBT = (LAS float*)(L + L_NB);
    const bf16* Q = (const bf16*)(F.ws + WS_Q); const bf16* KCMP = (const bf16*)(F.ws + WS_KCMP); const bf16* VCT = (const bf16*)(F.ws + WS_VCMPT);
    const bf16* KS = (const bf16*)(F.ws + WS_KS); const bf16* KW = (const bf16*)(F.ws + WS_KW); const bf16* VST = (const bf16*)(F.ws + WS_VST); const bf16* VWT = (const bf16*)(F.ws + WS_VWT);
    const float* GATE = (const float*)(F.ws + WS_GATE); const float* biasT = (const float*)(F.ws + WS_BIAST); bf16* ONSA = (bf16*)(F.ws + WS_ONSA);
#if defined(PROBE_SPIN_SEC)
    unsigned long long tacc[8] = {0, 0, 0, 0, 0, 0, 0, 0}, tlast = wall_clock64(); const unsigned long long tstart = tlast;
#define STAMP(k) do { const unsigned long long tn_ = wall_clock64(); tacc[k] += tn_ - tlast; tlast = tn_; } while (0)
#else
#define STAMP(k) do {} while (0)
#endif
    int g_bt = -1;
#pragma unroll 1
    for (int e = F.vcu; e < 2048; e += F.G) {
        const int ui = e >> 8, pl = (e >> 5) & 7, wi = e & 31, b = pl >> 2, g = pl & 3;
        if (g != g_bt) {
            __syncthreads();
            for (int i = tid; i < 512; i += NTHREADS) BT[i] = biasT[(i >> 2) * 16 + g * 4 + (i & 3)] * LOG2E;
            for (int i = tid; i < 16 * NB_P; i += NTHREADS) { const int c = i / (4 * NB_P), hd = (i / NB_P) & 3, dist = 127 - ((i % NB_P) + c - 64);
                NBT[i] = dist < 0 ? NEGB : biasT[(dist > 127 ? 127 : dist) * 16 + g * 4 + hd] * LOG2E; }
            g_bt = g;
            __syncthreads();
        }
        const int qt = 32 * ui + ((wi + 4 * ui) & 31);
        const int t0 = qt * 64, cur = qt, m0 = b * SEQ + t0;
#define TOK(r_) (t0 + 8 * w + ((r_) >> 2))
#define MROW(r_) (m0 + 8 * w + ((r_) >> 2))
#define HEADG(r_) (g * NR + ((r_) & 3))
#define B31(r_) (BT[127 * 4 + ((r_) & 3)])
        const int ncb = t0 >= 0 ? ((t0 + 63 - 31) / 16) / 64 + 1 : 0;
        const int icut = t0 >= 1152 ? (((t0 - 144) >> 4) - 63) / 64 + 1 : 0;
        const bf16* Kc = KCMP + (size_t)pl * 1024 * 64; const bf16* Vc = VCT + (size_t)pl * 64 * 1024;
#define CK(ii) (Kc + (size_t)(ii) * 64 * 64)
#define CV(ii) (Vc + (ii) * 64)
#define K0_ISSUE(g) do { _Pragma("unroll") for (int q_ = 0; q_ < 4; ++q_) { const int b_ = (g) * 4 + q_; if (b_ < ncb) ktile_issue(L, (((g) & 1) * 4 + q_) * SLOTB, CK(b_), w, lane); } } while (0)
        K0_ISSUE(0);
#define LOAD_QF() s16x8 qf[4]; { int r_o = r32_, h_o = h_; asm volatile("" : "+v"(r_o), "+v"(h_o)); _Pragma("unroll") for (int s = 0; s < 4; ++s) qf[s] = *(const GAS s16x8*)(GAS bf16*)(Q + (size_t)MROW(r_o) * 1024 + HEADG(r_o) * 64 + 16 * s + 8 * h_o); }
#define OACC_DECL() int t_o = tid; asm volatile("" : "+v"(t_o)); f32x4* OACC = (f32x4*)((float*)(F.ws + WS_MIX) + ((size_t)blockIdx.x * NTHREADS + t_o) * 64);
#define GATE_LOAD(k_) ({ int l_o = r32_; asm volatile("" : "+v"(l_o)); GATE[(size_t)(m0 + 8 * w + (l_o >> 2)) * 48 + (g * NR + (l_o & 3)) * 3 + (k_)]; })
        const float gate0 = GATE_LOAD(0);
        LOAD_QF()
        for (int i = lane; i < 8 * IMP_P; i += 64) IMP[8 * w * IMP_P + i] = 0.f;
        for (int i = tid; i < 512; i += NTHREADS) SELM[i] = 0u;
        __syncthreads();
        STAMP(0);
        f32x16 oc[2];
#pragma unroll
        for (int r = 0; r < 16; ++r) { oc[0][r] = 0.f; oc[1][r] = 0.f; }
        float mref = 0.f, lc = 0.f; bool first = true;
        {
            auto body0 = [&](int i, const LAS bf16* Kl) __attribute__((always_inline)) {
                int r32 = r32_, h = h_; asm volatile("" : "+v"(r32), "+v"(h));
                const bool far = i < icut;
#pragma unroll
                for (int kt = 0; kt < 2; ++kt) {
                    const int kr = 32 * kt + r32; s16x8 kf[4];
#pragma unroll
                    for (int s = 0; s < 4; ++s) kf[s] = *(const LAS s16x8*)(Kl + kr * KP + 8 * ((2 * s + h) ^ ((kr ^ (kr >> 3)) & 7)));
                    f32x16 pp = qk_frag(kf, qf, far ? B31(r32) - mref : -mref);
                    if (!far) cmp_bias(pp, TOK(r32) - 31 - 16 * (i * 64 + 32 * kt + 4 * h), BT + (r32 & 3));
                    float tmax = max3f(pp[0], pp[1], pp[2]);
#pragma unroll
                    for (int r = 3; r < 15; r += 2) tmax = max3f(tmax, pp[r], pp[r + 1]);
                    tmax = fmaxf(tmax, pp[15]); tmax = xhalf_max(tmax);
                    const float d = first ? tmax : fmaxf(tmax, 0.f);
                    if (__any(d != 0.f)) {
                        mref += d; lc = first ? 0.f : lc * __builtin_amdgcn_exp2f(-d);
#pragma unroll
                        for (int r = 0; r < 16; ++r) pp[r] -= d;
                    }
                    first = false;
#pragma unroll
                    for (int r = 0; r < 16; ++r) lc += __builtin_amdgcn_exp2f(pp[r]);
                }
            };
            const int ng0 = (ncb + 3) >> 2;
#pragma unroll 1
            for (int g_ = 0; g_ < ng0; ++g_) {
                asm volatile("s_waitcnt vmcnt(0)" ::: "memory"); NSA_BAR(); if (g_ + 1 < ng0) K0_ISSUE(g_ + 1);
#pragma unroll 1
                for (int q_ = 0; q_ < 4; ++q_) { const int b_ = g_ * 4 + q_; if (b_ < ncb) body0(b_, (const LAS bf16*)(L + ((g_ & 1) * 4 + q_) * SLOTB)); }
            }
            NSA_BAR();
#undef K0_ISSUE
        }
        {
            const float lt = lc + __shfl_xor(lc, 32);
            const float mcl = (mref > -1.0e29f && lt > 0.f) ? mref + __builtin_amdgcn_logf(lt) - 26.0f : 1.0e30f;
            auto body = [&](int i, const LAS bf16* Kl, const LAS bf16* Vl) __attribute__((always_inline)) {
                int r32 = r32_, h = h_; asm volatile("" : "+v"(r32), "+v"(h));
                const bool far = i < icut;
#pragma unroll
                for (int kt = 0; kt < 2; ++kt) {
                    KVFrag fr; frag_load(fr, Kl, Vl, kt, r32, h);
                    f32x16 pp = qk_tile(fr, qf, far ? B31(r32) - mcl : -mcl);
                    if (!far) cmp_bias(pp, TOK(r32) - 31 - 16 * (i * 64 + 32 * kt + 4 * h), BT + (r32 & 3));
#pragma unroll
                    for (int r = 0; r < 16; ++r) pp[r] = __builtin_amdgcn_exp2f(pp[r]);
#pragma unroll
                    for (int a = 0; a < 4; ++a) {
                        const float s4 = quad_sum((pp[4 * a] + pp[4 * a + 1]) + (pp[4 * a + 2] + pp[4 * a + 3])), s1 = quad_sum(pp[4 * a + 3]);
                        const int j = i * 16 + kt * 8 + 2 * a + h;
                        if ((r32 & 3) == 0) { LAS int* ip = (LAS int*)IMP + (8 * w + (r32 >> 2)) * IMP_P + j; lds_add_i32(ip, (int)s4); lds_add_i32(ip + 1, (int)s1); }
                    }
                    pv_tile(oc, fr, pp);
                }
            };
#define NSA_ISSUE(G, g, n, KPTR, VPTR, LDV) do { _Pragma("unroll") for (int q_ = 0; q_ < G; ++q_) { const int b_ = (g) * G + q_, s_ = ((g) & 1) * G + q_; \
                if (b_ < (n)) tile_issue(L, s_ * SLOTB, (2 * G + s_) * SLOTB, KPTR(b_), VPTR(b_), LDV, w, lane); } } while (0)
#define NSA_LOOP(G, n, KPTR, VPTR, LDV) do { const int ng_ = ((n) + G - 1) / G; NSA_ISSUE(G, 0, (n), KPTR, VPTR, LDV); \
                _Pragma("unroll 1") for (int g_ = 0; g_ < ng_; ++g_) { asm volatile("s_waitcnt vmcnt(0)" ::: "memory"); NSA_BAR(); if (g_ + 1 < ng_) NSA_ISSUE(G, g_ + 1, (n), KPTR, VPTR, LDV); \
                    _Pragma("unroll 1") for (int q_ = 0; q_ < G; ++q_) { const int b_ = g_ * G + q_; const int s_ = (g_ & 1) * G + q_; \
                        if (b_ < (n)) body(b_, (const LAS bf16*)(L + s_ * SLOTB), (const LAS bf16*)(L + (2 * G + s_) * SLOTB)); } } \
                NSA_BAR(); } while (0)
            NSA_LOOP(GC, ncb, CK, CV, 1024);
        }
#undef CK
#undef CV
        const float g0 = gate0 * 1.4901161193847656e-08f;
        OACC_DECL()
#pragma unroll
        for (int q = 0; q < 4; ++q) { OACC[q] = (f32x4){oc[0][4 * q], oc[0][4 * q + 1], oc[0][4 * q + 2], oc[0][4 * q + 3]} * g0; OACC[4 + q] = (f32x4){oc[1][4 * q], oc[1][4 * q + 1], oc[1][4 * q + 2], oc[1][4 * q + 3]} * g0; }
        STAMP(1);
        {
            int lane_q = lane; asm volatile("" : "+v"(lane_q));
#pragma unroll
            for (int q = 0; q < 4; ++q) { const int row = 32 * w + 8 * q + (lane_q >> 3), c = (lane_q & 7) ^ (row & 7);
                __builtin_amdgcn_global_load_lds((const unsigned*)(Q + (size_t)(m0 + (row >> 2)) * 1024 + (g * NR + (row & 3)) * 64 + c * 8), (LAS unsigned*)(L + L_SQ + (32 * w + 8 * q) * 128), 16, 0, 0); }
        }
        {
            int lane_o = lane; asm volatile("" : "+v"(lane_o));
            const int tk = lane_o >> 3, sub = lane_o & 7; LAS unsigned* sm = SELM + (8 * w + tk) * 8;
            const int ncand = cur - 2, nf = cur + 1 < 3 ? cur + 1 : 3, need = 16 - nf;
            asm volatile("s_waitcnt lgkmcnt(0)" ::: "memory");
            if (sub == 0) { (void)__hip_atomic_fetch_or(sm, 1u, __ATOMIC_RELAXED, __HIP_MEMORY_SCOPE_WORKGROUP); (void)__hip_atomic_fetch_or(sm + (cur >> 5), 1u << (cur & 31), __ATOMIC_RELAXED, __HIP_MEMORY_SCOPE_WORKGROUP); if (cur >= 1) (void)__hip_atomic_fetch_or(sm + ((cur - 1) >> 5), 1u << ((cur - 1) & 31), __ATOMIC_RELAXED, __HIP_MEMORY_SCOPE_WORKGROUP); }
            if (ncand <= need) {
                if (sub == 0) for (int j = 1; j <= cur - 2; ++j) (void)__hip_atomic_fetch_or(sm + (j >> 5), 1u << (j & 31), __ATOMIC_RELAXED, __HIP_MEMORY_SCOPE_WORKGROUP);
            } else {
                const LAS int* ip = (const LAS int*)IMP + (8 * w + tk) * IMP_P;
                const int nen = ((cur - 2) >> 3) + 1;
                if (nen <= 8) topk_rounds<8>(ip, sm, sub, cur, need); else if (nen <= 16) topk_rounds<16>(ip, sm, sub, cur, need);
                else if (nen <= 24) topk_rounds<24>(ip, sm, sub, cur, need); else topk_rounds<32>(ip, sm, sub, cur, need);
            }
        }
        asm volatile("s_waitcnt vmcnt(0)" ::: "memory");
        __syncthreads();
        STAMP(2);
        {
            LAS int* SO = (LAS int*)(L + L_SO); LAS int* SM = (LAS int*)(L + L_SM); LAS int* SL = (LAS int*)(L + L_SL);
            LAS unsigned char* SQ = L + L_SQ; LAS unsigned* TL = (LAS unsigned*)(L + L_TL); LAS unsigned* TC = (LAS unsigned*)(L + L_TC); LAS unsigned char* TOKB = L + L_TOK;
            {
                int tid_o = tid; asm volatile("" : "+v"(tid_o));
                const int ln = tid_o & 63;
                const unsigned word = SELM[ln * 8 + w];
                unsigned long long tm = 0ull;
#pragma unroll
                for (int bt = 0; bt < 32; ++bt) { const unsigned long long mk = __ballot((word >> bt) & 1u); tm = ln == bt ? mk : tm; }
                const int jb = 32 * w + ln;
                const int cnt = (ln < 32 && jb != 0 && jb != cur && jb != cur - 1) ? __popcll(tm) : 0, nt = (cnt + 31) >> 5;
                int sc = nt;
#pragma unroll
                for (int o = 1; o < 32; o <<= 1) { const int v = __shfl_up(sc, o); if (ln >= o) sc += v; }
                if (ln == 31) TC[4 + w] = (unsigned)sc;
                if (tid_o < 256) SM[tid_o] = f2ord(NEGB);
                __syncthreads();
                if (nt > 0) {
                    const int j = 32 * w + ln;
                    int pos = sc - nt; for (int ww = 0; ww < w; ++ww) pos += (int)TC[4 + ww];
                    LAS unsigned char* tb = TOKB + pos * 32;
                    if (tm == ~0ull) {
                        unsigned pat = 0x03020100u; asm volatile("" : "+v"(pat));
#pragma unroll 1
                        for (int q = 0; q < 16; ++q) { ((LAS unsigned*)tb)[q] = pat; pat += 0x04040404u; }
                        TL[pos] = (unsigned)j | (32u << 8); TL[pos + 1] = (unsigned)j | (32u << 8);
                    } else {
                        unsigned long long rem = tm; int c = 0;
                        for (; rem != 0ull; ++c) { const int t = __ffsll((long long)rem) - 1; rem &= rem - 1ull; tb[c] = (unsigned char)t; }
                        for (; (c & 7) != 0; ++c) tb[c] = (unsigned char)0xff;
                        for (int k = 0; k < nt; ++k) TL[pos + k] = (unsigned)j | ((unsigned)(cnt - 32 * k < 32 ? cnt - 32 * k : 32) << 8);
                    }
                }
                __syncthreads();
            }
            STAMP(5);
            const int ntl = (int)(TC[4] + TC[5] + TC[6] + TC[7] + TC[8] + TC[9] + TC[10] + TC[11]);
            const int nmine = (ntl - w + 7) >> 3;
            const float vmax = __uint_as_float(((const unsigned*)(F.ws + WS_CTL))[CW_VMAX + pl]);
            const float kexp = fminf(20.f, floorf(19.f - log2f(fmaxf(vmax, 1.0e-30f))));
            const bf16* Kg = KS + (size_t)pl * SEQ * 64; const bf16* Vg = VST + (size_t)pl * 64 * SEQ;
#define SEL_DESC(k_) ({ int kk_ = (k_) < nmine ? (k_) : nmine - 1; kk_ = kk_ < 0 ? 0 : kk_; (unsigned)__builtin_amdgcn_readfirstlane(TL[w + 8 * kk_]); })
#define SEL_COLS(tb_, grp_) int r32 = r32_, h = h_; asm volatile("" : "+v"(r32), "+v"(h)); \
                    const unsigned tokb = (tb_)[8 * (grp_) + (r32 >> 2)]; \
                    const bool valid = tokb != 0xffu; const int tokl = valid ? (int)tokb : 0, row = tokl * 4 + (r32 & 3); \
                    s16x8 qg[4]; const unsigned qa = (unsigned)(uintptr_t)(SQ + row * 128) + (unsigned)((h ^ (row & 7)) << 4);     \
                    _Pragma("unroll") for (int s = 0; s < 4; ++s) qg[s] = *(const LAS s16x8*)(uintptr_t)(qa ^ (unsigned)(32 * s));
            const float kexpT = kexp - 2.0f;
            f32x4 pc[8];
            LAS float* SMF = (LAS float*)(L + L_SMF);
#pragma unroll 1
            for (int attempt = 0; attempt < 2; ++attempt) {
                int lane_ = lane; asm volatile("" : "+v"(lane_));
#define lane lane_
                if (attempt == 1) {
                {
                    KF ka, kb, kc; unsigned da = SEL_DESC(0), db = SEL_DESC(1), dc = 0u;
                    kf_load(ka, Kg + (size_t)(da & 255u) * 4096, lane); kf_load(kb, Kg + (size_t)(db & 255u) * 4096, lane);
                    auto step = [&](int k, KF& kcur, const unsigned dcur, KF& kpre, unsigned& dpre) __attribute__((always_inline)) {
                        dpre = SEL_DESC(k + 2);
                        kf_load(kpre, Kg + (size_t)(dpre & 255u) * 4096, lane);
                        const int j = (int)(dcur & 255u), ngrp = (int)((dcur >> 8) + 7u) >> 3; const bool near = j >= cur - 2;
                        const LAS unsigned char* tb = TOKB + (w + 8 * k) * 32;
#pragma unroll 1
                        for (int grp = 0; grp < ngrp; ++grp) {
                            SEL_COLS(tb, grp)
                            f32x16 p0 = qk_frag(kcur.k[0], qg, 0.f), p1 = qk_frag(kcur.k[1], qg, 0.f);
                            if (near) { bias_tile(p0, NBT, j * 64 + 4 * h, t0 + tokl, r32 & 3); bias_tile(p1, NBT, j * 64 + 32 + 4 * h, t0 + tokl, r32 & 3); }
                            float mx = max3f(p0[0], p1[0], NEGB);
#pragma unroll
                            for (int r = 1; r < 16; ++r) mx = max3f(mx, p0[r], p1[r]);
                            if (!near) mx += B31(r32);
                            { auto rr2 = __builtin_amdgcn_permlane32_swap(__float_as_uint(mx), __float_as_uint(mx), false, false); mx = max3f(__uint_as_float(rr2[0]), __uint_as_float(rr2[1]), NEGB); }
                            if (valid && h == 0) lds_max_i32(SM + row, f2ord(mx));
                        }
                    };
#pragma unroll 1
                    for (int k = 0; k < nmine; k += 3) {
                        step(k, ka, da, kc, dc);
                        if (k + 1 >= nmine) break;
                        step(k + 1, kb, db, ka, da);
                        if (k + 2 >= nmine) break;
                        step(k + 2, kc, dc, kb, db);
                    }
                    asm volatile("s_waitcnt vmcnt(0) lgkmcnt(0)" ::: "memory");
                }

                    __syncthreads();
                }
                {
                    LOAD_QF()
                    unsigned one2 = 0x3f803f80u; asm volatile("" : "+v"(one2));
                    const s16x8 ones = __builtin_bit_cast(s16x8, (v4u){one2, one2, one2, one2});
                    int r32 = r32_, h = h_; asm volatile("" : "+v"(r32), "+v"(h));
                    const int nfb = cur >= 2 ? 3 : cur + 1;
                    float mref = 0.f; bool seen = false; f32x16 ow[3];
#pragma unroll
                    for (int r = 0; r < 16; ++r) { ow[0][r] = 0.f; ow[1][r] = 0.f; ow[2][r] = 0.f; }
                    KF ka, kb; VF vf;
                    kf_load(ka, Kg, lane);
                    auto fstep = [&](int i, KF& kcur, KF& knext) __attribute__((always_inline)) {
                        const int j = i == 0 ? 0 : cur - (nfb - 1 - i), jn = (i + 1 < nfb) ? cur - (nfb - 2 - i) : j;
                        vf_load(vf, Vg + (size_t)j * 4096, lane); kf_load(knext, Kg + (size_t)jn * 4096, lane);
                        const bool nearb = j >= cur - 2;
#pragma unroll
                        for (int kt = 0; kt < 2; ++kt) {
                            f32x16 pp = qk_frag(kcur.k[kt], qf, (nearb ? 0.f : B31(r32)) - mref);
                            if (nearb) bias_tile(pp, NBT, j * 64 + 32 * kt + 4 * h, TOK(r32), r32 & 3);
                            float tmax = max3f(pp[0], pp[1], pp[2]);
#pragma unroll
                            for (int r = 3; r < 15; r += 2) tmax = max3f(tmax, pp[r], pp[r + 1]);
                            tmax = fmaxf(tmax, pp[15]); tmax = xhalf_max(tmax);
                            const bool ok = tmax > -1.0e29f;
                            const float d = seen ? fmaxf(tmax, 0.f) : (ok ? tmax : 0.f);
                            if (__any(d != 0.f)) {
                                const float al = seen ? __builtin_amdgcn_exp2f(-d) : 1.0f; mref += d; ow[2][0] *= al;
#pragma unroll
                                for (int r = 0; r < 16; ++r) { ow[0][r] *= al; ow[1][r] *= al; pp[r] -= d; }
                            }
                            seen = seen || ok;
#pragma unroll
                            for (int r = 0; r < 16; ++r) pp[r] = __builtin_amdgcn_exp2f(pp[r]);
                            pvl_frag(ow, vf.v[kt], pp, ones);
                        }
                    };
                    fstep(0, ka, kb);
                    if (nfb > 1) fstep(1, kb, ka);
                    if (nfb > 2) fstep(2, ka, kb);
                    const int row = (8 * w + (r32 >> 2)) * 4 + (r32 & 3);
                    const float refr = attempt == 0 ? mref + 4.0f : fmaxf(ord2f(SM[row]), mref);
                    const float fac = __builtin_amdgcn_exp2f(mref - refr + kexpT);
                    LAS int* op = SO + row * SO_P + 4 * h;
#pragma unroll
                    for (int dt = 0; dt < 2; ++dt)
#pragma unroll
                        for (int a = 0; a < 4; ++a) {
                            const int l0 = (int)(ow[dt][4 * a] * fac), h0 = (int)(ow[dt][4 * a + 1] * fac), l1 = (int)(ow[dt][4 * a + 2] * fac), h1 = (int)(ow[dt][4 * a + 3] * fac);
                            *(LAS v4u*)(op + 32 * dt + 8 * a) = (v4u){(unsigned)l0, (unsigned)(h0 + (l0 >> 31)), (unsigned)l1, (unsigned)(h1 + (l1 >> 31))};
                        }
                    if (h == 0) { SL[row] = (int)(ow[2][0] * fac); SMF[row] = refr; }
                    if (tid == 0) TC[3] = 0u;
                }
                __syncthreads();
                {
                    unsigned one2 = 0x3f803f80u; asm volatile("" : "+v"(one2));
                    const s16x8 ones = __builtin_bit_cast(s16x8, (v4u){one2, one2, one2, one2});
                    KF ka, kb; VF vf; unsigned dcur = SEL_DESC(0);
                    kf_load(ka, Kg + (size_t)(dcur & 255u) * 4096, lane); vf_load(vf, Vg + (size_t)(dcur & 255u) * 4096, lane);
                    auto step = [&](int k, KF& kcur, KF& knext) __attribute__((always_inline)) {
                        const unsigned dn = SEL_DESC(k + 1);
                        kf_load(knext, Kg + (size_t)(dn & 255u) * 4096, lane);
                        const int j = (int)(dcur & 255u), ngrp = (int)((dcur >> 8) + 7u) >> 3; const bool near = j >= cur - 2;
                        const LAS unsigned char* tb = TOKB + (w + 8 * k) * 32;
#pragma unroll 1
                        for (int grp = 0; grp < ngrp; ++grp) {
                            SEL_COLS(tb, grp)
                            const float mrow = SMF[row] - kexpT;
                            const float ci = valid ? (near ? -mrow : B31(r32) - mrow) : NEGB;
                            f32x16 p0 = qk_frag(kcur.k[0], qg, ci), p1 = qk_frag(kcur.k[1], qg, ci);
                            if (near) { bias_tile(p0, NBT, j * 64 + 4 * h, t0 + tokl, r32 & 3); bias_tile(p1, NBT, j * 64 + 32 + 4 * h, t0 + tokl, r32 & 3); }
                            if (attempt == 0) {
                                float tmax = max3f(p0[0], p1[0], p0[1]);
#pragma unroll
                                for (int r = 1; r < 15; ++r) tmax = max3f(tmax, p1[r], p0[r + 1]);
                                tmax = fmaxf(tmax, p1[15]);
                                if (__any(tmax > kexpT + 2.0f)) { if (lane == 0) TC[3] = 1u; }
                            }
#pragma unroll
                            for (int r = 0; r < 16; ++r) { p0[r] = __builtin_amdgcn_exp2f(p0[r]); p1[r] = __builtin_amdgcn_exp2f(p1[r]); }
                            f32x16 o[3];
#pragma unroll
                            for (int r = 0; r < 16; ++r) { o[0][r] = 0.f; o[1][r] = 0.f; o[2][r] = 0.f; }
                            pvl_frag(o, vf.v[0], p0, ones); pvl_frag(o, vf.v[1], p1, ones);
                            if (valid) {
                                LAS int* op = SO + row * SO_P + 4 * h;
                                if (h == 0) lds_add_i32(SL + row, (int)o[2][0]);
#define SEL_ADD4(dt_, a_) lds_add_2i32_off<(32 * dt_ + 8 * a_) * 4>(op, (int)o[dt_][4 * a_], (int)o[dt_][4 * a_ + 1]); lds_add_2i32_off<(32 * dt_ + 8 * a_ + 2) * 4>(op, (int)o[dt_][4 * a_ + 2], (int)o[dt_][4 * a_ + 3]);
                                SEL_ADD4(0, 0) SEL_ADD4(0, 1) SEL_ADD4(0, 2) SEL_ADD4(0, 3) SEL_ADD4(1, 0) SEL_ADD4(1, 1) SEL_ADD4(1, 2) SEL_ADD4(1, 3)
#undef SEL_ADD4
                            }
                        }
                        vf_load(vf, Vg + (size_t)(dn & 255u) * 4096, lane);
                        dcur = dn;
                    };
#pragma unroll 1
                    for (int k = 0; k < nmine; k += 2) {
                        step(k, ka, kb);
                        if (k + 1 >= nmine) break;
                        step(k + 1, kb, ka);
                    }
                    asm volatile("s_waitcnt vmcnt(0) lgkmcnt(0)" ::: "memory");
                }

{ OACC_DECL()
#pragma unroll
                for (int q = 0; q < 8; ++q) pc[q] = OACC[q];
                }
                __syncthreads();
                if (attempt == 1 || TC[3] == 0u) break;
#undef lane
            }
#undef SEL_DESC
#undef SEL_COLS
            STAMP(7);
            {
                int r32 = r32_, h = h_; asm volatile("" : "+v"(r32), "+v"(h));
                const int row = (8 * w + (r32 >> 2)) * 4 + (r32 & 3);
                OACC_DECL()
                const float g1 = GATE_LOAD(1), lt = (float)SL[row], sc = lt > 0.f ? g1 / lt : 0.f;
                const LAS int* op = SO + row * SO_P + 4 * h;
#define SEL_RD4(off_) ({ const int l0 = op[off_], h0 = op[off_ + 1] - (l0 >> 31), l1 = op[off_ + 2], h1 = op[off_ + 3] - (l1 >> 31); (f32x4){(float)l0, (float)h0, (float)l1, (float)h1} * sc; })
#pragma unroll
                for (int q = 0; q < 4; ++q) { OACC[q] = SEL_RD4(8 * q) + pc[q]; OACC[4 + q] = SEL_RD4(32 + 8 * q) + pc[4 + q]; }
#undef SEL_RD4
            }
            NSA_BAR();
        }
        STAMP(3);
        {
            const int jb0 = cur >= 8 ? cur - 8 : 0, nwb = cur - jb0 + 1;
            const bf16* Kg = KW + (size_t)pl * SEQ * 64; const bf16* Vg = VWT + (size_t)pl * 64 * SEQ;
            float mref = 0.f; bool seen = false; f32x16 ow[3];
            LOAD_QF()
            unsigned one2 = 0x3f803f80u; asm volatile("" : "+v"(one2));
            const s16x8 ones = __builtin_bit_cast(s16x8, (v4u){one2, one2, one2, one2});
#pragma unroll
            for (int r = 0; r < 16; ++r) { ow[0][r] = 0.f; ow[1][r] = 0.f; ow[2][r] = 0.f; }
            auto body = [&](int i, const LAS bf16* Kl, const LAS bf16* Vl) __attribute__((always_inline)) {
                const int j = jb0 + i;
                const bool far = j <= cur - 3 && j >= cur - 7, nearb = j >= cur - 2;
                int r32 = r32_, h = h_; asm volatile("" : "+v"(r32), "+v"(h));
#pragma unroll
                for (int kt = 0; kt < 2; ++kt) {
                    KVFrag fr; frag_load(fr, Kl, Vl, kt, r32, h);
                    f32x16 pp = qk_tile(fr, qf, (nearb ? 0.f : B31(r32)) - mref);
                    if (nearb) bias_tile(pp, NBT, j * 64 + 32 * kt + 4 * h, TOK(r32), r32 & 3);
                    else if (!far) {
                        const int klo = TOK(r32) - 512 - (j * 64 + 32 * kt + 4 * h);
#pragma unroll
                        for (int r = 0; r < 16; ++r) pp[r] = krow(r) > klo ? pp[r] : NEGB;
                    }
                    float tmax = max3f(pp[0], pp[1], pp[2]);
#pragma unroll
                    for (int r = 3; r < 15; r += 2) tmax = max3f(tmax, pp[r], pp[r + 1]);
                    tmax = fmaxf(tmax, pp[15]); tmax = xhalf_max(tmax);
                    const bool ok = tmax > -1.0e29f;
                    const float d = seen ? fmaxf(tmax, 0.f) : (ok ? tmax : 0.f);
                    if (__any(d != 0.f)) {
                        const float al = seen ? __builtin_amdgcn_exp2f(-d) : 1.0f; mref += d; ow[2][0] *= al;
#pragma unroll
                        for (int r = 0; r < 16; ++r) { ow[0][r] *= al; ow[1][r] *= al; pp[r] -= d; }
                    }
                    seen = seen || ok;
#pragma unroll
                    for (int r = 0; r < 16; ++r) pp[r] = __builtin_amdgcn_exp2f(pp[r]);
                    pvl_frag(ow, fr.v, pp, ones);
                }
            };
#define WK(ii) (Kg + (size_t)(jb0 + (ii)) * 64 * 64)
#define WV(ii) (Vg + (jb0 + (ii)) * 64)
            const float gate2 = GATE_LOAD(2);
            OACC_DECL()
            f32x4 pk[8];
#pragma unroll
            for (int q = 0; q < 8; ++q) pk[q] = OACC[q];
            NSA_LOOP(GS, nwb, WK, WV, SEQ);
#undef WK
#undef WV
            const float g2 = gate2, lt = ow[2][0], sc = lt > 0.f ? g2 / lt : 0.f;
#pragma unroll
            for (int r = 0; r < 16; ++r) { ow[0][r] *= sc; ow[1][r] *= sc; }
#pragma unroll
            for (int q = 0; q < 4; ++q) {
                const f32x4 a0 = pk[q], a1 = pk[4 + q];
#pragma unroll
                for (int j = 0; j < 4; ++j) { ow[0][4 * q + j] += a0[j]; ow[1][4 * q + j] += a1[j]; }
                __builtin_amdgcn_sched_barrier(0);
            }
            int r32 = r32_, h = h_; asm volatile("" : "+v"(r32), "+v"(h));
            bf16* op = ONSA + (size_t)MROW(r32) * 1024 + HEADG(r32) * 64 + 4 * h;
#pragma unroll
            for (int dt = 0; dt < 2; ++dt)
#pragma unroll
                for (int a = 0; a < 4; ++a) { v2u wv; wv.x = cvtpk(ow[dt][4 * a], ow[dt][4 * a + 1]); wv.y = cvtpk(ow[dt][4 * a + 2], ow[dt][4 * a + 3]); *(v2u*)(op + 32 * dt + 8 * a) = wv; }
            asm volatile("s_waitcnt lgkmcnt(0)" ::: "memory");
        }
        STAMP(4);
    }
#ifdef PROBE_SPIN_SEC
    { const unsigned long long t1_ = wall_clock64(); while (wall_clock64() - t1_ < tacc[PROBE_SPIN_SEC]) __builtin_amdgcn_s_sleep(8); }
#endif
#undef STAMP
#undef TOK
#undef MROW
#undef HEADG
#undef B31
#undef OACC_DECL
#undef GATE_LOAD
#undef LOAD_QF
#undef NSA_ISSUE
#undef NSA_LOOP
}

template <class Epi, class Map>
__device__ __forceinline__ void run_gemm(const Frame& F, const bf16* A, const bf16* Bt, int lda, int ldb, int K, int nM, int nN, const Map& map, const Epi& E, int Gs = 0, int c0 = 0) {
    pg8::Gemm g{A, Bt, lda, ldb, K}; pg8::Order<Map> S; S.init(nM, nN, Gs ? Gs : F.G, (int)blockIdx.x - c0, map);
    int tid = F.tid; asm volatile("" : "+v"(tid));
    pg8::gemm_phase<Epi, pg8::Order<Map>, true, true>(F.lds + RING_OFF, g, S, E, tid);
}
enum { PH_PRO, PH_P1, PH_R1, PH_R2, PH_R3, PH_G, PH_OUT, PH_RES, PH_FI, PH_KVQN, PH_KVQS, PH_CMP, PH_CMP2, PH_NSA, PH_COUNT };

template <int PH> __device__ __forceinline__ void phase_body(const Frame& F, int b) {
    unsigned char* ws = F.ws; float* rinv = (float*)(ws + WS_RINV); bf16* XB = (bf16*)(ws + WS_XB);
    if constexpr (PH == PH_PRO) phase_prologue(F);
    if constexpr (PH == PH_P1) {
        { EpiP1N E{rinv + b * SEQ, (const f32x4*)(ws + WS_TABA), (bf16*)(ws + WS_AP), (bf16*)(ws + WS_KN)};
          run_gemm(F, XB + (size_t)b * SEQ * DM, (const bf16*)(ws + W_RI), DM, DM, DM, SEQ / 256, 8, pg8::MapPlain{DM, DM}, E); }
        __syncthreads();
        { EpiP1S E{rinv + b * SEQ, (const f32x4*)(ws + WS_TABB), (bf16*)(ws + WS_KT), (bf16*)(ws + WS_BP)};
          run_gemm(F, (const bf16*)(ws + W_RI) + (size_t)1024 * DM, XB + (size_t)b * SEQ * DM, DM, DM, DM, 12, SEQ / 256, pg8::MapPlain{DM, DM}, E); }
    }
    if constexpr (PH == PH_R1) {
        { EpiKV E{(bf16*)(ws + WS_KV)};
          run_gemm(F, (const bf16*)(ws + WS_BP), (const bf16*)(ws + WS_KT), APLD, SEQ, RCH, RH * NCH * 2, 1, MapKV{}, E); }
        __syncthreads();
        { EpiS E{(bf16*)(ws + WS_AP)};
          run_gemm(F, (const bf16*)(ws + WS_AP), (const bf16*)(ws + WS_KN), APLD, 1024, RDK, RH * NCH * 2, 2, MapS{}, E); }
    }
    if constexpr (PH == PH_R2) phase_ret_scan(F);
    if constexpr (PH == PH_R3) { EpiO E{(bf16*)F.out, (float*)(ws + WS_GSLOT), b};
        run_gemm(F, (const bf16*)(ws + WS_AP), (const bf16*)(ws + WS_BP), APLD, APLD, APLD, RH * NCH * 2, 2, MapO{}, E); }
    if constexpr (PH == PH_G) { EpiG E{rinv, (const float*)(ws + WS_GSLOT), (bf16*)F.out};
        run_gemm(F, XB, (const bf16*)(ws + W_RI) + (size_t)4096 * DM, DM, DM, DM, MTOK / 256, 8, pg8::MapPlain{DM, DM}, E); }
    if constexpr (PH == PH_OUT) {
        const bf16* A = b == 0 ? (const bf16*)F.out : b == 2 ? (const bf16*)(ws + WS_ONSA) : (const bf16*)(ws + WS_HID);
        const bf16* Bt = (const bf16*)(ws + (b == 0 ? W_RO : b == 1 ? W_FO0 : b == 2 ? W_NO : W_FO1));
        const int K = b == 0 ? 2048 : b == 2 ? DM : FFH;
        EpiOut E{(bf16*)(ws + WS_MIX), (float*)(ws + WS_OSLOT)};
        run_gemm(F, A, Bt, K, K, K, MTOK / 256, 4, pg8::MapPlain{K, K}, E); }
    if constexpr (PH == PH_RES) phase_resid(F, b == 0 ? gp(F.in[0]) : (const float*)nullptr, gp(b & 1 ? F.in[4] : F.in[2]) + (b >> 1) * DM, b == 3);
    if constexpr (PH == PH_FI) { EpiFfnIn E{rinv, (bf16*)(ws + WS_HID)};
        run_gemm(F, XB, (const bf16*)(ws + (b ? W_FI1 : W_FI0)), DM, DM, DM, MTOK / 256, 22, pg8::MapPlain{DM, DM}, E); }
    if constexpr (PH == PH_KVQN) { phase_peb_final(F);
        EpiKvqN E{rinv, (bf16*)(ws + WS_KC), (bf16*)(ws + WS_VC), (bf16*)(ws + WS_KS), (bf16*)(ws + WS_KW), (bf16*)(ws + WS_Q), (float*)(ws + WS_GATE)};
        run_gemm(F, XB, (const bf16*)(ws + W_KVQ), DM, DM, DM, MTOK / 256, 8, pg8::MapPlain{DM, DM}, E); }
    if constexpr (PH == PH_KVQS) {
        const int ncmp = F.G >= 128 ? F.G / 4 : 0;
        if (ncmp == 0 || (int)blockIdx.x < ncmp) { EpiCmp E{(const float*)(ws + WS_PEB), (bf16*)(ws + WS_HIDC)};
            run_gemm(F, (const bf16*)(ws + WS_KC), (const bf16*)(ws + W_C1), 1024, 2048, 2048, 64, 1, MapCmp{}, E, ncmp ? ncmp : F.G, 0); }
        if (ncmp == 0 || (int)blockIdx.x >= ncmp) {
            if (ncmp == 0) __syncthreads();
            { EpiKvqS E{rinv, (bf16*)(ws + WS_VST), (bf16*)(ws + WS_VWT), (unsigned*)(ws + WS_CTL) + CW_VMAX};
              run_gemm(F, (const bf16*)(ws + W_KVV), XB, DM, DM, DM, 2, MTOK / 256, pg8::MapPlain{DM, DM}, E, F.G - ncmp, ncmp); }
            __syncthreads();
            { EpiGate E{rinv, (float*)(ws + WS_GATE)};
              run_gemm(F, XB, (const bf16*)(ws + W_KVQ) + (size_t)2048 * DM, DM, DM, DM, MTOK / 256, 1, pg8::MapPlain{DM, DM}, E, F.G - ncmp, ncmp); }
        }
    }
    if constexpr (PH == PH_CMP2) phase_cmp2(F);
    if constexpr (PH == PH_NSA) phase_nsa(F);
}
__device__ __forceinline__ void make_frame(Frame& F, unsigned char* lds, const Args& args) {
    int tid = threadIdx.x; asm volatile("" : "+v"(tid));
    GAS unsigned char* wsg = (GAS unsigned char*)args.ws; GAS float* outg = (GAS float*)args.out; asm volatile("" : "+s"(wsg), "+s"(outg));
    F.lds = (LAS unsigned char*)lds; F.ws = (unsigned char*)wsg; F.out = (float*)outg; F.in = args.in;
    F.tid = tid; F.lane = tid & 63; F.wave = __builtin_amdgcn_readfirstlane(tid >> 6);
    F.G = gridDim.x; { const int bx = blockIdx.x; F.vcu = (F.G % 8 == 0) ? (bx % 8) * (F.G / 8) + bx / 8 : bx; }
    F.gw = F.vcu * NWAVES + F.wave; F.NGW = F.G * NWAVES;
}
__global__ void __launch_bounds__(NTHREADS, 2) fwd(Args args) {
    extern __shared__ __attribute__((aligned(16))) unsigned char lds[];
    {   LAS unsigned* ctl = (LAS unsigned*)((LAS unsigned char*)lds + LDSCTL_OFF);
        for (int u = threadIdx.x; u < (LDS_BYTES - LDSCTL_OFF) / 4; u += NTHREADS) ctl[u] = 0u; }
    __syncthreads();
    const int lo = args.ph, hi = args.b;
    XcdBarrier bar; bar.bar = (unsigned*)(args.ws + WS_CTL) + CW_BAR; bar.x = 0; bar.st = nullptr;
    if (hi - lo > 1) bar = xcd_barrier_post((unsigned*)(args.ws + WS_CTL) + CW_BAR, (volatile LAS unsigned*)((LAS unsigned char*)lds + MISC_OFF) + 8);
    int ph = 0;
#ifndef DBG_MASK
#define DBG_MASK 0xffffffffu
#endif
#ifdef PROBE_SPIN_PH
#define SPIN_T0() const unsigned long long t0_ = wall_clock64()
#define SPIN_T1(PH) do { if (PH == PROBE_SPIN_PH) { const unsigned long long t1_ = wall_clock64(); while (wall_clock64() - t1_ < t1_ - t0_) __builtin_amdgcn_s_sleep(8); } } while (0)
#else
#define SPIN_T0() do {} while (0)
#define SPIN_T1(PH) do {} while (0)
#endif
#define RUN(PH, bval) do { if (ph >= lo && ph < hi) { Frame F; make_frame(F, lds, args); SPIN_T0(); if constexpr ((DBG_MASK >> PH) & 1u) phase_body<PH>(F, (bval)); SPIN_T1(PH); if (ph + 1 < hi) xcd_barrier(bar); } ++ph; } while (0)
    RUN(PH_PRO, 0);
#pragma unroll 1
    for (int layer = 0; layer < 2; ++layer) {
#pragma unroll 1
        for (int sub = 0; sub < 2; ++sub) {
            if (sub == 0) {
                if (layer == 0) {
#pragma unroll 1
                    for (int b = 0; b < NBATCH; ++b) { RUN(PH_P1, b); RUN(PH_R1, b); RUN(PH_R2, b); RUN(PH_R3, b); }
                    RUN(PH_G, 0);
                } else { RUN(PH_KVQN, 0); RUN(PH_KVQS, 0); RUN(PH_CMP2, 0); RUN(PH_NSA, 0); }
            } else RUN(PH_FI, layer);
            RUN(PH_OUT, 2 * layer + sub);
            RUN(PH_RES, 2 * layer + sub);
        }
    }
#undef RUN
}
constexpr int NPHASES = 1 + (8 + 1 + 2) + 3 + (4 + 2) + 3;
#ifndef MK_N_LAUNCH
#define MK_N_LAUNCH 1
#endif
extern "C" void kernel_launch(void* const* d_in, const int* in_sizes, int n_in, void* d_out, int out_size, void* d_ws, size_t ws_size, hipStream_t stream) {
    static int grid = 0;
    if (grid == 0) {
        if (n_in != 20 || out_size != MTOK * DM || ws_size < WS_NEED) { fprintf(stderr, "kernel_launch: unexpected problem shape (n_in %d, out %d, ws %zu)\n", n_in, out_size, ws_size); grid = -1; return; }
        int dev = 0, cus = 0, per_cu = 0;
        if (hipGetDevice(&dev) != hipSuccess || hipDeviceGetAttribute(&cus, hipDeviceAttributeMultiprocessorCount, dev) != hipSuccess) { grid = -1; return; }
        if (hipFuncSetAttribute((const void*)fwd, hipFuncAttributeMaxDynamicSharedMemorySize, LDS_BYTES) != hipSuccess) { fprintf(stderr, "kernel_launch: hipFuncSetAttribute failed\n"); grid = -1; return; }
        if (hipOccupancyMaxActiveBlocksPerMultiprocessor(&per_cu, (const void*)fwd, NTHREADS, LDS_BYTES) != hipSuccess || per_cu < 1) { fprintf(stderr, "kernel_launch: occupancy query says %d blocks per CU\n", per_cu); }
        (void)hipGetLastError();
        grid = cus;
    }
    if (grid < 0) return;
    (void)hipMemsetAsync((char*)d_ws + WS_CTL, 0, CTL_ZERO_BYTES, stream);
    Args a{};
    for (int i = 0; i < 20; ++i) a.in[i] = (const float*)d_in[i];
    a.out = (float*)d_out; a.ws = (unsigned char*)d_ws;
    if (MK_N_LAUNCH == 1) { a.ph = 0; a.b = NPHASES; hipLaunchKernelGGL(fwd, dim3(grid), dim3(NTHREADS), LDS_BYTES, stream, a); }
    else for (int p = 0; p < NPHASES; ++p) { a.ph = p; a.b = p + 1; hipLaunchKernelGGL(fwd, dim3(grid), dim3(NTHREADS), LDS_BYTES, stream, a); }
}
```

```cpp
#include <hip/hip_runtime.h>
#include <cstdio>
#include <cstdint>
#include <utility>

namespace pg8 {
#define PG8_LAS __attribute__((address_space(3)))
typedef unsigned short bf16_t;
typedef short bf16x8 __attribute__((ext_vector_type(8)));
typedef float f32x4 __attribute__((ext_vector_type(4)));
typedef unsigned u32x4 __attribute__((ext_vector_type(4)));
constexpr int BM = 256, BK = 64, HALF = 128, HTB = HALF * BK * 2  , STAGE_BYTES = 8 * HTB, NXCD = 8, WGM = 8;

__host__ __device__ __forceinline__ int lds_byte(int r, int c) { const int st = (r >> 4) * 2 + (c >> 5), rr = r & 15, cc = c & 31, ob = rr * 64 + cc * 2; return st * 1024 + (ob ^ (((ob >> 9) & 1) << 5)); }
__host__ __device__ __forceinline__ void stage_rc(int b, int& R, int& C) { const int st = b / 1024, sb = b % 1024, swz = sb ^ (((sb >> 9) & 1) << 5); R = (st >> 1) * 16 + swz / 64; C = (st & 1) * 32 + (swz % 64) / 2; }
__host__ __device__ __forceinline__ int perm32(int rho) { const int n = rho >> 4, i = rho & 15; return 8 * (i >> 2) + 4 * n + (i & 3); }

struct Unit { int pm, pn; size_t offA, offB; };
struct Gemm { const bf16_t* A; const bf16_t* Bt; int lda, ldb, K; };

template <class Map> struct Order {
    int nM, nN, nwg, G, c; Map map;
    __device__ __forceinline__ void init(int nM_, int nN_, int G_, int c_, const Map& m) { nM = nM_; nN = nN_; nwg = nM * nN; G = G_; c = c_; map = m; }
    __device__ __forceinline__ bool next(int i, Unit& u) const {
        const long L = (long)i * G + c; if (L >= nwg) return false;
        int wgid = (int)L; { const int q = nwg / NXCD, r = nwg % NXCD, xcd = wgid % NXCD, off = wgid / NXCD; wgid = (xcd < r ? xcd * (q + 1) : r * (q + 1) + (xcd - r) * q) + off; }
        const int nig = WGM * nN, gid = wgid / nig, fm = gid * WGM, gsz = (nM - fm) < WGM ? (nM - fm) : WGM;
        u.pm = fm + ((wgid % nig) % gsz); u.pn = (wgid % nig) / gsz; map(u); return true;
    }
    __device__ __forceinline__ void a_ready(const Unit&) const {}
    __device__ __forceinline__ void done(const Unit&) const {}
};
struct MapPlain { int lda, ldb; __device__ __forceinline__ void operator()(Unit& u) const { u.offA = (size_t)u.pm * 256 * lda * 2; u.offB = (size_t)u.pn * 256 * ldb * 2; } };

template <class Epi, class Sched, bool ALIGN_EPI = false, bool SP2 = false>
__device__ __forceinline__ void gemm_phase(PG8_LAS unsigned char* lds, const Gemm g, const Sched& S, const Epi& E, const int tid) {
    const int wid = __builtin_amdgcn_readfirstlane(tid >> 6), lane = tid & 63, wr = wid >> 2, wc = wid & 3, fr = lane & 15, fq = lane >> 4;
    const int K = g.K, nt = K / BK;
    unsigned voffA[2], voffB[2];
#pragma unroll
    for (int i = 0; i < 2; ++i) { int R, C; stage_rc(tid * 16 + i * 8192, R, C); const int Rb = Epi::PERM ? ((R & ~31) + perm32(R & 31)) : R;
        voffA[i] = (unsigned)(R * g.lda + C) * 2u; voffB[i] = (unsigned)(Rb * g.ldb + C) * 2u; }
    const size_t kstep = (size_t)(BK * 2);
    const size_t hstepA = (size_t)HALF * g.lda * 2, hstepB = (size_t)HALF * g.ldb * 2;
    const unsigned ldsw = (unsigned)wid * 1024u;
    const int aoff = lds_byte(wr * 64 + fr, fq * 8), boff = lds_byte(wc * 32 + fr, fq * 8);
#define PG8_SA(b, h) (((b) * 2 + (h)) * HTB)
#define PG8_SB(b, h) ((4 + (b) * 2 + (h)) * HTB)
#define PG8_STAGE(bufoff, gbase, voff) do { _Pragma("unroll") for (int _i = 0; _i < 2; ++_i) \
        __builtin_amdgcn_global_load_lds((const unsigned*)((const char*)(gbase) + (voff)[_i]), (PG8_LAS unsigned*)(lds + (bufoff) + ldsw + _i * 8192), 16, 0, 0); } while (0)
#define PG8_LDA(dst, b, h) do { _Pragma("unroll") for (int m = 0; m < 4; ++m) _Pragma("unroll") for (int k = 0; k < 2; ++k) dst[m][k] = *(const PG8_LAS bf16x8*)(lds + PG8_SA(b, h) + aoff + m * 2048 + k * 1024); } while (0)
#define PG8_LDB(dst, b, h) do { _Pragma("unroll") for (int n = 0; n < 2; ++n) _Pragma("unroll") for (int k = 0; k < 2; ++k) dst[n][k] = *(const PG8_LAS bf16x8*)(lds + PG8_SB(b, h) + boff + n * 2048 + k * 1024); } while (0)
#define PG8_MMA(ai, bj, At, Bt) do { __builtin_amdgcn_s_setprio(1); _Pragma("unroll") for (int m = 0; m < 4; ++m) _Pragma("unroll") for (int n = 0; n < 2; ++n) _Pragma("unroll") for (int k = 0; k < 2; ++k) \
        acc[ai][bj][m][n] = __builtin_amdgcn_mfma_f32_16x16x32_bf16(Bt[n][k], At[m][k], acc[ai][bj][m][n], 0, 0, 0); __builtin_amdgcn_s_setprio(0); } while (0)
#define PG8_WAIT_V(n) asm volatile("s_waitcnt vmcnt(" #n ")" ::: "memory")
#define PG8_WAIT_L(n) asm volatile("s_waitcnt lgkmcnt(" #n ")" ::: "memory")
#define PG8_BAR __builtin_amdgcn_s_barrier()
#define PG8_SCHED __builtin_amdgcn_sched_barrier(0)
    Unit cur, nxt; int ui = 0;
    if (!S.next(0, cur)) return;
    f32x4 acc[2][2][4][2];
#pragma unroll
    for (int a = 0; a < 2; ++a)
#pragma unroll
        for (int b = 0; b < 2; ++b)
#pragma unroll
            for (int m = 0; m < 4; ++m)
#pragma unroll
                for (int n = 0; n < 2; ++n) acc[a][b][m][n] = (f32x4){0.f, 0.f, 0.f, 0.f};
    bf16x8 At[4][2], B0[2][2], B1[2][2];
    const char* cA = (const char*)g.A + cur.offA; const char* cB = (const char*)g.Bt + cur.offB;
    S.a_ready(cur);
    if constexpr (SP2) {
        PG8_STAGE(PG8_SB(0, 0), cB, voffB); PG8_STAGE(PG8_SB(0, 1), cB + hstepB, voffB); PG8_STAGE(PG8_SA(0, 0), cA, voffA); PG8_STAGE(PG8_SA(0, 1), cA + hstepA, voffA);
        if (wr == 1) PG8_BAR;
        PG8_WAIT_V(2); PG8_BAR;
        PG8_STAGE(PG8_SB(1, 0), cB + kstep, voffB); PG8_STAGE(PG8_SA(1, 0), cA + kstep, voffA); PG8_STAGE(PG8_SB(1, 1), cB + hstepB + kstep, voffB);
        PG8_WAIT_V(6); PG8_BAR;
    } else {
        PG8_STAGE(PG8_SB(0, 0), cB, voffB); PG8_STAGE(PG8_SA(0, 0), cA, voffA); PG8_STAGE(PG8_SB(0, 1), cB + hstepB, voffB); PG8_STAGE(PG8_SA(0, 1), cA + hstepA, voffA);
        if (wr == 1) PG8_BAR;
        PG8_WAIT_V(4); PG8_BAR;
        PG8_STAGE(PG8_SB(1, 0), cB + kstep, voffB); PG8_STAGE(PG8_SA(1, 0), cA + kstep, voffA); PG8_STAGE(PG8_SB(1, 1), cB + hstepB + kstep, voffB);
        PG8_WAIT_V(6); PG8_BAR;
    }
    for (;;) {
        const bool has_next = S.next(ui + 1, nxt);
        const char* nA = has_next ? (const char*)g.A + nxt.offA : cA; const char* nB = has_next ? (const char*)g.Bt + nxt.offB : cB;
#pragma unroll 1
        for (int t = 0; t < nt; t += 2) {
            const bool last = (t == nt - 2);
            const char* a1 = cA + (size_t)(t + 1) * kstep;
            const char* a2 = last ? nA : cA + (size_t)(t + 2) * kstep; const char* b2 = last ? nB : cB + (size_t)(t + 2) * kstep;
            const char* a3 = a2 + kstep; const char* b3 = b2 + kstep;
            if (last && has_next) S.a_ready(nxt);
            if constexpr (SP2) {
            PG8_LDB(B0, 0, 0); PG8_LDB(B1, 0, 1); PG8_SCHED; PG8_LDA(At, 0, 0); PG8_STAGE(PG8_SA(1, 1), a1 + hstepA, voffA);
            PG8_WAIT_V(8); PG8_WAIT_L(0); PG8_BAR; PG8_MMA(0, 0, At, B0); PG8_MMA(0, 1, At, B1); PG8_BAR; PG8_SCHED;
            PG8_LDA(At, 0, 1); PG8_STAGE(PG8_SB(0, 0), b2, voffB); PG8_STAGE(PG8_SB(0, 1), b2 + hstepB, voffB); PG8_STAGE(PG8_SA(0, 0), a2, voffA);
            PG8_WAIT_V(8); PG8_WAIT_L(0); PG8_BAR; PG8_MMA(1, 0, At, B0); PG8_MMA(1, 1, At, B1); PG8_BAR; PG8_SCHED;
            PG8_LDB(B0, 1, 0); PG8_LDB(B1, 1, 1); PG8_SCHED; PG8_LDA(At, 1, 0); PG8_STAGE(PG8_SA(0, 1), a2 + hstepA, voffA);
            PG8_WAIT_V(8); PG8_WAIT_L(0); PG8_BAR; PG8_MMA(0, 0, At, B0); PG8_MMA(0, 1, At, B1); PG8_BAR; PG8_SCHED;
            PG8_LDA(At, 1, 1); PG8_STAGE(PG8_SB(1, 0), b3, voffB); PG8_STAGE(PG8_SB(1, 1), b3 + hstepB, voffB); PG8_STAGE(PG8_SA(1, 0), a3, voffA);
            PG8_WAIT_V(8); PG8_WAIT_L(0); PG8_BAR; PG8_MMA(1, 0, At, B0); PG8_MMA(1, 1, At, B1); PG8_BAR; PG8_SCHED;
            } else {
            PG8_LDB(B0, 0, 0); PG8_SCHED; PG8_LDA(At, 0, 0); PG8_STAGE(PG8_SA(1, 1), a1 + hstepA, voffA);
            PG8_WAIT_L(8); PG8_BAR; PG8_WAIT_L(0); PG8_MMA(0, 0, At, B0); PG8_BAR; PG8_SCHED;
            PG8_LDB(B1, 0, 1); PG8_STAGE(PG8_SB(0, 0), b2, voffB);
            PG8_BAR; PG8_WAIT_L(0); PG8_MMA(0, 1, At, B1); PG8_BAR;
            PG8_LDA(At, 0, 1); PG8_STAGE(PG8_SA(0, 0), a2, voffA);
            PG8_BAR; PG8_WAIT_L(0); PG8_MMA(1, 0, At, B0); PG8_BAR; PG8_SCHED;
            PG8_STAGE(PG8_SB(0, 1), b2 + hstepB, voffB);
            PG8_WAIT_V(6); PG8_BAR; PG8_MMA(1, 1, At, B1); PG8_BAR;
            PG8_LDB(B0, 1, 0); PG8_SCHED; PG8_LDA(At, 1, 0); PG8_STAGE(PG8_SA(0, 1), a2 + hstepA, voffA);
            PG8_WAIT_L(8); PG8_BAR; PG8_WAIT_L(0); PG8_MMA(0, 0, At, B0); PG8_BAR; PG8_SCHED;
            PG8_LDB(B1, 1, 1); PG8_STAGE(PG8_SB(1, 0), b3, voffB);
            PG8_BAR; PG8_WAIT_L(0); PG8_MMA(0, 1, At, B1); PG8_BAR;
            PG8_LDA(At, 1, 1); PG8_STAGE(PG8_SA(1, 0), a3, voffA);
            PG8_BAR; PG8_WAIT_L(0); PG8_MMA(1, 0, At, B0); PG8_BAR; PG8_SCHED;
            PG8_STAGE(PG8_SB(1, 1), b3 + hstepB, voffB);
            PG8_WAIT_V(6); PG8_BAR; PG8_MMA(1, 1, At, B1); PG8_BAR;
            }
        }
        if constexpr (ALIGN_EPI) { if (wr == 0) PG8_BAR; }
        if constexpr (!Epi::AFTER_DRAIN) { E(acc, cur, wr, wc, fr, fq); S.done(cur); }
        if (!has_next) break;
#pragma unroll
        for (int a = 0; a < 2; ++a)
#pragma unroll
            for (int b = 0; b < 2; ++b)
#pragma unroll
                for (int m = 0; m < 4; ++m)
#pragma unroll
                    for (int n = 0; n < 2; ++n) acc[a][b][m][n] = (f32x4){0.f, 0.f, 0.f, 0.f};
        cur = nxt; cA = nA; cB = nB; ++ui;
        if constexpr (ALIGN_EPI) { if (wr == 1) PG8_BAR; }
    }
    PG8_WAIT_V(0);
    if constexpr (!ALIGN_EPI) { if (wr == 0) PG8_BAR; }
    PG8_BAR;
    if constexpr (Epi::AFTER_DRAIN) { E.fused(acc, cur, wr, wc, fr, fq, lds, wid, lane); S.done(cur); }
#undef PG8_SA
#undef PG8_SB
#undef PG8_STAGE
#undef PG8_LDA
#undef PG8_LDB
#undef PG8_MMA
#undef PG8_WAIT_V
#undef PG8_WAIT_L
#undef PG8_BAR
#undef PG8_SCHED
}
}

constexpr int DM = 1024, NBATCH = 2, SEQ = 16384, MTOK = NBATCH * SEQ;
constexpr int FFH = 2816;
constexpr int RH = 4, RDK = 256, RDV = 512, RCH = 512, NCH = SEQ / RCH;
constexpr int RIN = 2 * RH * RDK + 2 * RH * RDV;
constexpr int NG = 4, NR = 4, HD = 64, NCMP = 1023, NSEL = 256, NSAIN = 1072;
constexpr float RMS_EPS = 1e-6f;
constexpr int APLD = 768;

constexpr size_t MiB = 1u << 20;
constexpr size_t WS_CTL = 0, CTL_ZERO_BYTES = 1 * MiB;
constexpr int CW_VMAX = 16384;
constexpr size_t WS_RINV = 1 * MiB;
constexpr size_t WS_BIAST = WS_RINV + 256 * 1024;
constexpr size_t WS_PEB = WS_BIAST + 16 * 1024;
constexpr size_t WS_PEBP = WS_PEB + 4 * 1024;
constexpr size_t WS_GSLOT = 2 * MiB;
constexpr size_t WS_OSLOT = 6 * MiB;
constexpr size_t WS_W = 8 * MiB;
constexpr size_t W_RI = WS_W, W_RO = W_RI + 12 * MiB, W_FI0 = W_RO + 4 * MiB, W_FI1 = W_FI0 + 11 * MiB, W_FO0 = W_FI1 + 11 * MiB, W_FO1 = W_FO0 + 11 * MiB / 2,
                 W_KVQ = W_FO1 + 11 * MiB / 2, W_KVV = W_KVQ + 9 * MiB / 2, W_NO = W_KVV + 1 * MiB, W_C1 = W_NO + 2 * MiB, W_C2 = W_C1 + 2 * MiB, W_END = W_C2 + 1 * MiB;
static_assert(W_END <= 68 * MiB, "weights");
constexpr size_t WS_TABA = 68 * MiB, WS_TABB = 84 * MiB;
constexpr size_t WS_XB = 100 * MiB;
constexpr size_t WS_MIX = 164 * MiB;
constexpr size_t WS_KT = WS_MIX, WS_KV = WS_MIX + 32 * MiB;
constexpr size_t WS_SCR = 228 * MiB;
constexpr size_t WS_AP = WS_SCR, WS_BP = WS_AP + 96 * MiB, WS_KN = WS_BP + 96 * MiB;
static_assert(WS_KN + 32 * MiB <= 512 * MiB, "ret scratch");
constexpr size_t WS_HID = WS_SCR;
constexpr size_t WS_KC = WS_SCR, WS_VC = WS_KC + 16 * MiB, WS_KS = WS_VC + 17 * MiB, WS_KW = WS_KS + 16 * MiB, WS_VST = WS_KW + 16 * MiB, WS_VWT = WS_VST + 16 * MiB,
                 WS_Q = WS_VWT + 16 * MiB, WS_GATE = WS_Q + 64 * MiB, WS_HIDC = WS_GATE + 6 * MiB, WS_KCMP = WS_HIDC + 8 * MiB, WS_VCMPT = WS_KCMP + 1 * MiB, WS_ONSA = WS_VCMPT + 1 * MiB,
                 WS_NSA_END = WS_ONSA + 64 * MiB;
static_assert(WS_NSA_END <= 512 * MiB, "nsa scratch");
constexpr size_t WS_NEED = 512 * MiB;

#define GAS __attribute__((address_space(1)))
#define LAS __attribute__((address_space(3)))
typedef unsigned short bf16;
typedef unsigned v4u __attribute__((ext_vector_type(4)));
typedef unsigned v2u __attribute__((ext_vector_type(2)));
typedef float f32x4 __attribute__((ext_vector_type(4)));
typedef float f32x2_t __attribute__((ext_vector_type(2)));
typedef __bf16 bf16x2_t __attribute__((ext_vector_type(2)));
typedef GAS unsigned gu32;
#define RLX_AGENT __ATOMIC_RELAXED, __HIP_MEMORY_SCOPE_AGENT
__device__ __forceinline__ unsigned cvtpk(float lo, float hi) { f32x2_t v = {lo, hi}; bf16x2_t b = __builtin_convertvector(v, bf16x2_t); return __builtin_bit_cast(unsigned, b); }
__device__ __forceinline__ v4u pack8(f32x4 a, f32x4 b) { v4u w; w.x = cvtpk(a[0], a[1]); w.y = cvtpk(a[2], a[3]); w.z = cvtpk(b[0], b[1]); w.w = cvtpk(b[2], b[3]); return w; }
__device__ __forceinline__ float bflo(unsigned w) { return __uint_as_float(w << 16); }
__device__ __forceinline__ float bfhi(unsigned w) { return __uint_as_float(w & 0xffff0000u); }
__device__ __forceinline__ float bf2f(bf16 b) { return __uint_as_float(((unsigned)b) << 16); }
__device__ __forceinline__ void unpack8(v4u w, float* f) { f[0] = bflo(w.x); f[1] = bfhi(w.x); f[2] = bflo(w.y); f[3] = bfhi(w.y); f[4] = bflo(w.z); f[5] = bfhi(w.z); f[6] = bflo(w.w); f[7] = bfhi(w.w); }
__device__ __forceinline__ bf16 f2bf(float f) { return (bf16)(cvtpk(f, 0.f) & 0xffffu); }
__device__ __forceinline__ int vperm(int t) { return (t & ~12) | ((t & 4) << 1) | ((t & 8) >> 1); }
__device__ __forceinline__ float sigm(float x) { return 1.f / (1.f + __expf(-x)); }
__device__ __forceinline__ float silu(float x) { return x / (1.f + __expf(-x)); }
__device__ __forceinline__ float lg2gamma(int h) { return log2f(1.0f - exp2f(-5.0f - (float)h)); }
__device__ __forceinline__ float wave_sum(float v) {
#pragma unroll
    for (int o = 1; o < 64; o <<= 1) v += __shfl_xor(v, o);
    return v;
}
__device__ __forceinline__ float wave_max(float v) {
#pragma unroll
    for (int o = 1; o < 64; o <<= 1) v = fmaxf(v, __shfl_xor(v, o));
    return v;
}
__device__ __forceinline__ int t5_bucket(int n) {
    if (n < 16) return n;
    if (n >= 113) return 31;
    int b = 16 + (int)(logf((float)n * 0.0625f) / 2.0794415416798357f * 16.0f);
    return b < 31 ? b : 31;
}

#define XB_TMO      128
#define XB_XCNT(j)  (256  + 64 * (j))
#define XB_XSUB(j)  (1280 + 64 * (j))
#define XB_XGEN(j)  (2304 + 64 * (j))
#define XB_TOP      3328
#define XB_TOPGEN   3392
#define XCD_BAR_WORDS 3456
#define XB_SPIN_CAP (1u << 18)
__device__ __forceinline__ unsigned xb_ld(unsigned* p)              { return __hip_atomic_load(p, __ATOMIC_RELAXED, __HIP_MEMORY_SCOPE_AGENT); }
__device__ __forceinline__ unsigned xb_add(unsigned* p, unsigned v) { return __hip_atomic_fetch_add(p, v, __ATOMIC_RELAXED, __HIP_MEMORY_SCOPE_AGENT); }
__device__ __forceinline__ unsigned xb_xcc_id() { return (unsigned)__builtin_amdgcn_s_getreg((3 << 11) | 20) & 0xFu; }
#define XB_SPIN(cond, bar) do { unsigned _sp = 0; while (cond) { __builtin_amdgcn_s_sleep(1); \
    if ((++_sp & 255u) == 0u) { if (xb_ld(&(bar)[XB_TMO])) break; if (_sp > XB_SPIN_CAP) { atomicAdd(&(bar)[XB_TMO], 1u); break; } } } } while (0)
struct XcdBarrier { unsigned* bar; unsigned x; volatile LAS unsigned* st; };
__device__ __forceinline__ XcdBarrier xcd_barrier_post(unsigned* bar, volatile LAS unsigned* st) {
    XcdBarrier b; b.bar = bar; b.x = xb_xcc_id(); b.st = st;
    if (threadIdx.x == 0) { const unsigned rank = xb_add(&bar[XB_XCNT(b.x)], 1u); st[2] = rank; st[3] = b.x; }
    return b;
}
__device__ __forceinline__ void xcd_barrier_complete(unsigned* bar, unsigned x, unsigned& nloc, unsigned& nx) {
    const unsigned G = gridDim.x * gridDim.y * gridDim.z;
    unsigned sum, cnt, mine, sp = 0u;
    for (;;) {
        sum = 0u; cnt = 0u; mine = 0u;
#pragma unroll
        for (unsigned j = 0; j < 16; ++j) { const unsigned c = xb_ld(&bar[XB_XCNT(j)]); sum += c; cnt += (c > 0u) ? 1u : 0u; mine = (j == x) ? c : mine; }
        if (sum == G) break;
        __builtin_amdgcn_s_sleep(1);
        if ((++sp & 255u) == 0u) { if (xb_ld(&bar[XB_TMO])) break; if (sp > XB_SPIN_CAP) { atomicAdd(&bar[XB_TMO], 1u); break; } }
    }
    nloc = mine > 0u ? mine : 1u; nx = cnt > 0u ? cnt : 1u;
}
__device__ __forceinline__ void xcd_barrier(const XcdBarrier& b) {
    asm volatile("s_waitcnt vmcnt(0)" ::: "memory");
    __syncthreads();
    if (threadIdx.x == 0) {
        unsigned* bar = b.bar;
        __builtin_amdgcn_s_waitcnt(0);
        unsigned nloc = b.st[0], nx = b.st[1];
        if (nloc == 0u) { xcd_barrier_complete(bar, b.x, nloc, nx); b.st[0] = nloc; b.st[1] = nx; }
        const unsigned old = xb_add(&bar[XB_XSUB(b.x)], 1u);
        const unsigned gen = old / nloc;
        if (old + 1u == (gen + 1u) * nloc) {
            __builtin_amdgcn_fence(__ATOMIC_RELEASE, "agent");
            asm volatile("s_waitcnt vmcnt(0)" ::: "memory");
            const unsigned og = xb_add(&bar[XB_TOP], 1u);
            const unsigned tg = og / nx;
            if (og + 1u == (tg + 1u) * nx) xb_add(&bar[XB_TOPGEN], 1u);
            else XB_SPIN(xb_ld(&bar[XB_TOPGEN]) == tg, bar);
            __builtin_amdgcn_fence(__ATOMIC_ACQUIRE, "agent");
            xb_add(&bar[XB_XGEN(b.x)], 1u);
            asm volatile("s_waitcnt vmcnt(0)" ::: "memory");
        } else {
            XB_SPIN(xb_ld(&bar[XB_XGEN(b.x)]) == gen, bar);
            __builtin_amdgcn_fence(__ATOMIC_ACQUIRE, "agent");
            asm volatile("s_waitcnt vmcnt(0)" ::: "memory");
        }
    }
    __syncthreads();
}

using pg8::Unit;
typedef const f32x4 (&AccRef)[2][2][4][2];
#define EPI_ROW(u, ai, m) ((u).pm * 256 + (ai) * 128 + wr * 64 + (m) * 16 + fr)
#define EPI_COL(bj) ((bj) * 128 + wc * 32 + 8 * fq)

struct EpiP1N {
    static constexpr bool PERM = true, AFTER_DRAIN = false;
    const float* rinv; const f32x4* tabA; bf16* AP; bf16* KN;
    __device__ __forceinline__ void operator()(AccRef acc, const Unit& u, int wr, int wc, int fr, int fq) const {
        const int h = u.pn & 3; const bool isk = u.pn >= 4; const float lg = lg2gamma(h);
#pragma unroll
        for (int ai = 0; ai < 2; ++ai)
#pragma unroll
            for (int m = 0; m < 4; ++m) {
                const int t = EPI_ROW(u, ai, m); const int p = t & (RCH - 1), c = t / RCH;
                const float rs = rinv[t] * (isk ? 0.0625f * exp2f(-(float)p * lg) : exp2f((float)p * lg));
#pragma unroll
                for (int bj = 0; bj < 2; ++bj) {
                    const int d0 = EPI_COL(bj);
                    const f32x4 c0 = tabA[(size_t)t * 64 + (d0 >> 2)], c1 = tabA[(size_t)t * 64 + (d0 >> 2) + 1];
                    const f32x4 v0 = acc[ai][bj][m][0] * rs, v1 = acc[ai][bj][m][1] * rs;
                    const f32x4 o0 = {v0[0] * c0[0] - v0[1] * c0[1], v0[0] * c0[1] + v0[1] * c0[0], v0[2] * c0[2] - v0[3] * c0[3], v0[2] * c0[3] + v0[3] * c0[2]};
                    const f32x4 o1 = {v1[0] * c1[0] - v1[1] * c1[1], v1[0] * c1[1] + v1[1] * c1[0], v1[2] * c1[2] - v1[3] * c1[3], v1[2] * c1[3] + v1[3] * c1[2]};
                    const v4u w = pack8(o0, o1);
                    if (isk) *(v4u*)(KN + (size_t)t * 1024 + h * 256 + d0) = w;
                    else *(v4u*)(AP + ((size_t)(h * NCH + c) * RCH + p) * APLD + RCH + d0) = w;
                }
            }
    }
};
struct EpiP1S {
    static constexpr bool PERM = true, AFTER_DRAIN = false;
    const float* rinv; const f32x4* tabB; bf16* KT; bf16* BP;
    __device__ __forceinline__ void operator()(AccRef acc, const Unit& u, int wr, int wc, int fr, int fq) const {
        const bool isk = u.pm < 4; const float lg = lg2gamma(u.pm & 3);
#pragma unroll
        for (int bj = 0; bj < 2; ++bj) {
            const int t0 = u.pn * 256 + EPI_COL(bj); const int c = t0 / RCH, p0 = t0 & (RCH - 1);
            const f32x4 r0 = *(const f32x4*)(rinv + t0), r1 = *(const f32x4*)(rinv + t0 + 4);
            f32x4 s0, s1;
#pragma unroll
            for (int j = 0; j < 4; ++j) { s0[j] = r0[j] * 0.0625f * exp2f(-(float)(p0 + j) * lg); s1[j] = r1[j] * 0.0625f * exp2f(-(float)(p0 + 4 + j) * lg); }
#pragma unroll
            for (int ai = 0; ai < 2; ++ai)
#pragma unroll
                for (int m = 0; m < 4; ++m) {
                    const int row = EPI_ROW(u, ai, m);
                    if (isk) {
                        const int d = row & 255, i = d >> 1; const bool odd = d & 1;
                        const f32x4 v0 = acc[ai][bj][m][0] * s0, v1 = acc[ai][bj][m][1] * s1; f32x4 q0, q1;
#pragma unroll
                        for (int j = 0; j < 4; ++j) { q0[j] = __shfl_xor(v0[j], 1); q1[j] = __shfl_xor(v1[j], 1); }
                        const f32x4* tb = tabB + ((size_t)i * SEQ + t0) / 2;
                        const f32x4 ca = tb[0], cb = tb[1], cc = tb[2], cd = tb[3];
                        f32x4 o0, o1;
                        if (odd) { o0 = (f32x4){q0[0] * ca[1] + v0[0] * ca[0], q0[1] * ca[3] + v0[1] * ca[2], q0[2] * cb[1] + v0[2] * cb[0], q0[3] * cb[3] + v0[3] * cb[2]};
                                   o1 = (f32x4){q1[0] * cc[1] + v1[0] * cc[0], q1[1] * cc[3] + v1[1] * cc[2], q1[2] * cd[1] + v1[2] * cd[0], q1[3] * cd[3] + v1[3] * cd[2]}; }
                        else     { o0 = (f32x4){v0[0] * ca[0] - q0[0] * ca[1], v0[1] * ca[2] - q0[1] * ca[3], v0[2] * cb[0] - q0[2] * cb[1], v0[3] * cb[2] - q0[3] * cb[3]};
                                   o1 = (f32x4){v1[0] * cc[0] - q1[0] * cc[1], v1[1] * cc[2] - q1[1] * cc[3], v1[2] * cd[0] - q1[2] * cd[1], v1[3] * cd[2] - q1[3] * cd[3]}; }
                        *(v4u*)(KT + (size_t)row * SEQ + t0) = pack8(o0, o1);
                    } else {
                        const int eg = row - 1024, h = eg >> 9, e = eg & 511;
                        *(v4u*)(BP + ((size_t)(h * NCH + c) * RCH + e) * APLD + p0) = pack8(acc[ai][bj][m][0] * r0, acc[ai][bj][m][1] * r1);
                    }
                }
        }
    }
};
struct EpiG {
    static constexpr bool PERM = true, AFTER_DRAIN = false;
    const float* rinv; const float* gslots; bf16* O;
    __device__ __forceinline__ void operator()(AccRef acc, const Unit& u, int wr, int wc, int fr, int fq) const {
        const int h = u.pn >> 1;
#pragma unroll
        for (int ai = 0; ai < 2; ++ai)
#pragma unroll
            for (int m = 0; m < 4; ++m) {
                const int row = EPI_ROW(u, ai, m); const float rin = rinv[row];
                const f32x4 sa = *(const f32x4*)(gslots + (size_t)row * 32 + h * 8), sb = *(const f32x4*)(gslots + (size_t)row * 32 + h * 8 + 4);
                const float ss = ((sa[0] + sa[1]) + (sa[2] + sa[3])) + ((sb[0] + sb[1]) + (sb[2] + sb[3]));
                const float rs = rsqrtf(ss * (1.0f / RDV) + RMS_EPS);
#pragma unroll
                for (int bj = 0; bj < 2; ++bj) {
                    bf16* op = O + (size_t)row * 2048 + u.pn * 256 + EPI_COL(bj);
                    float o[8]; unpack8(*(const v4u*)op, o);
                    const f32x4 g0 = acc[ai][bj][m][0] * rin, g1 = acc[ai][bj][m][1] * rin; f32x4 a, b;
#pragma unroll
                    for (int j = 0; j < 4; ++j) { a[j] = o[j] * rs * silu(g0[j]); b[j] = o[4 + j] * rs * silu(g1[j]); }
                    *(v4u*)op = pack8(a, b);
                }
            }
    }
};
struct EpiOut {
    static constexpr bool PERM = true, AFTER_DRAIN = false;
    bf16* MIX; float* oslots;
    __device__ __forceinline__ void operator()(AccRef acc, const Unit& u, int wr, int wc, int fr, int fq) const {
#pragma unroll
        for (int ai = 0; ai < 2; ++ai)
#pragma unroll
            for (int m = 0; m < 4; ++m) {
                const int row = EPI_ROW(u, ai, m); float ss = 0.f;
#pragma unroll
                for (int bj = 0; bj < 2; ++bj) {
                    const f32x4 v0 = acc[ai][bj][m][0], v1 = acc[ai][bj][m][1];
                    ss += (v0[0] * v0[0] + v0[1] * v0[1]) + (v0[2] * v0[2] + v0[3] * v0[3]) + (v1[0] * v1[0] + v1[1] * v1[1]) + (v1[2] * v1[2] + v1[3] * v1[3]);
                    *(v4u*)(MIX + (size_t)row * 1024 + u.pn * 256 + EPI_COL(bj)) = pack8(v0, v1);
                }
                ss += __shfl_xor(ss, 16); ss += __shfl_xor(ss, 32);
                if (fq == 0) oslots[(size_t)row * 16 + u.pn * 4 + wc] = ss;
            }
    }
};
struct EpiFfnIn {
    static constexpr bool PERM = true, AFTER_DRAIN = false;
    const float* rinv; bf16* HID;
    __device__ __forceinline__ void operator()(AccRef acc, const Unit& u, int wr, int wc, int fr, int fq) const {
#pragma unroll
        for (int ai = 0; ai < 2; ++ai)
#pragma unroll
            for (int m = 0; m < 4; ++m) {
                const int row = EPI_ROW(u, ai, m); const float rin = rinv[row];
                const f32x4 a0 = acc[ai][0][m][0] * rin, a1 = acc[ai][0][m][1] * rin, b0 = acc[ai][1][m][0] * rin, b1 = acc[ai][1][m][1] * rin; f32x4 x, y;
#pragma unroll
                for (int j = 0; j < 4; ++j) { x[j] = silu(a0[j]) * b0[j]; y[j] = silu(a1[j]) * b1[j]; }
                *(v4u*)(HID + (size_t)row * FFH + u.pn * 128 + wc * 32 + 8 * fq) = pack8(x, y);
            }
    }
};
struct EpiKvqN {
    static constexpr bool PERM = true, AFTER_DRAIN = false;
    const float* rinv; bf16 *KC, *VC, *KS, *KW, *Q; float* GATE;
    __device__ __forceinline__ void operator()(AccRef acc, const Unit& u, int wr, int wc, int fr, int fq) const {
        bf16* plane = u.pn == 0 ? KC : u.pn == 1 ? VC : u.pn == 2 ? KS : KW;
#pragma unroll
        for (int ai = 0; ai < 2; ++ai)
#pragma unroll
            for (int m = 0; m < 4; ++m) {
                const int row = EPI_ROW(u, ai, m); const float rin = rinv[row]; const int b = row / SEQ, t = row % SEQ;
#pragma unroll
                for (int bj = 0; bj < 2; ++bj) {
                    const int cc = EPI_COL(bj);
                    f32x4 v0 = acc[ai][bj][m][0] * rin, v1 = acc[ai][bj][m][1] * rin;
                    if (u.pn < 4) { const int g = cc >> 6, d = cc & 63;
                        const int o = u.pn >= 2 ? (t & ~63) * HD + ((((t >> 5) & 1) * 4 + (d >> 4)) * 64 + ((d >> 3) & 1) * 32 + (t & 31)) * 8 : t * HD + d;
                        *(v4u*)(plane + (size_t)(b * NG + g) * SEQ * HD + o) = pack8(v0, v1); }
                    else { *(v4u*)(Q + (size_t)row * 1024 + (u.pn - 4) * 256 + cc) = pack8(v0 * (0.125f * 1.4426950408889634f), v1 * (0.125f * 1.4426950408889634f)); }
                }
            }
    }
};
struct EpiGate {
    static constexpr bool PERM = true, AFTER_DRAIN = false;
    const float* rinv; float* GATE;
    __device__ __forceinline__ void operator()(AccRef acc, const Unit& u, int wr, int wc, int fr, int fq) const {
#pragma unroll
        for (int ai = 0; ai < 2; ++ai)
#pragma unroll
            for (int m = 0; m < 4; ++m) {
                const int row = EPI_ROW(u, ai, m); const float rin = rinv[row]; const int cc = EPI_COL(0);
                if (cc < 48) { f32x4 v0 = acc[ai][0][m][0] * rin, v1 = acc[ai][0][m][1] * rin;
#pragma unroll
                    for (int j = 0; j < 4; ++j) { v0[j] = sigm(v0[j]); v1[j] = sigm(v1[j]); }
                    *(f32x4*)(GATE + (size_t)row * 48 + cc) = v0; *(f32x4*)(GATE + (size_t)row * 48 + cc + 4) = v1; }
            }
    }
};
struct EpiKvqS {
    static constexpr bool PERM = true, AFTER_DRAIN = false;
    const float* rinv; bf16 *VST, *VWT; unsigned* vmx;
    __device__ __forceinline__ void operator()(AccRef acc, const Unit& u, int wr, int wc, int fr, int fq) const {
        bf16* plane = u.pm == 0 ? VST : VWT;
        float vm[2] = {0.f, 0.f};
#pragma unroll
        for (int bj = 0; bj < 2; ++bj) {
            const int mg = u.pn * 256 + EPI_COL(bj); const int b = mg / SEQ, t = mg % SEQ;
            const f32x4 r0 = *(const f32x4*)(rinv + mg), r1 = *(const f32x4*)(rinv + mg + 4);
#pragma unroll
            for (int ai = 0; ai < 2; ++ai)
#pragma unroll
                for (int m = 0; m < 4; ++m) {
                    const int r256 = ai * 128 + wr * 64 + m * 16 + fr; const int g = r256 >> 6, d = r256 & 63;
                    const f32x4 w0 = acc[ai][bj][m][0] * r0, w1 = acc[ai][bj][m][1] * r1;
                    const v4u pk = pack8(w0, w1);
                    v2u lo; lo.x = pk.x; lo.y = pk.y; v2u hi; hi.x = pk.z; hi.y = pk.w;
                    if (u.pm == 0) vm[ai] = fmaxf(vm[ai], fmaxf(fmaxf(fmaxf(fabsf(w0[0]), fabsf(w0[1])), fmaxf(fabsf(w0[2]), fabsf(w0[3]))), fmaxf(fmaxf(fabsf(w1[0]), fabsf(w1[1])), fmaxf(fabsf(w1[2]), fabsf(w1[3])))));
                    {
                        bf16* fp = plane + (size_t)(b * NG + g) * HD * SEQ + (size_t)(t >> 6) * 4096 + ((((t >> 4) & 3) * 2 + (d >> 5)) * 64 + (d & 31)) * 8 + 4 * ((t >> 3) & 1);
                        *(v2u*)fp = lo; *(v2u*)(fp + 256) = hi;
                    }
                }
        }
        if (u.pm == 0) {
#pragma unroll
            for (int ai = 0; ai < 2; ++ai) { const float mx = wave_max(vm[ai]);
                if ((fr | fq) == 0) __hip_atomic_fetch_max(vmx + ((u.pn * 256) / SEQ) * NG + 2 * ai + wr, __float_as_uint(mx), __ATOMIC_RELAXED, __HIP_MEMORY_SCOPE_AGENT); }
        }
    }
};
struct EpiCmp {
    static constexpr bool PERM = true, AFTER_DRAIN = false;
    const float* peb; bf16* HIDC;
    __device__ __forceinline__ void operator()(AccRef acc, const Unit& u, int wr, int wc, int fr, int fq) const {
        const int kv = u.pm >= 32 ? 1 : 0;
#pragma unroll
        for (int bj = 0; bj < 2; ++bj) {
            const int col = EPI_COL(bj);
            const f32x4 b0 = *(const f32x4*)(peb + kv * 256 + col), b1 = *(const f32x4*)(peb + kv * 256 + col + 4);
#pragma unroll
            for (int ai = 0; ai < 2; ++ai)
#pragma unroll
                for (int m = 0; m < 4; ++m) {
                    const int row = EPI_ROW(u, ai, m); f32x4 x = acc[ai][bj][m][0] + b0, y = acc[ai][bj][m][1] + b1;
#pragma unroll
                    for (int j = 0; j < 4; ++j) { x[j] = silu(x[j]); y[j] = silu(y[j]); }
                    *(v4u*)(HIDC + (size_t)row * 256 + col) = pack8(x, y);
                }
        }
    }
};
struct MapCmp { __device__ __forceinline__ void operator()(Unit& u) const { u.offA = (size_t)u.pm * 256 * 1024 * 2; u.offB = (size_t)(u.pm >= 32 ? 256 : 0) * 2048 * 2; } };

struct MapKV { __device__ __forceinline__ void operator()(Unit& u) const { const int hc = u.pm >> 1, eh = u.pm & 1, h = hc / NCH, c = hc % NCH;
    u.offA = ((size_t)(hc * RCH + eh * 256) * APLD) * 2; u.offB = ((size_t)(h * RDK) * SEQ + (size_t)c * RCH) * 2; } };
struct EpiKV {
    static constexpr bool PERM = true, AFTER_DRAIN = false;
    bf16* KV;
    __device__ __forceinline__ void operator()(AccRef acc, const Unit& u, int wr, int wc, int fr, int fq) const {
#pragma unroll
        for (int ai = 0; ai < 2; ++ai)
#pragma unroll
            for (int m = 0; m < 4; ++m) { const int row = EPI_ROW(u, ai, m);
#pragma unroll
                for (int bj = 0; bj < 2; ++bj) *(v4u*)(KV + (size_t)row * RDK + EPI_COL(bj)) = pack8(acc[ai][bj][m][0], acc[ai][bj][m][1]); }
    }
};
struct MapS { __device__ __forceinline__ void operator()(Unit& u) const { const int hc = u.pm >> 1, qh = u.pm & 1, h = hc / NCH, c = hc % NCH;
    u.offA = ((size_t)(hc * RCH + qh * 256) * APLD + RCH) * 2; u.offB = ((size_t)(c * RCH + u.pn * 256) * 1024 + h * RDK) * 2; } };
struct EpiS {
    static constexpr bool PERM = true, AFTER_DRAIN = false;
    bf16* AP;
    __device__ __forceinline__ void operator()(AccRef acc, const Unit& u, int wr, int wc, int fr, int fq) const {
        const int qh = u.pm & 1;
#pragma unroll
        for (int ai = 0; ai < 2; ++ai)
#pragma unroll
            for (int m = 0; m < 4; ++m) { const int row = EPI_ROW(u, ai, m); const int qi = qh * 256 + ai * 128 + wr * 64 + m * 16 + fr;
#pragma unroll
                for (int bj = 0; bj < 2; ++bj) { const int k0 = u.pn * 256 + EPI_COL(bj); f32x4 v0 = acc[ai][bj][m][0], v1 = acc[ai][bj][m][1];
#pragma unroll
                    for (int j = 0; j < 4; ++j) { if (k0 + j > qi) v0[j] = 0.f; if (k0 + 4 + j > qi) v1[j] = 0.f; }
                    *(v4u*)(AP + (size_t)row * APLD + k0) = pack8(v0, v1); } }
    }
};
struct MapO { __device__ __forceinline__ void operator()(Unit& u) const { const int hc = u.pm >> 1, qh = u.pm & 1;
    u.offA = ((size_t)(hc * RCH + qh * 256) * APLD) * 2; u.offB = ((size_t)(hc * RCH + u.pn * 256) * APLD) * 2; } };
struct EpiO {
    static constexpr bool PERM = true, AFTER_DRAIN = false;
    bf16* O; float* gslots; int b;
    __device__ __forceinline__ void operator()(AccRef acc, const Unit& u, int wr, int wc, int fr, int fq) const {
        const int hc = u.pm >> 1, qh = u.pm & 1, h = hc / NCH, c = hc % NCH;
#pragma unroll
        for (int ai = 0; ai < 2; ++ai)
#pragma unroll
            for (int m = 0; m < 4; ++m) { const size_t row = (size_t)b * SEQ + c * RCH + qh * 256 + ai * 128 + wr * 64 + m * 16 + fr; float ss = 0.f;
#pragma unroll
                for (int bj = 0; bj < 2; ++bj) { const f32x4 v0 = acc[ai][bj][m][0], v1 = acc[ai][bj][m][1];
                    ss += (v0[0] * v0[0] + v0[1] * v0[1]) + (v0[2] * v0[2] + v0[3] * v0[3]) + (v1[0] * v1[0] + v1[1] * v1[1]) + (v1[2] * v1[2] + v1[3] * v1[3]);
                    *(v4u*)(O + row * 2048 + h * RDV + u.pn * 256 + EPI_COL(bj)) = pack8(v0, v1); }
                ss += __shfl_xor(ss, 16); ss += __shfl_xor(ss, 32);
                if (fq == 0) gslots[row * 32 + h * 8 + u.pn * 4 + wc] = ss; }
    }
};

constexpr int NWAVES = 8, NTHREADS = NWAVES * 64;
constexpr int RING_OFF = 0, RING_BYTES = 131072;
constexpr int LDS_BYTES = 163840;
constexpr int LDSCTL_OFF = LDS_BYTES - 1024, MISC_OFF = LDSCTL_OFF + 320;
constexpr int CW_BAR = 4096;

struct Args { const float* in[20]; float* out; unsigned char* ws; int ph, b; };
struct Frame {
    LAS unsigned char* lds; unsigned char* ws; float* out; const float* const* in;
    int tid, lane, wave, G, vcu, gw, NGW;
};

template <class T> __device__ __forceinline__ T* gp(T* p) { return (T*)(GAS T*)p; }
struct TDesc { const float* W; const float* gain; bf16* WT; int K, ldw, ncols, nblk, mode, off, start, pad; };
__device__ __forceinline__ int dest_row(int mode, int off, int n) {
    if (mode == 1) { const int up = n >= FFH, j = up ? n - FFH : n; return (j >> 7) * 256 + up * 128 + (j & 127); }
    if (mode == 2) { const int s = n >> 8, d = n & 255; return s < 3 ? n : s == 3 ? 2304 + d : s == 4 ? 768 + d : 2304 + 256 + d; }
    return n + off;
}
__device__ __forceinline__ void transpose_item(const LAS TDesc& D, LAS float* scr, int it, int lane) {
    const float* W = D.W; const float* gain = D.gain; const int K = D.K, ldw = D.ldw, ncols = D.ncols, nblk = D.nblk;
    const int k0 = 64 * (it / nblk), n0 = 32 * (it % nblk);
    const int q = lane & 7, kr = lane >> 3;
#pragma unroll
    for (int i = 0; i < 8; ++i) { const int kk = 8 * i + kr, n = n0 + 4 * q;
        f32x4 v = {0.f, 0.f, 0.f, 0.f}; if (n < ncols) v = *(const f32x4*)(W + (size_t)(k0 + kk) * ldw + n);
        if (gain) v *= gain[k0 + kk];
        LAS float* s = scr + kk * 33 + 4 * q; s[0] = v[0]; s[1] = v[1]; s[2] = v[2]; s[3] = v[3]; }
    asm volatile("s_waitcnt lgkmcnt(0)" ::: "memory");
    const int c = lane & 7;
#pragma unroll
    for (int j = 0; j < 4; ++j) { const int n = (lane >> 3) + 8 * j; const LAS float* s = scr + (8 * c) * 33 + n;
        v4u o; o.x = cvtpk(s[0 * 33], s[1 * 33]); o.y = cvtpk(s[2 * 33], s[3 * 33]); o.z = cvtpk(s[4 * 33], s[5 * 33]); o.w = cvtpk(s[6 * 33], s[7 * 33]);
        *(v4u*)(D.WT + (size_t)dest_row(D.mode, D.off, n0 + n) * K + k0 + 8 * c) = o; }
    asm volatile("s_waitcnt lgkmcnt(0)" ::: "memory");
}

__device__ __forceinline__ void row_to_bf16(const float* xrow, bf16* orow, float* rinv, int lane) {
    const f32x4* xr = (const f32x4*)xrow + lane; f32x4 v[4]; float s = 0.f;
#pragma unroll
    for (int j = 0; j < 4; ++j) { v[j] = xr[64 * j]; s += (v[j][0] * v[j][0] + v[j][1] * v[j][1]) + (v[j][2] * v[j][2] + v[j][3] * v[j][3]); }
    s = wave_sum(s);
    v2u* o8 = (v2u*)orow + lane;
#pragma unroll
    for (int j = 0; j < 4; ++j) { v2u w; w.x = cvtpk(v[j][0], v[j][1]); w.y = cvtpk(v[j][2], v[j][3]); o8[64 * j] = w; }
    if (lane == 0) *rinv = rsqrtf(s * (1.0f / DM) + RMS_EPS);
}

__device__ __forceinline__ void rows2_to_bf16(const float* xa, const float* xb, bf16* oa, bf16* ob, float* ra, float* rb, int lane) {
    const f32x4* pa = (const f32x4*)xa + lane; const f32x4* pb = (const f32x4*)xb + lane; f32x4 va[4], vb[4]; float sa = 0.f, sb = 0.f;
#pragma unroll
    for (int j = 0; j < 4; ++j) { va[j] = pa[64 * j]; vb[j] = pb[64 * j]; }
#pragma unroll
    for (int j = 0; j < 4; ++j) { sa += (va[j][0] * va[j][0] + va[j][1] * va[j][1]) + (va[j][2] * va[j][2] + va[j][3] * va[j][3]); sb += (vb[j][0] * vb[j][0] + vb[j][1] * vb[j][1]) + (vb[j][2] * vb[j][2] + vb[j][3] * vb[j][3]); }
    sa = wave_sum(sa); sb = wave_sum(sb);
    v2u* qa = (v2u*)oa + lane; v2u* qb = (v2u*)ob + lane;
#pragma unroll
    for (int j = 0; j < 4; ++j) { v2u w; w.x = cvtpk(va[j][0], va[j][1]); w.y = cvtpk(va[j][2], va[j][3]); qa[64 * j] = w; v2u u; u.x = cvtpk(vb[j][0], vb[j][1]); u.y = cvtpk(vb[j][2], vb[j][3]); qb[64 * j] = u; }
    if (lane == 0) { *ra = rsqrtf(sa * (1.0f / DM) + RMS_EPS); *rb = rsqrtf(sb * (1.0f / DM) + RMS_EPS); }
}
constexpr int NTD = 13;
__device__ __forceinline__ void phase_prologue(const Frame& F) {
    unsigned char* ws = F.ws; const float* in[20];
#pragma unroll
    for (int i = 0; i < 20; ++i) in[i] = gp(F.in[i]);
    LAS TDesc* TD = (LAS TDesc*)(F.lds + RING_OFF + 8 * 16384);
    if (F.tid == 0) {
        int st = 0;
#define TDSET(k, W_, K_, ldw_, nc_, ncp_, gain_, WT_, mode_, off_) do { TD[k].W = (W_); TD[k].gain = (gain_); TD[k].WT = (bf16*)(WT_); TD[k].K = (K_); TD[k].ldw = (ldw_); TD[k].ncols = (nc_); \
            TD[k].nblk = (ncp_) / 32; TD[k].mode = (mode_); TD[k].off = (off_); TD[k].start = st; st += ((K_) / 64) * ((ncp_) / 32); } while (0)
        TDSET(0, in[7], DM, RIN, RIN, RIN, in[1], ws + W_RI, 0, 0);
        TDSET(1, in[8], 2048, DM, DM, DM, (const float*)nullptr, ws + W_RO, 0, 0);
        TDSET(2, in[5], DM, 2 * FFH, 2 * FFH, 2 * FFH, in[3], ws + W_FI0, 1, 0);
        TDSET(3, in[5] + (size_t)DM * 2 * FFH, DM, 2 * FFH, 2 * FFH, 2 * FFH, in[3] + DM, ws + W_FI1, 1, 0);
        TDSET(4, in[6], FFH, DM, DM, DM, (const float*)nullptr, ws + W_FO0, 0, 0);
        TDSET(5, in[6] + (size_t)FFH * DM, FFH, DM, DM, DM, (const float*)nullptr, ws + W_FO1, 0, 0);
        TDSET(6, in[10], DM, 1536, 1536, 1536, in[9], ws + W_KVQ, 2, 0);
        TDSET(7, in[17], DM, NSAIN, NSAIN, 1280, in[1] + DM, ws + W_KVQ, 0, 1024);
        TDSET(8, in[18], DM, DM, DM, DM, (const float*)nullptr, ws + W_NO, 0, 0);
        TDSET(9, in[12], 2048, 256, 256, 256, (const float*)nullptr, ws + W_C1, 0, 0);
        TDSET(10, in[15], 2048, 256, 256, 256, (const float*)nullptr, ws + W_C1, 0, 256);
        TDSET(11, in[13], 256, 64, 64, 64, (const float*)nullptr, ws + W_C2, 0, 0);
        TDSET(12, in[16], 256, 64, 64, 64, (const float*)nullptr, ws + W_C2, 0, 64);
#undef TDSET
        TD[NTD].start = st;
    }
    __syncthreads();
    const int NT = TD[NTD].start, NJ = NT + MTOK / 2 + SEQ * 128 / 64;
    LAS float* scr = (LAS float*)(F.lds + RING_OFF + F.wave * 16384);
    f32x2_t* tabA = (f32x2_t*)(ws + WS_TABA); f32x2_t* tabB = (f32x2_t*)(ws + WS_TABB);
    for (int jb = F.gw; jb < NJ; jb += F.NGW) {
        const int it = (int)(((long long)jb * 7919) % NJ);
        if (it < NT) {
            int k = 0;
#pragma unroll
            for (int q = 1; q < NTD; ++q) k = it >= TD[q].start ? q : k;
            transpose_item(TD[k], scr, it - TD[k].start, F.lane);
        } else if (it < NT + MTOK / 2) {
            const int m = it - NT, m2 = m + MTOK / 2;
            rows2_to_bf16(in[0] + (size_t)m * DM, in[0] + (size_t)m2 * DM, (bf16*)(ws + WS_XB) + (size_t)m * DM, (bf16*)(ws + WS_XB) + (size_t)m2 * DM, (float*)(ws + WS_RINV) + m, (float*)(ws + WS_RINV) + m2, F.lane);
        } else {
            const int idx = (it - NT - MTOK / 2) * 64 + F.lane, t = idx >> 7, i = idx & 127;
            const float theta = 1.0f / powf(10000.0f, (float)i * (1.0f / 127.0f));
            const float ang = (float)t * theta; float s, c; sincosf(ang, &s, &c);
            const f32x2_t v = {c, s}; tabA[idx] = v; tabB[(size_t)i * SEQ + t] = v;
        }
    }
    if (blockIdx.x == 0) for (int i = F.tid; i < 128 * 16; i += NTHREADS) ((float*)(ws + WS_BIAST))[i] = in[19][t5_bucket(i >> 4) * 16 + (i & 15)];
    if (blockIdx.x < 32) {
        const int kv = F.tid >> 8, c = F.tid & 255; const float* pe = kv ? in[14] : in[11]; const float* w1 = kv ? in[15] : in[12]; float s = 0.f;
        for (int k = 64 * blockIdx.x; k < 64 * blockIdx.x + 64; ++k) s += pe[k] * w1[(size_t)k * 256 + c];
        ((float*)(ws + WS_PEBP))[blockIdx.x * 512 + F.tid] = s;
    }
}
__device__ __forceinline__ void phase_peb_final(const Frame& F) {
    if (blockIdx.x == 0) { float s = 0.f; for (int w = 0; w < 32; ++w) s += ((const float*)(F.ws + WS_PEBP))[w * 512 + F.tid]; ((float*)(F.ws + WS_PEB))[F.tid] = s; }
}

__device__ __forceinline__ void phase_resid(const Frame& F, const float* hold_f32, const float* gpost, bool last) {
    const bf16* MIX = (const bf16*)(F.ws + WS_MIX); const float* oslots = (const float*)(F.ws + WS_OSLOT);
    bf16* XB = (bf16*)(F.ws + WS_XB); float* rinv = (float*)(F.ws + WS_RINV);
    constexpr int RPP = 4;
    f32x4 gp[4];
#pragma unroll
    for (int j = 0; j < 4; ++j) gp[j] = ((const f32x4*)gpost)[F.lane + 64 * j];
    for (int m0 = F.gw; m0 < MTOK; m0 += RPP * F.NGW) {
        f32x4 hn[RPP][4]; float sq[RPP]; float rs[RPP];
#pragma unroll
        for (int r = 0; r < RPP; ++r) { const int m = m0 + r * F.NGW < MTOK ? m0 + r * F.NGW : m0;
            const f32x4* sl = (const f32x4*)(oslots + (size_t)m * 16); const f32x4 s0 = sl[0], s1 = sl[1], s2 = sl[2], s3 = sl[3];
            const float ss = (((s0[0] + s0[1]) + (s0[2] + s0[3])) + ((s1[0] + s1[1]) + (s1[2] + s1[3]))) + (((s2[0] + s2[1]) + (s2[2] + s2[3])) + ((s3[0] + s3[1]) + (s3[2] + s3[3])));
            rs[r] = rsqrtf(ss * (1.0f / DM) + RMS_EPS);
            const v2u* mr = (const v2u*)(MIX + (size_t)m * DM) + F.lane; const v2u* xr = (const v2u*)(XB + (size_t)m * DM) + F.lane;
            sq[r] = 0.f;
#pragma unroll
            for (int j = 0; j < 4; ++j) { f32x4 hv;
                if (hold_f32) hv = ((const f32x4*)(hold_f32 + (size_t)m * DM) + F.lane)[64 * j];
                else { const v2u hw = xr[64 * j]; hv = (f32x4){bflo(hw.x), bfhi(hw.x), bflo(hw.y), bfhi(hw.y)}; }
                const v2u mw = mr[64 * j]; const f32x4 mx = {bflo(mw.x), bfhi(mw.x), bflo(mw.y), bfhi(mw.y)};
                hn[r][j] = hv + mx * rs[r] * gp[j]; sq[r] += (hn[r][j][0] * hn[r][j][0] + hn[r][j][1] * hn[r][j][1]) + (hn[r][j][2] * hn[r][j][2] + hn[r][j][3] * hn[r][j][3]); } }
#pragma unroll
        for (int r = 0; r < RPP; ++r) { const int m = m0 + r * F.NGW; if (m >= MTOK) break;
            if (last) { f32x4* ho = (f32x4*)(F.out + (size_t)m * DM) + F.lane;
#pragma unroll
                for (int j = 0; j < 4; ++j) ho[64 * j] = hn[r][j];
            } else {
                const float s = wave_sum(sq[r]); v2u* xw = (v2u*)(XB + (size_t)m * DM) + F.lane;
#pragma unroll
                for (int j = 0; j < 4; ++j) { v2u w; w.x = cvtpk(hn[r][j][0], hn[r][j][1]); w.y = cvtpk(hn[r][j][2], hn[r][j][3]); xw[64 * j] = w; }
                if (F.lane == 0) rinv[m] = rsqrtf(s * (1.0f / DM) + RMS_EPS);
            } }
    }
}

__device__ __forceinline__ void phase_cmp2(const Frame& F) {
    typedef short s8_t __attribute__((ext_vector_type(8))); typedef float f16_t __attribute__((ext_vector_type(16)));
    const bf16* HIDC = (const bf16*)(F.ws + WS_HIDC); bf16* KCMP = (bf16*)(F.ws + WS_KCMP); bf16* VCT = (bf16*)(F.ws + WS_VCMPT); const bf16* W2T = (const bf16*)(F.ws + W_C2);
    const int r32 = F.lane & 31, h = F.lane >> 5;
    for (int task = F.gw; task < 1024; task += F.NGW) {
        const int R0 = (task >> 1) * 32, ch = task & 1, kv = R0 >> 13, pl = (R0 >> 10) & 7, n0 = R0 & 1023;
        const GAS s8_t* xp = (const GAS s8_t*)(GAS bf16*)(HIDC + (size_t)(R0 + r32) * 256 + 8 * h);
        const GAS s8_t* wp = (const GAS s8_t*)(GAS bf16*)(W2T + (size_t)(kv * 64 + ch * 32 + r32) * 256 + 8 * h);
        s8_t x[16], wv[16];
#pragma unroll
        for (int s = 0; s < 16; ++s) { x[s] = xp[2 * s]; wv[s] = wp[2 * s]; }
        f16_t acc;
#pragma unroll
        for (int r = 0; r < 16; ++r) acc[r] = 0.f;
        if (kv == 0) {
#pragma unroll
            for (int s = 0; s < 16; ++s) acc = __builtin_amdgcn_mfma_f32_32x32x16_bf16(wv[s], x[s], acc, 0, 0, 0);
            const int n = n0 + r32; const float z = n == NCMP ? 0.f : 1.f;
#pragma unroll
            for (int a = 0; a < 4; ++a) { v2u pk; pk.x = cvtpk(acc[4 * a] * z, acc[4 * a + 1] * z); pk.y = cvtpk(acc[4 * a + 2] * z, acc[4 * a + 3] * z);
                *(v2u*)(KCMP + (size_t)pl * 65536 + (size_t)(n >> 6) * 4096 + (((((n >> 5) & 1) * 4 + 2 * ch + (a >> 1)) * 64 + (a & 1) * 32 + (n & 31)) * 8 + 4 * h)) = pk; }
        } else {
#pragma unroll
            for (int s = 0; s < 16; ++s) acc = __builtin_amdgcn_mfma_f32_32x32x16_bf16(x[s], wv[s], acc, 0, 0, 0);
            if (n0 == 992 && h == 1) acc[15] = 0.f;
            #pragma unroll
            for (int a = 0; a < 4; ++a) { v2u pk; pk.x = cvtpk(acc[4 * a], acc[4 * a + 1]); pk.y = cvtpk(acc[4 * a + 2], acc[4 * a + 3]);
                *(v2u*)(VCT + (size_t)pl * 65536 + (size_t)(n0 >> 6) * 4096 + ((((((n0 >> 5) & 1) * 2 + (a >> 1)) * 2 + ch) * 64 + h * 32 + r32) * 8 + 4 * (a & 1))) = pk; }
        }
    }
}

__device__ __forceinline__ void phase_ret_scan(const Frame& F) {
    const bf16* KV = (const bf16*)(F.ws + WS_KV); bf16* BP = (bf16*)(F.ws + WS_BP);
    for (int it = F.vcu * NTHREADS + F.tid; it < RH * RDV * (RDK / 8); it += F.G * NTHREADS) {
        const int d8 = it & 31, e = (it >> 5) & 511, h = it >> 14;
        const float cdec = exp2f((float)RCH * lg2gamma(h));
        float carry[8];
#pragma unroll
        for (int i = 0; i < 8; ++i) carry[i] = 0.f;
#pragma unroll 4
        for (int c = 0; c < NCH; ++c) {
            const size_t r = (size_t)(h * NCH + c) * RCH + e;
            float kv[8]; unpack8(*(const v4u*)(KV + r * RDK + d8 * 8), kv);
            v4u w; w.x = cvtpk(carry[0], carry[1]); w.y = cvtpk(carry[2], carry[3]); w.z = cvtpk(carry[4], carry[5]); w.w = cvtpk(carry[6], carry[7]);
            *(v4u*)(BP + r * APLD + RCH + d8 * 8) = w;
#pragma unroll
            for (int i = 0; i < 8; ++i) carry[i] = cdec * (carry[i] + kv[i]);
        }
    }
}

namespace nsa {
typedef float f32x16 __attribute__((ext_vector_type(16)));
typedef short s16x8 __attribute__((ext_vector_type(8)));
constexpr int KP = 64, SLOTB = 8192, GC = 2, GS = 4;
constexpr float LOG2E = 1.4426950408889634f, NEGB = -1.0e30f;
constexpr int L_IMP = 4 * GC * SLOTB, IMP_P = 260, L_SELM = L_IMP + 64 * IMP_P * 4, L_BT = L_SELM + 2048, L_UNI = L_BT + 2048, L_LIST = L_UNI + 64, L_END = L_LIST + 1024 + 16;
static_assert(L_END <= LDSCTL_OFF, "nsa lds");
constexpr int NB_P = 264, L_NB = 137344;
static_assert(L_NB >= L_END && L_NB % 16 == 0 && L_NB + 16 * NB_P * 4 <= LDSCTL_OFF, "bias table");
constexpr float IMP_SC = 67108864.f;
constexpr int L_SQ = 0, L_SM = 32768, L_SL = L_SM + 1024, L_TL = L_SL + 1024, TL_CAP = 320, L_TC = L_TL + TL_CAP * 4, L_TOK = L_TC + 64, L_SMF = L_TOK + TL_CAP * 32, L_SEND = L_SMF + 1024, SO_P = 66, L_SO = 64000;
static_assert(L_SEND <= L_SO && L_TOK % 32 == 0 && L_SO + 256 * SO_P * 4 <= L_SELM && L_SO % 16 == 0 && (256 * SO_P * 4) % 16 == 0, "sel lds");
__device__ __forceinline__ constexpr int krow(int r) { return (r & 3) + 8 * (r >> 2); }

__device__ __forceinline__ void tile_issue(LAS unsigned char* L, int koff, int voff, const bf16* Kg, const bf16* Vg, int ldv, int w, int lane) {
    asm volatile("" : "+v"(lane));
    const int row = 8 * w + (lane >> 3), c = (lane & 7) ^ ((row ^ (row >> 3)) & 7);
    __builtin_amdgcn_global_load_lds((const unsigned*)(Kg + (size_t)row * 64 + c * 8), (LAS unsigned*)(L + koff + w * 1024), 16, 0, 0);
    __builtin_amdgcn_global_load_lds((const unsigned*)(Vg + (size_t)row * ldv + c * 8), (LAS unsigned*)(L + voff + w * 1024), 16, 0, 0);
}
__device__ __forceinline__ void ktile_issue(LAS unsigned char* L, int koff, const bf16* Kg, int w, int lane) {
    asm volatile("" : "+v"(lane));
    const int row = 8 * w + (lane >> 3), c = (lane & 7) ^ ((row ^ (row >> 3)) & 7);
    __builtin_amdgcn_global_load_lds((const unsigned*)(Kg + (size_t)row * 64 + c * 8), (LAS unsigned*)(L + koff + w * 1024), 16, 0, 0);
}
struct KVFrag { s16x8 k[4], v[2][2]; };
__device__ __forceinline__ void frag_load(KVFrag& f, const LAS bf16* Kl, const LAS bf16* Vl, int kt, int r32, int h) {
    const int kr = 32 * kt + r32;
#pragma unroll
    for (int s = 0; s < 4; ++s) f.k[s] = *(const LAS s16x8*)(Kl + kr * KP + 8 * ((2 * s + h) ^ ((kr ^ (kr >> 3)) & 7)));
#pragma unroll
    for (int s2 = 0; s2 < 2; ++s2)
#pragma unroll
        for (int dt = 0; dt < 2; ++dt) { const int d = 32 * dt + r32; f.v[s2][dt] = *(const LAS s16x8*)(Vl + d * KP + 8 * ((4 * kt + 2 * s2 + h) ^ ((d ^ (d >> 3)) & 7))); }
    __builtin_amdgcn_sched_barrier(0);
}
__device__ __forceinline__ f32x16 qk_tile(const KVFrag& f, const s16x8 (&qf)[4], float cinit) {
    f32x16 p;
#pragma unroll
    for (int r = 0; r < 16; ++r) p[r] = cinit;
#pragma unroll
    for (int s = 0; s < 4; ++s) p = __builtin_amdgcn_mfma_f32_32x32x16_bf16(f.k[s], qf[s], p, 0, 0, 0);
    return p;
}
__device__ __forceinline__ void pv_tile(f32x16 (&o)[2], const KVFrag& f, const f32x16& p) {
#pragma unroll
    for (int s2 = 0; s2 < 2; ++s2) {
        v4u pw; pw.x = cvtpk(p[8 * s2 + 0], p[8 * s2 + 1]); pw.y = cvtpk(p[8 * s2 + 2], p[8 * s2 + 3]); pw.z = cvtpk(p[8 * s2 + 4], p[8 * s2 + 5]); pw.w = cvtpk(p[8 * s2 + 6], p[8 * s2 + 7]);
        const s16x8 pb = __builtin_bit_cast(s16x8, pw);
#pragma unroll
        for (int dt = 0; dt < 2; ++dt) {
            o[dt] = __builtin_amdgcn_mfma_f32_32x32x16_bf16(f.v[s2][dt], pb, o[dt], 0, 0, 0);
        }
    }
}
__device__ __forceinline__ float xhalf_max(float v) { auto rr = __builtin_amdgcn_permlane32_swap(__float_as_uint(v), __float_as_uint(v), false, false); return fmaxf(__uint_as_float(rr[0]), __uint_as_float(rr[1])); }
template <int MODE> __device__ __forceinline__ unsigned post_tile(f32x16& p, int kbase, int t, int lim, bool colok, const LAS float* bT) {
    unsigned vm = 0u;
#pragma unroll
    for (int r = 0; r < 16; ++r) {
        const int key = kbase + krow(r);
        const int dist = MODE == 0 ? t - 31 - 16 * key : t - key;
        const bool ok = colok && dist >= 0 && (MODE == 0 ? key < NCMP : dist < lim);
        const int di = dist < 0 ? 0 : (dist > 127 ? 127 : dist);
        p[r] = p[r] + bT[di * 4];
        vm |= ok ? (1u << r) : 0u;
    }
    return vm;
}
__device__ __forceinline__ void bias_tile(f32x16& p, const LAS float* NB, int kb, int t, int hd) {
    const int idx = 191 - t + kb, c = idx & 3;
    const LAS f32x4* b = (const LAS f32x4*)(NB + (c * 4 + hd) * NB_P + (idx - c));
#pragma unroll
    for (int a = 0; a < 4; ++a) { const f32x4 v = b[2 * a]; p[4 * a] += v[0]; p[4 * a + 1] += v[1]; p[4 * a + 2] += v[2]; p[4 * a + 3] += v[3]; }
}
__device__ __forceinline__ void cmp_bias(f32x16& p, int d0, const LAS float* bT) {
#pragma unroll
    for (int r = 0; r < 16; ++r) {
        const int dist = d0 - 16 * krow(r), di = dist < 0 ? 0 : (dist > 127 ? 127 : dist);
        const float b = bT[di * 4];
        p[r] = dist < 0 ? NEGB : p[r] + b;
    }
}
__device__ __forceinline__ void softmax_update(f32x16& p, unsigned vm, float& m, float& l, f32x16 (&o)[2], bool has_o) {
    float mx = NEGB;
#pragma unroll
    for (int r = 0; r < 16; ++r) if ((vm >> r) & 1u) mx = fmaxf(mx, p[r]);
    mx = xhalf_max(mx);
    const float mn = fmaxf(m, mx), alpha = __builtin_amdgcn_exp2f(m - mn);
    m = mn; float ls = 0.f;
#pragma unroll
    for (int r = 0; r < 16; ++r) { p[r] = ((vm >> r) & 1u) ? __builtin_amdgcn_exp2f(p[r] - mn) : 0.f; ls += p[r]; }
    l = l * alpha + ls;
    if (has_o && !__all(alpha == 1.0f)) {
#pragma unroll
        for (int r = 0; r < 16; ++r) { o[0][r] *= alpha; o[1][r] *= alpha; } }
}
__device__ __forceinline__ void softmax_update_fast(f32x16& p, float& m, float& l, f32x16 (&o)[2]) {
    float mx = p[0];
#pragma unroll
    for (int r = 1; r < 16; ++r) mx = fmaxf(mx, p[r]);
    mx = xhalf_max(mx);
    const float mn = fmaxf(m, mx), alpha = __builtin_amdgcn_exp2f(m - mn);
    m = mn; float ls = 0.f;
#pragma unroll
    for (int r = 0; r < 16; ++r) { p[r] = __builtin_amdgcn_exp2f(p[r] - mn); ls += p[r]; }
    l = l * alpha + ls;
    if (!__all(alpha == 1.0f)) {
#pragma unroll
        for (int r = 0; r < 16; ++r) { o[0][r] *= alpha; o[1][r] *= alpha; } }
}
#define DPP_XOR1 0xB1
#define DPP_XOR2 0x4E
#define DPP_HMIR 0x141
__device__ __forceinline__ float quad_sum(float v) { v += __int_as_float(__builtin_amdgcn_update_dpp(0, __float_as_int(v), DPP_XOR1, 0xf, 0xf, true)); v += __int_as_float(__builtin_amdgcn_update_dpp(0, __float_as_int(v), DPP_XOR2, 0xf, 0xf, true)); return v; }
__device__ __forceinline__ unsigned oct_umax(unsigned v) {
    unsigned o = (unsigned)__builtin_amdgcn_update_dpp(0, (int)v, DPP_XOR1, 0xf, 0xf, true); v = v > o ? v : o;
    o = (unsigned)__builtin_amdgcn_update_dpp(0, (int)v, DPP_XOR2, 0xf, 0xf, true); v = v > o ? v : o;
    o = (unsigned)__builtin_amdgcn_update_dpp(0, (int)v, DPP_HMIR, 0xf, 0xf, true); return v > o ? v : o;
}
__device__ __forceinline__ unsigned umax3(unsigned a, unsigned b, unsigned c) { unsigned d; asm("v_max3_u32 %0, %1, %2, %3" : "=v"(d) : "v"(a), "v"(b), "v"(c)); return d; }
template <int N> __device__ __forceinline__ unsigned umax_tree(const unsigned (&t)[N]) {
    if constexpr (N == 1) return t[0];
    else { constexpr int M = (N + 2) / 3; unsigned u[M];
#pragma unroll
        for (int i = 0; i < M; ++i) u[i] = umax3(t[3 * i], 3 * i + 1 < N ? t[3 * i + 1] : t[3 * i], 3 * i + 2 < N ? t[3 * i + 2] : t[3 * i]);
        return umax_tree<M>(u); }
}
template <int NE> __device__ __forceinline__ void topk_rounds(const LAS int* ip, LAS unsigned* sm, int sub, int cur, int need) {
    unsigned key[NE];
#pragma unroll
    for (int i = 0; i < NE; ++i) { const int j = sub + 8 * i; key[i] = (j >= 1 && j <= cur - 2) ? ((((unsigned)ip[j] >> 5) << 8) | (unsigned)(255 - j)) : 0u; }
#pragma unroll 1
    for (int round = 0; round < need; ++round) {
        unsigned bk = oct_umax(umax_tree<NE>(key));
#pragma unroll
        for (int i = 0; i < NE; ++i) key[i] = key[i] == bk ? 0u : key[i];
        const int bj = 255 - (int)(bk & 0xffu);
        if (sub == 0 && bk != 0u) (void)__hip_atomic_fetch_or(sm + (bj >> 5), 1u << (bj & 31), __ATOMIC_RELAXED, __HIP_MEMORY_SCOPE_WORKGROUP);
    }
}
__device__ __forceinline__ void lds_add_f32(LAS float* p, float v) { asm volatile("ds_add_f32 %0, %1" :: "v"((unsigned)(uintptr_t)p), "v"(v) : "memory"); }
__device__ __forceinline__ float max3f(float a, float b, float c) { float d; asm("v_max3_f32 %0, %1, %2, %3" : "=v"(d) : "v"(a), "v"(b), "v"(c)); return d; }
template <int OFF> __device__ __forceinline__ void lds_add_2i32_off(LAS int* p, int lo, int hi) {
    const unsigned long long v = ((unsigned long long)(unsigned)(hi + (lo >> 31)) << 32) | (unsigned)lo;
    asm volatile("ds_add_u64 %0, %1 offset:%2" :: "v"((unsigned)(uintptr_t)p), "v"(v), "n"(OFF) : "memory"); }
__device__ __forceinline__ void lds_max_i32(LAS int* p, int v) { asm volatile("ds_max_i32 %0, %1" :: "v"((unsigned)(uintptr_t)p), "v"(v) : "memory"); }
__device__ __forceinline__ void lds_add_i32(LAS int* p, int v) { asm volatile("ds_add_u32 %0, %1" :: "v"((unsigned)(uintptr_t)p), "v"(v) : "memory"); }
__device__ __forceinline__ int f2ord(float f) { const int b = __float_as_int(f); return b ^ ((b >> 31) & 0x7fffffff); }
__device__ __forceinline__ float ord2f(int o) { return __int_as_float(o ^ ((o >> 31) & 0x7fffffff)); }
struct KF { s16x8 k[2][4]; };
struct VF { s16x8 v[2][2][2]; };
__device__ __forceinline__ void kf_load(KF& f, const bf16* blk, int lane) {
    const GAS s16x8* p = (const GAS s16x8*)(GAS bf16*)blk + lane;
#pragma unroll
    for (int kt = 0; kt < 2; ++kt)
#pragma unroll
        for (int s = 0; s < 4; ++s) f.k[kt][s] = p[(kt * 4 + s) * 64];
}
__device__ __forceinline__ void vf_load(VF& f, const bf16* blk, int lane) {
    const GAS s16x8* p = (const GAS s16x8*)(GAS bf16*)blk + lane;
#pragma unroll
    for (int kt = 0; kt < 2; ++kt)
#pragma unroll
        for (int s2 = 0; s2 < 2; ++s2)
#pragma unroll
            for (int dt = 0; dt < 2; ++dt) f.v[kt][s2][dt] = p[((kt * 2 + s2) * 2 + dt) * 64];
}
__device__ __forceinline__ f32x16 qk_frag(const s16x8 (&kf)[4], const s16x8 (&qf)[4], float cinit) {
    f32x16 p;
#pragma unroll
    for (int r = 0; r < 16; ++r) p[r] = cinit;
#pragma unroll
    for (int s = 0; s < 4; ++s) p = __builtin_amdgcn_mfma_f32_32x32x16_bf16(kf[s], qf[s], p, 0, 0, 0);
    return p;
}
__device__ __forceinline__ void pv_frag(f32x16 (&o)[2], const s16x8 (&vf)[2][2], const f32x16& p) {
#pragma unroll
    for (int s2 = 0; s2 < 2; ++s2) {
        v4u pw; pw.x = cvtpk(p[8 * s2 + 0], p[8 * s2 + 1]); pw.y = cvtpk(p[8 * s2 + 2], p[8 * s2 + 3]); pw.z = cvtpk(p[8 * s2 + 4], p[8 * s2 + 5]); pw.w = cvtpk(p[8 * s2 + 6], p[8 * s2 + 7]);
        const s16x8 pb = __builtin_bit_cast(s16x8, pw);
#pragma unroll
        for (int dt = 0; dt < 2; ++dt) o[dt] = __builtin_amdgcn_mfma_f32_32x32x16_bf16(vf[s2][dt], pb, o[dt], 0, 0, 0);
    }
}
__device__ __forceinline__ void pvl_frag(f32x16 (&o)[3], const s16x8 (&vf)[2][2], const f32x16& p, const s16x8& ones) {
#pragma unroll
    for (int s2 = 0; s2 < 2; ++s2) {
        v4u pw; pw.x = cvtpk(p[8 * s2 + 0], p[8 * s2 + 1]); pw.y = cvtpk(p[8 * s2 + 2], p[8 * s2 + 3]); pw.z = cvtpk(p[8 * s2 + 4], p[8 * s2 + 5]); pw.w = cvtpk(p[8 * s2 + 6], p[8 * s2 + 7]);
        const s16x8 pb = __builtin_bit_cast(s16x8, pw);
#pragma unroll
        for (int dt = 0; dt < 2; ++dt) o[dt] = __builtin_amdgcn_mfma_f32_32x32x16_bf16(vf[s2][dt], pb, o[dt], 0, 0, 0);
        o[2] = __builtin_amdgcn_mfma_f32_32x32x16_bf16(ones, pb, o[2], 0, 0, 0);
    }
}
__device__ __forceinline__ void stats_update_fast(const f32x16& p, float& m, float& l) {
    float mx = p[0];
#pragma unroll
    for (int r = 1; r < 16; ++r) mx = fmaxf(mx, p[r]);
    mx = xhalf_max(mx);
    const float mn = fmaxf(m, mx), alpha = __builtin_amdgcn_exp2f(m - mn);
    m = mn; float ls = 0.f;
#pragma unroll
    for (int r = 0; r < 16; ++r) ls += __builtin_amdgcn_exp2f(p[r] - mn);
    l = l * alpha + ls;
}
#define NSA_BAR() do { asm volatile("s_waitcnt lgkmcnt(0)" ::: "memory"); __builtin_amdgcn_s_barrier(); asm volatile("" ::: "memory"); } while (0)
}

__device__ __forceinline__ void phase_nsa(const Frame& F) {
    using namespace nsa;
    const int tid = F.tid, lane = F.lane, w = F.wave, r32_ = lane & 31, h_ = lane >> 5;
    LAS unsigned char* L = F.lds + RING_OFF;
    LAS float* IMP = (LAS float*)(L + L_IMP); LAS unsigned* SELM = (LAS unsigned*)(L + L_SELM); LAS float* BT = (LAS float*)(L + L_BT);
    LAS float* NBT = (LAS float*)(L + L_NB);
    const bf16* Q = (const bf16*)(F.ws + WS_Q); const bf16* KCMP = (const bf16*)(F.ws + WS_KCMP); const bf16* VCT = (const bf16*)(F.ws + WS_VCMPT);
    const bf16* KS = (const bf16*)(F.ws + WS_KS); const bf16* KW = (const bf16*)(F.ws + WS_KW); const bf16* VST = (const bf16*)(F.ws + WS_VST); const bf16* VWT = (const bf16*)(F.ws + WS_VWT);
    const float* GATE = (const float*)(F.ws + WS_GATE); const float* biasT = (const float*)(F.ws + WS_BIAST); bf16* ONSA = (bf16*)(F.ws + WS_ONSA);
#if defined(PROBE_SPIN_SEC)
    unsigned long long tacc[8] = {0, 0, 0, 0, 0, 0, 0, 0}, tlast = wall_clock64(); const unsigned long long tstart = tlast;
#define STAMP(k) do { const unsigned long long tn_ = wall_clock64(); tacc[k] += tn_ - tlast; tlast = tn_; } while (0)
#else
#define STAMP(k) do {} while (0)
#endif
    int g_bt = -1;
#pragma unroll 1
    for (int e = F.vcu; e < 2048; e += F.G) {
        const int ui = e >> 8, pl = (e >> 5) & 7, wi = e & 31, b = pl >> 2, g = pl & 3;
        if (g != g_bt) {
            __syncthreads();
            for (int i = tid; i < 512; i += NTHREADS) BT[i] = biasT[(i >> 2) * 16 + g * 4 + (i & 3)] * LOG2E;
            for (int i = tid; i < 16 * NB_P; i += NTHREADS) { const int c = i / (4 * NB_P), hd = (i / NB_P) & 3, dist = 127 - ((i % NB_P) + c - 64);
                NBT[i] = dist < 0 ? NEGB : biasT[(dist > 127 ? 127 : dist) * 16 + g * 4 + hd] * LOG2E; }
            g_bt = g;
            __syncthreads();
        }
        const int qt = 32 * ui + ((wi + 4 * ui) & 31);
        const int t0 = qt * 64, cur = qt, m0 = b * SEQ + t0;
#define TOK(r_) (t0 + 8 * w + ((r_) >> 2))
#define MROW(r_) (m0 + 8 * w + ((r_) >> 2))
#define HEADG(r_) (g * NR + ((r_) & 3))
#define B31(r_) (BT[127 * 4 + ((r_) & 3)])
        const int ncb = t0 >= 0 ? ((t0 + 63 - 31) / 16) / 64 + 1 : 0;
        const int icut = t0 >= 1152 ? (((t0 - 144) >> 4) - 63) / 64 + 1 : 0;
        const bf16* Kc = KCMP + (size_t)pl * 1024 * 64; const bf16* Vc = VCT + (size_t)pl * 64 * 1024;
        NSA_BAR();
#define LOAD_QF() s16x8 qf[4]; { int r_o = r32_, h_o = h_; asm volatile("" : "+v"(r_o), "+v"(h_o)); _Pragma("unroll") for (int s = 0; s < 4; ++s) qf[s] = *(const GAS s16x8*)(GAS bf16*)(Q + (size_t)MROW(r_o) * 1024 + HEADG(r_o) * 64 + 16 * s + 8 * h_o); }
#define OACC_DECL() int t_o = tid; asm volatile("" : "+v"(t_o)); f32x4* OACC = (f32x4*)((float*)(F.ws + WS_MIX) + ((size_t)blockIdx.x * NTHREADS + t_o) * 64);
#define GATE_LOAD(k_) ({ int l_o = r32_; asm volatile("" : "+v"(l_o)); GATE[(size_t)(m0 + 8 * w + (l_o >> 2)) * 48 + (g * NR + (l_o & 3)) * 3 + (k_)]; })
        const float gate0 = GATE_LOAD(0);
        LOAD_QF()
        for (int i = lane; i < 8 * IMP_P; i += 64) IMP[8 * w * IMP_P + i] = 0.f;
        for (int i = tid; i < 512; i += NTHREADS) SELM[i] = 0u;
        __syncthreads();
        STAMP(0);
        f32x16 oc[2];
#pragma unroll
        for (int r = 0; r < 16; ++r) { oc[0][r] = 0.f; oc[1][r] = 0.f; }
        float mref = 0.f, lc = 0.f; bool first = true;
        {
            int r32 = r32_, h = h_, lane_c = lane; asm volatile("" : "+v"(r32), "+v"(h), "+v"(lane_c));
            KF kf; kf_load(kf, Kc, lane_c);
#pragma unroll 1
            for (int i = 0; i < ncb; ++i) {
                const bool far = i < icut;
                const float ci = far ? B31(r32) - mref : -mref;
                f32x16 pq[2] = {qk_frag(kf.k[0], qf, ci), qk_frag(kf.k[1], qf, ci)};
                kf_load(kf, Kc + (size_t)(i + 1 < ncb ? i + 1 : i) * 4096, lane_c);
#pragma unroll
                for (int kt = 0; kt < 2; ++kt) {
                    f32x16& pp = pq[kt];
                    if (!far) cmp_bias(pp, TOK(r32) - 31 - 16 * (i * 64 + 32 * kt + 4 * h), BT + (r32 & 3));
                    float tmax = max3f(pp[0], pp[1], pp[2]);
#pragma unroll
                    for (int r = 3; r < 15; r += 2) tmax = max3f(tmax, pp[r], pp[r + 1]);
                    tmax = fmaxf(tmax, pp[15]); tmax = xhalf_max(tmax);
                    const float d = first ? tmax : fmaxf(tmax, 0.f);
                    if (__any(d != 0.f)) {
                        mref += d; lc = first ? 0.f : lc * __builtin_amdgcn_exp2f(-d);
#pragma unroll
                        for (int r = 0; r < 16; ++r) { pq[0][r] -= d; pq[1][r] -= d; }
                    }
                    first = false;
#pragma unroll
                    for (int r = 0; r < 16; ++r) lc += __builtin_amdgcn_exp2f(pp[r]);
                }
            }
        }
        {
            const float lt = lc + __shfl_xor(lc, 32);
            const float mcl = (mref > -1.0e29f && lt > 0.f) ? mref + __builtin_amdgcn_logf(lt) - 26.0f : 1.0e30f;
            int r32 = r32_, h = h_, lane_c = lane; asm volatile("" : "+v"(r32), "+v"(h), "+v"(lane_c));
            KF kf; VF vf; kf_load(kf, Kc, lane_c);
#pragma unroll 1
            for (int i = 0; i < ncb; ++i) {
                vf_load(vf, Vc + (size_t)i * 4096, lane_c);
                const bool far = i < icut;
                const float ci = far ? B31(r32) - mcl : -mcl;
                f32x16 pq[2] = {qk_frag(kf.k[0], qf, ci), qk_frag(kf.k[1], qf, ci)};
                kf_load(kf, Kc + (size_t)(i + 1 < ncb ? i + 1 : i) * 4096, lane_c);
#pragma unroll
                for (int kt = 0; kt < 2; ++kt) {
                    f32x16& pp = pq[kt];
                    if (!far) cmp_bias(pp, TOK(r32) - 31 - 16 * (i * 64 + 32 * kt + 4 * h), BT + (r32 & 3));
#pragma unroll
                    for (int r = 0; r < 16; ++r) pp[r] = __builtin_amdgcn_exp2f(pp[r]);
#pragma unroll
                    for (int a = 0; a < 4; ++a) {
                        const float s4 = quad_sum((pp[4 * a] + pp[4 * a + 1]) + (pp[4 * a + 2] + pp[4 * a + 3])), s1 = quad_sum(pp[4 * a + 3]);
                        const int j = i * 16 + kt * 8 + 2 * a + h;
                        if ((r32 & 3) == 0) { LAS int* ip = (LAS int*)IMP + (8 * w + (r32 >> 2)) * IMP_P + j; lds_add_i32(ip, (int)s4); lds_add_i32(ip + 1, (int)s1); }
                    }
                    pv_frag(oc, vf.v[kt], pp);
                }
            }
            asm volatile("s_waitcnt vmcnt(0)" ::: "memory");
        }
        const float g0 = gate0 * 1.4901161193847656e-08f;
        OACC_DECL()
#pragma unroll
        for (int q = 0; q < 4; ++q) { OACC[q] = (f32x4){oc[0][4 * q], oc[0][4 * q + 1], oc[0][4 * q + 2], oc[0][4 * q + 3]} * g0; OACC[4 + q] = (f32x4){oc[1][4 * q], oc[1][4 * q + 1], oc[1][4 * q + 2], oc[1][4 * q + 3]} * g0; }
        STAMP(1);
        {
            int lane_q = lane; asm volatile("" : "+v"(lane_q));
#pragma unroll
            for (int q = 0; q < 4; ++q) { const int row = 32 * w + 8 * q + (lane_q >> 3), c = (lane_q & 7) ^ (row & 7);
                __builtin_amdgcn_global_load_lds((const unsigned*)(Q + (size_t)(m0 + (row >> 2)) * 1024 + (g * NR + (row & 3)) * 64 + c * 8), (LAS unsigned*)(L + L_SQ + (32 * w + 8 * q) * 128), 16, 0, 0); }
        }
        {
            int lane_o = lane; asm volatile("" : "+v"(lane_o));
            const int tk = lane_o >> 3, sub = lane_o & 7; LAS unsigned* sm = SELM + (8 * w + tk) * 8;
            const int ncand = cur - 2, nf = cur + 1 < 3 ? cur + 1 : 3, need = 16 - nf;
            asm volatile("s_waitcnt lgkmcnt(0)" ::: "memory");
            if (sub == 0) { (void)__hip_atomic_fetch_or(sm, 1u, __ATOMIC_RELAXED, __HIP_MEMORY_SCOPE_WORKGROUP); (void)__hip_atomic_fetch_or(sm + (cur >> 5), 1u << (cur & 31), __ATOMIC_RELAXED, __HIP_MEMORY_SCOPE_WORKGROUP); if (cur >= 1) (void)__hip_atomic_fetch_or(sm + ((cur - 1) >> 5), 1u << ((cur - 1) & 31), __ATOMIC_RELAXED, __HIP_MEMORY_SCOPE_WORKGROUP); }
            if (ncand <= need) {
                if (sub == 0) for (int j = 1; j <= cur - 2; ++j) (void)__hip_atomic_fetch_or(sm + (j >> 5), 1u << (j & 31), __ATOMIC_RELAXED, __HIP_MEMORY_SCOPE_WORKGROUP);
            } else {
                const LAS int* ip = (const LAS int*)IMP + (8 * w + tk) * IMP_P;
                const int nen = ((cur - 2) >> 3) + 1;
                if (nen <= 8) topk_rounds<8>(ip, sm, sub, cur, need); else if (nen <= 16) topk_rounds<16>(ip, sm, sub, cur, need);
                else if (nen <= 24) topk_rounds<24>(ip, sm, sub, cur, need); else topk_rounds<32>(ip, sm, sub, cur, need);
            }
        }
        asm volatile("s_waitcnt vmcnt(0)" ::: "memory");
        __syncthreads();
        STAMP(2);
        {
            LAS int* SO = (LAS int*)(L + L_SO); LAS int* SM = (LAS int*)(L + L_SM); LAS int* SL = (LAS int*)(L + L_SL);
            LAS unsigned char* SQ = L + L_SQ; LAS unsigned* TL = (LAS unsigned*)(L + L_TL); LAS unsigned* TC = (LAS unsigned*)(L + L_TC); LAS unsigned char* TOKB = L + L_TOK;
            {
                int tid_o = tid; asm volatile("" : "+v"(tid_o));
                const int ln = tid_o & 63;
                const unsigned word = SELM[ln * 8 + w];
                unsigned long long tm = 0ull;
#pragma unroll
                for (int bt = 0; bt < 32; ++bt) { const unsigned long long mk = __ballot((word >> bt) & 1u); tm = ln == bt ? mk : tm; }
                const int jb = 32 * w + ln;
                const int cnt = (ln < 32 && jb != 0 && jb != cur && jb != cur - 1) ? __popcll(tm) : 0, nt = (cnt + 31) >> 5;
                int sc = nt;
#pragma unroll
                for (int o = 1; o < 32; o <<= 1) { const int v = __shfl_up(sc, o); if (ln >= o) sc += v; }
                if (ln == 31) TC[4 + w] = (unsigned)sc;
                if (tid_o < 256) SM[tid_o] = f2ord(NEGB);
                __syncthreads();
                if (nt > 0) {
                    const int j = 32 * w + ln;
                    int pos = sc - nt; for (int ww = 0; ww < w; ++ww) pos += (int)TC[4 + ww];
                    LAS unsigned char* tb = TOKB + pos * 32;
                    if (tm == ~0ull) {
                        unsigned pat = 0x03020100u; asm volatile("" : "+v"(pat));
#pragma unroll 1
                        for (int q = 0; q < 16; ++q) { ((LAS unsigned*)tb)[q] = pat; pat += 0x04040404u; }
                        TL[pos] = (unsigned)j | (32u << 8); TL[pos + 1] = (unsigned)j | (32u << 8);
                    } else {
                        unsigned long long rem = tm; int c = 0;
                        for (; rem != 0ull; ++c) { const int t = __ffsll((long long)rem) - 1; rem &= rem - 1ull; tb[c] = (unsigned char)t; }
                        for (; (c & 7) != 0; ++c) tb[c] = (unsigned char)0xff;
                        for (int k = 0; k < nt; ++k) TL[pos + k] = (unsigned)j | ((unsigned)(cnt - 32 * k < 32 ? cnt - 32 * k : 32) << 8);
                    }
                }
                __syncthreads();
            }
            STAMP(5);
            const int ntl = (int)(TC[4] + TC[5] + TC[6] + TC[7] + TC[8] + TC[9] + TC[10] + TC[11]);
            const int nmine = (ntl - w + 7) >> 3;
            const float vmax = __uint_as_float(((const unsigned*)(F.ws + WS_CTL))[CW_VMAX + pl]);
            const float kexp = fminf(20.f, floorf(19.f - log2f(fmaxf(vmax, 1.0e-30f))));
            const bf16* Kg = KS + (size_t)pl * SEQ * 64; const bf16* Vg = VST + (size_t)pl * 64 * SEQ;
#define SEL_DESC(k_) ({ int kk_ = (k_) < nmine ? (k_) : nmine - 1; kk_ = kk_ < 0 ? 0 : kk_; (unsigned)__builtin_amdgcn_readfirstlane(TL[w + 8 * kk_]); })
#define SEL_COLS(tb_, grp_) int r32 = r32_, h = h_; asm volatile("" : "+v"(r32), "+v"(h)); \
                    const unsigned tokb = (tb_)[8 * (grp_) + (r32 >> 2)]; \
                    const bool valid = tokb != 0xffu; const int tokl = valid ? (int)tokb : 0, row = tokl * 4 + (r32 & 3); \
                    s16x8 qg[4]; const unsigned qa = (unsigned)(uintptr_t)(SQ + row * 128) + (unsigned)((h ^ (row & 7)) << 4);     \
                    _Pragma("unroll") for (int s = 0; s < 4; ++s) qg[s] = *(const LAS s16x8*)(uintptr_t)(qa ^ (unsigned)(32 * s));
            const float kexpT = kexp - 2.0f;
            f32x4 pc[8];
            LAS float* SMF = (LAS float*)(L + L_SMF);
#pragma unroll 1
            for (int attempt = 0; attempt < 2; ++attempt) {
                int lane_ = lane; asm volatile("" : "+v"(lane_));
#define lane lane_
                if (attempt == 1) {
                {
                    KF ka, kb, kc; unsigned da = SEL_DESC(0), db = SEL_DESC(1), dc = 0u;
                    kf_load(ka, Kg + (size_t)(da & 255u) * 4096, lane); kf_load(kb, Kg + (size_t)(db & 255u) * 4096, lane);
                    auto step = [&](int k, KF& kcur, const unsigned dcur, KF& kpre, unsigned& dpre) __attribute__((always_inline)) {
                        dpre = SEL_DESC(k + 2);
                        kf_load(kpre, Kg + (size_t)(dpre & 255u) * 4096, lane);
                        const int j = (int)(dcur & 255u), ngrp = (int)((dcur >> 8) + 7u) >> 3; const bool near = j >= cur - 2;
                        const LAS unsigned char* tb = TOKB + (w + 8 * k) * 32;
#pragma unroll 1
                        for (int grp = 0; grp < ngrp; ++grp) {
                            SEL_COLS(tb, grp)
                            f32x16 p0 = qk_frag(kcur.k[0], qg, 0.f), p1 = qk_frag(kcur.k[1], qg, 0.f);
                            if (near) { bias_tile(p0, NBT, j * 64 + 4 * h, t0 + tokl, r32 & 3); bias_tile(p1, NBT, j * 64 + 32 + 4 * h, t0 + tokl, r32 & 3); }
                            float mx = max3f(p0[0], p1[0], NEGB);
#pragma unroll
                            for (int r = 1; r < 16; ++r) mx = max3f(mx, p0[r], p1[r]);
                            if (!near) mx += B31(r32);
                            { auto rr2 = __builtin_amdgcn_permlane32_swap(__float_as_uint(mx), __float_as_uint(mx), false, false); mx = max3f(__uint_as_float(rr2[0]), __uint_as_float(rr2[1]), NEGB); }
                            if (valid && h == 0) lds_max_i32(SM + row, f2ord(mx));
                        }
                    };
#pragma unroll 1
                    for (int k = 0; k < nmine; k += 3) {
                        step(k, ka, da, kc, dc);
                        if (k + 1 >= nmine) break;
                        step(k + 1, kb, db, ka, da);
                        if (k + 2 >= nmine) break;
                        step(k + 2, kc, dc, kb, db);
                    }
                    asm volatile("s_waitcnt vmcnt(0) lgkmcnt(0)" ::: "memory");
                }

                    __syncthreads();
                }
                {
                    LOAD_QF()
                    unsigned one2 = 0x3f803f80u; asm volatile("" : "+v"(one2));
                    const s16x8 ones = __builtin_bit_cast(s16x8, (v4u){one2, one2, one2, one2});
                    int r32 = r32_, h = h_; asm volatile("" : "+v"(r32), "+v"(h));
                    const int nfb = cur >= 2 ? 3 : cur + 1;
                    float mref = 0.f; bool seen = false; f32x16 ow[3];
#pragma unroll
                    for (int r = 0; r < 16; ++r) { ow[0][r] = 0.f; ow[1][r] = 0.f; ow[2][r] = 0.f; }
                    KF ka, kb; VF vf;
                    kf_load(ka, Kg, lane);
                    auto fstep = [&](int i, KF& kcur, KF& knext) __attribute__((always_inline)) {
                        const int j = i == 0 ? 0 : cur - (nfb - 1 - i), jn = (i + 1 < nfb) ? cur - (nfb - 2 - i) : j;
                        vf_load(vf, Vg + (size_t)j * 4096, lane); kf_load(knext, Kg + (size_t)jn * 4096, lane);
                        const bool nearb = j >= cur - 2;
#pragma unroll
                        for (int kt = 0; kt < 2; ++kt) {
                            f32x16 pp = qk_frag(kcur.k[kt], qf, (nearb ? 0.f : B31(r32)) - mref);
                            if (nearb) bias_tile(pp, NBT, j * 64 + 32 * kt + 4 * h, TOK(r32), r32 & 3);
                            float tmax = max3f(pp[0], pp[1], pp[2]);
#pragma unroll
                            for (int r = 3; r < 15; r += 2) tmax = max3f(tmax, pp[r], pp[r + 1]);
                            tmax = fmaxf(tmax, pp[15]); tmax = xhalf_max(tmax);
                            const bool ok = tmax > -1.0e29f;
                            const float d = seen ? fmaxf(tmax, 0.f) : (ok ? tmax : 0.f);
                            if (__any(d != 0.f)) {
                                const float al = seen ? __builtin_amdgcn_exp2f(-d) : 1.0f; mref += d; ow[2][0] *= al;
#pragma unroll
                                for (int r = 0; r < 16; ++r) { ow[0][r] *= al; ow[1][r] *= al; pp[r] -= d; }
                            }
                            seen = seen || ok;
#pragma unroll
                            for (int r = 0; r < 16; ++r) pp[r] = __builtin_amdgcn_exp2f(pp[r]);
                            pvl_frag(ow, vf.v[kt], pp, ones);
                        }
                    };
                    fstep(0, ka, kb);
                    if (nfb > 1) fstep(1, kb, ka);
                    if (nfb > 2) fstep(2, ka, kb);
                    const int row = (8 * w + (r32 >> 2)) * 4 + (r32 & 3);
                    const float refr = attempt == 0 ? mref + 4.0f : fmaxf(ord2f(SM[row]), mref);
                    const float fac = __builtin_amdgcn_exp2f(mref - refr + kexpT);
                    LAS int* op = SO + row * SO_P + 4 * h;
#pragma unroll
                    for (int dt = 0; dt < 2; ++dt)
#pragma unroll
                        for (int a = 0; a < 4; ++a) {
                            const int l0 = (int)(ow[dt][4 * a] * fac), h0 = (int)(ow[dt][4 * a + 1] * fac), l1 = (int)(ow[dt][4 * a + 2] * fac), h1 = (int)(ow[dt][4 * a + 3] * fac);
                            *(LAS v4u*)(op + 32 * dt + 8 * a) = (v4u){(unsigned)l0, (unsigned)(h0 + (l0 >> 31)), (unsigned)l1, (unsigned)(h1 + (l1 >> 31))};
                        }
                    if (h == 0) { SL[row] = (int)(ow[2][0] * fac); SMF[row] = refr; }
                    if (tid == 0) TC[3] = 0u;
                }
                __syncthreads();
                {
                    unsigned one2 = 0x3f803f80u; asm volatile("" : "+v"(one2));
                    const s16x8 ones = __builtin_bit_cast(s16x8, (v4u){one2, one2, one2, one2});
                    KF ka, kb; VF vf; unsigned dcur = SEL_DESC(0);
                    kf_load(ka, Kg + (size_t)(dcur & 255u) * 4096, lane); vf_load(vf, Vg + (size_t)(dcur & 255u) * 4096, lane);
                    auto step = [&](int k, KF& kcur, KF& knext) __attribute__((always_inline)) {
                        const unsigned dn = SEL_DESC(k + 1);
                        kf_load(knext, Kg + (size_t)(dn & 255u) * 4096, lane);
                        const int j = (int)(dcur & 255u), ngrp = (int)((dcur >> 8) + 7u) >> 3; const bool near = j >= cur - 2;
                        const LAS unsigned char* tb = TOKB + (w + 8 * k) * 32;
#pragma unroll 1
                        for (int grp = 0; grp < ngrp; ++grp) {
                            SEL_COLS(tb, grp)
                            const float mrow = SMF[row] - kexpT;
                            const float ci = valid ? (near ? -mrow : B31(r32) - mrow) : NEGB;
                            f32x16 p0 = qk_frag(kcur.k[0], qg, ci), p1 = qk_frag(kcur.k[1], qg, ci);
                            if (near) { bias_tile(p0, NBT, j * 64 + 4 * h, t0 + tokl, r32 & 3); bias_tile(p1, NBT, j * 64 + 32 + 4 * h, t0 + tokl, r32 & 3); }
                            if (attempt == 0) {
                                float tmax = max3f(p0[0], p1[0], p0[1]);
#pragma unroll
                                for (int r = 1; r < 15; ++r) tmax = max3f(tmax, p1[r], p0[r + 1]);
                                tmax = fmaxf(tmax, p1[15]);
                                if (__any(tmax > kexpT + 2.0f)) { if (lane == 0) TC[3] = 1u; }
                            }
#pragma unroll
                            for (int r = 0; r < 16; ++r) { p0[r] = __builtin_amdgcn_exp2f(p0[r]); p1[r] = __builtin_amdgcn_exp2f(p1[r]); }
                            f32x16 o[3];
#pragma unroll
                            for (int r = 0; r < 16; ++r) { o[0][r] = 0.f; o[1][r] = 0.f; o[2][r] = 0.f; }
                            pvl_frag(o, vf.v[0], p0, ones); pvl_frag(o, vf.v[1], p1, ones);
                            if (valid) {
                                LAS int* op = SO + row * SO_P + 4 * h;
                                if (h == 0) lds_add_i32(SL + row, (int)o[2][0]);
#define SEL_ADD4(dt_, a_) lds_add_2i32_off<(32 * dt_ + 8 * a_) * 4>(op, (int)o[dt_][4 * a_], (int)o[dt_][4 * a_ + 1]); lds_add_2i32_off<(32 * dt_ + 8 * a_ + 2) * 4>(op, (int)o[dt_][4 * a_ + 2], (int)o[dt_][4 * a_ + 3]);
                                SEL_ADD4(0, 0) SEL_ADD4(0, 1) SEL_ADD4(0, 2) SEL_ADD4(0, 3) SEL_ADD4(1, 0) SEL_ADD4(1, 1) SEL_ADD4(1, 2) SEL_ADD4(1, 3)
#undef SEL_ADD4
                            }
                        }
                        vf_load(vf, Vg + (size_t)(dn & 255u) * 4096, lane);
                        dcur = dn;
                    };
#pragma unroll 1
                    for (int k = 0; k < nmine; k += 2) {
                        step(k, ka, kb);
                        if (k + 1 >= nmine) break;
                        step(k + 1, kb, ka);
                    }
                    asm volatile("s_waitcnt vmcnt(0) lgkmcnt(0)" ::: "memory");
                }

{ OACC_DECL()
#pragma unroll
                for (int q = 0; q < 8; ++q) pc[q] = OACC[q];
                }
                __syncthreads();
                if (attempt == 1 || TC[3] == 0u) break;
#undef lane
            }
#undef SEL_DESC
#undef SEL_COLS
            STAMP(7);
            {
                int r32 = r32_, h = h_; asm volatile("" : "+v"(r32), "+v"(h));
                const int row = (8 * w + (r32 >> 2)) * 4 + (r32 & 3);
                const float g1 = GATE_LOAD(1), lt = (float)SL[row], sc = lt > 0.f ? g1 / lt : 0.f;
                const LAS int* op = SO + row * SO_P + 4 * h;
#define SEL_RD4(off_) ({ const int l0 = op[off_], h0 = op[off_ + 1] - (l0 >> 31), l1 = op[off_ + 2], h1 = op[off_ + 3] - (l1 >> 31); (f32x4){(float)l0, (float)h0, (float)l1, (float)h1} * sc; })
                f32x4 cs[8];
#pragma unroll
                for (int q = 0; q < 4; ++q) { cs[q] = SEL_RD4(8 * q) + pc[q]; cs[4 + q] = SEL_RD4(32 + 8 * q) + pc[4 + q]; }
#undef SEL_RD4
                asm volatile("s_waitcnt lgkmcnt(0)" ::: "memory");
                int lane_p = lane; asm volatile("" : "+v"(lane_p));
                LAS f32x4* PW = (LAS f32x4*)(L + L_SO + w * (32 * SO_P * 4)) + lane_p;
#pragma unroll
                for (int q = 0; q < 8; ++q) PW[64 * q] = cs[q];
            }
        }
        STAMP(3);
        {
            const int jb0 = cur >= 8 ? cur - 8 : 0, nwb = cur - jb0 + 1;
            const bf16* Kg = KW + (size_t)pl * SEQ * 64; const bf16* Vg = VWT + (size_t)pl * 64 * SEQ;
            float mref = 0.f; bool seen = false; f32x16 ow[3];
            LOAD_QF()
            unsigned one2 = 0x3f803f80u; asm volatile("" : "+v"(one2));
            const s16x8 ones = __builtin_bit_cast(s16x8, (v4u){one2, one2, one2, one2});
#pragma unroll
            for (int r = 0; r < 16; ++r) { ow[0][r] = 0.f; ow[1][r] = 0.f; ow[2][r] = 0.f; }
            const float gate2 = GATE_LOAD(2);
            int r32 = r32_, h = h_, lane_w = lane; asm volatile("" : "+v"(r32), "+v"(h), "+v"(lane_w));
            KF kf; VF vf;
            kf_load(kf, Kg + (size_t)jb0 * 4096, lane_w);
#pragma unroll 1
            for (int i = 0; i < nwb; ++i) {
                const int j = jb0 + i, jn = j < cur ? j + 1 : cur;
                vf_load(vf, Vg + (size_t)j * 4096, lane_w);
                const bool far = j <= cur - 3 && j >= cur - 7, nearb = j >= cur - 2;
                const float ci = (nearb ? 0.f : B31(r32)) - mref;
                f32x16 pq[2] = {qk_frag(kf.k[0], qf, ci), qk_frag(kf.k[1], qf, ci)};
                kf_load(kf, Kg + (size_t)jn * 4096, lane_w);
#pragma unroll
                for (int kt = 0; kt < 2; ++kt) {
                    f32x16& pp = pq[kt];
                    if (nearb) bias_tile(pp, NBT, j * 64 + 32 * kt + 4 * h, TOK(r32), r32 & 3);
                    else if (!far) {
                        const int klo = TOK(r32) - 512 - (j * 64 + 32 * kt + 4 * h);
#pragma unroll
                        for (int r = 0; r < 16; ++r) pp[r] = krow(r) > klo ? pp[r] : NEGB;
                    }
                    float tmax = max3f(pp[0], pp[1], pp[2]);
#pragma unroll
                    for (int r = 3; r < 15; r += 2) tmax = max3f(tmax, pp[r], pp[r + 1]);
                    tmax = fmaxf(tmax, pp[15]); tmax = xhalf_max(tmax);
                    const bool ok = tmax > -1.0e29f;
                    const float d = seen ? fmaxf(tmax, 0.f) : (ok ? tmax : 0.f);
                    if (__any(d != 0.f)) {
                        const float al = seen ? __builtin_amdgcn_exp2f(-d) : 1.0f; mref += d; ow[2][0] *= al;
#pragma unroll
                        for (int r = 0; r < 16; ++r) { ow[0][r] *= al; ow[1][r] *= al; pq[0][r] -= d; pq[1][r] -= d; }
                    }
                    seen = seen || ok;
#pragma unroll
                    for (int r = 0; r < 16; ++r) pp[r] = __builtin_amdgcn_exp2f(pp[r]);
                    pvl_frag(ow, vf.v[kt], pp, ones);
                }
            }
            asm volatile("s_waitcnt vmcnt(0)" ::: "memory");
            const float g2 = gate2, lt = ow[2][0], sc = lt > 0.f ? g2 / lt : 0.f;
#pragma unroll
            for (int r = 0; r < 16; ++r) { ow[0][r] *= sc; ow[1][r] *= sc; }
            const LAS f32x4* PW = (const LAS f32x4*)(L + L_SO + w * (32 * SO_P * 4)) + lane_w;
#pragma unroll
            for (int q = 0; q < 4; ++q) {
                const f32x4 a0 = PW[64 * q], a1 = PW[64 * (4 + q)];
#pragma unroll
                for (int j = 0; j < 4; ++j) { ow[0][4 * q + j] += a0[j]; ow[1][4 * q + j] += a1[j]; }
            }
            bf16* op = ONSA + (size_t)MROW(r32) * 1024 + HEADG(r32) * 64 + 4 * h;
#pragma unroll
            for (int dt = 0; dt < 2; ++dt)
#pragma unroll
                for (int a = 0; a < 4; ++a) { v2u wv; wv.x = cvtpk(ow[dt][4 * a], ow[dt][4 * a + 1]); wv.y = cvtpk(ow[dt][4 * a + 2], ow[dt][4 * a + 3]); *(v2u*)(op + 32 * dt + 8 * a) = wv; }
            asm volatile("s_waitcnt lgkmcnt(0)" ::: "memory");
        }
        STAMP(4);
    }
#ifdef PROBE_SPIN_SEC
    { const unsigned long long t1_ = wall_clock64(); while (wall_clock64() - t1_ < tacc[PROBE_SPIN_SEC]) __builtin_amdgcn_s_sleep(8); }
#endif
#undef STAMP
#undef TOK
#undef MROW
#undef HEADG
#undef B31
#undef OACC_DECL
#undef GATE_LOAD
#undef LOAD_QF
#undef NSA_ISSUE
#undef NSA_LOOP
}

template <class Epi, class Map>
__device__ __forceinline__ void run_gemm(const Frame& F, const bf16* A, const bf16* Bt, int lda, int ldb, int K, int nM, int nN, const Map& map, const Epi& E, int Gs = 0, int c0 = 0) {
    pg8::Gemm g{A, Bt, lda, ldb, K}; pg8::Order<Map> S; S.init(nM, nN, Gs ? Gs : F.G, (int)blockIdx.x - c0, map);
    int tid = F.tid; asm volatile("" : "+v"(tid));
    pg8::gemm_phase<Epi, pg8::Order<Map>, true, true>(F.lds + RING_OFF, g, S, E, tid);
}
enum { PH_PRO, PH_P1, PH_R1, PH_R2, PH_R3, PH_G, PH_OUT, PH_RES, PH_FI, PH_KVQN, PH_KVQS, PH_CMP, PH_CMP2, PH_NSA, PH_COUNT };

template <int PH> __device__ __forceinline__ void phase_body(const Frame& F, int b) {
    unsigned char* ws = F.ws; float* rinv = (float*)(ws + WS_RINV); bf16* XB = (bf16*)(ws + WS_XB);
    if constexpr (PH == PH_PRO) phase_prologue(F);
    if constexpr (PH == PH_P1) {
        { EpiP1N E{rinv + b * SEQ, (const f32x4*)(ws + WS_TABA), (bf16*)(ws + WS_AP), (bf16*)(ws + WS_KN)};
          run_gemm(F, XB + (size_t)b * SEQ * DM, (const bf16*)(ws + W_RI), DM, DM, DM, SEQ / 256, 8, pg8::MapPlain{DM, DM}, E); }
        __syncthreads();
        { EpiP1S E{rinv + b * SEQ, (const f32x4*)(ws + WS_TABB), (bf16*)(ws + WS_KT), (bf16*)(ws + WS_BP)};
          run_gemm(F, (const bf16*)(ws + W_RI) + (size_t)1024 * DM, XB + (size_t)b * SEQ * DM, DM, DM, DM, 12, SEQ / 256, pg8::MapPlain{DM, DM}, E); }
    }
    if constexpr (PH == PH_R1) {
        { EpiKV E{(bf16*)(ws + WS_KV)};
          run_gemm(F, (const bf16*)(ws + WS_BP), (const bf16*)(ws + WS_KT), APLD, SEQ, RCH, RH * NCH * 2, 1, MapKV{}, E); }
        __syncthreads();
        { EpiS E{(bf16*)(ws + WS_AP)};
          run_gemm(F, (const bf16*)(ws + WS_AP), (const bf16*)(ws + WS_KN), APLD, 1024, RDK, RH * NCH * 2, 2, MapS{}, E); }
    }
    if constexpr (PH == PH_R2) phase_ret_scan(F);
    if constexpr (PH == PH_R3) { EpiO E{(bf16*)F.out, (float*)(ws + WS_GSLOT), b};
        run_gemm(F, (const bf16*)(ws + WS_AP), (const bf16*)(ws + WS_BP), APLD, APLD, APLD, RH * NCH * 2, 2, MapO{}, E); }
    if constexpr (PH == PH_G) { EpiG E{rinv, (const float*)(ws + WS_GSLOT), (bf16*)F.out};
        run_gemm(F, XB, (const bf16*)(ws + W_RI) + (size_t)4096 * DM, DM, DM, DM, MTOK / 256, 8, pg8::MapPlain{DM, DM}, E); }
    if constexpr (PH == PH_OUT) {
        const bf16* A = b == 0 ? (const bf16*)F.out : b == 2 ? (const bf16*)(ws + WS_ONSA) : (const bf16*)(ws + WS_HID);
        const bf16* Bt = (const bf16*)(ws + (b == 0 ? W_RO : b == 1 ? W_FO0 : b == 2 ? W_NO : W_FO1));
        const int K = b == 0 ? 2048 : b == 2 ? DM : FFH;
        EpiOut E{(bf16*)(ws + WS_MIX), (float*)(ws + WS_OSLOT)};
        run_gemm(F, A, Bt, K, K, K, MTOK / 256, 4, pg8::MapPlain{K, K}, E); }
    if constexpr (PH == PH_RES) phase_resid(F, b == 0 ? gp(F.in[0]) : (const float*)nullptr, gp(b & 1 ? F.in[4] : F.in[2]) + (b >> 1) * DM, b == 3);
    if constexpr (PH == PH_FI) { EpiFfnIn E{rinv, (bf16*)(ws + WS_HID)};
        run_gemm(F, XB, (const bf16*)(ws + (b ? W_FI1 : W_FI0)), DM, DM, DM, MTOK / 256, 22, pg8::MapPlain{DM, DM}, E); }
    if constexpr (PH == PH_KVQN) { phase_peb_final(F);
        EpiKvqN E{rinv, (bf16*)(ws + WS_KC), (bf16*)(ws + WS_VC), (bf16*)(ws + WS_KS), (bf16*)(ws + WS_KW), (bf16*)(ws + WS_Q), (float*)(ws + WS_GATE)};
        run_gemm(F, XB, (const bf16*)(ws + W_KVQ), DM, DM, DM, MTOK / 256, 8, pg8::MapPlain{DM, DM}, E); }
    if constexpr (PH == PH_KVQS) {
        const int ncmp = F.G >= 128 ? F.G / 4 : 0;
        if (ncmp == 0 || (int)blockIdx.x < ncmp) { EpiCmp E{(const float*)(ws + WS_PEB), (bf16*)(ws + WS_HIDC)};
            run_gemm(F, (const bf16*)(ws + WS_KC), (const bf16*)(ws + W_C1), 1024, 2048, 2048, 64, 1, MapCmp{}, E, ncmp ? ncmp : F.G, 0); }
        if (ncmp == 0 || (int)blockIdx.x >= ncmp) {
            if (ncmp == 0) __syncthreads();
            { EpiKvqS E{rinv, (bf16*)(ws + WS_VST), (bf16*)(ws + WS_VWT), (unsigned*)(ws + WS_CTL) + CW_VMAX};
              run_gemm(F, (const bf16*)(ws + W_KVV), XB, DM, DM, DM, 2, MTOK / 256, pg8::MapPlain{DM, DM}, E, F.G - ncmp, ncmp); }
            __syncthreads();
            { EpiGate E{rinv, (float*)(ws + WS_GATE)};
              run_gemm(F, XB, (const bf16*)(ws + W_KVQ) + (size_t)2048 * DM, DM, DM, DM, MTOK / 256, 1, pg8::MapPlain{DM, DM}, E, F.G - ncmp, ncmp); }
        }
    }
    if constexpr (PH == PH_CMP2) phase_cmp2(F);
    if constexpr (PH == PH_NSA) phase_nsa(F);
}
__device__ __forceinline__ void make_frame(Frame& F, unsigned char* lds, const Args& args) {
    int tid = threadIdx.x; asm volatile("" : "+v"(tid));
    GAS unsigned char* wsg = (GAS unsigned char*)args.ws; GAS float* outg = (GAS float*)args.out; asm volatile("" : "+s"(wsg), "+s"(outg));
    F.lds = (LAS unsigned char*)lds; F.ws = (unsigned char*)wsg; F.out = (float*)outg; F.in = args.in;
    F.tid = tid; F.lane = tid & 63; F.wave = __builtin_amdgcn_readfirstlane(tid >> 6);
    F.G = gridDim.x; { const int bx = blockIdx.x; F.vcu = (F.G % 8 == 0) ? (bx % 8) * (F.G / 8) + bx / 8 : bx; }
    F.gw = F.vcu * NWAVES + F.wave; F.NGW = F.G * NWAVES;
}
__global__ void __launch_bounds__(NTHREADS, 2) fwd(Args args) {
    extern __shared__ __attribute__((aligned(16))) unsigned char lds[];
    {   LAS unsigned* ctl = (LAS unsigned*)((LAS unsigned char*)lds + LDSCTL_OFF);
        for (int u = threadIdx.x; u < (LDS_BYTES - LDSCTL_OFF) / 4; u += NTHREADS) ctl[u] = 0u; }
    __syncthreads();
    const int lo = args.ph, hi = args.b;
    XcdBarrier bar; bar.bar = (unsigned*)(args.ws + WS_CTL) + CW_BAR; bar.x = 0; bar.st = nullptr;
    if (hi - lo > 1) bar = xcd_barrier_post((unsigned*)(args.ws + WS_CTL) + CW_BAR, (volatile LAS unsigned*)((LAS unsigned char*)lds + MISC_OFF) + 8);
    int ph = 0;
#ifndef DBG_MASK
#define DBG_MASK 0xffffffffu
#endif
#ifdef PROBE_SPIN_PH
#define SPIN_T0() const unsigned long long t0_ = wall_clock64()
#define SPIN_T1(PH) do { if (PH == PROBE_SPIN_PH) { const unsigned long long t1_ = wall_clock64(); while (wall_clock64() - t1_ < t1_ - t0_) __builtin_amdgcn_s_sleep(8); } } while (0)
#else
#define SPIN_T0() do {} while (0)
#define SPIN_T1(PH) do {} while (0)
#endif
#define RUN(PH, bval) do { if (ph >= lo && ph < hi) { Frame F; make_frame(F, lds, args); SPIN_T0(); if constexpr ((DBG_MASK >> PH) & 1u) phase_body<PH>(F, (bval)); SPIN_T1(PH); if (ph + 1 < hi) xcd_barrier(bar); } ++ph; } while (0)
    RUN(PH_PRO, 0);
#pragma unroll 1
    for (int layer = 0; layer < 2; ++layer) {
#pragma unroll 1
        for (int sub = 0; sub < 2; ++sub) {
            if (sub == 0) {
                if (layer == 0) {
#pragma unroll 1
                    for (int b = 0; b < NBATCH; ++b) { RUN(PH_P1, b); RUN(PH_R1, b); RUN(PH_R2, b); RUN(PH_R3, b); }
                    RUN(PH_G, 0);
                } else { RUN(PH_KVQN, 0); RUN(PH_KVQS, 0); RUN(PH_CMP2, 0); RUN(PH_NSA, 0); }
            } else RUN(PH_FI, layer);
            RUN(PH_OUT, 2 * layer + sub);
            RUN(PH_RES, 2 * layer + sub);
        }
    }
#undef RUN
}
constexpr int NPHASES = 1 + (8 + 1 + 2) + 3 + (4 + 2) + 3;
#ifndef MK_N_LAUNCH
#define MK_N_LAUNCH 1
#endif
extern "C" void kernel_launch(void* const* d_in, const int* in_sizes, int n_in, void* d_out, int out_size, void* d_ws, size_t ws_size, hipStream_t stream) {
    static int grid = 0;
    if (grid == 0) {
        if (n_in != 20 || out_size != MTOK * DM || ws_size < WS_NEED) { fprintf(stderr, "kernel_launch: unexpected problem shape (n_in %d, out %d, ws %zu)\n", n_in, out_size, ws_size); grid = -1; return; }
        int dev = 0, cus = 0, per_cu = 0;
        if (hipGetDevice(&dev) != hipSuccess || hipDeviceGetAttribute(&cus, hipDeviceAttributeMultiprocessorCount, dev) != hipSuccess) { grid = -1; return; }
        if (hipFuncSetAttribute((const void*)fwd, hipFuncAttributeMaxDynamicSharedMemorySize, LDS_BYTES) != hipSuccess) { fprintf(stderr, "kernel_launch: hipFuncSetAttribute failed\n"); grid = -1; return; }
        if (hipOccupancyMaxActiveBlocksPerMultiprocessor(&per_cu, (const void*)fwd, NTHREADS, LDS_BYTES) != hipSuccess || per_cu < 1) { fprintf(stderr, "kernel_launch: occupancy query says %d blocks per CU\n", per_cu); }
        (void)hipGetLastError();
        grid = cus;
    }
    if (grid < 0) return;
    (void)hipMemsetAsync((char*)d_ws + WS_CTL, 0, CTL_ZERO_BYTES, stream);
    Args a{};
    for (int i = 0; i < 20; ++i) a.in[i] = (const float*)d_in[i];
    a.out = (float*)d_out; a.ws = (unsigned char*)d_ws;
    if (MK_N_LAUNCH == 1) { a.ph = 0; a.b = NPHASES; hipLaunchKernelGGL(fwd, dim3(grid), dim3(NTHREADS), LDS_BYTES, stream, a); }
    else for (int p = 0; p < NPHASES; ++p) { a.ph = p; a.b = p + 1; hipLaunchKernelGGL(fwd, dim3(grid), dim3(NTHREADS), LDS_BYTES, stream, a); }
}
```

```cpp
#include <hip/hip_runtime.h>
#include <cstdio>
#include <cstdint>
#include <utility>

namespace pg8 {
#define PG8_LAS __attribute__((address_space(3)))
typedef unsigned short bf16_t;
typedef short bf16x8 __attribute__((ext_vector_type(8)));
typedef float f32x4 __attribute__((ext_vector_type(4)));
typedef unsigned u32x4 __attribute__((ext_vector_type(4)));
constexpr int BM = 256, BK = 64, HALF = 128, HTB = HALF * BK * 2  , STAGE_BYTES = 8 * HTB, NXCD = 8, WGM = 8;

__host__ __device__ __forceinline__ int lds_byte(int r, int c) { const int st = (r >> 4) * 2 + (c >> 5), rr = r & 15, cc = c & 31, ob = rr * 64 + cc * 2; return st * 1024 + (ob ^ (((ob >> 9) & 1) << 5)); }
__host__ __device__ __forceinline__ void stage_rc(int b, int& R, int& C) { const int st = b / 1024, sb = b % 1024, swz = sb ^ (((sb >> 9) & 1) << 5); R = (st >> 1) * 16 + swz / 64; C = (st & 1) * 32 + (swz % 64) / 2; }
__host__ __device__ __forceinline__ int perm32(int rho) { const int n = rho >> 4, i = rho & 15; return 8 * (i >> 2) + 4 * n + (i & 3); }

struct Unit { int pm, pn; size_t offA, offB; };
struct Gemm { const bf16_t* A; const bf16_t* Bt; int lda, ldb, K; };

template <class Map> struct Order {
    int nM, nN, nwg, G, c; Map map;
    __device__ __forceinline__ void init(int nM_, int nN_, int G_, int c_, const Map& m) { nM = nM_; nN = nN_; nwg = nM * nN; G = G_; c = c_; map = m; }
    __device__ __forceinline__ bool next(int i, Unit& u) const {
        const long L = (long)i * G + c; if (L >= nwg) return false;
        int wgid = (int)L; { const int q = nwg / NXCD, r = nwg % NXCD, xcd = wgid % NXCD, off = wgid / NXCD; wgid = (xcd < r ? xcd * (q + 1) : r * (q + 1) + (xcd - r) * q) + off; }
        const int nig = WGM * nN, gid = wgid / nig, fm = gid * WGM, gsz = (nM - fm) < WGM ? (nM - fm) : WGM;
        u.pm = fm + ((wgid % nig) % gsz); u.pn = (wgid % nig) / gsz; map(u); return true;
    }
    __device__ __forceinline__ void a_ready(const Unit&) const {}
    __device__ __forceinline__ void done(const Unit&) const {}
};
struct MapPlain { int lda, ldb; __device__ __forceinline__ void operator()(Unit& u) const { u.offA = (size_t)u.pm * 256 * lda * 2; u.offB = (size_t)u.pn * 256 * ldb * 2; } };

template <class Epi, class Sched, bool ALIGN_EPI = false, bool SP2 = false>
__device__ __forceinline__ void gemm_phase(PG8_LAS unsigned char* lds, const Gemm g, const Sched& S, const Epi& E, const int tid) {
    const int wid = __builtin_amdgcn_readfirstlane(tid >> 6), lane = tid & 63, wr = wid >> 2, wc = wid & 3, fr = lane & 15, fq = lane >> 4;
    const int K = g.K, nt = K / BK;
    unsigned voffA[2], voffB[2];
#pragma unroll
    for (int i = 0; i < 2; ++i) { int R, C; stage_rc(tid * 16 + i * 8192, R, C); const int Rb = Epi::PERM ? ((R & ~31) + perm32(R & 31)) : R;
        voffA[i] = (unsigned)(R * g.lda + C) * 2u; voffB[i] = (unsigned)(Rb * g.ldb + C) * 2u; }
    const size_t kstep = (size_t)(BK * 2);
    const size_t hstepA = (size_t)HALF * g.lda * 2, hstepB = (size_t)HALF * g.ldb * 2;
    const unsigned ldsw = (unsigned)wid * 1024u;
    const int aoff = lds_byte(wr * 64 + fr, fq * 8), boff = lds_byte(wc * 32 + fr, fq * 8);
#define PG8_SA(b, h) (((b) * 2 + (h)) * HTB)
#define PG8_SB(b, h) ((4 + (b) * 2 + (h)) * HTB)
#define PG8_STAGE(bufoff, gbase, voff) do { _Pragma("unroll") for (int _i = 0; _i < 2; ++_i) \
        __builtin_amdgcn_global_load_lds((const unsigned*)((const char*)(gbase) + (voff)[_i]), (PG8_LAS unsigned*)(lds + (bufoff) + ldsw + _i * 8192), 16, 0, 0); } while (0)
#define PG8_LDA(dst, b, h) do { _Pragma("unroll") for (int m = 0; m < 4; ++m) _Pragma("unroll") for (int k = 0; k < 2; ++k) dst[m][k] = *(const PG8_LAS bf16x8*)(lds + PG8_SA(b, h) + aoff + m * 2048 + k * 1024); } while (0)
#define PG8_LDB(dst, b, h) do { _Pragma("unroll") for (int n = 0; n < 2; ++n) _Pragma("unroll") for (int k = 0; k < 2; ++k) dst[n][k] = *(const PG8_LAS bf16x8*)(lds + PG8_SB(b, h) + boff + n * 2048 + k * 1024); } while (0)
#define PG8_MMA(ai, bj, At, Bt) do { __builtin_amdgcn_s_setprio(1); _Pragma("unroll") for (int m = 0; m < 4; ++m) _Pragma("unroll") for (int n = 0; n < 2; ++n) _Pragma("unroll") for (int k = 0; k < 2; ++k) \
        acc[ai][bj][m][n] = __builtin_amdgcn_mfma_f32_16x16x32_bf16(Bt[n][k], At[m][k], acc[ai][bj][m][n], 0, 0, 0); __builtin_amdgcn_s_setprio(0); } while (0)
#define PG8_WAIT_V(n) asm volatile("s_waitcnt vmcnt(" #n ")" ::: "memory")
#define PG8_WAIT_L(n) asm volatile("s_waitcnt lgkmcnt(" #n ")" ::: "memory")
#define PG8_BAR __builtin_amdgcn_s_barrier()
#define PG8_SCHED __builtin_amdgcn_sched_barrier(0)
    Unit cur, nxt; int ui = 0;
    if (!S.next(0, cur)) return;
    f32x4 acc[2][2][4][2];
#pragma unroll
    for (int a = 0; a < 2; ++a)
#pragma unroll
        for (int b = 0; b < 2; ++b)
#pragma unroll
            for (int m = 0; m < 4; ++m)
#pragma unroll
                for (int n = 0; n < 2; ++n) acc[a][b][m][n] = (f32x4){0.f, 0.f, 0.f, 0.f};
    bf16x8 At[4][2], B0[2][2], B1[2][2];
    const char* cA = (const char*)g.A + cur.offA; const char* cB = (const char*)g.Bt + cur.offB;
    S.a_ready(cur);
    if constexpr (SP2) {
        PG8_STAGE(PG8_SB(0, 0), cB, voffB); PG8_STAGE(PG8_SB(0, 1), cB + hstepB, voffB); PG8_STAGE(PG8_SA(0, 0), cA, voffA); PG8_STAGE(PG8_SA(0, 1), cA + hstepA, voffA);
        if (wr == 1) PG8_BAR;
        PG8_WAIT_V(2); PG8_BAR;
        PG8_STAGE(PG8_SB(1, 0), cB + kstep, voffB); PG8_STAGE(PG8_SA(1, 0), cA + kstep, voffA); PG8_STAGE(PG8_SB(1, 1), cB + hstepB + kstep, voffB);
        PG8_WAIT_V(6); PG8_BAR;
    } else {
        PG8_STAGE(PG8_SB(0, 0), cB, voffB); PG8_STAGE(PG8_SA(0, 0), cA, voffA); PG8_STAGE(PG8_SB(0, 1), cB + hstepB, voffB); PG8_STAGE(PG8_SA(0, 1), cA + hstepA, voffA);
        if (wr == 1) PG8_BAR;
        PG8_WAIT_V(4); PG8_BAR;
        PG8_STAGE(PG8_SB(1, 0), cB + kstep, voffB); PG8_STAGE(PG8_SA(1, 0), cA + kstep, voffA); PG8_STAGE(PG8_SB(1, 1), cB + hstepB + kstep, voffB);
        PG8_WAIT_V(6); PG8_BAR;
    }
    for (;;) {
        const bool has_next = S.next(ui + 1, nxt);
        const char* nA = has_next ? (const char*)g.A + nxt.offA : cA; const char* nB = has_next ? (const char*)g.Bt + nxt.offB : cB;
#pragma unroll 1
        for (int t = 0; t < nt; t += 2) {
            const bool last = (t == nt - 2);
            const char* a1 = cA + (size_t)(t + 1) * kstep;
            const char* a2 = last ? nA : cA + (size_t)(t + 2) * kstep; const char* b2 = last ? nB : cB + (size_t)(t + 2) * kstep;
            const char* a3 = a2 + kstep; const char* b3 = b2 + kstep;
            if (last && has_next) S.a_ready(nxt);
            if constexpr (SP2) {
            PG8_LDB(B0, 0, 0); PG8_LDB(B1, 0, 1); PG8_SCHED; PG8_LDA(At, 0, 0); PG8_STAGE(PG8_SA(1, 1), a1 + hstepA, voffA);
            PG8_WAIT_V(8); PG8_WAIT_L(0); PG8_BAR; PG8_MMA(0, 0, At, B0); PG8_MMA(0, 1, At, B1); PG8_BAR; PG8_SCHED;
            PG8_LDA(At, 0, 1); PG8_STAGE(PG8_SB(0, 0), b2, voffB); PG8_STAGE(PG8_SB(0, 1), b2 + hstepB, voffB); PG8_STAGE(PG8_SA(0, 0), a2, voffA);
            PG8_WAIT_V(8); PG8_WAIT_L(0); PG8_BAR; PG8_MMA(1, 0, At, B0); PG8_MMA(1, 1, At, B1); PG8_BAR; PG8_SCHED;
            PG8_LDB(B0, 1, 0); PG8_LDB(B1, 1, 1); PG8_SCHED; PG8_LDA(At, 1, 0); PG8_STAGE(PG8_SA(0, 1), a2 + hstepA, voffA);
            PG8_WAIT_V(8); PG8_WAIT_L(0); PG8_BAR; PG8_MMA(0, 0, At, B0); PG8_MMA(0, 1, At, B1); PG8_BAR; PG8_SCHED;
            PG8_LDA(At, 1, 1); PG8_STAGE(PG8_SB(1, 0), b3, voffB); PG8_STAGE(PG8_SB(1, 1), b3 + hstepB, voffB); PG8_STAGE(PG8_SA(1, 0), a3, voffA);
            PG8_WAIT_V(8); PG8_WAIT_L(0); PG8_BAR; PG8_MMA(1, 0, At, B0); PG8_MMA(1, 1, At, B1); PG8_BAR; PG8_SCHED;
            } else {
            PG8_LDB(B0, 0, 0); PG8_SCHED; PG8_LDA(At, 0, 0); PG8_STAGE(PG8_SA(1, 1), a1 + hstepA, voffA);
            PG8_WAIT_L(8); PG8_BAR; PG8_WAIT_L(0); PG8_MMA(0, 0, At, B0); PG8_BAR; PG8_SCHED;
            PG8_LDB(B1, 0, 1); PG8_STAGE(PG8_SB(0, 0), b2, voffB);
            PG8_BAR; PG8_WAIT_L(0); PG8_MMA(0, 1, At, B1); PG8_BAR;
            PG8_LDA(At, 0, 1); PG8_STAGE(PG8_SA(0, 0), a2, voffA);
            PG8_BAR; PG8_WAIT_L(0); PG8_MMA(1, 0, At, B0); PG8_BAR; PG8_SCHED;
            PG8_STAGE(PG8_SB(0, 1), b2 + hstepB, voffB);
            PG8_WAIT_V(6); PG8_BAR; PG8_MMA(1, 1, At, B1); PG8_BAR;
            PG8_LDB(B0, 1, 0); PG8_SCHED; PG8_LDA(At, 1, 0); PG8_STAGE(PG8_SA(0, 1), a2 + hstepA, voffA);
            PG8_WAIT_L(8); PG8_BAR; PG8_WAIT_L(0); PG8_MMA(0, 0, At, B0); PG8_BAR; PG8_SCHED;
            PG8_LDB(B1, 1, 1); PG8_STAGE(PG8_SB(1, 0), b3, voffB);
            PG8_BAR; PG8_WAIT_L(0); PG8_MMA(0, 1, At, B1); PG8_BAR;
            PG8_LDA(At, 1, 1); PG8_STAGE(PG8_SA(1, 0), a3, voffA);
            PG8_BAR; PG8_WAIT_L(0); PG8_MMA(1, 0, At, B0); PG8_BAR; PG8_SCHED;
            PG8_STAGE(PG8_SB(1, 1), b3 + hstepB, voffB);
            PG8_WAIT_V(6); PG8_BAR; PG8_MMA(1, 1, At, B1); PG8_BAR;
            }
        }
        if constexpr (ALIGN_EPI) { if (wr == 0) PG8_BAR; }
        if constexpr (!Epi::AFTER_DRAIN) { E(acc, cur, wr, wc, fr, fq); S.done(cur); }
        if (!has_next) break;
#pragma unroll
        for (int a = 0; a < 2; ++a)
#pragma unroll
            for (int b = 0; b < 2; ++b)
#pragma unroll
                for (int m = 0; m < 4; ++m)
#pragma unroll
                    for (int n = 0; n < 2; ++n) acc[a][b][m][n] = (f32x4){0.f, 0.f, 0.f, 0.f};
        cur = nxt; cA = nA; cB = nB; ++ui;
        if constexpr (ALIGN_EPI) { if (wr == 1) PG8_BAR; }
    }
    PG8_WAIT_V(0);
    if constexpr (!ALIGN_EPI) { if (wr == 0) PG8_BAR; }
    PG8_BAR;
    if constexpr (Epi::AFTER_DRAIN) { E.fused(acc, cur, wr, wc, fr, fq, lds, wid, lane); S.done(cur); }
#undef PG8_SA
#undef PG8_SB
#undef PG8_STAGE
#undef PG8_LDA
#undef PG8_LDB
#undef PG8_MMA
#undef PG8_WAIT_V
#undef PG8_WAIT_L
#undef PG8_BAR
#undef PG8_SCHED
}
}

constexpr int DM = 1024, NBATCH = 2, SEQ = 16384, MTOK = NBATCH * SEQ;
constexpr int FFH = 2816;
constexpr int RH = 4, RDK = 256, RDV = 512, RCH = 512, NCH = SEQ / RCH;
constexpr int RIN = 2 * RH * RDK + 2 * RH * RDV;
constexpr int NG = 4, NR = 4, HD = 64, NCMP = 1023, NSEL = 256, NSAIN = 1072;
constexpr float RMS_EPS = 1e-6f;
constexpr int APLD = 768;

constexpr size_t MiB = 1u << 20;
constexpr size_t WS_CTL = 0, CTL_ZERO_BYTES = 1 * MiB;
constexpr int CW_VMAX = 16384;
constexpr size_t WS_RINV = 1 * MiB;
constexpr size_t WS_BIAST = WS_RINV + 256 * 1024;
constexpr size_t WS_PEB = WS_BIAST + 16 * 1024;
constexpr size_t WS_PEBP = WS_PEB + 4 * 1024;
constexpr size_t WS_GSLOT = 2 * MiB;
constexpr size_t WS_OSLOT = 6 * MiB;
constexpr size_t WS_W = 8 * MiB;
constexpr size_t W_RI = WS_W, W_RO = W_RI + 12 * MiB, W_FI0 = W_RO + 4 * MiB, W_FI1 = W_FI0 + 11 * MiB, W_FO0 = W_FI1 + 11 * MiB, W_FO1 = W_FO0 + 11 * MiB / 2,
                 W_KVQ = W_FO1 + 11 * MiB / 2, W_KVV = W_KVQ + 9 * MiB / 2, W_NO = W_KVV + 1 * MiB, W_C1 = W_NO + 2 * MiB, W_C2 = W_C1 + 2 * MiB, W_END = W_C2 + 1 * MiB;
static_assert(W_END <= 68 * MiB, "weights");
constexpr size_t WS_TABA = 68 * MiB, WS_TABB = 84 * MiB;
constexpr size_t WS_XB = 100 * MiB;
constexpr size_t WS_MIX = 164 * MiB;
constexpr size_t WS_KT = WS_MIX, WS_KV = WS_MIX + 32 * MiB;
constexpr size_t WS_SCR = 228 * MiB;
constexpr size_t WS_AP = WS_SCR, WS_BP = WS_AP + 96 * MiB, WS_KN = WS_BP + 96 * MiB;
static_assert(WS_KN + 32 * MiB <= 512 * MiB, "ret scratch");
constexpr size_t WS_HID = WS_SCR;
constexpr size_t WS_KC = WS_SCR, WS_VC = WS_KC + 16 * MiB, WS_KS = WS_VC + 17 * MiB, WS_KW = WS_KS + 16 * MiB, WS_VST = WS_KW + 16 * MiB, WS_VWT = WS_VST + 16 * MiB,
                 WS_Q = WS_VWT + 16 * MiB, WS_GATE = WS_Q + 64 * MiB, WS_HIDC = WS_GATE + 6 * MiB, WS_KCMP = WS_HIDC + 8 * MiB, WS_VCMPT = WS_KCMP + 1 * MiB, WS_ONSA = WS_VCMPT + 1 * MiB,
                 WS_NSA_END = WS_ONSA + 64 * MiB;
static_assert(WS_NSA_END <= 512 * MiB, "nsa scratch");
constexpr size_t WS_NEED = 512 * MiB;

#define GAS __attribute__((address_space(1)))
#define LAS __attribute__((address_space(3)))
typedef unsigned short bf16;
typedef unsigned v4u __attribute__((ext_vector_type(4)));
typedef unsigned v2u __attribute__((ext_vector_type(2)));
typedef float f32x4 __attribute__((ext_vector_type(4)));
typedef float f32x2_t __attribute__((ext_vector_type(2)));
typedef __bf16 bf16x2_t __attribute__((ext_vector_type(2)));
typedef GAS unsigned gu32;
#define RLX_AGENT __ATOMIC_RELAXED, __HIP_MEMORY_SCOPE_AGENT
__device__ __forceinline__ unsigned cvtpk(float lo, float hi) { f32x2_t v = {lo, hi}; bf16x2_t b = __builtin_convertvector(v, bf16x2_t); return __builtin_bit_cast(unsigned, b); }
__device__ __forceinline__ v4u pack8(f32x4 a, f32x4 b) { v4u w; w.x = cvtpk(a[0], a[1]); w.y = cvtpk(a[2], a[3]); w.z = cvtpk(b[0], b[1]); w.w = cvtpk(b[2], b[3]); return w; }
__device__ __forceinline__ float bflo(unsigned w) { return __uint_as_float(w << 16); }
__device__ __forceinline__ float bfhi(unsigned w) { return __uint_as_float(w & 0xffff0000u); }
__device__ __forceinline__ float bf2f(bf16 b) { return __uint_as_float(((unsigned)b) << 16); }
__device__ __forceinline__ void unpack8(v4u w, float* f) { f[0] = bflo(w.x); f[1] = bfhi(w.x); f[2] = bflo(w.y); f[3] = bfhi(w.y); f[4] = bflo(w.z); f[5] = bfhi(w.z); f[6] = bflo(w.w); f[7] = bfhi(w.w); }
__device__ __forceinline__ bf16 f2bf(float f) { return (bf16)(cvtpk(f, 0.f) & 0xffffu); }
__device__ __forceinline__ int vperm(int t) { return (t & ~12) | ((t & 4) << 1) | ((t & 8) >> 1); }
__device__ __forceinline__ float sigm(float x) { return __builtin_amdgcn_rcpf(1.f + __expf(-x)); }
__device__ __forceinline__ float silu(float x) { return x * __builtin_amdgcn_rcpf(1.f + __expf(-x)); }
__device__ __forceinline__ float lg2gamma(int h) { return __builtin_amdgcn_logf(1.0f - __builtin_amdgcn_exp2f(-5.0f - (float)h)); }
__device__ __forceinline__ float wave_sum(float v) {
#pragma unroll
    for (int o = 1; o < 64; o <<= 1) v += __shfl_xor(v, o);
    return v;
}
__device__ __forceinline__ float wave_max(float v) {
#pragma unroll
    for (int o = 1; o < 64; o <<= 1) v = fmaxf(v, __shfl_xor(v, o));
    return v;
}
__device__ __forceinline__ int t5_bucket(int n) {
    if (n < 16) return n;
    if (n >= 113) return 31;
    int b = 16 + (int)(logf((float)n * 0.0625f) / 2.0794415416798357f * 16.0f);
    return b < 31 ? b : 31;
}

#define XB_TMO      128
#define XB_XCNT(j)  (256  + 64 * (j))
#define XB_XSUB(j)  (1280 + 64 * (j))
#define XB_XGEN(j)  (2304 + 64 * (j))
#define XB_TOP      3328
#define XB_TOPGEN   3392
#define XCD_BAR_WORDS 3456
#define XB_SPIN_CAP (1u << 18)
__device__ __forceinline__ unsigned xb_ld(unsigned* p)              { return __hip_atomic_load(p, __ATOMIC_RELAXED, __HIP_MEMORY_SCOPE_AGENT); }
__device__ __forceinline__ unsigned xb_add(unsigned* p, unsigned v) { return __hip_atomic_fetch_add(p, v, __ATOMIC_RELAXED, __HIP_MEMORY_SCOPE_AGENT); }
__device__ __forceinline__ unsigned xb_xcc_id() { return (unsigned)__builtin_amdgcn_s_getreg((3 << 11) | 20) & 0xFu; }
#define XB_SPIN(cond, bar) do { unsigned _sp = 0; while (cond) { __builtin_amdgcn_s_sleep(1); \
    if ((++_sp & 255u) == 0u) { if (xb_ld(&(bar)[XB_TMO])) break; if (_sp > XB_SPIN_CAP) { atomicAdd(&(bar)[XB_TMO], 1u); break; } } } } while (0)
struct XcdBarrier { unsigned* bar; unsigned x; volatile LAS unsigned* st; };
__device__ __forceinline__ XcdBarrier xcd_barrier_post(unsigned* bar, volatile LAS unsigned* st) {
    XcdBarrier b; b.bar = bar; b.x = xb_xcc_id(); b.st = st;
    if (threadIdx.x == 0) { const unsigned rank = xb_add(&bar[XB_XCNT(b.x)], 1u); st[2] = rank; st[3] = b.x; }
    return b;
}
__device__ __forceinline__ void xcd_barrier_complete(unsigned* bar, unsigned x, unsigned& nloc, unsigned& nx) {
    const unsigned G = gridDim.x * gridDim.y * gridDim.z;
    unsigned sum, cnt, mine, sp = 0u;
    for (;;) {
        sum = 0u; cnt = 0u; mine = 0u;
#pragma unroll
        for (unsigned j = 0; j < 16; ++j) { const unsigned c = xb_ld(&bar[XB_XCNT(j)]); sum += c; cnt += (c > 0u) ? 1u : 0u; mine = (j == x) ? c : mine; }
        if (sum == G) break;
        __builtin_amdgcn_s_sleep(1);
        if ((++sp & 255u) == 0u) { if (xb_ld(&bar[XB_TMO])) break; if (sp > XB_SPIN_CAP) { atomicAdd(&bar[XB_TMO], 1u); break; } }
    }
    nloc = mine > 0u ? mine : 1u; nx = cnt > 0u ? cnt : 1u;
}
__device__ __forceinline__ void xcd_barrier(const XcdBarrier& b) {
    asm volatile("s_waitcnt vmcnt(0)" ::: "memory");
    __syncthreads();
    if (threadIdx.x == 0) {
        unsigned* bar = b.bar;
        __builtin_amdgcn_s_waitcnt(0);
        unsigned nloc = b.st[0], nx = b.st[1];
        if (nloc == 0u) { xcd_barrier_complete(bar, b.x, nloc, nx); b.st[0] = nloc; b.st[1] = nx; }
        const unsigned old = xb_add(&bar[XB_XSUB(b.x)], 1u);
        const unsigned gen = old / nloc;
        if (old + 1u == (gen + 1u) * nloc) {
            __builtin_amdgcn_fence(__ATOMIC_RELEASE, "agent");
            asm volatile("s_waitcnt vmcnt(0)" ::: "memory");
            const unsigned og = xb_add(&bar[XB_TOP], 1u);
            const unsigned tg = og / nx;
            if (og + 1u == (tg + 1u) * nx) xb_add(&bar[XB_TOPGEN], 1u);
            else XB_SPIN(xb_ld(&bar[XB_TOPGEN]) == tg, bar);
            __builtin_amdgcn_fence(__ATOMIC_ACQUIRE, "agent");
            xb_add(&bar[XB_XGEN(b.x)], 1u);
            asm volatile("s_waitcnt vmcnt(0)" ::: "memory");
        } else {
            XB_SPIN(xb_ld(&bar[XB_XGEN(b.x)]) == gen, bar);
            __builtin_amdgcn_fence(__ATOMIC_ACQUIRE, "agent");
            asm volatile("s_waitcnt vmcnt(0)" ::: "memory");
        }
    }
    __syncthreads();
}

using pg8::Unit;
typedef const f32x4 (&AccRef)[2][2][4][2];
#define EPI_ROW(u, ai, m) ((u).pm * 256 + (ai) * 128 + wr * 64 + (m) * 16 + fr)
#define EPI_COL(bj) ((bj) * 128 + wc * 32 + 8 * fq)

struct EpiP1N {
    static constexpr bool PERM = true, AFTER_DRAIN = false;
    const float* rinv; const f32x4* tabA; bf16* AP; bf16* KN;
    __device__ __forceinline__ void operator()(AccRef acc, const Unit& u, int wr, int wc, int fr, int fq) const {
        const int h = u.pn & 3; const bool isk = u.pn >= 4; const float lg = lg2gamma(h);
#pragma unroll
        for (int aq = 0; aq < 4; ++aq) { const int ai = aq >> 1, m0 = (aq & 1) * 2;
            float rsp[4]; f32x4 cp[4][2][2];
#pragma unroll
            for (int m = m0; m < m0 + 2; ++m) { const int t = EPI_ROW(u, ai, m); rsp[m] = rinv[t];
#pragma unroll
                for (int bj = 0; bj < 2; ++bj) { const int d0 = EPI_COL(bj); cp[m][bj][0] = tabA[(size_t)t * 64 + (d0 >> 2)]; cp[m][bj][1] = tabA[(size_t)t * 64 + (d0 >> 2) + 1]; } }
            __builtin_amdgcn_sched_barrier(0);
#pragma unroll
            for (int m = m0; m < m0 + 2; ++m) {
                const int t = EPI_ROW(u, ai, m); const int p = t & (RCH - 1), c = t / RCH;
                const float rs = rsp[m] * (isk ? 0.0625f * __builtin_amdgcn_exp2f(-(float)p * lg) : __builtin_amdgcn_exp2f((float)p * lg));
#pragma unroll
                for (int bj = 0; bj < 2; ++bj) {
                    const int d0 = EPI_COL(bj);
                    const f32x4 c0 = cp[m][bj][0], c1 = cp[m][bj][1];
                    const f32x4 v0 = acc[ai][bj][m][0] * rs, v1 = acc[ai][bj][m][1] * rs;
                    const f32x4 o0 = {v0[0] * c0[0] - v0[1] * c0[1], v0[0] * c0[1] + v0[1] * c0[0], v0[2] * c0[2] - v0[3] * c0[3], v0[2] * c0[3] + v0[3] * c0[2]};
                    const f32x4 o1 = {v1[0] * c1[0] - v1[1] * c1[1], v1[0] * c1[1] + v1[1] * c1[0], v1[2] * c1[2] - v1[3] * c1[3], v1[2] * c1[3] + v1[3] * c1[2]};
                    const v4u w = pack8(o0, o1);
                    if (isk) *(v4u*)(KN + (size_t)t * 1024 + h * 256 + d0) = w;
                    else *(v4u*)(AP + ((size_t)(h * NCH + c) * RCH + p) * APLD + RCH + d0) = w;
                }
            }
            __builtin_amdgcn_sched_barrier(0);
        }
    }
};
struct EpiP1S {
    static constexpr bool PERM = true, AFTER_DRAIN = false;
    const float* rinv; const f32x4* tabB; bf16* KT; bf16* BP;
    __device__ __forceinline__ void operator()(AccRef acc, const Unit& u, int wr, int wc, int fr, int fq) const {
        const bool isk = u.pm < 4; const float lg = lg2gamma(u.pm & 3);
#pragma unroll
        for (int bj = 0; bj < 2; ++bj) {
            const int t0 = u.pn * 256 + EPI_COL(bj); const int c = t0 / RCH, p0 = t0 & (RCH - 1);
            const f32x4 r0 = *(const f32x4*)(rinv + t0), r1 = *(const f32x4*)(rinv + t0 + 4);
            f32x4 s0, s1;
#pragma unroll
            for (int j = 0; j < 4; ++j) { s0[j] = r0[j] * 0.0625f * __builtin_amdgcn_exp2f(-(float)(p0 + j) * lg); s1[j] = r1[j] * 0.0625f * __builtin_amdgcn_exp2f(-(float)(p0 + 4 + j) * lg); }
            if (isk) {
                f32x4 tn[4];
                { const f32x4* tb = tabB + ((size_t)((EPI_ROW(u, 0, 0) & 255) >> 1) * SEQ + t0) / 2;
#pragma unroll
                  for (int q = 0; q < 4; ++q) tn[q] = tb[q]; }
#pragma unroll
                for (int idx = 0; idx < 8; ++idx) { const int ai = idx >> 2, m = idx & 3;
                    const int row = EPI_ROW(u, ai, m); const int d = row & 255; const bool odd = d & 1;
                    const f32x4 ca = tn[0], cb = tn[1], cc = tn[2], cd = tn[3];
                    if (idx + 1 < 8) { const f32x4* tb = tabB + ((size_t)((EPI_ROW(u, (idx + 1) >> 2, (idx + 1) & 3) & 255) >> 1) * SEQ + t0) / 2;
#pragma unroll
                        for (int q = 0; q < 4; ++q) tn[q] = tb[q]; }
                    __builtin_amdgcn_sched_barrier(0);
                    const f32x4 v0 = acc[ai][bj][m][0] * s0, v1 = acc[ai][bj][m][1] * s1; f32x4 q0, q1;
#pragma unroll
                    for (int j = 0; j < 4; ++j) { q0[j] = __shfl_xor(v0[j], 1); q1[j] = __shfl_xor(v1[j], 1); }
                    f32x4 o0, o1;
                    if (odd) { o0 = (f32x4){q0[0] * ca[1] + v0[0] * ca[0], q0[1] * ca[3] + v0[1] * ca[2], q0[2] * cb[1] + v0[2] * cb[0], q0[3] * cb[3] + v0[3] * cb[2]};
                               o1 = (f32x4){q1[0] * cc[1] + v1[0] * cc[0], q1[1] * cc[3] + v1[1] * cc[2], q1[2] * cd[1] + v1[2] * cd[0], q1[3] * cd[3] + v1[3] * cd[2]}; }
                    else     { o0 = (f32x4){v0[0] * ca[0] - q0[0] * ca[1], v0[1] * ca[2] - q0[1] * ca[3], v0[2] * cb[0] - q0[2] * cb[1], v0[3] * cb[2] - q0[3] * cb[3]};
                               o1 = (f32x4){v1[0] * cc[0] - q1[0] * cc[1], v1[1] * cc[2] - q1[1] * cc[3], v1[2] * cd[0] - q1[2] * cd[1], v1[3] * cd[2] - q1[3] * cd[3]}; }
                    *(v4u*)(KT + (size_t)row * SEQ + t0) = pack8(o0, o1);
                    __builtin_amdgcn_sched_barrier(0);
                }
            } else {
#pragma unroll
                for (int ai = 0; ai < 2; ++ai)
#pragma unroll
                    for (int m = 0; m < 4; ++m) {
                        const int row = EPI_ROW(u, ai, m);
                        const int eg = row - 1024, h = eg >> 9, e = eg & 511;
                        *(v4u*)(BP + ((size_t)(h * NCH + c) * RCH + e) * APLD + p0) = pack8(acc[ai][bj][m][0] * r0, acc[ai][bj][m][1] * r1);
                    }
            }
        }
    }
};
struct EpiG {
    static constexpr bool PERM = true, AFTER_DRAIN = false;
    const float* rinv; const float* gslots; bf16* O;
    __device__ __forceinline__ void operator()(AccRef acc, const Unit& u, int wr, int wc, int fr, int fq) const {
        const int h = u.pn >> 1;
#pragma unroll
        for (int ai = 0; ai < 2; ++ai) {
            v4u ov[4][2]; float rinp[4], rsp[4];
#pragma unroll
            for (int m = 0; m < 4; ++m)
#pragma unroll
                for (int bj = 0; bj < 2; ++bj) ov[m][bj] = *(const v4u*)(O + (size_t)EPI_ROW(u, ai, m) * 2048 + u.pn * 256 + EPI_COL(bj));
#pragma unroll
            for (int m = 0; m < 4; ++m) {
                const int row = EPI_ROW(u, ai, m); rinp[m] = rinv[row];
                const f32x4 sa = *(const f32x4*)(gslots + (size_t)row * 32 + h * 8), sb = *(const f32x4*)(gslots + (size_t)row * 32 + h * 8 + 4);
                const float ss = ((sa[0] + sa[1]) + (sa[2] + sa[3])) + ((sb[0] + sb[1]) + (sb[2] + sb[3]));
                rsp[m] = rsqrtf(ss * (1.0f / RDV) + RMS_EPS); }
            __builtin_amdgcn_sched_barrier(0);
#pragma unroll
            for (int m = 0; m < 4; ++m) {
                const int row = EPI_ROW(u, ai, m); const float rin = rinp[m], rs = rsp[m];
#pragma unroll
                for (int bj = 0; bj < 2; ++bj) {
                    bf16* op = O + (size_t)row * 2048 + u.pn * 256 + EPI_COL(bj);
                    float o[8]; unpack8(ov[m][bj], o);
                    const f32x4 g0 = acc[ai][bj][m][0] * rin, g1 = acc[ai][bj][m][1] * rin; f32x4 a, b;
#pragma unroll
                    for (int j = 0; j < 4; ++j) { a[j] = o[j] * rs * silu(g0[j]); b[j] = o[4 + j] * rs * silu(g1[j]); }
                    *(v4u*)op = pack8(a, b);
                }
            }
            __builtin_amdgcn_sched_barrier(0);
        }
    }
};
struct EpiOut {
    static constexpr bool PERM = true, AFTER_DRAIN = false;
    bf16* MIX; float* oslots;
    __device__ __forceinline__ void operator()(AccRef acc, const Unit& u, int wr, int wc, int fr, int fq) const {
#pragma unroll
        for (int ai = 0; ai < 2; ++ai)
#pragma unroll
            for (int m = 0; m < 4; ++m) {
                const int row = EPI_ROW(u, ai, m); float ss = 0.f;
#pragma unroll
                for (int bj = 0; bj < 2; ++bj) {
                    const f32x4 v0 = acc[ai][bj][m][0], v1 = acc[ai][bj][m][1];
                    ss += (v0[0] * v0[0] + v0[1] * v0[1]) + (v0[2] * v0[2] + v0[3] * v0[3]) + (v1[0] * v1[0] + v1[1] * v1[1]) + (v1[2] * v1[2] + v1[3] * v1[3]);
                    *(v4u*)(MIX + (size_t)row * 1024 + u.pn * 256 + EPI_COL(bj)) = pack8(v0, v1);
                }
                ss += __shfl_xor(ss, 16); ss += __shfl_xor(ss, 32);
                if (fq == 0) oslots[(size_t)row * 16 + u.pn * 4 + wc] = ss;
            }
    }
};
struct EpiFfnIn {
    static constexpr bool PERM = true, AFTER_DRAIN = false;
    const float* rinv; bf16* HID;
    __device__ __forceinline__ void operator()(AccRef acc, const Unit& u, int wr, int wc, int fr, int fq) const {
        float rinp[2][4];
#pragma unroll
        for (int ai = 0; ai < 2; ++ai)
#pragma unroll
            for (int m = 0; m < 4; ++m) rinp[ai][m] = rinv[EPI_ROW(u, ai, m)];
        __builtin_amdgcn_sched_barrier(0);
#pragma unroll
        for (int ai = 0; ai < 2; ++ai)
#pragma unroll
            for (int m = 0; m < 4; ++m) {
                const int row = EPI_ROW(u, ai, m); const float rin = rinp[ai][m];
                const f32x4 a0 = acc[ai][0][m][0] * rin, a1 = acc[ai][0][m][1] * rin, b0 = acc[ai][1][m][0] * rin, b1 = acc[ai][1][m][1] * rin; f32x4 x, y;
#pragma unroll
                for (int j = 0; j < 4; ++j) { x[j] = silu(a0[j]) * b0[j]; y[j] = silu(a1[j]) * b1[j]; }
                *(v4u*)(HID + (size_t)row * FFH + u.pn * 128 + wc * 32 + 8 * fq) = pack8(x, y);
            }
    }
};
struct EpiKvqN {
    static constexpr bool PERM = true, AFTER_DRAIN = false;
    const float* rinv; bf16 *KC, *VC, *KS, *KW, *Q; float* GATE;
    __device__ __forceinline__ void operator()(AccRef acc, const Unit& u, int wr, int wc, int fr, int fq) const {
        bf16* plane = u.pn == 0 ? KC : u.pn == 1 ? VC : u.pn == 2 ? KS : KW;
        float rinp[2][4];
#pragma unroll
        for (int ai = 0; ai < 2; ++ai)
#pragma unroll
            for (int m = 0; m < 4; ++m) rinp[ai][m] = rinv[EPI_ROW(u, ai, m)];
        __builtin_amdgcn_sched_barrier(0);
#pragma unroll
        for (int ai = 0; ai < 2; ++ai)
#pragma unroll
            for (int m = 0; m < 4; ++m) {
                const int row = EPI_ROW(u, ai, m); const float rin = rinp[ai][m]; const int b = row / SEQ, t = row % SEQ;
#pragma unroll
                for (int bj = 0; bj < 2; ++bj) {
                    const int cc = EPI_COL(bj);
                    f32x4 v0 = acc[ai][bj][m][0] * rin, v1 = acc[ai][bj][m][1] * rin;
                    if (u.pn < 4) { const int g = cc >> 6, d = cc & 63;
                        const int o = u.pn >= 2 ? (t & ~63) * HD + ((((t >> 5) & 1) * 4 + (d >> 4)) * 64 + ((d >> 3) & 1) * 32 + (t & 31)) * 8 : t * HD + d;
                        *(v4u*)(plane + (size_t)(b * NG + g) * SEQ * HD + o) = pack8(v0, v1); }
                    else { *(v4u*)(Q + (size_t)row * 1024 + (u.pn - 4) * 256 + cc) = pack8(v0 * (0.125f * 1.4426950408889634f), v1 * (0.125f * 1.4426950408889634f)); }
                }
            }
    }
};
struct EpiGate {
    static constexpr bool PERM = true, AFTER_DRAIN = false;
    const float* rinv; float* GATE;
    __device__ __forceinline__ void operator()(AccRef acc, const Unit& u, int wr, int wc, int fr, int fq) const {
        float rinp[2][4];
#pragma unroll
        for (int ai = 0; ai < 2; ++ai)
#pragma unroll
            for (int m = 0; m < 4; ++m) rinp[ai][m] = rinv[EPI_ROW(u, ai, m)];
        __builtin_amdgcn_sched_barrier(0);
#pragma unroll
        for (int ai = 0; ai < 2; ++ai)
#pragma unroll
            for (int m = 0; m < 4; ++m) {
                const int row = EPI_ROW(u, ai, m); const float rin = rinp[ai][m]; const int cc = EPI_COL(0);
                if (cc < 48) { f32x4 v0 = acc[ai][0][m][0] * rin, v1 = acc[ai][0][m][1] * rin;
#pragma unroll
                    for (int j = 0; j < 4; ++j) { v0[j] = sigm(v0[j]); v1[j] = sigm(v1[j]); }
                    *(f32x4*)(GATE + (size_t)row * 48 + cc) = v0; *(f32x4*)(GATE + (size_t)row * 48 + cc + 4) = v1; }
            }
    }
};
struct EpiKvqS {
    static constexpr bool PERM = true, AFTER_DRAIN = false;
    const float* rinv; bf16 *VST, *VWT; unsigned* vmx;
    __device__ __forceinline__ void operator()(AccRef acc, const Unit& u, int wr, int wc, int fr, int fq) const {
        bf16* plane = u.pm == 0 ? VST : VWT;
        float vm[2] = {0.f, 0.f};
        f32x4 rp[2][2];
#pragma unroll
        for (int bj = 0; bj < 2; ++bj) { const int mg = u.pn * 256 + EPI_COL(bj); rp[bj][0] = *(const f32x4*)(rinv + mg); rp[bj][1] = *(const f32x4*)(rinv + mg + 4); }
        __builtin_amdgcn_sched_barrier(0);
#pragma unroll
        for (int bj = 0; bj < 2; ++bj) {
            const int mg = u.pn * 256 + EPI_COL(bj); const int b = mg / SEQ, t = mg % SEQ;
            const f32x4 r0 = rp[bj][0], r1 = rp[bj][1];
#pragma unroll
            for (int ai = 0; ai < 2; ++ai)
#pragma unroll
                for (int m = 0; m < 4; ++m) {
                    const int r256 = ai * 128 + wr * 64 + m * 16 + fr; const int g = r256 >> 6, d = r256 & 63;
                    const f32x4 w0 = acc[ai][bj][m][0] * r0, w1 = acc[ai][bj][m][1] * r1;
                    const v4u pk = pack8(w0, w1);
                    v2u lo; lo.x = pk.x; lo.y = pk.y; v2u hi; hi.x = pk.z; hi.y = pk.w;
                    if (u.pm == 0) vm[ai] = fmaxf(vm[ai], fmaxf(fmaxf(fmaxf(fabsf(w0[0]), fabsf(w0[1])), fmaxf(fabsf(w0[2]), fabsf(w0[3]))), fmaxf(fmaxf(fabsf(w1[0]), fabsf(w1[1])), fmaxf(fabsf(w1[2]), fabsf(w1[3])))));
                    {
                        bf16* fp = plane + (size_t)(b * NG + g) * HD * SEQ + (size_t)(t >> 6) * 4096 + ((((t >> 4) & 3) * 2 + (d >> 5)) * 64 + (d & 31)) * 8 + 4 * ((t >> 3) & 1);
                        *(v2u*)fp = lo; *(v2u*)(fp + 256) = hi;
                    }
                }
        }
        if (u.pm == 0) {
#pragma unroll
            for (int ai = 0; ai < 2; ++ai) { const float mx = wave_max(vm[ai]);
                if ((fr | fq) == 0) __hip_atomic_fetch_max(vmx + ((u.pn * 256) / SEQ) * NG + 2 * ai + wr, __float_as_uint(mx), __ATOMIC_RELAXED, __HIP_MEMORY_SCOPE_AGENT); }
        }
    }
};
struct EpiCmp {
    static constexpr bool PERM = true, AFTER_DRAIN = false;
    const float* peb; bf16* HIDC;
    __device__ __forceinline__ void operator()(AccRef acc, const Unit& u, int wr, int wc, int fr, int fq) const {
        const int kv = u.pm >= 32 ? 1 : 0;
        f32x4 bp[2][2];
#pragma unroll
        for (int bj = 0; bj < 2; ++bj) { bp[bj][0] = *(const f32x4*)(peb + kv * 256 + EPI_COL(bj)); bp[bj][1] = *(const f32x4*)(peb + kv * 256 + EPI_COL(bj) + 4); }
        __builtin_amdgcn_sched_barrier(0);
#pragma unroll
        for (int bj = 0; bj < 2; ++bj) {
            const int col = EPI_COL(bj);
            const f32x4 b0 = bp[bj][0], b1 = bp[bj][1];
#pragma unroll
            for (int ai = 0; ai < 2; ++ai)
#pragma unroll
                for (int m = 0; m < 4; ++m) {
                    const int row = EPI_ROW(u, ai, m); f32x4 x = acc[ai][bj][m][0] + b0, y = acc[ai][bj][m][1] + b1;
#pragma unroll
                    for (int j = 0; j < 4; ++j) { x[j] = silu(x[j]); y[j] = silu(y[j]); }
                    *(v4u*)(HIDC + (size_t)row * 256 + col) = pack8(x, y);
                }
        }
    }
};
struct MapCmp { __device__ __forceinline__ void operator()(Unit& u) const { u.offA = (size_t)u.pm * 256 * 1024 * 2; u.offB = (size_t)(u.pm >= 32 ? 256 : 0) * 2048 * 2; } };

struct MapKV { __device__ __forceinline__ void operator()(Unit& u) const { const int hc = u.pm >> 1, eh = u.pm & 1, h = hc / NCH, c = hc % NCH;
    u.offA = ((size_t)(hc * RCH + eh * 256) * APLD) * 2; u.offB = ((size_t)(h * RDK) * SEQ + (size_t)c * RCH) * 2; } };
struct EpiKV {
    static constexpr bool PERM = true, AFTER_DRAIN = false;
    bf16* KV;
    __device__ __forceinline__ void operator()(AccRef acc, const Unit& u, int wr, int wc, int fr, int fq) const {
#pragma unroll
        for (int ai = 0; ai < 2; ++ai)
#pragma unroll
            for (int m = 0; m < 4; ++m) { const int row = EPI_ROW(u, ai, m);
#pragma unroll
                for (int bj = 0; bj < 2; ++bj) *(v4u*)(KV + (size_t)row * RDK + EPI_COL(bj)) = pack8(acc[ai][bj][m][0], acc[ai][bj][m][1]); }
    }
};
struct MapS { __device__ __forceinline__ void operator()(Unit& u) const { const int hc = u.pm >> 1, qh = u.pm & 1, h = hc / NCH, c = hc % NCH;
    u.offA = ((size_t)(hc * RCH + qh * 256) * APLD + RCH) * 2; u.offB = ((size_t)(c * RCH + u.pn * 256) * 1024 + h * RDK) * 2; } };
struct EpiS {
    static constexpr bool PERM = true, AFTER_DRAIN = false;
    bf16* AP;
    __device__ __forceinline__ void operator()(AccRef acc, const Unit& u, int wr, int wc, int fr, int fq) const {
        const int qh = u.pm & 1;
#pragma unroll
        for (int ai = 0; ai < 2; ++ai)
#pragma unroll
            for (int m = 0; m < 4; ++m) { const int row = EPI_ROW(u, ai, m); const int qi = qh * 256 + ai * 128 + wr * 64 + m * 16 + fr;
#pragma unroll
                for (int bj = 0; bj < 2; ++bj) { const int k0 = u.pn * 256 + EPI_COL(bj); f32x4 v0 = acc[ai][bj][m][0], v1 = acc[ai][bj][m][1];
#pragma unroll
                    for (int j = 0; j < 4; ++j) { if (k0 + j > qi) v0[j] = 0.f; if (k0 + 4 + j > qi) v1[j] = 0.f; }
                    *(v4u*)(AP + (size_t)row * APLD + k0) = pack8(v0, v1); } }
    }
};
struct MapO { __device__ __forceinline__ void operator()(Unit& u) const { const int hc = u.pm >> 1, qh = u.pm & 1;
    u.offA = ((size_t)(hc * RCH + qh * 256) * APLD) * 2; u.offB = ((size_t)(hc * RCH + u.pn * 256) * APLD) * 2; } };
struct EpiO {
    static constexpr bool PERM = true, AFTER_DRAIN = false;
    bf16* O; float* gslots; int b;
    __device__ __forceinline__ void operator()(AccRef acc, const Unit& u, int wr, int wc, int fr, int fq) const {
        const int hc = u.pm >> 1, qh = u.pm & 1, h = hc / NCH, c = hc % NCH;
#pragma unroll
        for (int ai = 0; ai < 2; ++ai)
#pragma unroll
            for (int m = 0; m < 4; ++m) { const size_t row = (size_t)b * SEQ + c * RCH + qh * 256 + ai * 128 + wr * 64 + m * 16 + fr; float ss = 0.f;
#pragma unroll
                for (int bj = 0; bj < 2; ++bj) { const f32x4 v0 = acc[ai][bj][m][0], v1 = acc[ai][bj][m][1];
                    ss += (v0[0] * v0[0] + v0[1] * v0[1]) + (v0[2] * v0[2] + v0[3] * v0[3]) + (v1[0] * v1[0] + v1[1] * v1[1]) + (v1[2] * v1[2] + v1[3] * v1[3]);
                    *(v4u*)(O + row * 2048 + h * RDV + u.pn * 256 + EPI_COL(bj)) = pack8(v0, v1); }
                ss += __shfl_xor(ss, 16); ss += __shfl_xor(ss, 32);
                if (fq == 0) gslots[row * 32 + h * 8 + u.pn * 4 + wc] = ss; }
    }
};

constexpr int NWAVES = 8, NTHREADS = NWAVES * 64;
constexpr int RING_OFF = 0, RING_BYTES = 131072;
constexpr int LDS_BYTES = 163840;
constexpr int LDSCTL_OFF = LDS_BYTES - 1024, MISC_OFF = LDSCTL_OFF + 320;
constexpr int CW_BAR = 4096;

struct Args { const float* in[20]; float* out; unsigned char* ws; int ph, b; };
struct Frame {
    LAS unsigned char* lds; unsigned char* ws; float* out; const float* const* in;
    int tid, lane, wave, G, vcu, gw, NGW;
};

template <class T> __device__ __forceinline__ T* gp(T* p) { return (T*)(GAS T*)p; }
struct TDesc { const float* W; const float* gain; bf16* WT; int K, ldw, ncols, nblk, mode, off, start, pad; };
__device__ __forceinline__ int dest_row(int mode, int off, int n) {
    if (mode == 1) { const int up = n >= FFH, j = up ? n - FFH : n; return (j >> 7) * 256 + up * 128 + (j & 127); }
    if (mode == 2) { const int s = n >> 8, d = n & 255; return s < 3 ? n : s == 3 ? 2304 + d : s == 4 ? 768 + d : 2304 + 256 + d; }
    return n + off;
}
__device__ __forceinline__ void transpose_item(const LAS TDesc& D, LAS float* scr, int it, int lane) {
    const float* W = D.W; const float* gain = D.gain; const int K = D.K, ldw = D.ldw, ncols = D.ncols, nblk = D.nblk;
    const int k0 = 64 * (it / nblk), n0 = 32 * (it % nblk);
    const int q = lane & 7, kr = lane >> 3;
#pragma unroll
    for (int i = 0; i < 8; ++i) { const int kk = 8 * i + kr, n = n0 + 4 * q;
        f32x4 v = {0.f, 0.f, 0.f, 0.f}; if (n < ncols) v = *(const f32x4*)(W + (size_t)(k0 + kk) * ldw + n);
        if (gain) v *= gain[k0 + kk];
        LAS float* s = scr + kk * 33 + 4 * q; s[0] = v[0]; s[1] = v[1]; s[2] = v[2]; s[3] = v[3]; }
    asm volatile("s_waitcnt lgkmcnt(0)" ::: "memory");
    const int c = lane & 7;
#pragma unroll
    for (int j = 0; j < 4; ++j) { const int n = (lane >> 3) + 8 * j; const LAS float* s = scr + (8 * c) * 33 + n;
        v4u o; o.x = cvtpk(s[0 * 33], s[1 * 33]); o.y = cvtpk(s[2 * 33], s[3 * 33]); o.z = cvtpk(s[4 * 33], s[5 * 33]); o.w = cvtpk(s[6 * 33], s[7 * 33]);
        *(v4u*)(D.WT + (size_t)dest_row(D.mode, D.off, n0 + n) * K + k0 + 8 * c) = o; }
    asm volatile("s_waitcnt lgkmcnt(0)" ::: "memory");
}

__device__ __forceinline__ void row_to_bf16(const float* xrow, bf16* orow, float* rinv, int lane) {
    const f32x4* xr = (const f32x4*)xrow + lane; f32x4 v[4]; float s = 0.f;
#pragma unroll
    for (int j = 0; j < 4; ++j) { v[j] = xr[64 * j]; s += (v[j][0] * v[j][0] + v[j][1] * v[j][1]) + (v[j][2] * v[j][2] + v[j][3] * v[j][3]); }
    s = wave_sum(s);
    v2u* o8 = (v2u*)orow + lane;
#pragma unroll
    for (int j = 0; j < 4; ++j) { v2u w; w.x = cvtpk(v[j][0], v[j][1]); w.y = cvtpk(v[j][2], v[j][3]); o8[64 * j] = w; }
    if (lane == 0) *rinv = rsqrtf(s * (1.0f / DM) + RMS_EPS);
}

__device__ __forceinline__ void rows2_to_bf16(const float* xa, const float* xb, bf16* oa, bf16* ob, float* ra, float* rb, int lane) {
    f32x4 va[2][2], vb[2][2]; float sa = 0.f, sb = 0.f;
#pragma unroll
    for (int j = 0; j < 2; ++j) { const f32x4* pa = (const f32x4*)(xa + 512 * j + 8 * lane); const f32x4* pb = (const f32x4*)(xb + 512 * j + 8 * lane);
        va[j][0] = pa[0]; va[j][1] = pa[1]; vb[j][0] = pb[0]; vb[j][1] = pb[1]; }
#pragma unroll
    for (int j = 0; j < 2; ++j)
#pragma unroll
        for (int q = 0; q < 2; ++q) { const f32x4 a = va[j][q], b = vb[j][q];
            sa += (a[0] * a[0] + a[1] * a[1]) + (a[2] * a[2] + a[3] * a[3]); sb += (b[0] * b[0] + b[1] * b[1]) + (b[2] * b[2] + b[3] * b[3]); }
    sa = wave_sum(sa); sb = wave_sum(sb);
#pragma unroll
    for (int j = 0; j < 2; ++j) { *(v4u*)(oa + 512 * j + 8 * lane) = pack8(va[j][0], va[j][1]); *(v4u*)(ob + 512 * j + 8 * lane) = pack8(vb[j][0], vb[j][1]); }
    if (lane == 0) { *ra = rsqrtf(sa * (1.0f / DM) + RMS_EPS); *rb = rsqrtf(sb * (1.0f / DM) + RMS_EPS); }
}
constexpr int NTD = 13;
__device__ __forceinline__ void phase_prologue(const Frame& F) {
    unsigned char* ws = F.ws; const float* in[20];
#pragma unroll
    for (int i = 0; i < 20; ++i) in[i] = gp(F.in[i]);
    LAS TDesc* TD = (LAS TDesc*)(F.lds + RING_OFF + 8 * 16384);
    if (F.tid == 0) {
        int st = 0;
#define TDSET(k, W_, K_, ldw_, nc_, ncp_, gain_, WT_, mode_, off_) do { TD[k].W = (W_); TD[k].gain = (gain_); TD[k].WT = (bf16*)(WT_); TD[k].K = (K_); TD[k].ldw = (ldw_); TD[k].ncols = (nc_); \
            TD[k].nblk = (ncp_) / 32; TD[k].mode = (mode_); TD[k].off = (off_); TD[k].start = st; st += ((K_) / 64) * ((ncp_) / 32); } while (0)
        TDSET(0, in[7], DM, RIN, RIN, RIN, in[1], ws + W_RI, 0, 0);
        TDSET(1, in[8], 2048, DM, DM, DM, (const float*)nullptr, ws + W_RO, 0, 0);
        TDSET(2, in[5], DM, 2 * FFH, 2 * FFH, 2 * FFH, in[3], ws + W_FI0, 1, 0);
        TDSET(3, in[5] + (size_t)DM * 2 * FFH, DM, 2 * FFH, 2 * FFH, 2 * FFH, in[3] + DM, ws + W_FI1, 1, 0);
        TDSET(4, in[6], FFH, DM, DM, DM, (const float*)nullptr, ws + W_FO0, 0, 0);
        TDSET(5, in[6] + (size_t)FFH * DM, FFH, DM, DM, DM, (const float*)nullptr, ws + W_FO1, 0, 0);
        TDSET(6, in[10], DM, 1536, 1536, 1536, in[9], ws + W_KVQ, 2, 0);
        TDSET(7, in[17], DM, NSAIN, NSAIN, 1280, in[1] + DM, ws + W_KVQ, 0, 1024);
        TDSET(8, in[18], DM, DM, DM, DM, (const float*)nullptr, ws + W_NO, 0, 0);
        TDSET(9, in[12], 2048, 256, 256, 256, (const float*)nullptr, ws + W_C1, 0, 0);
        TDSET(10, in[15], 2048, 256, 256, 256, (const float*)nullptr, ws + W_C1, 0, 256);
        TDSET(11, in[13], 256, 64, 64, 64, (const float*)nullptr, ws + W_C2, 0, 0);
        TDSET(12, in[16], 256, 64, 64, 64, (const float*)nullptr, ws + W_C2, 0, 64);
#undef TDSET
        TD[NTD].start = st;
    }
    __syncthreads();
    const int NT = TD[NTD].start, NJ = NT + MTOK / 2 + SEQ / 2;
    LAS float* scr = (LAS float*)(F.lds + RING_OFF + F.wave * 16384);
    f32x2_t* tabA = (f32x2_t*)(ws + WS_TABA); f32x2_t* tabB = (f32x2_t*)(ws + WS_TABB);
    const float th0 = 1.0f / powf(10000.0f, (float)F.lane * (1.0f / 127.0f)), th1 = 1.0f / powf(10000.0f, (float)(64 + F.lane) * (1.0f / 127.0f));
    const int NG16 = (NJ + 15) >> 4;
    const int gw_s = __builtin_amdgcn_readfirstlane(F.gw), ngw_s = __builtin_amdgcn_readfirstlane(F.NGW);
    for (int jb = gw_s; jb < NG16 * 16; jb += ngw_s) {
        const int it = (int)(((unsigned)(jb >> 4) * 7919u) % (unsigned)NG16) * 16 + (jb & 15);
        if (it >= NJ) continue;
        if (it < NT) {
            int k = 0;
#pragma unroll
            for (int q = 1; q < NTD; ++q) k = it >= TD[q].start ? q : k;
            transpose_item(TD[k], scr, it - TD[k].start, F.lane);
        } else if (it < NT + MTOK / 2) {
            const int m = it - NT, m2 = m + MTOK / 2;
            rows2_to_bf16(in[0] + (size_t)m * DM, in[0] + (size_t)m2 * DM, (bf16*)(ws + WS_XB) + (size_t)m * DM, (bf16*)(ws + WS_XB) + (size_t)m2 * DM, (float*)(ws + WS_RINV) + m, (float*)(ws + WS_RINV) + m2, F.lane);
        } else {
            const int t = 2 * (it - NT - MTOK / 2);
            float s00, c00, s01, c01, s10, c10, s11, c11;
            sincosf((float)t * th0, &s00, &c00); sincosf((float)t * th1, &s01, &c01);
            sincosf((float)(t + 1) * th0, &s10, &c10); sincosf((float)(t + 1) * th1, &s11, &c11);
            tabA[(size_t)t * 128 + F.lane] = (f32x2_t){c00, s00}; tabA[(size_t)t * 128 + 64 + F.lane] = (f32x2_t){c01, s01};
            tabA[(size_t)(t + 1) * 128 + F.lane] = (f32x2_t){c10, s10}; tabA[(size_t)(t + 1) * 128 + 64 + F.lane] = (f32x2_t){c11, s11};
            *(f32x4*)(tabB + (size_t)F.lane * SEQ + t) = (f32x4){c00, s00, c10, s10};
            *(f32x4*)(tabB + (size_t)(64 + F.lane) * SEQ + t) = (f32x4){c01, s01, c11, s11};
        }
    }
}
__device__ __forceinline__ void phase_small_tables(const Frame& F) {
    unsigned char* ws = F.ws;
    const int vb = F.G >= 192 ? F.vcu - 128 : F.vcu;
    if (vb == 32) { const float* rb = gp(F.in[19]); for (int i = F.tid; i < 128 * 16; i += NTHREADS) ((float*)(ws + WS_BIAST))[i] = rb[t5_bucket(i >> 4) * 16 + (i & 15)]; }
    if (vb >= 0 && vb < 32) {
        const int kv = F.tid >> 8, c = F.tid & 255; const float* pe = gp(kv ? F.in[14] : F.in[11]); const float* w1 = gp(kv ? F.in[15] : F.in[12]); float s = 0.f;
        for (int k = 64 * vb; k < 64 * vb + 64; ++k) s += pe[k] * w1[(size_t)k * 256 + c];
        ((float*)(ws + WS_PEBP))[vb * 512 + F.tid] = s;
    }
}
__device__ __forceinline__ void phase_peb_final(const Frame& F) {
    if (blockIdx.x == 0) { float s = 0.f; for (int w = 0; w < 32; ++w) s += ((const float*)(F.ws + WS_PEBP))[w * 512 + F.tid]; ((float*)(F.ws + WS_PEB))[F.tid] = s; }
}

template <bool F32IN> __device__ __forceinline__ void phase_resid(const Frame& F, const float* hold_f32, const float* gpost, bool last) {
    const bf16* MIX = (const bf16*)(F.ws + WS_MIX); const float* oslots = (const float*)(F.ws + WS_OSLOT);
    bf16* XB = (bf16*)(F.ws + WS_XB); float* rinv = (float*)(F.ws + WS_RINV);
    constexpr int RPP = 4;
    const int c0 = 8 * F.lane;
    f32x4 gp[2][2];
#pragma unroll
    for (int j = 0; j < 2; ++j) { gp[j][0] = *(const f32x4*)(gpost + 512 * j + c0); gp[j][1] = *(const f32x4*)(gpost + 512 * j + c0 + 4); }
    for (int m0 = F.gw; m0 < MTOK; m0 += RPP * F.NGW) {
        f32x4 hn[RPP][2][2]; float sq[RPP];
        f32x4 sl[RPP]; v4u mw[RPP][2]; v4u xw[F32IN ? 1 : RPP][2]; f32x4 xf[F32IN ? RPP : 1][2][2];
#pragma unroll
        for (int r = 0; r < RPP; ++r) { const int m = m0 + r * F.NGW < MTOK ? m0 + r * F.NGW : m0;
            sl[r] = ((const f32x4*)(oslots + (size_t)m * 16))[F.lane & 3];
#pragma unroll
            for (int j = 0; j < 2; ++j) { mw[r][j] = *(const v4u*)(MIX + (size_t)m * DM + 512 * j + c0);
                if constexpr (F32IN) { xf[r][j][0] = *(const f32x4*)(hold_f32 + (size_t)m * DM + 512 * j + c0); xf[r][j][1] = *(const f32x4*)(hold_f32 + (size_t)m * DM + 512 * j + c0 + 4); }
                else xw[r][j] = *(const v4u*)(XB + (size_t)m * DM + 512 * j + c0); } }
#pragma unroll
        for (int r = 0; r < RPP; ++r) {
            float ss = (sl[r][0] + sl[r][1]) + (sl[r][2] + sl[r][3]); ss += __shfl_xor(ss, 1); ss += __shfl_xor(ss, 2);
            const float rs = rsqrtf(ss * (1.0f / DM) + RMS_EPS);
            sq[r] = 0.f;
#pragma unroll
            for (int j = 0; j < 2; ++j) { float mx[8]; unpack8(mw[r][j], mx); f32x4 h0, h1;
                if constexpr (F32IN) { h0 = xf[r][j][0]; h1 = xf[r][j][1]; } else { float hx[8]; unpack8(xw[r][j], hx); h0 = (f32x4){hx[0], hx[1], hx[2], hx[3]}; h1 = (f32x4){hx[4], hx[5], hx[6], hx[7]}; }
                const f32x4 a0 = h0 + (f32x4){mx[0], mx[1], mx[2], mx[3]} * rs * gp[j][0], a1 = h1 + (f32x4){mx[4], mx[5], mx[6], mx[7]} * rs * gp[j][1];
                hn[r][j][0] = a0; hn[r][j][1] = a1;
                sq[r] += ((a0[0] * a0[0] + a0[1] * a0[1]) + (a0[2] * a0[2] + a0[3] * a0[3])) + ((a1[0] * a1[0] + a1[1] * a1[1]) + (a1[2] * a1[2] + a1[3] * a1[3])); } }
#pragma unroll
        for (int r = 0; r < RPP; ++r) { const int m = m0 + r * F.NGW; if (m >= MTOK) break;
            if (last) {
#pragma unroll
                for (int j = 0; j < 2; ++j) { *(f32x4*)(F.out + (size_t)m * DM + 512 * j + c0) = hn[r][j][0]; *(f32x4*)(F.out + (size_t)m * DM + 512 * j + c0 + 4) = hn[r][j][1]; }
            } else {
                const float s = wave_sum(sq[r]);
#pragma unroll
                for (int j = 0; j < 2; ++j) *(v4u*)(XB + (size_t)m * DM + 512 * j + c0) = pack8(hn[r][j][0], hn[r][j][1]);
                if (F.lane == 0) rinv[m] = rsqrtf(s * (1.0f / DM) + RMS_EPS);
            } }
    }
}

__device__ __forceinline__ void phase_cmp2(const Frame& F) {
    typedef short s8_t __attribute__((ext_vector_type(8))); typedef float f16_t __attribute__((ext_vector_type(16)));
    const bf16* HIDC = (const bf16*)(F.ws + WS_HIDC); bf16* KCMP = (bf16*)(F.ws + WS_KCMP); bf16* VCT = (bf16*)(F.ws + WS_VCMPT); const bf16* W2T = (const bf16*)(F.ws + W_C2);
    const int r32 = F.lane & 31, h = F.lane >> 5;
    for (int task = F.vcu + F.G * F.wave; task < 1024; task += F.G * NWAVES) {
        const int R0 = (task >> 1) * 32, ch = task & 1, kv = R0 >> 13, pl = (R0 >> 10) & 7, n0 = R0 & 1023;
        const GAS s8_t* xp = (const GAS s8_t*)(GAS bf16*)(HIDC + (size_t)(R0 + r32) * 256 + 8 * h);
        const GAS s8_t* wp = (const GAS s8_t*)(GAS bf16*)(W2T + (size_t)(kv * 64 + ch * 32 + r32) * 256 + 8 * h);
        s8_t x[16], wv[16];
#pragma unroll
        for (int s = 0; s < 16; ++s) { x[s] = xp[2 * s]; wv[s] = wp[2 * s]; }
        f16_t acc;
#pragma unroll
        for (int r = 0; r < 16; ++r) acc[r] = 0.f;
        if (kv == 0) {
#pragma unroll
            for (int s = 0; s < 16; ++s) acc = __builtin_amdgcn_mfma_f32_32x32x16_bf16(wv[s], x[s], acc, 0, 0, 0);
            const int n = n0 + r32; const float z = n == NCMP ? 0.f : 1.f;
#pragma unroll
            for (int a = 0; a < 4; ++a) { v2u pk; pk.x = cvtpk(acc[4 * a] * z, acc[4 * a + 1] * z); pk.y = cvtpk(acc[4 * a + 2] * z, acc[4 * a + 3] * z);
                *(v2u*)(KCMP + (size_t)pl * 65536 + (size_t)(n >> 6) * 4096 + (((((n >> 5) & 1) * 4 + 2 * ch + (a >> 1)) * 64 + (a & 1) * 32 + (n & 31)) * 8 + 4 * h)) = pk; }
        } else {
#pragma unroll
            for (int s = 0; s < 16; ++s) acc = __builtin_amdgcn_mfma_f32_32x32x16_bf16(x[s], wv[s], acc, 0, 0, 0);
            if (n0 == 992 && h == 1) acc[15] = 0.f;
            #pragma unroll
            for (int a = 0; a < 4; ++a) { v2u pk; pk.x = cvtpk(acc[4 * a], acc[4 * a + 1]); pk.y = cvtpk(acc[4 * a + 2], acc[4 * a + 3]);
                *(v2u*)(VCT + (size_t)pl * 65536 + (size_t)(n0 >> 6) * 4096 + ((((((n0 >> 5) & 1) * 2 + (a >> 1)) * 2 + ch) * 64 + h * 32 + r32) * 8 + 4 * (a & 1))) = pk; }
        }
    }
}

__device__ __forceinline__ void phase_ret_scan(const Frame& F) {
    const bf16* KV = (const bf16*)(F.ws + WS_KV); bf16* BP = (bf16*)(F.ws + WS_BP);
    for (int it = F.vcu * NTHREADS + F.tid; it < RH * RDV * (RDK / 8); it += F.G * NTHREADS) {
        const int d8 = it & 31, e = (it >> 5) & 511, h = it >> 14;
        const float cdec = __builtin_amdgcn_exp2f((float)RCH * lg2gamma(h));
        float carry[8]; float z0 = 0.f; asm volatile("" : "+v"(z0));
#pragma unroll
        for (int i = 0; i < 8; ++i) carry[i] = z0;
        v4u kvr[NCH];
#pragma unroll
        for (int c = 0; c < NCH; ++c) kvr[c] = *(const GAS v4u*)(GAS bf16*)(KV + ((size_t)(h * NCH + c) * RCH + e) * RDK + d8 * 8);
        __builtin_amdgcn_sched_barrier(0);
#pragma unroll
        for (int c = 0; c < NCH; ++c) {
            const size_t r = (size_t)(h * NCH + c) * RCH + e;
            float kv[8]; unpack8(kvr[c], kv);
            v4u w; w.x = cvtpk(carry[0], carry[1]); w.y = cvtpk(carry[2], carry[3]); w.z = cvtpk(carry[4], carry[5]); w.w = cvtpk(carry[6], carry[7]);
            *(v4u*)(BP + r * APLD + RCH + d8 * 8) = w;
#pragma unroll
            for (int i = 0; i < 8; ++i) carry[i] = cdec * (carry[i] + kv[i]);
        }
    }
}

namespace nsa {
typedef float f32x16 __attribute__((ext_vector_type(16)));
typedef short s16x8 __attribute__((ext_vector_type(8)));
constexpr float LOG2E = 1.4426950408889634f, NEGB = -1.0e30f;
constexpr int L_IMP = 65536, IMP_P = 260, L_SELM = L_IMP + 64 * IMP_P * 4, L_BT = L_SELM + 2048, L_END = L_BT + 2048;
static_assert(L_END <= LDSCTL_OFF, "nsa lds");
constexpr int NB_P = 264, L_NB = 137344;
static_assert(L_NB >= L_END && L_NB % 16 == 0 && L_NB + 16 * NB_P * 4 <= LDSCTL_OFF, "bias table");
constexpr int L_SQ = 0, L_SM = 32768, L_SL = L_SM + 1024, L_TL = L_SL + 1024, TL_CAP = 320, L_TC = L_TL + TL_CAP * 4, L_TOK = L_TC + 64, L_SMF = L_TOK + TL_CAP * 32, L_SEND = L_SMF + 1024, SO_P = 66, L_SO = 64000;
static_assert(L_SEND <= L_SO && L_TOK % 32 == 0 && L_SO + 256 * SO_P * 4 <= L_SELM && L_SO % 16 == 0 && (256 * SO_P * 4) % 16 == 0, "sel lds");
__device__ __forceinline__ constexpr int krow(int r) { return (r & 3) + 8 * (r >> 2); }

__device__ __forceinline__ float xhalf_max(float v) { auto rr = __builtin_amdgcn_permlane32_swap(__float_as_uint(v), __float_as_uint(v), false, false); return fmaxf(__uint_as_float(rr[0]), __uint_as_float(rr[1])); }
__device__ __forceinline__ void bias_tile(f32x16& p, const LAS float* NB, int kb, int t, int hd) {
    const int idx = 191 - t + kb, c = idx & 3;
    const LAS f32x4* b = (const LAS f32x4*)(NB + (c * 4 + hd) * NB_P + (idx - c));
#pragma unroll
    for (int a = 0; a < 4; ++a) { const f32x4 v = b[2 * a]; p[4 * a] += v[0]; p[4 * a + 1] += v[1]; p[4 * a + 2] += v[2]; p[4 * a + 3] += v[3]; }
}
__device__ __forceinline__ void cmp_bias(f32x16& p, int d0, const LAS float* bT) {
#pragma unroll
    for (int r = 0; r < 16; ++r) {
        const int dist = d0 - 16 * krow(r), di = dist < 0 ? 0 : (dist > 127 ? 127 : dist);
        const float b = bT[di * 4];
        p[r] = dist < 0 ? NEGB : p[r] + b;
    }
}
#define DPP_XOR1 0xB1
#define DPP_XOR2 0x4E
#define DPP_HMIR 0x141
__device__ __forceinline__ float quad_sum(float v) { v += __int_as_float(__builtin_amdgcn_update_dpp(0, __float_as_int(v), DPP_XOR1, 0xf, 0xf, true)); v += __int_as_float(__builtin_amdgcn_update_dpp(0, __float_as_int(v), DPP_XOR2, 0xf, 0xf, true)); return v; }
__device__ __forceinline__ unsigned oct_umax(unsigned v) {
    unsigned o = (unsigned)__builtin_amdgcn_update_dpp(0, (int)v, DPP_XOR1, 0xf, 0xf, true); v = v > o ? v : o;
    o = (unsigned)__builtin_amdgcn_update_dpp(0, (int)v, DPP_XOR2, 0xf, 0xf, true); v = v > o ? v : o;
    o = (unsigned)__builtin_amdgcn_update_dpp(0, (int)v, DPP_HMIR, 0xf, 0xf, true); return v > o ? v : o;
}
__device__ __forceinline__ unsigned umax3(unsigned a, unsigned b, unsigned c) { unsigned d; asm("v_max3_u32 %0, %1, %2, %3" : "=v"(d) : "v"(a), "v"(b), "v"(c)); return d; }
template <int N> __device__ __forceinline__ unsigned umax_tree(const unsigned (&t)[N]) {
    if constexpr (N == 1) return t[0];
    else { constexpr int M = (N + 2) / 3; unsigned u[M];
#pragma unroll
        for (int i = 0; i < M; ++i) u[i] = umax3(t[3 * i], 3 * i + 1 < N ? t[3 * i + 1] : t[3 * i], 3 * i + 2 < N ? t[3 * i + 2] : t[3 * i]);
        return umax_tree<M>(u); }
}
template <int NE> __device__ __forceinline__ void topk_rounds(const LAS int* ip, LAS unsigned* sm, int sub, int cur, int need) {
    unsigned key[NE];
#pragma unroll
    for (int i = 0; i < NE; ++i) { const int j = sub + 8 * i; key[i] = (j >= 1 && j <= cur - 2) ? ((((unsigned)ip[j] >> 5) << 8) | (unsigned)(255 - j)) : 0u; }
#pragma unroll 1
    for (int round = 0; round < need; ++round) {
        unsigned bk = oct_umax(umax_tree<NE>(key));
#pragma unroll
        for (int i = 0; i < NE; ++i) key[i] = key[i] == bk ? 0u : key[i];
        const int bj = 255 - (int)(bk & 0xffu);
        if (sub == 0 && bk != 0u) (void)__hip_atomic_fetch_or(sm + (bj >> 5), 1u << (bj & 31), __ATOMIC_RELAXED, __HIP_MEMORY_SCOPE_WORKGROUP);
    }
}
__device__ __forceinline__ float max3f(float a, float b, float c) { float d; asm("v_max3_f32 %0, %1, %2, %3" : "=v"(d) : "v"(a), "v"(b), "v"(c)); return d; }
template <int OFF> __device__ __forceinline__ void lds_add_2i32_off(LAS int* p, int lo, int hi) {
    const unsigned long long v = ((unsigned long long)(unsigned)(hi + (lo >> 31)) << 32) | (unsigned)lo;
    asm volatile("ds_add_u64 %0, %1 offset:%2" :: "v"((unsigned)(uintptr_t)p), "v"(v), "n"(OFF) : "memory"); }
__device__ __forceinline__ void lds_max_i32(LAS int* p, int v) { asm volatile("ds_max_i32 %0, %1" :: "v"((unsigned)(uintptr_t)p), "v"(v) : "memory"); }
__device__ __forceinline__ void lds_add_i32(LAS int* p, int v) { asm volatile("ds_add_u32 %0, %1" :: "v"((unsigned)(uintptr_t)p), "v"(v) : "memory"); }
__device__ __forceinline__ int f2ord(float f) { const int b = __float_as_int(f); return b ^ ((b >> 31) & 0x7fffffff); }
__device__ __forceinline__ float ord2f(int o) { return __int_as_float(o ^ ((o >> 31) & 0x7fffffff)); }
struct KF { s16x8 k[2][4]; };
struct VF { s16x8 v[2][2][2]; };
__device__ __forceinline__ void kf_load(KF& f, const bf16* blk, int lane) {
    const GAS s16x8* p = (const GAS s16x8*)(GAS bf16*)blk + lane;
#pragma unroll
    for (int kt = 0; kt < 2; ++kt)
#pragma unroll
        for (int s = 0; s < 4; ++s) f.k[kt][s] = p[(kt * 4 + s) * 64];
}
__device__ __forceinline__ void vf_load(VF& f, const bf16* blk, int lane) {
    const GAS s16x8* p = (const GAS s16x8*)(GAS bf16*)blk + lane;
#pragma unroll
    for (int kt = 0; kt < 2; ++kt)
#pragma unroll
        for (int s2 = 0; s2 < 2; ++s2)
#pragma unroll
            for (int dt = 0; dt < 2; ++dt) f.v[kt][s2][dt] = p[((kt * 2 + s2) * 2 + dt) * 64];
}
__device__ __forceinline__ f32x16 qk_frag(const s16x8 (&kf)[4], const s16x8 (&qf)[4], float cinit) {
    f32x16 p;
#pragma unroll
    for (int r = 0; r < 16; ++r) p[r] = cinit;
#pragma unroll
    for (int s = 0; s < 4; ++s) p = __builtin_amdgcn_mfma_f32_32x32x16_bf16(kf[s], qf[s], p, 0, 0, 0);
    return p;
}
__device__ __forceinline__ void pv_frag(f32x16 (&o)[2], const s16x8 (&vf)[2][2], const f32x16& p) {
#pragma unroll
    for (int s2 = 0; s2 < 2; ++s2) {
        v4u pw; pw.x = cvtpk(p[8 * s2 + 0], p[8 * s2 + 1]); pw.y = cvtpk(p[8 * s2 + 2], p[8 * s2 + 3]); pw.z = cvtpk(p[8 * s2 + 4], p[8 * s2 + 5]); pw.w = cvtpk(p[8 * s2 + 6], p[8 * s2 + 7]);
        const s16x8 pb = __builtin_bit_cast(s16x8, pw);
#pragma unroll
        for (int dt = 0; dt < 2; ++dt) o[dt] = __builtin_amdgcn_mfma_f32_32x32x16_bf16(vf[s2][dt], pb, o[dt], 0, 0, 0);
    }
}
__device__ __forceinline__ void pvl_frag(f32x16 (&o)[3], const s16x8 (&vf)[2][2], const f32x16& p, const s16x8& ones) {
#pragma unroll
    for (int s2 = 0; s2 < 2; ++s2) {
        v4u pw; pw.x = cvtpk(p[8 * s2 + 0], p[8 * s2 + 1]); pw.y = cvtpk(p[8 * s2 + 2], p[8 * s2 + 3]); pw.z = cvtpk(p[8 * s2 + 4], p[8 * s2 + 5]); pw.w = cvtpk(p[8 * s2 + 6], p[8 * s2 + 7]);
        const s16x8 pb = __builtin_bit_cast(s16x8, pw);
#pragma unroll
        for (int dt = 0; dt < 2; ++dt) o[dt] = __builtin_amdgcn_mfma_f32_32x32x16_bf16(vf[s2][dt], pb, o[dt], 0, 0, 0);
        o[2] = __builtin_amdgcn_mfma_f32_32x32x16_bf16(ones, pb, o[2], 0, 0, 0);
    }
}
struct FB { s16x8 r[8]; };
template <bool B> struct BoolC { static constexpr bool value = B; };
__device__ __forceinline__ void fb_load(FB& f, const bf16* blk, int lane) {
    const GAS s16x8* p = (const GAS s16x8*)(GAS bf16*)blk + lane;
#pragma unroll
    for (int i = 0; i < 8; ++i) f.r[i] = p[i * 64];
}
template <int KT> __device__ __forceinline__ f32x16 qk_fb(const FB& f, const s16x8 (&qf)[4], float cinit) {
    f32x16 p;
#pragma unroll
    for (int r = 0; r < 16; ++r) p[r] = cinit;
#pragma unroll
    for (int s = 0; s < 4; ++s) p = __builtin_amdgcn_mfma_f32_32x32x16_bf16(f.r[4 * KT + s], qf[s], p, 0, 0, 0);
    return p;
}
template <int KT> __device__ __forceinline__ void pv_fb(f32x16 (&o)[2], const FB& f, const f32x16& p) {
#pragma unroll
    for (int s2 = 0; s2 < 2; ++s2) {
        v4u pw; pw.x = cvtpk(p[8 * s2 + 0], p[8 * s2 + 1]); pw.y = cvtpk(p[8 * s2 + 2], p[8 * s2 + 3]); pw.z = cvtpk(p[8 * s2 + 4], p[8 * s2 + 5]); pw.w = cvtpk(p[8 * s2 + 6], p[8 * s2 + 7]);
        const s16x8 pb = __builtin_bit_cast(s16x8, pw);
#pragma unroll
        for (int dt = 0; dt < 2; ++dt) o[dt] = __builtin_amdgcn_mfma_f32_32x32x16_bf16(f.r[4 * KT + 2 * s2 + dt], pb, o[dt], 0, 0, 0);
    }
}
#define NSA_BAR() do { asm volatile("s_waitcnt lgkmcnt(0)" ::: "memory"); __builtin_amdgcn_s_barrier(); asm volatile("" ::: "memory"); } while (0)
}

__device__ __forceinline__ void phase_nsa(const Frame& F) {
    using namespace nsa;
    const int tid = F.tid, lane = F.lane, w = F.wave, r32_ = lane & 31, h_ = lane >> 5;
    LAS unsigned char* L = F.lds + RING_OFF;
    LAS float* IMP = (LAS float*)(L + L_IMP); LAS unsigned* SELM = (LAS unsigned*)(L + L_SELM); LAS float* BT = (LAS float*)(L + L_BT);
    LAS float* NBT = (LAS float*)(L + L_NB);
    const bf16* Q = (const bf16*)(F.ws + WS_Q); const bf16* KCMP = (const bf16*)(F.ws + WS_KCMP); const bf16* VCT = (const bf16*)(F.ws + WS_VCMPT);
    const bf16* KS = (const bf16*)(F.ws + WS_KS); const bf16* KW = (const bf16*)(F.ws + WS_KW); const bf16* VST = (const bf16*)(F.ws + WS_VST); const bf16* VWT = (const bf16*)(F.ws + WS_VWT);
    const float* GATE = (const float*)(F.ws + WS_GATE); const float* biasT = (const float*)(F.ws + WS_BIAST); bf16* ONSA = (bf16*)(F.ws + WS_ONSA);
#if defined(PROBE_SPIN_SEC)
    unsigned long long tacc[8] = {0, 0, 0, 0, 0, 0, 0, 0}, tlast = wall_clock64(); const unsigned long long tstart = tlast;
#define STAMP(k) do { const unsigned long long tn_ = wall_clock64(); tacc[k] += tn_ - tlast; tlast = tn_; } while (0)
#else
#define STAMP(k) do {} while (0)
#endif
    int g_bt = -1;
#pragma unroll 1
    for (int e = F.vcu; e < 2048; e += F.G) {
        const int ui = e >> 8, pl = (e >> 5) & 7, wi = e & 31, b = pl >> 2, g = pl & 3;
        if (g != g_bt) {
            __syncthreads();
            for (int i = tid; i < 512; i += NTHREADS) BT[i] = biasT[(i >> 2) * 16 + g * 4 + (i & 3)] * LOG2E;
            for (int i = tid; i < 16 * NB_P; i += NTHREADS) { const int c = i / (4 * NB_P), hd = (i / NB_P) & 3, dist = 127 - ((i % NB_P) + c - 64);
                NBT[i] = dist < 0 ? NEGB : biasT[(dist > 127 ? 127 : dist) * 16 + g * 4 + hd] * LOG2E; }
            g_bt = g;
            __syncthreads();
        }
        const int qt = 32 * ui + ((wi + 4 * ui) & 31);
        const int t0 = qt * 64, cur = qt, m0 = b * SEQ + t0;
#define TOK(r_) (t0 + 8 * w + ((r_) >> 2))
#define MROW(r_) (m0 + 8 * w + ((r_) >> 2))
#define HEADG(r_) (g * NR + ((r_) & 3))
#define B31(r_) (BT[127 * 4 + ((r_) & 3)])
        const int ncb = t0 >= 0 ? ((t0 + 63 - 31) / 16) / 64 + 1 : 0;
        const int icut = t0 >= 1152 ? (((t0 - 144) >> 4) - 63) / 64 + 1 : 0;
        const bf16* Kc = KCMP + (size_t)pl * 1024 * 64; const bf16* Vc = VCT + (size_t)pl * 64 * 1024;
        NSA_BAR();
#define LOAD_QF() s16x8 qf[4]; { int r_o = r32_, h_o = h_; asm volatile("" : "+v"(r_o), "+v"(h_o)); _Pragma("unroll") for (int s = 0; s < 4; ++s) qf[s] = *(const GAS s16x8*)(GAS bf16*)(Q + (size_t)MROW(r_o) * 1024 + HEADG(r_o) * 64 + 16 * s + 8 * h_o); }
#define OACC_DECL() int t_o = tid; asm volatile("" : "+v"(t_o)); f32x4* OACC = (f32x4*)((float*)(F.ws + WS_MIX) + ((size_t)blockIdx.x * NTHREADS + t_o) * 64);
#define GATE_LOAD(k_) ({ int l_o = r32_; asm volatile("" : "+v"(l_o)); GATE[(size_t)(m0 + 8 * w + (l_o >> 2)) * 48 + (g * NR + (l_o & 3)) * 3 + (k_)]; })
        const float gate0 = GATE_LOAD(0);
        LOAD_QF()
        {
            unsigned zz = 0u; int lane_z = lane; asm volatile("" : "+v"(zz), "+v"(lane_z));
            const v4u z4 = {zz, zz, zz, zz};
            for (int i = lane_z; i < 8 * IMP_P / 4; i += 64) ((LAS v4u*)(IMP + 8 * w * IMP_P))[i] = z4;
            SELM[64 * w + lane_z] = zz;
        }
        STAMP(0);
        f32x16 oc[2];
#pragma unroll
        for (int r = 0; r < 16; ++r) { oc[0][r] = 0.f; oc[1][r] = 0.f; }
        float mref = 0.f, lc = 0.f; bool first = true;
        {
            int r32 = r32_, h = h_, lane_c = lane; asm volatile("" : "+v"(r32), "+v"(h), "+v"(lane_c));
            KF kf; kf_load(kf, Kc, lane_c);
#pragma unroll 1
            for (int i = 0; i < ncb; ++i) {
                const bool far = i < icut;
                const float ci = far ? B31(r32) - mref : -mref;
                f32x16 pq[2] = {qk_frag(kf.k[0], qf, ci), qk_frag(kf.k[1], qf, ci)};
                kf_load(kf, Kc + (size_t)(i + 1 < ncb ? i + 1 : i) * 4096, lane_c);
#pragma unroll
                for (int kt = 0; kt < 2; ++kt) {
                    f32x16& pp = pq[kt];
                    if (!far) cmp_bias(pp, TOK(r32) - 31 - 16 * (i * 64 + 32 * kt + 4 * h), BT + (r32 & 3));
                    float tmax = max3f(pp[0], pp[1], pp[2]);
#pragma unroll
                    for (int r = 3; r < 15; r += 2) tmax = max3f(tmax, pp[r], pp[r + 1]);
                    tmax = fmaxf(tmax, pp[15]); tmax = xhalf_max(tmax);
                    const float d = first ? tmax : fmaxf(tmax, 0.f);
                    if (__any(d != 0.f)) {
                        mref += d; lc = first ? 0.f : lc * __builtin_amdgcn_exp2f(-d);
#pragma unroll
                        for (int r = 0; r < 16; ++r) { pq[0][r] -= d; pq[1][r] -= d; }
                    }
                    first = false;
#pragma unroll
                    for (int r = 0; r < 16; ++r) lc += __builtin_amdgcn_exp2f(pp[r]);
                }
            }
        }
        {
            const float lt = lc + __shfl_xor(lc, 32);
            const float mcl = (mref > -1.0e29f && lt > 0.f) ? mref + __builtin_amdgcn_logf(lt) - 26.0f : 1.0e30f;
            int r32 = r32_, h = h_, lane_c = lane; asm volatile("" : "+v"(r32), "+v"(h), "+v"(lane_c));
            KF kf; VF vf; kf_load(kf, Kc, lane_c);
#pragma unroll 1
            for (int i = 0; i < ncb; ++i) {
                vf_load(vf, Vc + (size_t)i * 4096, lane_c);
                const bool far = i < icut;
                const float ci = far ? B31(r32) - mcl : -mcl;
                f32x16 pq[2] = {qk_frag(kf.k[0], qf, ci), qk_frag(kf.k[1], qf, ci)};
                kf_load(kf, Kc + (size_t)(i + 1 < ncb ? i + 1 : i) * 4096, lane_c);
#pragma unroll
                for (int kt = 0; kt < 2; ++kt) {
                    f32x16& pp = pq[kt];
                    if (!far) cmp_bias(pp, TOK(r32) - 31 - 16 * (i * 64 + 32 * kt + 4 * h), BT + (r32 & 3));
#pragma unroll
                    for (int r = 0; r < 16; ++r) pp[r] = __builtin_amdgcn_exp2f(pp[r]);
#pragma unroll
                    for (int a = 0; a < 4; ++a) {
                        const float s4 = quad_sum((pp[4 * a] + pp[4 * a + 1]) + (pp[4 * a + 2] + pp[4 * a + 3])), s1 = quad_sum(pp[4 * a + 3]);
                        const int j = i * 16 + kt * 8 + 2 * a + h;
                        if ((r32 & 3) == 0) { LAS int* ip = (LAS int*)IMP + (8 * w + (r32 >> 2)) * IMP_P + j; lds_add_i32(ip, (int)s4); lds_add_i32(ip + 1, (int)s1); }
                    }
                    pv_frag(oc, vf.v[kt], pp);
                }
            }
            asm volatile("s_waitcnt vmcnt(0)" ::: "memory");
        }
        const float g0 = gate0 * 1.4901161193847656e-08f;
        OACC_DECL()
#pragma unroll
        for (int q = 0; q < 4; ++q) { OACC[q] = (f32x4){oc[0][4 * q], oc[0][4 * q + 1], oc[0][4 * q + 2], oc[0][4 * q + 3]} * g0; OACC[4 + q] = (f32x4){oc[1][4 * q], oc[1][4 * q + 1], oc[1][4 * q + 2], oc[1][4 * q + 3]} * g0; }
        STAMP(1);
        {
            int lane_q = lane; asm volatile("" : "+v"(lane_q));
#pragma unroll
            for (int q = 0; q < 4; ++q) { const int row = 32 * w + 8 * q + (lane_q >> 3), c = (lane_q & 7) ^ (row & 7);
                __builtin_amdgcn_global_load_lds((const unsigned*)(Q + (size_t)(m0 + (row >> 2)) * 1024 + (g * NR + (row & 3)) * 64 + c * 8), (LAS unsigned*)(L + L_SQ + (32 * w + 8 * q) * 128), 16, 0, 0); }
        }
        {
            int lane_o = lane; asm volatile("" : "+v"(lane_o));
            const int tk = lane_o >> 3, sub = lane_o & 7; LAS unsigned* sm = SELM + (8 * w + tk) * 8;
            const int ncand = cur - 2, nf = cur + 1 < 3 ? cur + 1 : 3, need = 16 - nf;
            asm volatile("s_waitcnt lgkmcnt(0)" ::: "memory");
            if (sub == 0) { (void)__hip_atomic_fetch_or(sm, 1u, __ATOMIC_RELAXED, __HIP_MEMORY_SCOPE_WORKGROUP); (void)__hip_atomic_fetch_or(sm + (cur >> 5), 1u << (cur & 31), __ATOMIC_RELAXED, __HIP_MEMORY_SCOPE_WORKGROUP); if (cur >= 1) (void)__hip_atomic_fetch_or(sm + ((cur - 1) >> 5), 1u << ((cur - 1) & 31), __ATOMIC_RELAXED, __HIP_MEMORY_SCOPE_WORKGROUP); }
            if (ncand <= need) {
                if (sub == 0) for (int j = 1; j <= cur - 2; ++j) (void)__hip_atomic_fetch_or(sm + (j >> 5), 1u << (j & 31), __ATOMIC_RELAXED, __HIP_MEMORY_SCOPE_WORKGROUP);
            } else {
                const LAS int* ip = (const LAS int*)IMP + (8 * w + tk) * IMP_P;
                const int nen = ((cur - 2) >> 3) + 1;
                if (nen <= 8) topk_rounds<8>(ip, sm, sub, cur, need); else if (nen <= 16) topk_rounds<16>(ip, sm, sub, cur, need);
                else if (nen <= 24) topk_rounds<24>(ip, sm, sub, cur, need); else topk_rounds<32>(ip, sm, sub, cur, need);
            }
        }
        asm volatile("s_waitcnt vmcnt(0)" ::: "memory");
        __syncthreads();
        STAMP(2);
        {
            LAS int* SO = (LAS int*)(L + L_SO); LAS int* SM = (LAS int*)(L + L_SM); LAS int* SL = (LAS int*)(L + L_SL);
            LAS unsigned char* SQ = L + L_SQ; LAS unsigned* TL = (LAS unsigned*)(L + L_TL); LAS unsigned* TC = (LAS unsigned*)(L + L_TC); LAS unsigned char* TOKB = L + L_TOK;
            auto build = [&]() __attribute__((always_inline)) {
                int tid_o = tid; asm volatile("" : "+v"(tid_o));
                const int ln = tid_o & 63;
                const unsigned word = SELM[ln * 8 + w];
                unsigned long long tm = 0ull;
#pragma unroll
                for (int bt = 0; bt < 32; ++bt) { const unsigned long long mk = __ballot((word >> bt) & 1u); tm = ln == bt ? mk : tm; }
                const int jb = 32 * w + ln;
                const int cnt = (ln < 32 && jb != 0 && jb != cur && jb != cur - 1) ? __popcll(tm) : 0, nt = (cnt + 31) >> 5;
                int sc = nt;
#pragma unroll
                for (int o = 1; o < 32; o <<= 1) { const int v = __shfl_up(sc, o); if (ln >= o) sc += v; }
                if (ln == 31) TC[4 + w] = (unsigned)sc;
                if (tid_o < 256) SM[tid_o] = f2ord(NEGB);
                __syncthreads();
                if (nt > 0) {
                    const int j = 32 * w + ln;
                    int pos = sc - nt; for (int ww = 0; ww < w; ++ww) pos += (int)TC[4 + ww];
                    LAS unsigned char* tb = TOKB + pos * 32;
                    if (tm == ~0ull) {
                        unsigned pat = 0x03020100u; asm volatile("" : "+v"(pat));
#pragma unroll 1
                        for (int q = 0; q < 16; ++q) { ((LAS unsigned*)tb)[q] = pat; pat += 0x04040404u; }
                        TL[pos] = (unsigned)j | (32u << 8); TL[pos + 1] = (unsigned)j | (32u << 8);
                    } else {
                        unsigned long long rem = tm; int c = 0;
                        for (; rem != 0ull; ++c) { const int t = __ffsll((long long)rem) - 1; rem &= rem - 1ull; tb[c] = (unsigned char)t; }
                        for (; (c & 7) != 0; ++c) tb[c] = (unsigned char)0xff;
                        for (int k = 0; k < nt; ++k) TL[pos + k] = (unsigned)j | ((unsigned)(cnt - 32 * k < 32 ? cnt - 32 * k : 32) << 8);
                    }
                }
                __syncthreads();
            };
            STAMP(5);
            int ntl = 0, nmine = 0;
            const float vmax = __uint_as_float(((const unsigned*)(F.ws + WS_CTL))[CW_VMAX + pl]);
            const float kexp = fminf(20.f, floorf(19.f - __builtin_amdgcn_logf(fmaxf(vmax, 1.0e-30f))));
            const bf16* Kg = KS + (size_t)pl * SEQ * 64; const bf16* Vg = VST + (size_t)pl * 64 * SEQ;
#define SEL_DESC(k_) ({ int kk_ = (k_) < nmine ? (k_) : nmine - 1; kk_ = kk_ < 0 ? 0 : kk_; (unsigned)__builtin_amdgcn_readfirstlane(TL[w + 8 * kk_]); })
#define SEL_COLS(tb_, grp_) int r32 = r32_, h = h_; asm volatile("" : "+v"(r32), "+v"(h)); \
                    const unsigned tokb = (tb_)[8 * (grp_) + (r32 >> 2)]; \
                    const bool valid = tokb != 0xffu; const int tokl = valid ? (int)tokb : 0, row = tokl * 4 + (r32 & 3); \
                    s16x8 qg[4]; const unsigned qa = (unsigned)(uintptr_t)(SQ + row * 128) + (unsigned)((h ^ (row & 7)) << 4);     \
                    _Pragma("unroll") for (int s = 0; s < 4; ++s) qg[s] = *(const LAS s16x8*)(uintptr_t)(qa ^ (unsigned)(32 * s));
            const float kexpT = kexp - 2.0f;
            f32x4 pc[8]; f32x16 wo[2];
            LAS float* SMF = (LAS float*)(L + L_SMF);
#pragma unroll 1
            for (int attempt = 0; attempt < 2; ++attempt) {
                int lane_ = lane; asm volatile("" : "+v"(lane_));
#define lane lane_
                if (attempt == 1) {
                {
                    KF ka, kb, kc; unsigned da = SEL_DESC(0), db = SEL_DESC(1), dc = 0u;
                    kf_load(ka, Kg + (size_t)(da & 255u) * 4096, lane); kf_load(kb, Kg + (size_t)(db & 255u) * 4096, lane);
                    auto step = [&](int k, KF& kcur, const unsigned dcur, KF& kpre, unsigned& dpre) __attribute__((always_inline)) {
                        dpre = SEL_DESC(k + 2);
                        kf_load(kpre, Kg + (size_t)(dpre & 255u) * 4096, lane);
                        const int j = (int)(dcur & 255u), ngrp = (int)((dcur >> 8) + 7u) >> 3; const bool near = j >= cur - 2;
                        const LAS unsigned char* tb = TOKB + (w + 8 * k) * 32;
#pragma unroll 1
                        for (int grp = 0; grp < ngrp; ++grp) {
                            SEL_COLS(tb, grp)
                            f32x16 p0 = qk_frag(kcur.k[0], qg, 0.f), p1 = qk_frag(kcur.k[1], qg, 0.f);
                            if (near) { bias_tile(p0, NBT, j * 64 + 4 * h, t0 + tokl, r32 & 3); bias_tile(p1, NBT, j * 64 + 32 + 4 * h, t0 + tokl, r32 & 3); }
                            float mx = max3f(p0[0], p1[0], NEGB);
#pragma unroll
                            for (int r = 1; r < 16; ++r) mx = max3f(mx, p0[r], p1[r]);
                            if (!near) mx += B31(r32);
                            { auto rr2 = __builtin_amdgcn_permlane32_swap(__float_as_uint(mx), __float_as_uint(mx), false, false); mx = max3f(__uint_as_float(rr2[0]), __uint_as_float(rr2[1]), NEGB); }
                            if (valid && h == 0) lds_max_i32(SM + row, f2ord(mx));
                        }
                    };
#pragma unroll 1
                    for (int k = 0; k < nmine; k += 3) {
                        step(k, ka, da, kc, dc);
                        if (k + 1 >= nmine) break;
                        step(k + 1, kb, db, ka, da);
                        if (k + 2 >= nmine) break;
                        step(k + 2, kc, dc, kb, db);
                    }
                    asm volatile("s_waitcnt vmcnt(0) lgkmcnt(0)" ::: "memory");
                }

                    __syncthreads();
                }
                {
                    LOAD_QF()
                    int r32 = r32_, h = h_; asm volatile("" : "+v"(r32), "+v"(h));
                    const int nfb = cur >= 2 ? 3 : cur + 1;
                    float mref = 0.f; bool seen = false; f32x16 ow[2]; float lso = 0.f;
#pragma unroll
                    for (int r = 0; r < 16; ++r) { ow[0][r] = 0.f; ow[1][r] = 0.f; }
                    KF ka, kb; VF vf;
                    kf_load(ka, Kg, lane);
                    auto fstep = [&](int i, KF& kcur, KF& knext) __attribute__((always_inline)) {
                        const int j = i == 0 ? 0 : cur - (nfb - 1 - i), jn = (i + 1 < nfb) ? cur - (nfb - 2 - i) : j;
                        vf_load(vf, Vg + (size_t)j * 4096, lane); kf_load(knext, Kg + (size_t)jn * 4096, lane);
                        const bool nearb = j >= cur - 2;
#pragma unroll
                        for (int kt = 0; kt < 2; ++kt) {
                            f32x16 pp = qk_frag(kcur.k[kt], qf, (nearb ? 0.f : B31(r32)) - mref);
                            if (nearb) bias_tile(pp, NBT, j * 64 + 32 * kt + 4 * h, TOK(r32), r32 & 3);
                            float tmax = max3f(pp[0], pp[1], pp[2]);
#pragma unroll
                            for (int r = 3; r < 15; r += 2) tmax = max3f(tmax, pp[r], pp[r + 1]);
                            tmax = fmaxf(tmax, pp[15]); tmax = xhalf_max(tmax);
                            const bool ok = tmax > -1.0e29f;
                            const float d = seen ? fmaxf(tmax, 0.f) : (ok ? tmax : 0.f);
                            if (__any(d != 0.f)) {
                                const float al = seen ? __builtin_amdgcn_exp2f(-d) : 1.0f; mref += d; lso *= al;
#pragma unroll
                                for (int r = 0; r < 16; ++r) { ow[0][r] *= al; ow[1][r] *= al; pp[r] -= d; }
                            }
                            seen = seen || ok;
#pragma unroll
                            for (int r = 0; r < 16; ++r) pp[r] = __builtin_amdgcn_exp2f(pp[r]);
                            float la = 0.f;
#pragma unroll
                            for (int r = 0; r < 16; ++r) la += pp[r];
                            lso += la;
                            pv_frag(ow, vf.v[kt], pp);
                        }
                    };
                    fstep(0, ka, kb);
                    if (nfb > 1) fstep(1, kb, ka);
                    if (nfb > 2) fstep(2, ka, kb);
                    const float lto = lso + __shfl_xor(lso, 32);
                    const int row = (8 * w + (r32 >> 2)) * 4 + (r32 & 3);
                    const float refr = attempt == 0 ? mref + 4.0f : fmaxf(ord2f(SM[row]), mref);
                    const float fac = __builtin_amdgcn_exp2f(mref - refr + kexpT);
                    LAS int* op = SO + row * SO_P + 4 * h;
#pragma unroll
                    for (int dt = 0; dt < 2; ++dt)
#pragma unroll
                        for (int a = 0; a < 4; ++a) {
                            const int l0 = (int)(ow[dt][4 * a] * fac), h0 = (int)(ow[dt][4 * a + 1] * fac), l1 = (int)(ow[dt][4 * a + 2] * fac), h1 = (int)(ow[dt][4 * a + 3] * fac);
                            *(LAS v4u*)(op + 32 * dt + 8 * a) = (v4u){(unsigned)l0, (unsigned)(h0 + (l0 >> 31)), (unsigned)l1, (unsigned)(h1 + (l1 >> 31))};
                        }
                    if (h == 0) { SL[row] = (int)(lto * fac); SMF[row] = refr; }
                    if (tid == 0) TC[3] = 0u;
                }
                if (attempt == 0) { build(); ntl = (int)(TC[4] + TC[5] + TC[6] + TC[7] + TC[8] + TC[9] + TC[10] + TC[11]); nmine = (ntl - w + 7) >> 3; }
                else __syncthreads();
                {
                    unsigned one2 = 0x3f803f80u; asm volatile("" : "+v"(one2));
                    const s16x8 ones = __builtin_bit_cast(s16x8, (v4u){one2, one2, one2, one2});
                    FB fa, fb, fc; unsigned dcur = SEL_DESC(0);
                    fb_load(fa, Kg + (size_t)(dcur & 255u) * 4096, lane); fb_load(fb, Vg + (size_t)(dcur & 255u) * 4096, lane);
                    asm volatile("" ::: "memory");
                    auto step = [&](int k, FB& kx, FB& vy, FB& fz) __attribute__((always_inline)) {
                        const unsigned dn = SEL_DESC(k + 1);
                        fb_load(fz, Kg + (size_t)(dn & 255u) * 4096, lane);
                        asm volatile("" ::: "memory");
                        const int j = (int)(dcur & 255u), ngrp = (int)((dcur >> 8) + 7u) >> 3; const bool near = j >= cur - 2;
                        const LAS unsigned char* tb = TOKB + (w + 8 * k) * 32;
                        auto body = [&](auto lastc, int grp) __attribute__((always_inline)) {
                            SEL_COLS(tb, grp)
                            const float mrow = SMF[row] - kexpT;
                            const float ci = valid ? (near ? -mrow : B31(r32) - mrow) : NEGB;
                            f32x16 p0 = qk_fb<0>(kx, qg, ci), p1 = qk_fb<1>(kx, qg, ci);
                            if constexpr (decltype(lastc)::value) { fb_load(kx, Vg + (size_t)(dn & 255u) * 4096, lane); asm volatile("" ::: "memory"); }
                            if (near) { bias_tile(p0, NBT, j * 64 + 4 * h, t0 + tokl, r32 & 3); bias_tile(p1, NBT, j * 64 + 32 + 4 * h, t0 + tokl, r32 & 3); }
                            if (attempt == 0) {
                                float tmax = max3f(p0[0], p1[0], p0[1]);
#pragma unroll
                                for (int r = 1; r < 15; ++r) tmax = max3f(tmax, p1[r], p0[r + 1]);
                                tmax = fmaxf(tmax, p1[15]);
                                if (__any(tmax > kexpT + 2.0f)) { if (lane == 0) TC[3] = 1u; }
                            }
#pragma unroll
                            for (int r = 0; r < 16; ++r) { p0[r] = __builtin_amdgcn_exp2f(p0[r]); p1[r] = __builtin_amdgcn_exp2f(p1[r]); }
                            float ls = 0.f;
#pragma unroll
                            for (int r = 0; r < 16; ++r) ls += p0[r] + p1[r];
                            f32x16 o[2];
#pragma unroll
                            for (int r = 0; r < 16; ++r) { o[0][r] = 0.f; o[1][r] = 0.f; }
                            pv_fb<0>(o, vy, p0); pv_fb<1>(o, vy, p1);
                            if (valid) {
                                LAS int* op = SO + row * SO_P + 4 * h;
                                lds_add_i32(SL + row, (int)ls);
#define SEL_ADD4(dt_, a_) lds_add_2i32_off<(32 * dt_ + 8 * a_) * 4>(op, (int)o[dt_][4 * a_], (int)o[dt_][4 * a_ + 1]); lds_add_2i32_off<(32 * dt_ + 8 * a_ + 2) * 4>(op, (int)o[dt_][4 * a_ + 2], (int)o[dt_][4 * a_ + 3]);
                                SEL_ADD4(0, 0) SEL_ADD4(0, 1) SEL_ADD4(0, 2) SEL_ADD4(0, 3) SEL_ADD4(1, 0) SEL_ADD4(1, 1) SEL_ADD4(1, 2) SEL_ADD4(1, 3)
#undef SEL_ADD4
                            }
                        };
#pragma unroll 1
                        for (int grp = 0; grp < ngrp - 1; ++grp) body(BoolC<false>{}, grp);
                        body(BoolC<true>{}, ngrp - 1);
                        dcur = dn;
                    };
#pragma unroll 1
                    for (int k = 0; k < nmine; k += 3) {
                        step(k, fa, fb, fc);
                        if (k + 1 >= nmine) break;
                        step(k + 1, fc, fa, fb);
                        if (k + 2 >= nmine) break;
                        step(k + 2, fb, fc, fa);
                    }
                    asm volatile("s_waitcnt vmcnt(0) lgkmcnt(0)" ::: "memory");
                }

                {
                const int jb0 = cur >= 8 ? cur - 8 : 0, nwb = cur - jb0 + 1;
                const bf16* Kwg = KW + (size_t)pl * SEQ * 64; const bf16* Vwg = VWT + (size_t)pl * 64 * SEQ;
                float mref = 0.f; bool seen = false; f32x16 ow[2]; float lsw = 0.f;
                LOAD_QF()
#pragma unroll
                for (int r = 0; r < 16; ++r) { ow[0][r] = 0.f; ow[1][r] = 0.f; }
                const float gate2 = GATE_LOAD(2);
                int r32 = r32_, h = h_, lane_w = lane; asm volatile("" : "+v"(r32), "+v"(h), "+v"(lane_w));
                KF kf; VF va, vb;
                kf_load(kf, Kwg + (size_t)jb0 * 4096, lane_w); vf_load(va, Vwg + (size_t)jb0 * 4096, lane_w);
                asm volatile("" ::: "memory");
                auto wstep = [&](int i, VF& vcur, VF& vnext) __attribute__((always_inline)) {
                    const int j = jb0 + i, jn = j < cur ? j + 1 : cur;
                    vf_load(vnext, Vwg + (size_t)jn * 4096, lane_w);
                    asm volatile("" ::: "memory");
                    const bool far = j <= cur - 3 && j >= cur - 7, nearb = j >= cur - 2;
                    const float ci = (nearb ? 0.f : B31(r32)) - mref;
                    f32x16 pq[2] = {qk_frag(kf.k[0], qf, ci), qk_frag(kf.k[1], qf, ci)};
                    kf_load(kf, Kwg + (size_t)jn * 4096, lane_w);
#pragma unroll
                    for (int kt = 0; kt < 2; ++kt) {
                        f32x16& pp = pq[kt];
                        if (nearb) bias_tile(pp, NBT, j * 64 + 32 * kt + 4 * h, TOK(r32), r32 & 3);
                        else if (!far) {
                            const int klo = TOK(r32) - 512 - (j * 64 + 32 * kt + 4 * h);
#pragma unroll
                            for (int r = 0; r < 16; ++r) pp[r] = krow(r) > klo ? pp[r] : NEGB;
                        }
                        float tmax = max3f(pp[0], pp[1], pp[2]);
#pragma unroll
                        for (int r = 3; r < 15; r += 2) tmax = max3f(tmax, pp[r], pp[r + 1]);
                        tmax = fmaxf(tmax, pp[15]); tmax = xhalf_max(tmax);
                        const bool ok = tmax > -1.0e29f;
                        const float d = seen ? fmaxf(tmax, 0.f) : (ok ? tmax : 0.f);
                        if (__any(d != 0.f)) {
                            const float al = seen ? __builtin_amdgcn_exp2f(-d) : 1.0f; mref += d; lsw *= al;
#pragma unroll
                            for (int r = 0; r < 16; ++r) { ow[0][r] *= al; ow[1][r] *= al; pq[0][r] -= d; pq[1][r] -= d; }
                        }
                        seen = seen || ok;
#pragma unroll
                        for (int r = 0; r < 16; ++r) pp[r] = __builtin_amdgcn_exp2f(pp[r]);
                        float la = 0.f;
#pragma unroll
                        for (int r = 0; r < 16; ++r) la += pp[r];
                        lsw += la;
                        pv_frag(ow, vcur.v[kt], pp);
                    }
                };
#pragma unroll 1
                for (int i = 0; i < nwb; i += 2) { wstep(i, va, vb); if (i + 1 >= nwb) break; wstep(i + 1, vb, va); }
                asm volatile("s_waitcnt vmcnt(0)" ::: "memory");
                const float g2 = gate2, lt = lsw + __shfl_xor(lsw, 32), sc = lt > 0.f ? g2 / lt : 0.f;
#pragma unroll
                for (int r = 0; r < 16; ++r) { ow[0][r] *= sc; ow[1][r] *= sc; }
#pragma unroll
                    for (int r = 0; r < 16; ++r) { wo[0][r] = ow[0][r]; wo[1][r] = ow[1][r]; }
                }

{ OACC_DECL()
#pragma unroll
                for (int q = 0; q < 8; ++q) pc[q] = OACC[q];
                }
                __syncthreads();
                if (attempt == 1 || TC[3] == 0u) break;
#undef lane
            }
#undef SEL_DESC
#undef SEL_COLS
            STAMP(7);
            {
                int r32 = r32_, h = h_; asm volatile("" : "+v"(r32), "+v"(h));
                const int row = (8 * w + (r32 >> 2)) * 4 + (r32 & 3);
                const float g1 = GATE_LOAD(1), lt = (float)SL[row], sc = lt > 0.f ? g1 / lt : 0.f;
                const LAS int* op = SO + row * SO_P + 4 * h;
#define SEL_RD4(off_) ({ const int l0 = op[off_], h0 = op[off_ + 1] - (l0 >> 31), l1 = op[off_ + 2], h1 = op[off_ + 3] - (l1 >> 31); (f32x4){(float)l0, (float)h0, (float)l1, (float)h1} * sc; })
                f32x4 cs[8];
#pragma unroll
                for (int q = 0; q < 4; ++q) { cs[q] = SEL_RD4(8 * q) + pc[q]; cs[4 + q] = SEL_RD4(32 + 8 * q) + pc[4 + q]; }
#undef SEL_RD4
#pragma unroll
                for (int q = 0; q < 4; ++q)
#pragma unroll
                    for (int j = 0; j < 4; ++j) { wo[0][4 * q + j] += cs[q][j]; wo[1][4 * q + j] += cs[4 + q][j]; }
                bf16* og = ONSA + (size_t)MROW(r32) * 1024 + HEADG(r32) * 64 + 4 * h;
#pragma unroll
                for (int dt = 0; dt < 2; ++dt)
#pragma unroll
                    for (int a = 0; a < 4; ++a) { v2u wv; wv.x = cvtpk(wo[dt][4 * a], wo[dt][4 * a + 1]); wv.y = cvtpk(wo[dt][4 * a + 2], wo[dt][4 * a + 3]); *(v2u*)(og + 32 * dt + 8 * a) = wv; }
                asm volatile("s_waitcnt lgkmcnt(0)" ::: "memory");
            }
        }
        STAMP(3);
        STAMP(4);
    }
#ifdef PROBE_SPIN_SEC
    { const unsigned long long t1_ = wall_clock64(); while (wall_clock64() - t1_ < tacc[PROBE_SPIN_SEC]) __builtin_amdgcn_s_sleep(8); }
#endif
#undef STAMP
#undef TOK
#undef MROW
#undef HEADG
#undef B31
#undef OACC_DECL
#undef GATE_LOAD
#undef LOAD_QF
}

template <class Epi, class Map>
__device__ __forceinline__ void run_gemm(const Frame& F, const bf16* A, const bf16* Bt, int lda, int ldb, int K, int nM, int nN, const Map& map, const Epi& E, int Gs = 0, int c0 = 0) {
    pg8::Gemm g{A, Bt, lda, ldb, K}; pg8::Order<Map> S; S.init(nM, nN, Gs ? Gs : F.G, (int)blockIdx.x - c0, map);
    int tid = F.tid; asm volatile("" : "+v"(tid));
    pg8::gemm_phase<Epi, pg8::Order<Map>, true, true>(F.lds + RING_OFF, g, S, E, tid);
}
enum { PH_PRO, PH_P1, PH_R1, PH_R2, PH_R3, PH_G, PH_OUT, PH_RES, PH_FI, PH_KVQN, PH_KVQS, PH_CMP, PH_CMP2, PH_NSA, PH_COUNT };

template <int PH> __device__ __forceinline__ void phase_body(const Frame& F, int b) {
    unsigned char* ws = F.ws; float* rinv = (float*)(ws + WS_RINV); bf16* XB = (bf16*)(ws + WS_XB);
    if constexpr (PH == PH_PRO) phase_prologue(F);
    if constexpr (PH == PH_P1) {
        { EpiP1N E{rinv + b * SEQ, (const f32x4*)(ws + WS_TABA), (bf16*)(ws + WS_AP), (bf16*)(ws + WS_KN)};
          run_gemm(F, XB + (size_t)b * SEQ * DM, (const bf16*)(ws + W_RI), DM, DM, DM, SEQ / 256, 8, pg8::MapPlain{DM, DM}, E); }
        __syncthreads();
        { EpiP1S E{rinv + b * SEQ, (const f32x4*)(ws + WS_TABB), (bf16*)(ws + WS_KT), (bf16*)(ws + WS_BP)};
          run_gemm(F, (const bf16*)(ws + W_RI) + (size_t)1024 * DM, XB + (size_t)b * SEQ * DM, DM, DM, DM, 12, SEQ / 256, pg8::MapPlain{DM, DM}, E); }
    }
    if constexpr (PH == PH_R1) {
        { EpiKV E{(bf16*)(ws + WS_KV)};
          run_gemm(F, (const bf16*)(ws + WS_BP), (const bf16*)(ws + WS_KT), APLD, SEQ, RCH, RH * NCH * 2, 1, MapKV{}, E); }
        __syncthreads();
        { EpiS E{(bf16*)(ws + WS_AP)};
          run_gemm(F, (const bf16*)(ws + WS_AP), (const bf16*)(ws + WS_KN), APLD, 1024, RDK, RH * NCH * 2, 2, MapS{}, E); }
    }
    if constexpr (PH == PH_R2) { phase_ret_scan(F); if (b == 0) phase_small_tables(F); }
    if constexpr (PH == PH_R3) { EpiO E{(bf16*)F.out, (float*)(ws + WS_GSLOT), b};
        run_gemm(F, (const bf16*)(ws + WS_AP), (const bf16*)(ws + WS_BP), APLD, APLD, APLD, RH * NCH * 2, 2, MapO{}, E); }
    if constexpr (PH == PH_G) { EpiG E{rinv, (const float*)(ws + WS_GSLOT), (bf16*)F.out};
        run_gemm(F, XB, (const bf16*)(ws + W_RI) + (size_t)4096 * DM, DM, DM, DM, MTOK / 256, 8, pg8::MapPlain{DM, DM}, E); }
    if constexpr (PH == PH_OUT) {
        const bf16* A = b == 0 ? (const bf16*)F.out : b == 2 ? (const bf16*)(ws + WS_ONSA) : (const bf16*)(ws + WS_HID);
        const bf16* Bt = (const bf16*)(ws + (b == 0 ? W_RO : b == 1 ? W_FO0 : b == 2 ? W_NO : W_FO1));
        const int K = b == 0 ? 2048 : b == 2 ? DM : FFH;
        EpiOut E{(bf16*)(ws + WS_MIX), (float*)(ws + WS_OSLOT)};
        run_gemm(F, A, Bt, K, K, K, MTOK / 256, 4, pg8::MapPlain{K, K}, E); }
    if constexpr (PH == PH_RES) { const float* gpost = gp(b & 1 ? F.in[4] : F.in[2]) + (b >> 1) * DM;
        if (b == 0) phase_resid<true>(F, gp(F.in[0]), gpost, false); else phase_resid<false>(F, nullptr, gpost, b == 3); }
    if constexpr (PH == PH_FI) { EpiFfnIn E{rinv, (bf16*)(ws + WS_HID)};
        run_gemm(F, XB, (const bf16*)(ws + (b ? W_FI1 : W_FI0)), DM, DM, DM, MTOK / 256, 22, pg8::MapPlain{DM, DM}, E); }
    if constexpr (PH == PH_KVQN) { phase_peb_final(F);
        EpiKvqN E{rinv, (bf16*)(ws + WS_KC), (bf16*)(ws + WS_VC), (bf16*)(ws + WS_KS), (bf16*)(ws + WS_KW), (bf16*)(ws + WS_Q), (float*)(ws + WS_GATE)};
        run_gemm(F, XB, (const bf16*)(ws + W_KVQ), DM, DM, DM, MTOK / 256, 8, pg8::MapPlain{DM, DM}, E); }
    if constexpr (PH == PH_KVQS) {
        const int ncmp = F.G >= 128 ? F.G / 4 : 0;
        if (ncmp == 0 || (int)blockIdx.x < ncmp) { EpiCmp E{(const float*)(ws + WS_PEB), (bf16*)(ws + WS_HIDC)};
            run_gemm(F, (const bf16*)(ws + WS_KC), (const bf16*)(ws + W_C1), 1024, 2048, 2048, 64, 1, MapCmp{}, E, ncmp ? ncmp : F.G, 0); }
        if (ncmp == 0 || (int)blockIdx.x >= ncmp) {
            if (ncmp == 0) __syncthreads();
            { EpiKvqS E{rinv, (bf16*)(ws + WS_VST), (bf16*)(ws + WS_VWT), (unsigned*)(ws + WS_CTL) + CW_VMAX};
              run_gemm(F, (const bf16*)(ws + W_KVV), XB, DM, DM, DM, 2, MTOK / 256, pg8::MapPlain{DM, DM}, E, F.G - ncmp, ncmp); }
            __syncthreads();
            const int ng0 = (F.G - ncmp == 192) ? ncmp + 64 : ncmp, ngw = F.G - ng0;
            if ((int)blockIdx.x >= ng0) { EpiGate E{rinv, (float*)(ws + WS_GATE)};
              run_gemm(F, XB, (const bf16*)(ws + W_KVQ) + (size_t)2048 * DM, DM, DM, DM, MTOK / 256, 1, pg8::MapPlain{DM, DM}, E, ngw, ng0); }
        }
    }
    if constexpr (PH == PH_CMP2) phase_cmp2(F);
    if constexpr (PH == PH_NSA) phase_nsa(F);
}
__device__ __forceinline__ void make_frame(Frame& F, unsigned char* lds, const Args& args) {
    int tid = threadIdx.x; asm volatile("" : "+v"(tid));
    GAS unsigned char* wsg = (GAS unsigned char*)args.ws; GAS float* outg = (GAS float*)args.out; asm volatile("" : "+s"(wsg), "+s"(outg));
    F.lds = (LAS unsigned char*)lds; F.ws = (unsigned char*)wsg; F.out = (float*)outg; F.in = args.in;
    F.tid = tid; F.lane = tid & 63; F.wave = __builtin_amdgcn_readfirstlane(tid >> 6);
    F.G = gridDim.x; { const int bx = blockIdx.x; F.vcu = (F.G % 8 == 0) ? (bx % 8) * (F.G / 8) + bx / 8 : bx; }
    F.gw = F.vcu * NWAVES + F.wave; F.NGW = F.G * NWAVES;
}
__global__ void __launch_bounds__(NTHREADS, 2) fwd(Args args) {
    extern __shared__ __attribute__((aligned(16))) unsigned char lds[];
    {   LAS unsigned* ctl = (LAS unsigned*)((LAS unsigned char*)lds + LDSCTL_OFF);
        for (int u = threadIdx.x; u < (LDS_BYTES - LDSCTL_OFF) / 4; u += NTHREADS) ctl[u] = 0u; }
    __syncthreads();
    const int lo = args.ph, hi = args.b;
    XcdBarrier bar; bar.bar = (unsigned*)(args.ws + WS_CTL) + CW_BAR; bar.x = 0; bar.st = nullptr;
    if (hi - lo > 1) bar = xcd_barrier_post((unsigned*)(args.ws + WS_CTL) + CW_BAR, (volatile LAS unsigned*)((LAS unsigned char*)lds + MISC_OFF) + 8);
    int ph = 0;
#ifndef DBG_MASK
#define DBG_MASK 0xffffffffu
#endif
#ifdef PROBE_SPIN_PH
#define SPIN_T0() const unsigned long long t0_ = wall_clock64()
#define SPIN_T1(PH) do { if (PH == PROBE_SPIN_PH) { const unsigned long long t1_ = wall_clock64(); while (wall_clock64() - t1_ < t1_ - t0_) __builtin_amdgcn_s_sleep(8); } } while (0)
#else
#define SPIN_T0() do {} while (0)
#define SPIN_T1(PH) do {} while (0)
#endif
#define RUN(PH, bval) do { if (ph >= lo && ph < hi) { Frame F; make_frame(F, lds, args); SPIN_T0(); if constexpr ((DBG_MASK >> PH) & 1u) phase_body<PH>(F, (bval)); SPIN_T1(PH); if (ph + 1 < hi) xcd_barrier(bar); } ++ph; } while (0)
    RUN(PH_PRO, 0);
#pragma unroll 1
    for (int layer = 0; layer < 2; ++layer) {
#pragma unroll 1
        for (int sub = 0; sub < 2; ++sub) {
            if (sub == 0) {
                if (layer == 0) {
#pragma unroll 1
                    for (int b = 0; b < NBATCH; ++b) { RUN(PH_P1, b); RUN(PH_R1, b); RUN(PH_R2, b); RUN(PH_R3, b); }
                    RUN(PH_G, 0);
                } else { RUN(PH_KVQN, 0); RUN(PH_KVQS, 0); RUN(PH_CMP2, 0); RUN(PH_NSA, 0); }
            } else RUN(PH_FI, layer);
            RUN(PH_OUT, 2 * layer + sub);
            RUN(PH_RES, 2 * layer + sub);
        }
    }
#undef RUN
}
constexpr int NPHASES = 1 + (8 + 1 + 2) + 3 + (4 + 2) + 3;
#ifndef MK_N_LAUNCH
#define MK_N_LAUNCH 1
#endif
extern "C" void kernel_launch(void* const* d_in, const int* in_sizes, int n_in, void* d_out, int out_size, void* d_ws, size_t ws_size, hipStream_t stream) {
    static int grid = 0;
    if (grid == 0) {
        if (n_in != 20 || out_size != MTOK * DM || ws_size < WS_NEED) { fprintf(stderr, "kernel_launch: unexpected problem shape (n_in %d, out %d, ws %zu)\n", n_in, out_size, ws_size); grid = -1; return; }
        int dev = 0, cus = 0, per_cu = 0;
        if (hipGetDevice(&dev) != hipSuccess || hipDeviceGetAttribute(&cus, hipDeviceAttributeMultiprocessorCount, dev) != hipSuccess) { grid = -1; return; }
        if (hipFuncSetAttribute((const void*)fwd, hipFuncAttributeMaxDynamicSharedMemorySize, LDS_BYTES) != hipSuccess) { fprintf(stderr, "kernel_launch: hipFuncSetAttribute failed\n"); grid = -1; return; }
        if (hipOccupancyMaxActiveBlocksPerMultiprocessor(&per_cu, (const void*)fwd, NTHREADS, LDS_BYTES) != hipSuccess || per_cu < 1) { fprintf(stderr, "kernel_launch: occupancy query says %d blocks per CU\n", per_cu); }
        (void)hipGetLastError();
        grid = cus;
    }
    if (grid < 0) return;
    (void)hipMemsetAsync((char*)d_ws + WS_CTL, 0, CTL_ZERO_BYTES, stream);
    Args a{};
    for (int i = 0; i < 20; ++i) a.in[i] = (const float*)d_in[i];
    a.out = (float*)d_out; a.ws = (unsigned char*)d_ws;
    if (MK_N_LAUNCH == 1) { a.ph = 0; a.b = NPHASES; hipLaunchKernelGGL(fwd, dim3(grid), dim3(NTHREADS), LDS_BYTES, stream, a); }
    else for (int p = 0; p < NPHASES; ++p) { a.ph = p; a.b = p + 1; hipLaunchKernelGGL(fwd, dim3(grid), dim3(NTHREADS), LDS_BYTES, stream, a); }
}
```
